# Optimizing an MI355X kernel written in HIP

```python
import jax
import jax.numpy as jnp
from jax import lax
import numpy as np

D_MODEL = 4096
BATCH = 4
SEQ = 2048
DEPTH = 1
DEC_BATCH = 16
DEC_SEQ = 64
PAST_LEN = 2048

CHUNK = 64
N_META = 16
WINDOW = 128
WIN_CHUNKS = WINDOW // CHUNK
HEAD_DIM = 128
N_HEADS_SWA = (D_MODEL // 2) // HEAD_DIM
N_KV_SWA = N_HEADS_SWA // 4
GQA_GROUP = N_HEADS_SWA // N_KV_SWA
N_HEADS_GDN = (D_MODEL // 2) // HEAD_DIM
DK_GDN = 128
DV_GDN = 128
CONV_WIDTH = 4
D_SWA_Q = N_HEADS_SWA * HEAD_DIM
D_SWA_KV = N_KV_SWA * HEAD_DIM
D_GDN_QK = N_HEADS_GDN * DK_GDN
D_GDN_V = N_HEADS_GDN * DV_GDN
D_CONV = 2 * D_GDN_QK + D_GDN_V
D_MIX = D_SWA_Q + D_GDN_V
D_IN = D_SWA_Q + 2 * D_SWA_KV + D_CONV + D_GDN_V + 2 * N_HEADS_GDN
D_FF = ((8 * D_MODEL // 3 + 255) // 256) * 256
ROPE_THETA = 10000.0
LN_EPS = 1e-5
RMS_EPS = 1e-6
ALPHA = (2 * DEPTH) ** 0.25
BETA = (8 * DEPTH) ** -0.25

kernel_name = 'hymba_swa_gdn_macaron_stream_step'


def _layernorm(x, g, b):
    xf = x.astype(jnp.float32)
    mu = xf.mean(-1, keepdims=True)
    var = jnp.square(xf - mu).mean(-1, keepdims=True)
    return ((xf - mu) * lax.rsqrt(var + LN_EPS) * g.astype(jnp.float32) + b.astype(jnp.float32)).astype(x.dtype)


def _swiglu(x, w_gate, w_up, w_down):
    return (jax.nn.silu(x @ w_gate) * (x @ w_up)) @ w_down


def _split_in(h):
    sizes = [D_SWA_Q, D_SWA_KV, D_SWA_KV, D_CONV, D_GDN_V, N_HEADS_GDN, N_HEADS_GDN]
    offs = [int(o) for o in np.cumsum(sizes)[:-1]]
    return jnp.split(h, offs, axis=-1)


def _rope(x, pos):
    half = HEAD_DIM // 2
    inv = ROPE_THETA ** (-jnp.arange(half, dtype=jnp.float32) / half)
    ang = pos.astype(jnp.float32)[:, None] * inv[None, :]
    cos = jnp.cos(ang)[None, :, None, :]
    sin = jnp.sin(ang)[None, :, None, :]
    xf = x.astype(jnp.float32)
    x1, x2 = xf[..., :half], xf[..., half:]
    return jnp.concatenate([x1 * cos - x2 * sin, x2 * cos + x1 * sin], -1).astype(x.dtype)


def _attend(q, k, v, mask, sinks):
    s = jnp.einsum('bnqhgd,bnshd->bnhgqs', q, k, preferred_element_type=jnp.float32) * (HEAD_DIM ** -0.5)
    s = jnp.where(mask, s, -jnp.inf)
    sk = jnp.broadcast_to(sinks.astype(jnp.float32).reshape(N_KV_SWA, GQA_GROUP, 1, 1), s.shape[:-1] + (1,))
    p = jax.nn.softmax(jnp.concatenate([s, sk], -1), axis=-1)[..., :-1]
    return jnp.einsum('bnhgqs,bnshd->bnqhgd', p.astype(v.dtype), v)


def _swa_prompt(q, k, v, sinks):
    B, T = q.shape[:2]
    S = T - N_META
    NC = S // CHUNK
    qm, qf = q[:, :N_META], q[:, N_META:]
    km, kf = k[:, :N_META], k[:, N_META:]
    vm, vf = v[:, :N_META], v[:, N_META:]
    om = _attend(qm.reshape(B, 1, N_META, N_KV_SWA, GQA_GROUP, HEAD_DIM), km[:, None], vm[:, None], True, sinks)
    om = om.reshape(B, N_META, D_SWA_Q)

    def band(t):
        tp = jnp.pad(t, ((0, 0), (WIN_CHUNKS * CHUNK, 0), (0, 0), (0, 0)))
        tp = tp.reshape(B, NC + WIN_CHUNKS, CHUNK, N_KV_SWA, HEAD_DIM)
        return jnp.concatenate([tp[:, j:j + NC] for j in range(WIN_CHUNKS + 1)], axis=2)

    kb = jnp.concatenate([jnp.broadcast_to(km[:, None], (B, NC, N_META, N_KV_SWA, HEAD_DIM)), band(kf)], 2)
    vb = jnp.concatenate([jnp.broadcast_to(vm[:, None], (B, NC, N_META, N_KV_SWA, HEAD_DIM)), band(vf)], 2)
    nb = (WIN_CHUNKS + 1) * CHUNK
    valid = (jnp.arange(NC)[:, None] + jnp.arange(nb)[None, :] // CHUNK - WIN_CHUNKS) >= 0
    mask = jnp.concatenate([jnp.ones((NC, N_META), bool), valid], 1)[None, :, None, None, None, :]
    of = _attend(qf.reshape(B, NC, CHUNK, N_KV_SWA, GQA_GROUP, HEAD_DIM), kb, vb, mask, sinks)
    return jnp.concatenate([om, of.reshape(B, S, D_SWA_Q)], 1)


def _l2norm(x):
    return x * lax.rsqrt(jnp.sum(x * x, -1, keepdims=True) + RMS_EPS)


def _gdn_chunked(q, k, v, g, beta, s0, chunk):
    B, T, H, _ = q.shape
    N = T // chunk

    def blk(t):
        return jnp.moveaxis(t.reshape((B, N, chunk) + t.shape[2:]), 3, 1)

    qc, kc, vc, bc = blk(q), blk(k), blk(v), blk(beta)
    gc = jnp.cumsum(blk(g), axis=-1)
    idx = jnp.arange(chunk)
    incl = idx[:, None] >= idx[None, :]
    strict = idx[:, None] > idx[None, :]
    decay = jnp.exp(jnp.where(incl, gc[..., :, None] - gc[..., None, :], -jnp.inf))
    kb = kc * bc[..., None]
    a = jnp.where(strict, jnp.einsum('bhnid,bhnjd->bhnij', kb, kc) * decay, 0.0)
    eye = jnp.broadcast_to(jnp.eye(chunk, dtype=jnp.float32), a.shape)
    rhs = jnp.concatenate([vc * bc[..., None], kb * jnp.exp(gc)[..., None]], -1)
    sol = lax.linalg.triangular_solve(eye + a, rhs, left_side=True, lower=True, unit_diagonal=True)
    u, w = sol[..., :DV_GDN], sol[..., DV_GDN:]
    qk = jnp.einsum('bhnid,bhnjd->bhnij', qc, kc) * decay
    q_dec = qc * jnp.exp(gc)[..., None]
    k_dec = kc * jnp.exp(gc[..., -1:] - gc)[..., None]
    g_last = jnp.exp(gc[..., -1])
    xs = tuple(jnp.moveaxis(t, 2, 0) for t in (u, w, qk, q_dec, k_dec, g_last))

    def step(s, inp):
        u_n, w_n, qk_n, qd_n, kd_n, gl_n = inp
        v_new = u_n - jnp.einsum('bhcd,bhde->bhce', w_n, s)
        o_n = jnp.einsum('bhcd,bhde->bhce', qd_n, s) + jnp.einsum('bhij,bhje->bhie', qk_n, v_new)
        s = s * gl_n[..., None, None] + jnp.einsum('bhcd,bhce->bhde', kd_n, v_new)
        return s, o_n

    s_final, o = lax.scan(step, s0, xs)
    o = jnp.moveaxis(jnp.moveaxis(o, 0, 2), 1, 3).reshape(B, T, H, DV_GDN)
    return o, s_final


def _gdn_mix(conv_in, z, b_lin, a_lin, conv_buf, s0, conv_w, a_log, dt_bias, norm_w, n_pad, chunk):
    B, T, _ = conv_in.shape
    xcat = jnp.concatenate([conv_buf.astype(conv_in.dtype), conv_in], 1)
    y = sum(xcat[:, j:j + T] * conv_w[j] for j in range(CONV_WIDTH))
    y = jax.nn.silu(y.astype(jnp.float32))
    q, k, v = jnp.split(y, [D_GDN_QK, 2 * D_GDN_QK], axis=-1)
    q = _l2norm(q.reshape(B, T, N_HEADS_GDN, DK_GDN)) * (DK_GDN ** -0.5)
    k = _l2norm(k.reshape(B, T, N_HEADS_GDN, DK_GDN))
    v = v.reshape(B, T, N_HEADS_GDN, DV_GDN)
    beta = jax.nn.sigmoid(b_lin.astype(jnp.float32))
    g = -jnp.exp(a_log.astype(jnp.float32)) * jax.nn.softplus(a_lin.astype(jnp.float32) + dt_bias.astype(jnp.float32))
    if n_pad > 0:
        pad4 = ((0, 0), (n_pad, 0), (0, 0), (0, 0))
        pad3 = ((0, 0), (n_pad, 0), (0, 0))
        q, k, v = jnp.pad(q, pad4), jnp.pad(k, pad4), jnp.pad(v, pad4)
        g, beta = jnp.pad(g, pad3), jnp.pad(beta, pad3)
    o, s = _gdn_chunked(q, k, v, g, beta, s0, chunk)
    o = o[:, n_pad:]
    o = o * lax.rsqrt(jnp.mean(o * o, -1, keepdims=True) + RMS_EPS) * norm_w.astype(jnp.float32)
    o = o * jax.nn.silu(z.astype(jnp.float32).reshape(B, T, N_HEADS_GDN, DV_GDN))
    return o.reshape(B, T, D_GDN_V).astype(conv_in.dtype), xcat[:, -(CONV_WIDTH - 1):], s


def _mix_prompt(h, pos, sinks, conv_w, a_log, dt_bias, norm_w):
    B, T, _ = h.shape
    q, k, v, conv_in, z, b_lin, a_lin = _split_in(h)
    q = _rope(q.reshape(B, T, N_HEADS_SWA, HEAD_DIM), pos)
    k = _rope(k.reshape(B, T, N_KV_SWA, HEAD_DIM), pos)
    v = v.reshape(B, T, N_KV_SWA, HEAD_DIM)
    o_swa = _swa_prompt(q, k, v, sinks)
    buf0 = jnp.zeros((B, CONV_WIDTH - 1, D_CONV), h.dtype)
    s0 = jnp.zeros((B, N_HEADS_GDN, DK_GDN, DV_GDN), jnp.float32)
    o_gdn, buf, s = _gdn_mix(conv_in, z, b_lin, a_lin, buf0, s0, conv_w, a_log, dt_bias, norm_w,
                             CHUNK - N_META, CHUNK)
    mixed = jnp.concatenate([o_swa, o_gdn], -1)
    return mixed, (k[:, :N_META], v[:, :N_META], k[:, T - WINDOW:], v[:, T - WINDOW:], buf, s.astype(h.dtype))


def _mix_sample(h, pos, meta_k, meta_v, win_k, win_v, conv_buf, s_prev, sinks, conv_w, a_log, dt_bias, norm_w):
    B, T, _ = h.shape
    q, k, v, conv_in, z, b_lin, a_lin = _split_in(h)
    q = _rope(q.reshape(B, T, N_HEADS_SWA, HEAD_DIM), pos)
    k = _rope(k.reshape(B, T, N_KV_SWA, HEAD_DIM), pos)
    v = v.reshape(B, T, N_KV_SWA, HEAD_DIM)
    k_all = jnp.concatenate([meta_k.astype(k.dtype), win_k.astype(k.dtype), k], 1)[:, None]
    v_all = jnp.concatenate([meta_v.astype(v.dtype), win_v.astype(v.dtype), v], 1)[:, None]
    o_swa = _attend(q.reshape(B, 1, T, N_KV_SWA, GQA_GROUP, HEAD_DIM), k_all, v_all, True, sinks)
    o_swa = o_swa.reshape(B, T, D_SWA_Q)
    o_gdn, buf, s = _gdn_mix(conv_in, z, b_lin, a_lin, conv_buf, s_prev.astype(jnp.float32), conv_w, a_log,
                             dt_bias, norm_w, 0, T)
    mixed = jnp.concatenate([o_swa, o_gdn], -1)
    return mixed, (k, v, buf, s.astype(s_prev.dtype))


def _layer(x, ln_g, ln_b, w_gate, w_up, w_down, w_in, w_out, mixer):
    x = _layernorm(ALPHA * x + 0.5 * _swiglu(x, w_gate[0], w_up[0], w_down[0]), ln_g[0], ln_b[0])
    mixed, states = mixer(x @ w_in)
    x = _layernorm(ALPHA * x + mixed @ w_out, ln_g[1], ln_b[1])
    x = _layernorm(ALPHA * x + 0.5 * _swiglu(x, w_gate[1], w_up[1], w_down[1]), ln_g[2], ln_b[2])
    return x, states


def setup_inputs(seed: int = 0) -> dict:
    key = jax.random.key(seed)
    ks = jax.random.split(key, 24)
    f32 = jnp.float32

    def nrm(k, shape, scale):
        return jax.random.normal(k, shape, f32) * scale

    win = min(WINDOW, PAST_LEN)
    dt = jnp.exp(jax.random.uniform(ks[20], (DEPTH, N_HEADS_GDN), f32, float(np.log(1e-3)), float(np.log(1e-1))))
    return {
        'x_prompt': nrm(ks[0], (BATCH, SEQ, D_MODEL), 1.0),
        'x_sample': nrm(ks[1], (DEC_BATCH, DEC_SEQ, D_MODEL), 1.0),
        'cache_meta_k': nrm(ks[2], (DEPTH, DEC_BATCH, N_META, N_KV_SWA, HEAD_DIM), 1.0),
        'cache_meta_v': nrm(ks[3], (DEPTH, DEC_BATCH, N_META, N_KV_SWA, HEAD_DIM), 1.0),
        'cache_win_k': nrm(ks[4], (DEPTH, DEC_BATCH, win, N_KV_SWA, HEAD_DIM), 1.0),
        'cache_win_v': nrm(ks[5], (DEPTH, DEC_BATCH, win, N_KV_SWA, HEAD_DIM), 1.0),
        'state_conv': nrm(ks[6], (DEPTH, DEC_BATCH, CONV_WIDTH - 1, D_CONV), 1.0),
        'state_gdn': nrm(ks[7], (DEPTH, DEC_BATCH, N_HEADS_GDN, DK_GDN, DV_GDN), 0.5),
        'meta_tokens': nrm(ks[8], (N_META, D_MODEL), 1.0),
        'ln_g': 1.0 + nrm(ks[9], (DEPTH, 3, D_MODEL), 0.02),
        'ln_b': nrm(ks[10], (DEPTH, 3, D_MODEL), 0.02),
        'ffn_w_gate': nrm(ks[11], (DEPTH, 2, D_MODEL, D_FF), D_MODEL ** -0.5),
        'ffn_w_up': nrm(ks[12], (DEPTH, 2, D_MODEL, D_FF), D_MODEL ** -0.5),
        'ffn_w_down': nrm(ks[13], (DEPTH, 2, D_FF, D_MODEL), BETA * D_FF ** -0.5),
        'w_in': nrm(ks[14], (DEPTH, D_MODEL, D_IN), D_MODEL ** -0.5),
        'w_out': nrm(ks[15], (DEPTH, D_MIX, D_MODEL), BETA * D_MIX ** -0.5),
        'attn_sinks': nrm(ks[16], (DEPTH, N_HEADS_SWA), 0.5),
        'conv_w': nrm(ks[17], (DEPTH, CONV_WIDTH, D_CONV), CONV_WIDTH ** -0.5),
        'gdn_a_log': jnp.log(jax.random.uniform(ks[18], (DEPTH, N_HEADS_GDN), f32, 1.0, 16.0)),
        'gdn_dt_bias': dt + jnp.log(-jnp.expm1(-dt)),
        'gdn_norm_w': 1.0 + nrm(ks[19], (DEPTH, DV_GDN), 0.02),
    }


def reference(x_prompt, x_sample, cache_meta_k, cache_meta_v, cache_win_k, cache_win_v, state_conv, state_gdn,
              meta_tokens, ln_g, ln_b, ffn_w_gate, ffn_w_up, ffn_w_down, w_in, w_out, attn_sinks, conv_w,
              gdn_a_log, gdn_dt_bias, gdn_norm_w):
    B, S, _ = x_prompt.shape
    DS = x_sample.shape[1]
    pos_p = jnp.arange(N_META + S, dtype=jnp.int32)
    pos_s = N_META + PAST_LEN + jnp.arange(DS, dtype=jnp.int32)
    xp = jnp.concatenate([jnp.broadcast_to(meta_tokens.astype(x_prompt.dtype)[None], (B, N_META, D_MODEL)),
                          x_prompt], 1)
    xs = x_sample
    p_states = []
    s_states = []
    for l in range(DEPTH):
        mix_p = lambda h: _mix_prompt(h, pos_p, attn_sinks[l], conv_w[l], gdn_a_log[l], gdn_dt_bias[l],
                                      gdn_norm_w[l])
        mix_s = lambda h: _mix_sample(h, pos_s, cache_meta_k[l], cache_meta_v[l], cache_win_k[l], cache_win_v[l],
                                      state_conv[l], state_gdn[l], attn_sinks[l], conv_w[l], gdn_a_log[l],
                                      gdn_dt_bias[l], gdn_norm_w[l])
        xp, sp = _layer(xp, ln_g[l], ln_b[l], ffn_w_gate[l], ffn_w_up[l], ffn_w_down[l], w_in[l], w_out[l], mix_p)
        xs, ss = _layer(xs, ln_g[l], ln_b[l], ffn_w_gate[l], ffn_w_up[l], ffn_w_down[l], w_in[l], w_out[l], mix_s)
        p_states.append(sp)
        s_states.append(ss)
    y_prompt = xp[:, N_META:]
    y_sample = xs
    p_meta_k = jnp.stack([st[0] for st in p_states])
    p_meta_v = jnp.stack([st[1] for st in p_states])
    p_win_k = jnp.stack([st[2] for st in p_states])
    p_win_v = jnp.stack([st[3] for st in p_states])
    p_conv = jnp.stack([st[4] for st in p_states])
    p_gdn = jnp.stack([st[5] for st in p_states])
    s_win_k = jnp.stack([st[0] for st in s_states])
    s_win_v = jnp.stack([st[1] for st in s_states])
    s_conv = jnp.stack([st[2] for st in s_states])
    s_gdn = jnp.stack([st[3] for st in s_states])
    return (y_prompt, y_sample, p_meta_k, p_meta_v, p_win_k, p_win_v, p_conv, p_gdn, s_win_k, s_win_v, s_conv, s_gdn)
```

```cpp
#include <hip/hip_runtime.h>
#include <cstdio>
#include <cstdint>
namespace pg8 {
#define PG8_LAS __attribute__((address_space(3)))
typedef unsigned short bf16_t;
typedef short bf16x8 __attribute__((ext_vector_type(8)));
typedef float f32x4 __attribute__((ext_vector_type(4)));
typedef unsigned u32x4 __attribute__((ext_vector_type(4)));
constexpr int BM = 256, BK = 64, HALF = 128, HTB = HALF * BK * 2  , STAGE_BYTES = 8 * HTB, NXCD = 8, WGM = 8;

__host__ __device__ __forceinline__ int lds_byte(int r, int c) { const int st = (r >> 4) * 2 + (c >> 5), rr = r & 15, cc = c & 31, ob = rr * 64 + cc * 2; return st * 1024 + (ob ^ (((ob >> 9) & 1) << 5)); }
__host__ __device__ __forceinline__ void stage_rc(int b, int& R, int& C) { const int st = b / 1024, sb = b % 1024, swz = sb ^ (((sb >> 9) & 1) << 5); R = (st >> 1) * 16 + swz / 64; C = (st & 1) * 32 + (swz % 64) / 2; }
__host__ __device__ __forceinline__ int perm32(int rho) { const int n = rho >> 4, i = rho & 15; return 8 * (i >> 2) + 4 * n + (i & 3); }

struct Unit { int pm, pn; };
struct Gemm { const bf16_t* A; const bf16_t* Bt; int M, N, K; };

struct StaticOrder {
    int nM, nN, nwg, G, c;
    __host__ __device__ void init(int M, int N, int G_, int c_) { nM = M / BM; nN = N / BM; nwg = nM * nN; G = G_; c = c_; }
    __host__ __device__ bool next(int i, Unit& u) const {
        const long L = (long)i * G + c; if (L >= nwg) return false;
        int wgid = (int)L; { const int q = nwg / NXCD, r = nwg % NXCD, xcd = wgid % NXCD, off = wgid / NXCD; wgid = (xcd < r ? xcd * (q + 1) : r * (q + 1) + (xcd - r) * q) + off; }
        const int nig = WGM * nN, gid = wgid / nig, fm = gid * WGM, gsz = (nM - fm) < WGM ? (nM - fm) : WGM;
        u.pm = fm + ((wgid % nig) % gsz); u.pn = (wgid % nig) / gsz; return true;
    }
    __device__ __forceinline__ void a_ready(const Unit&) const {}
    __device__ __forceinline__ void done(const Unit&) const {}
};

__device__ __forceinline__ unsigned cvt_pk_bf16(float lo, float hi) { unsigned r; asm volatile("v_cvt_pk_bf16_f32 %0, %1, %2" : "=v"(r) : "v"(lo), "v"(hi)); return r; }
typedef float f32x2 __attribute__((ext_vector_type(2)));
__device__ __forceinline__ float silu_f(float g) { return g * __builtin_amdgcn_rcpf(1.0f + __builtin_amdgcn_exp2f(-1.4426950408889634f * g)); }
struct EpiSwiGLU {
    static constexpr bool PERM = true, AFTER_DRAIN = false;
    bf16_t* O; int ldc;
    __device__ __forceinline__ void operator()(const f32x4 (&acc)[2][2][4][2], const Unit& u, int wr, int wc, int fr, int fq) const {
        const int row0 = u.pm * BM + wr * 64 + fr, col0 = u.pn * HALF + wc * 32 + 8 * fq;
#pragma unroll
        for (int ai = 0; ai < 2; ++ai)
#pragma unroll
            for (int m = 0; m < 4; ++m) { bf16_t* rowp = O + (size_t)(row0 + ai * HALF + m * 16) * ldc + col0;
                const f32x4 g0 = acc[ai][0][m][0], g1 = acc[ai][0][m][1], u0 = acc[ai][1][m][0], u1 = acc[ai][1][m][1];
                u32x4 w;
                w.x = cvt_pk_bf16(silu_f(g0[0]) * u0[0], silu_f(g0[1]) * u0[1]); w.y = cvt_pk_bf16(silu_f(g0[2]) * u0[2], silu_f(g0[3]) * u0[3]);
                w.z = cvt_pk_bf16(silu_f(g1[0]) * u1[0], silu_f(g1[1]) * u1[1]); w.w = cvt_pk_bf16(silu_f(g1[2]) * u1[2], silu_f(g1[3]) * u1[3]);
                *(u32x4*)rowp = w; }
    }
};
struct EpiStoreBf16 {
    static constexpr bool PERM = true, AFTER_DRAIN = false;
    bf16_t* O; int ldc;
    __device__ __forceinline__ void operator()(const f32x4 (&acc)[2][2][4][2], const Unit& u, int wr, int wc, int fr, int fq) const {
        const int row0 = u.pm * BM + wr * 64 + fr, col0 = u.pn * BM + wc * 32 + 8 * fq;
#pragma unroll
        for (int ai = 0; ai < 2; ++ai)
#pragma unroll
            for (int m = 0; m < 4; ++m) { bf16_t* rowp = O + (size_t)(row0 + ai * HALF + m * 16) * ldc + col0;
#pragma unroll
                for (int bj = 0; bj < 2; ++bj) { const f32x4 v0 = acc[ai][bj][m][0], v1 = acc[ai][bj][m][1];
                    u32x4 w; w.x = cvt_pk_bf16(v0[0], v0[1]); w.y = cvt_pk_bf16(v0[2], v0[3]); w.z = cvt_pk_bf16(v1[0], v1[1]); w.w = cvt_pk_bf16(v1[2], v1[3]);
                    *(u32x4*)(rowp + bj * HALF) = w; } }
    }
};
template <int MODE> struct RowSrc {
    const float *p0, *p1, *p2; int n0, n1, n2, ld;
    __device__ __forceinline__ const float* row(int r) const {
        if (MODE == 1) return r < n0 ? p0 + (size_t)r * ld : nullptr;
        if (r < n0) return p0 + (size_t)r * ld;
        if (r < n1) return p1 + (size_t)(r - n0) * ld;
        if (r < n2) return p2 + (size_t)(r - n1) * ld;
        return nullptr; }
};
template <int MODE, bool HALF_> struct EpiResF32 {
    static constexpr bool PERM = false, AFTER_DRAIN = false;
    float* out; int ldc; RowSrc<MODE> src;
    __device__ __forceinline__ void operator()(const f32x4 (&acc)[2][2][4][2], const Unit& u, int wr, int wc, int fr, int fq) const {
        constexpr float alpha = 1.189207115002721f, scale = HALF_ ? 0.5f : 1.0f;
        const int col0 = u.pn * BM + wc * 32 + 4 * fq;
#pragma unroll
        for (int ai = 0; ai < 2; ++ai)
#pragma unroll
            for (int m = 0; m < 4; ++m) { const int r = u.pm * BM + ai * HALF + wr * 64 + m * 16 + fr; const float* b = src.row(r);
                if (b) { float* o = out + (size_t)r * ldc;
#pragma unroll
                    for (int bj = 0; bj < 2; ++bj)
#pragma unroll
                        for (int n = 0; n < 2; ++n) { const int c = col0 + bj * HALF + n * 16; const f32x4 bs = *(const f32x4*)(b + c);
                            *(f32x4*)(o + c) = bs * alpha + acc[ai][bj][m][n] * scale; } } }
    }
};
template <class Epi, class Sched, bool ALIGN_EPI = false, bool SP2 = false>
__device__ __forceinline__ void gemm_phase(PG8_LAS unsigned char* lds, const Gemm g, const Sched& S, const Epi& E) {
    const int tid = threadIdx.x, wid = __builtin_amdgcn_readfirstlane(tid >> 6), lane = tid & 63, wr = wid >> 2, wc = wid & 3, fr = lane & 15, fq = lane >> 4;
    const int K = g.K, nt = K / BK;
    unsigned voffA[2], voffB[2];
#pragma unroll
    for (int i = 0; i < 2; ++i) { int R, C; stage_rc(tid * 16 + i * 8192, R, C); const int Rb = Epi::PERM ? ((R & ~31) + perm32(R & 31)) : R;
        voffA[i] = (unsigned)(R * K + C) * 2u; voffB[i] = (unsigned)(Rb * K + C) * 2u; }
    const size_t kstep = (size_t)(BK * 2);
    const size_t hstep = (size_t)HALF * K * 2;
    const size_t tstep = 2 * hstep;
    const unsigned ldsw = (unsigned)wid * 1024u;
    const int aoff = lds_byte(wr * 64 + fr, fq * 8), boff = lds_byte(wc * 32 + fr, fq * 8);
#define PG8_SA(b, h) (((b) * 2 + (h)) * HTB)
#define PG8_SB(b, h) ((4 + (b) * 2 + (h)) * HTB)
#define PG8_STAGE(bufoff, gbase, voff) do { _Pragma("unroll") for (int _i = 0; _i < 2; ++_i) \
        __builtin_amdgcn_global_load_lds((const unsigned*)((const char*)(gbase) + (voff)[_i]), (PG8_LAS unsigned*)(lds + (bufoff) + ldsw + _i * 8192), 16, 0, 0); } while (0)
#define PG8_LDA(dst, b, h) do { _Pragma("unroll") for (int m = 0; m < 4; ++m) _Pragma("unroll") for (int k = 0; k < 2; ++k) dst[m][k] = *(const PG8_LAS bf16x8*)(lds + PG8_SA(b, h) + aoff + m * 2048 + k * 1024); } while (0)
#define PG8_LDB(dst, b, h) do { _Pragma("unroll") for (int n = 0; n < 2; ++n) _Pragma("unroll") for (int k = 0; k < 2; ++k) dst[n][k] = *(const PG8_LAS bf16x8*)(lds + PG8_SB(b, h) + boff + n * 2048 + k * 1024); } while (0)
#define PG8_MMA(ai, bj, At, Bt) do { __builtin_amdgcn_s_setprio(1); _Pragma("unroll") for (int m = 0; m < 4; ++m) _Pragma("unroll") for (int n = 0; n < 2; ++n) _Pragma("unroll") for (int k = 0; k < 2; ++k) \
        acc[ai][bj][m][n] = __builtin_amdgcn_mfma_f32_16x16x32_bf16(Bt[n][k], At[m][k], acc[ai][bj][m][n], 0, 0, 0); __builtin_amdgcn_s_setprio(0); } while (0)
#define PG8_WAIT_V(n) asm volatile("s_waitcnt vmcnt(" #n ")" ::: "memory")
#define PG8_WAIT_L(n) asm volatile("s_waitcnt lgkmcnt(" #n ")" ::: "memory")
#define PG8_BAR __builtin_amdgcn_s_barrier()
#define PG8_SCHED __builtin_amdgcn_sched_barrier(0)
    Unit cur, nxt; int ui = 0;
    if (!S.next(0, cur)) return;
    f32x4 acc[2][2][4][2];
#pragma unroll
    for (int a = 0; a < 2; ++a)
#pragma unroll
        for (int b = 0; b < 2; ++b)
#pragma unroll
            for (int m = 0; m < 4; ++m)
#pragma unroll
                for (int n = 0; n < 2; ++n) acc[a][b][m][n] = (f32x4){0.f, 0.f, 0.f, 0.f};
    bf16x8 At[4][2], B0[2][2], B1[2][2];
    const char* cA = (const char*)g.A + (size_t)cur.pm * tstep; const char* cB = (const char*)g.Bt + (size_t)cur.pn * tstep;
    S.a_ready(cur);
    if constexpr (SP2) {
        PG8_STAGE(PG8_SB(0, 0), cB, voffB); PG8_STAGE(PG8_SB(0, 1), cB + hstep, voffB); PG8_STAGE(PG8_SA(0, 0), cA, voffA); PG8_STAGE(PG8_SA(0, 1), cA + hstep, voffA);
        if (wr == 1) PG8_BAR;
        PG8_WAIT_V(2); PG8_BAR;
        PG8_STAGE(PG8_SB(1, 0), cB + kstep, voffB); PG8_STAGE(PG8_SA(1, 0), cA + kstep, voffA); PG8_STAGE(PG8_SB(1, 1), cB + hstep + kstep, voffB);
        PG8_WAIT_V(6); PG8_BAR;
    } else {
        PG8_STAGE(PG8_SB(0, 0), cB, voffB); PG8_STAGE(PG8_SA(0, 0), cA, voffA); PG8_STAGE(PG8_SB(0, 1), cB + hstep, voffB); PG8_STAGE(PG8_SA(0, 1), cA + hstep, voffA);
        if (wr == 1) PG8_BAR;
        PG8_WAIT_V(4); PG8_BAR;
        PG8_STAGE(PG8_SB(1, 0), cB + kstep, voffB); PG8_STAGE(PG8_SA(1, 0), cA + kstep, voffA); PG8_STAGE(PG8_SB(1, 1), cB + hstep + kstep, voffB);
        PG8_WAIT_V(6); PG8_BAR;
    }
    for (;;) {
        const bool has_next = S.next(ui + 1, nxt);
        const char* nA = has_next ? (const char*)g.A + (size_t)nxt.pm * tstep : cA; const char* nB = has_next ? (const char*)g.Bt + (size_t)nxt.pn * tstep : cB;
        for (int t = 0; t < nt; t += 2) {
            const bool last = (t == nt - 2);
            const char* a1 = cA + (size_t)(t + 1) * kstep;
            const char* a2 = last ? nA : cA + (size_t)(t + 2) * kstep; const char* b2 = last ? nB : cB + (size_t)(t + 2) * kstep;
            const char* a3 = a2 + kstep; const char* b3 = b2 + kstep;
            if (last && has_next) S.a_ready(nxt);
            if constexpr (SP2) {
            PG8_LDB(B0, 0, 0); PG8_LDB(B1, 0, 1); PG8_SCHED; PG8_LDA(At, 0, 0); PG8_STAGE(PG8_SA(1, 1), a1 + hstep, voffA);
            PG8_WAIT_V(8); PG8_WAIT_L(0); PG8_BAR; PG8_MMA(0, 0, At, B0); PG8_MMA(0, 1, At, B1); PG8_BAR; PG8_SCHED;
            PG8_LDA(At, 0, 1); PG8_STAGE(PG8_SB(0, 0), b2, voffB); PG8_STAGE(PG8_SB(0, 1), b2 + hstep, voffB); PG8_STAGE(PG8_SA(0, 0), a2, voffA);
            PG8_WAIT_V(8); PG8_WAIT_L(0); PG8_BAR; PG8_MMA(1, 0, At, B0); PG8_MMA(1, 1, At, B1); PG8_BAR; PG8_SCHED;
            PG8_LDB(B0, 1, 0); PG8_LDB(B1, 1, 1); PG8_SCHED; PG8_LDA(At, 1, 0); PG8_STAGE(PG8_SA(0, 1), a2 + hstep, voffA);
            PG8_WAIT_V(8); PG8_WAIT_L(0); PG8_BAR; PG8_MMA(0, 0, At, B0); PG8_MMA(0, 1, At, B1); PG8_BAR; PG8_SCHED;
            PG8_LDA(At, 1, 1); PG8_STAGE(PG8_SB(1, 0), b3, voffB); PG8_STAGE(PG8_SB(1, 1), b3 + hstep, voffB); PG8_STAGE(PG8_SA(1, 0), a3, voffA);
            PG8_WAIT_V(8); PG8_WAIT_L(0); PG8_BAR; PG8_MMA(1, 0, At, B0); PG8_MMA(1, 1, At, B1); PG8_BAR; PG8_SCHED;
            } else {
            PG8_LDB(B0, 0, 0); PG8_SCHED; PG8_LDA(At, 0, 0); PG8_STAGE(PG8_SA(1, 1), a1 + hstep, voffA);
            PG8_WAIT_L(8); PG8_BAR; PG8_WAIT_L(0); PG8_MMA(0, 0, At, B0); PG8_BAR; PG8_SCHED;
            PG8_LDB(B1, 0, 1); PG8_STAGE(PG8_SB(0, 0), b2, voffB);
            PG8_BAR; PG8_WAIT_L(0); PG8_MMA(0, 1, At, B1); PG8_BAR;
            PG8_LDA(At, 0, 1); PG8_STAGE(PG8_SA(0, 0), a2, voffA);
            PG8_BAR; PG8_WAIT_L(0); PG8_MMA(1, 0, At, B0); PG8_BAR; PG8_SCHED;
            PG8_STAGE(PG8_SB(0, 1), b2 + hstep, voffB);
            PG8_WAIT_V(6); PG8_BAR; PG8_MMA(1, 1, At, B1); PG8_BAR;
            PG8_LDB(B0, 1, 0); PG8_SCHED; PG8_LDA(At, 1, 0); PG8_STAGE(PG8_SA(0, 1), a2 + hstep, voffA);
            PG8_WAIT_L(8); PG8_BAR; PG8_WAIT_L(0); PG8_MMA(0, 0, At, B0); PG8_BAR; PG8_SCHED;
            PG8_LDB(B1, 1, 1); PG8_STAGE(PG8_SB(1, 0), b3, voffB);
            PG8_BAR; PG8_WAIT_L(0); PG8_MMA(0, 1, At, B1); PG8_BAR;
            PG8_LDA(At, 1, 1); PG8_STAGE(PG8_SA(1, 0), a3, voffA);
            PG8_BAR; PG8_WAIT_L(0); PG8_MMA(1, 0, At, B0); PG8_BAR; PG8_SCHED;
            PG8_STAGE(PG8_SB(1, 1), b3 + hstep, voffB);
            PG8_WAIT_V(6); PG8_BAR; PG8_MMA(1, 1, At, B1); PG8_BAR;
            }
        }
        if constexpr (ALIGN_EPI) { if (wr == 0) PG8_BAR; }
        if constexpr (!Epi::AFTER_DRAIN) { E(acc, cur, wr, wc, fr, fq); S.done(cur); }
        if (!has_next) break;
#pragma unroll
        for (int a = 0; a < 2; ++a)
#pragma unroll
            for (int b = 0; b < 2; ++b)
#pragma unroll
                for (int m = 0; m < 4; ++m)
#pragma unroll
                    for (int n = 0; n < 2; ++n) acc[a][b][m][n] = (f32x4){0.f, 0.f, 0.f, 0.f};
        cur = nxt; cA = nA; cB = nB; ++ui;
        if constexpr (ALIGN_EPI) { if (wr == 1) PG8_BAR; }
    }
    PG8_WAIT_V(0);
    if constexpr (!ALIGN_EPI) { if (wr == 0) PG8_BAR; }
    PG8_BAR;
    if constexpr (Epi::AFTER_DRAIN) { E.fused(acc, cur, wr, wc, fr, fq, lds, wid, lane); S.done(cur); }
#undef PG8_SA
#undef PG8_SB
#undef PG8_STAGE
#undef PG8_LDA
#undef PG8_LDB
#undef PG8_MMA
#undef PG8_WAIT_V
#undef PG8_WAIT_L
#undef PG8_BAR
#undef PG8_SCHED
}
}
#define GAS __attribute__((address_space(1)))
#define LAS __attribute__((address_space(3)))
typedef unsigned short bf16;
typedef unsigned v4u __attribute__((ext_vector_type(4)));
typedef float f32x4 __attribute__((ext_vector_type(4)));
typedef short bf16x8 __attribute__((ext_vector_type(8)));
typedef GAS unsigned gu32;
typedef GAS unsigned long long gu64;
#define RLX_AGENT __ATOMIC_RELAXED, __HIP_MEMORY_SCOPE_AGENT
#define LDS_WAIT() asm volatile("s_waitcnt lgkmcnt(0)" ::: "memory")
#define VM_WAIT() asm volatile("s_waitcnt vmcnt(0)" ::: "memory")
__device__ __forceinline__ unsigned long long rt() { return __builtin_amdgcn_s_memrealtime(); }
__device__ __forceinline__ unsigned f2bf(float f) { unsigned u = __builtin_bit_cast(unsigned, f); return (u + 0x7fffu + ((u >> 16) & 1u)) >> 16; }
__device__ __forceinline__ unsigned pk2(float lo, float hi) { return f2bf(lo) | (f2bf(hi) << 16); }

#define XB_TMO      128
#define XB_XCNT(j)  (256  + 64 * (j))
#define XB_XSUB(j)  (1280 + 64 * (j))
#define XB_XGEN(j)  (2304 + 64 * (j))
#define XB_TOP      3328
#define XB_TOPGEN   3392
#define XCD_BAR_WORDS 3456
#define XB_SPIN_CAP (1u << 18)

__device__ __forceinline__ unsigned xb_ld(unsigned* p)              { return __hip_atomic_load(p, __ATOMIC_RELAXED, __HIP_MEMORY_SCOPE_AGENT); }
__device__ __forceinline__ unsigned xb_add(unsigned* p, unsigned v) { return __hip_atomic_fetch_add(p, v, __ATOMIC_RELAXED, __HIP_MEMORY_SCOPE_AGENT); }
__device__ __forceinline__ unsigned xb_xcc_id() { return (unsigned)__builtin_amdgcn_s_getreg((3 << 11) | 20) & 0xFu; }
#define XB_SPIN(cond, bar) do { unsigned _sp = 0; while (cond) { __builtin_amdgcn_s_sleep(1); \
    if ((++_sp & 255u) == 0u) { if (xb_ld(&(bar)[XB_TMO])) break; if (_sp > XB_SPIN_CAP) { atomicAdd(&(bar)[XB_TMO], 1u); break; } } } } while (0)

struct XcdBarrier {
    unsigned* bar; unsigned x;
    volatile LAS unsigned* st;
};

__device__ __forceinline__ XcdBarrier xcd_barrier_post(unsigned* bar, volatile LAS unsigned* st) {
    XcdBarrier b; b.bar = bar; b.x = xb_xcc_id(); b.st = st;
    if (threadIdx.x == 0) (void)xb_add(&bar[XB_XCNT(b.x)], 1u);
    return b;
}
__device__ __forceinline__ void xcd_barrier_complete(unsigned* bar, unsigned x, unsigned& nloc, unsigned& nx) {
    const unsigned G = gridDim.x * gridDim.y * gridDim.z;
    unsigned sum, cnt, mine, sp = 0u;
    for (;;) {
        sum = 0u; cnt = 0u; mine = 0u;
#pragma unroll
        for (unsigned j = 0; j < 16; ++j) { const unsigned c = xb_ld(&bar[XB_XCNT(j)]); sum += c; cnt += (c > 0u) ? 1u : 0u; mine = (j == x) ? c : mine; }
        if (sum == G) break;
        __builtin_amdgcn_s_sleep(1);
        if ((++sp & 255u) == 0u) { if (xb_ld(&bar[XB_TMO])) break; if (sp > XB_SPIN_CAP) { atomicAdd(&bar[XB_TMO], 1u); break; } }
    }
    nloc = mine > 0u ? mine : 1u; nx = cnt > 0u ? cnt : 1u;
}

__device__ __forceinline__ void xcd_barrier(const XcdBarrier& b) {
    asm volatile("s_waitcnt vmcnt(0)" ::: "memory");
    __syncthreads();
    if (threadIdx.x == 0) {
        unsigned* bar = b.bar;
        __builtin_amdgcn_s_waitcnt(0);
        unsigned nloc = b.st[0], nx = b.st[1];
        if (nloc == 0u) { xcd_barrier_complete(bar, b.x, nloc, nx); b.st[0] = nloc; b.st[1] = nx; }
        const unsigned old = xb_add(&bar[XB_XSUB(b.x)], 1u);
        const unsigned gen = old / nloc;
        if (old + 1u == (gen + 1u) * nloc) {
            __builtin_amdgcn_fence(__ATOMIC_RELEASE, "agent");
            asm volatile("s_waitcnt vmcnt(0)" ::: "memory");
            const unsigned og = xb_add(&bar[XB_TOP], 1u);
            const unsigned tg = og / nx;
            if (og + 1u == (tg + 1u) * nx) xb_add(&bar[XB_TOPGEN], 1u);
            else XB_SPIN(xb_ld(&bar[XB_TOPGEN]) == tg, bar);
            __builtin_amdgcn_fence(__ATOMIC_ACQUIRE, "agent");
            xb_add(&bar[XB_XGEN(b.x)], 1u);
            asm volatile("s_waitcnt vmcnt(0)" ::: "memory");
        } else {
            XB_SPIN(xb_ld(&bar[XB_XGEN(b.x)]) == gen, bar);
            __builtin_amdgcn_fence(__ATOMIC_ACQUIRE, "agent");
            asm volatile("s_waitcnt vmcnt(0)" ::: "memory");
        }
    }
    __syncthreads();
}


constexpr int NWAVES = 8;
#ifndef MK_N_LAUNCHES
#define MK_N_LAUNCHES 12
#endif
constexpr int N_PHASES = 12;
constexpr int N_LAUNCHES = MK_N_LAUNCHES;
static_assert(N_LAUNCHES == 1 || N_LAUNCHES == N_PHASES, "MK_N_LAUNCHES is 1 or 12");

constexpr int D = 4096, FF = 11008, NGU = 2 * FF, DIN = 11296, DINP = 11520;
constexpr int NB_P = 4, SEQ_P = 2048, NB_S = 16, SEQ_S = 64, NMETA = 16, PAST = 2048;
constexpr int ROW_S = NB_P * SEQ_P  , ROW_M = ROW_S + NB_S * SEQ_S  , M1V = ROW_M + NMETA  , M1 = 9472  , M2 = ROW_M  ;
constexpr int KVH = 4, HD = 128, KVW = KVH * HD  , NHQ = 16, NHG = 16, WIN = 128;
constexpr int KVR_SMETA = M1, KVR_SWIN = M1 + NB_S * NMETA  , KV_ROWS = KVR_SWIN + NB_S * WIN  ;
constexpr int NPOS = NMETA + PAST + SEQ_S;
constexpr int C_Q = 0, C_K = 2048, C_V = 2560, C_CONV = 3072, C_Z = 9216, C_B = 11264, C_A = 11280, DCONV = 6144;
constexpr float LN_EPS = 1e-5f, RMS_EPS = 1e-6f, ALPHA = 1.189207115002721f;
enum { I_XP = 0, I_XS, I_CMK, I_CMV, I_CWK, I_CWV, I_SCONV, I_SGDN, I_META, I_LNG, I_LNB, I_WG, I_WU, I_WD, I_WIN, I_WOUT, I_SINK, I_CONVW, I_ALOG, I_DTB, I_NORMW, N_IN };
constexpr size_t O_YP = 0, O_YS = O_YP + (size_t)ROW_S * D, O_PMK = O_YS + (size_t)NB_S * SEQ_S * D, O_PMV = O_PMK + (size_t)NB_P * NMETA * KVW, O_PWK = O_PMV + (size_t)NB_P * NMETA * KVW,
                 O_PWV = O_PWK + (size_t)NB_P * WIN * KVW, O_PCONV = O_PWV + (size_t)NB_P * WIN * KVW, O_PGDN = O_PCONV + (size_t)NB_P * 3 * DCONV, O_SWK = O_PGDN + (size_t)NB_P * NHG * 128 * 128,
                 O_SWV = O_SWK + (size_t)NB_S * SEQ_S * KVW, O_SCONV = O_SWV + (size_t)NB_S * SEQ_S * KVW, O_SGDN = O_SCONV + (size_t)NB_S * 3 * DCONV, O_END = O_SGDN + (size_t)NB_S * NHG * 128 * 128;
static_assert(O_END == 44998656, "output map");

constexpr size_t AL(size_t x) { return (x + 4095) / 4096 * 4096; }
constexpr size_t WS_CTL = 0, CTL_ZERO_BYTES = 1u << 20;
constexpr size_t WS_WGU1 = CTL_ZERO_BYTES, SZ_WGU = (size_t)NGU * D * 2, SZ_WD = (size_t)D * FF * 2;
constexpr size_t WS_WD1 = WS_WGU1 + AL(SZ_WGU), WS_WGU2 = WS_WD1 + AL(SZ_WD), WS_WD2 = WS_WGU2 + AL(SZ_WGU), WS_WIN = WS_WD2 + AL(SZ_WD), WS_WOUT = WS_WIN + AL((size_t)DINP * D * 2);
constexpr size_t WS_XN = WS_WOUT + AL((size_t)D * D * 2), WS_MIX = WS_XN + AL((size_t)M1 * D * 2), WS_H = WS_MIX + AL((size_t)M2 * D * 2);
constexpr size_t WS_Y = WS_H + AL((size_t)M1 * DINP * 2), WS_KB = WS_Y + AL((size_t)M1 * D * 4), WS_VB = WS_KB + AL((size_t)KV_ROWS * KVW * 2), WS_ROPE = WS_VB + AL((size_t)KV_ROWS * KVW * 2);
constexpr size_t WS_END = WS_ROPE + AL((size_t)NPOS * 64 * 8);
constexpr int GU_U = 0, GU_W = 32768, GU_QD = GU_W + 16384, GU_KDT = GU_QD + 16384, GU_QK = GU_KDT + 16384, GU_GL = GU_QK + 8192, GU_BYTES = GU_GL + 256;
constexpr int N_GUNITS = NB_P * NHG * 32 + NHG + NB_S * NHG;
constexpr size_t WS_GDN = WS_WGU1;
static_assert((size_t)N_GUNITS * GU_BYTES <= WS_WGU2 - WS_WGU1, "GDN chunk data fits in the FFN1 weight region");
constexpr int CW_TMO = 0, CW_CODE = 1, CW_BAR = 4096;

constexpr int RING_OFF = 0, RING_BYTES = 135168;
constexpr int LDSCTL_OFF = RING_BYTES, MISC_OFF = LDSCTL_OFF + 320;
constexpr int LDS_BYTES = 147456;
static_assert(MISC_OFF + 128 <= LDS_BYTES, "LDS map");

struct Frame {
    LAS unsigned char* lds;
    volatile LAS unsigned* MISC;
    gu32* ctl;
    int tid, lane, wave;
    int vcu, G;
};
struct Ptrs {
    const float* in[N_IN]; float* out;
    bf16 *Wgu1, *Wd1, *Wgu2, *Wd2, *Win, *Wout, *XN, *MIX, *H, *KB, *VB;
    float* Y; float* ROPE; unsigned char* GDN;
};
typedef float f32x2v __attribute__((ext_vector_type(2)));
typedef unsigned u32x2v __attribute__((ext_vector_type(2)));
__device__ __forceinline__ float bf2f(unsigned b) { return __uint_as_float(b << 16); }
__device__ __forceinline__ float wave_sum(float v) {
#pragma unroll
    for (int o = 1; o < 64; o <<= 1) v += __shfl_xor(v, o);
    return v;
}
__device__ __forceinline__ float silu1(float g) { return g * __builtin_amdgcn_rcpf(1.0f + __builtin_amdgcn_exp2f(-1.4426950408889634f * g)); }

template <int NB, int MODE>
__device__ __forceinline__ void p0_transpose_item(const float* W, int K, int N, bf16* WT, LAS float* scr, int item, int lane) {
    constexpr int LPR = NB / 4, RPI = 64 / LPR, NIT = 64 / RPI, ST = NB + 1;
    const int nblk = N / NB, kb = item / nblk, nb = item - kb * nblk, k0 = 64 * kb, n0 = NB * nb;
    const int lr = lane / LPR, lc = 4 * (lane % LPR);
#pragma unroll
    for (int i = 0; i < NIT; ++i) { const int kk = RPI * i + lr; const f32x4 v = *(const GAS f32x4*)(W + (size_t)(k0 + kk) * N + n0 + lc);
        LAS float* s = scr + kk * ST + lc; s[0] = v.x; s[1] = v.y; s[2] = v.z; s[3] = v.w; }
    LDS_WAIT(); asm volatile("" ::: "memory");
    const int c = lane & 7;
#pragma unroll
    for (int j = 0; j < NB / 8; ++j) { const int n = (lane >> 3) + 8 * j; const LAS float* s = scr + (8 * c) * ST + n;
        v4u o; o.x = pk2(s[0 * ST], s[1 * ST]); o.y = pk2(s[2 * ST], s[3 * ST]); o.z = pk2(s[4 * ST], s[5 * ST]); o.w = pk2(s[6 * ST], s[7 * ST]);
        const int nn = n0 + n; const int r = (MODE == 0) ? nn : ((nn >> 7) * 256 + (nn & 127) + (MODE == 2 ? 128 : 0));
        *(GAS v4u*)(WT + (size_t)r * K + k0 + 8 * c) = o; }
    LDS_WAIT(); asm volatile("" ::: "memory");
}
__device__ __forceinline__ void cvt_flat(const float* src, bf16* dst, int n8, int gt, int NGT) {
    for (int i = gt; i < n8; i += NGT) { const f32x4 a = *(const GAS f32x4*)(src + (size_t)i * 8), b = *(const GAS f32x4*)(src + (size_t)i * 8 + 4);
        v4u o; o.x = pk2(a.x, a.y); o.y = pk2(a.z, a.w); o.z = pk2(b.x, b.y); o.w = pk2(b.z, b.w); *(GAS v4u*)(dst + (size_t)i * 8) = o; }
}
__device__ __forceinline__ void p0_prologue(Frame& F, const Ptrs& P) {
    LAS float* scr = (LAS float*)(F.lds + RING_OFF + F.wave * 16640);
    const int gw = F.vcu * NWAVES + F.wave, NGW = F.G * NWAVES;
    constexpr int IT_GU = (D / 64) * (FF / 64), IT_IN = (D / 64) * (DIN / 32), IT_OUT = (D / 64) * (D / 64);
    constexpr int NITEMS = 6 * IT_GU + IT_IN + IT_OUT;
    const float* wg = P.in[I_WG]; const float* wu = P.in[I_WU]; const float* wd = P.in[I_WD];
    for (int it = gw; it < NITEMS; it += NGW) {
        int r = it;
        if (r < IT_GU) { p0_transpose_item<64, 1>(wg, D, FF, P.Wgu1, scr, r, F.lane); continue; } r -= IT_GU;
        if (r < IT_GU) { p0_transpose_item<64, 2>(wu, D, FF, P.Wgu1, scr, r, F.lane); continue; } r -= IT_GU;
        if (r < IT_GU) { p0_transpose_item<64, 0>(wd, FF, D, P.Wd1, scr, r, F.lane); continue; } r -= IT_GU;
        if (r < IT_GU) { p0_transpose_item<64, 1>(wg + (size_t)D * FF, D, FF, P.Wgu2, scr, r, F.lane); continue; } r -= IT_GU;
        if (r < IT_GU) { p0_transpose_item<64, 2>(wu + (size_t)D * FF, D, FF, P.Wgu2, scr, r, F.lane); continue; } r -= IT_GU;
        if (r < IT_GU) { p0_transpose_item<64, 0>(wd + (size_t)D * FF, FF, D, P.Wd2, scr, r, F.lane); continue; } r -= IT_GU;
        if (r < IT_IN) { p0_transpose_item<32, 0>(P.in[I_WIN], D, DIN, P.Win, scr, r, F.lane); continue; } r -= IT_IN;
        p0_transpose_item<64, 0>(P.in[I_WOUT], D, D, P.Wout, scr, r, F.lane);
    }
    for (int m = gw; m < M1V; m += NGW) {
        const float* src = m < ROW_S ? P.in[I_XP] + (size_t)m * D : (m < ROW_M ? P.in[I_XS] + (size_t)(m - ROW_S) * D : P.in[I_META] + (size_t)(m - ROW_M) * D);
        const GAS f32x4* xr = (const GAS f32x4*)src + F.lane; GAS u32x2v* o8 = (GAS u32x2v*)(P.XN + (size_t)m * D) + F.lane;
#pragma unroll
        for (int j = 0; j < 16; ++j) { const f32x4 v = xr[64 * j]; u32x2v w; w.x = pk2(v.x, v.y); w.y = pk2(v.z, v.w); o8[64 * j] = w; }
    }
    const int gt = gw * 64 + F.lane, NGT = NGW * 64;
    for (int i = gt; i < NPOS * 64; i += NGT) { const int pos = i >> 6, k = i & 63;
        const double inv = exp2(-(double)k * (13.287712379549449 / 64.0)); const float ang = (float)((double)pos * inv);
        float s, c; sincosf(ang, &s, &c); ((GAS f32x2v*)P.ROPE)[i] = (f32x2v){c, s}; }
    cvt_flat(P.in[I_CMK], P.KB + (size_t)KVR_SMETA * KVW, NB_S * NMETA * KVW / 8, gt, NGT);
    cvt_flat(P.in[I_CMV], P.VB + (size_t)KVR_SMETA * KVW, NB_S * NMETA * KVW / 8, gt, NGT);
    cvt_flat(P.in[I_CWK], P.KB + (size_t)KVR_SWIN * KVW, NB_S * WIN * KVW / 8, gt, NGT);
    cvt_flat(P.in[I_CWV], P.VB + (size_t)KVR_SWIN * KVW, NB_S * WIN * KVW / 8, gt, NGT);
}

__device__ __forceinline__ void ln_phase(Frame& F, const float* Y, float* Xo, bf16* XN, const float* g, const float* b, int nrows) {
    const int gw = F.vcu * NWAVES + F.wave, NGW = F.G * NWAVES;
    for (int r = gw; r < nrows; r += NGW) {
        const GAS f32x4* yr = (const GAS f32x4*)(Y + (size_t)r * D) + F.lane;
        f32x4 v[16]; float s = 0.f;
#pragma unroll
        for (int j = 0; j < 16; ++j) { v[j] = yr[64 * j]; s += (v[j].x + v[j].y) + (v[j].z + v[j].w); }
        const float mean = wave_sum(s) * (1.f / D); float s2 = 0.f;
#pragma unroll
        for (int j = 0; j < 16; ++j) { v[j] = v[j] - mean; s2 += (v[j].x * v[j].x + v[j].y * v[j].y) + (v[j].z * v[j].z + v[j].w * v[j].w); }
        const float rstd = 1.f / sqrtf(wave_sum(s2) * (1.f / D) + LN_EPS);
#pragma unroll
        for (int j = 0; j < 16; ++j) { const f32x4 gg = ((const GAS f32x4*)g)[F.lane + 64 * j], bb = ((const GAS f32x4*)b)[F.lane + 64 * j];
            const f32x4 o = v[j] * rstd * gg + bb;
            if (Xo) ((GAS f32x4*)(Xo + (size_t)r * D))[F.lane + 64 * j] = o;
            if (XN) { u32x2v w; w.x = pk2(o.x, o.y); w.y = pk2(o.z, o.w); ((GAS u32x2v*)(XN + (size_t)r * D))[F.lane + 64 * j] = w; } }
    }
}

__device__ __forceinline__ void kv_prep(Frame& F, const Ptrs& P) {
    const int gw = F.vcu * NWAVES + F.wave, NGW = F.G * NWAVES, lane = F.lane;
    const bf16* HIN = P.H;
    for (int r = gw; r < M1V; r += NGW) {
        int pos; float* kdst = nullptr; float* vdst = nullptr; int ncp = 1;
        if (r < ROW_S) { const int t = r & (SEQ_P - 1), b = r >> 11; pos = NMETA + t;
            if (t >= SEQ_P - WIN) { kdst = P.out + O_PWK + (size_t)(b * WIN + t - (SEQ_P - WIN)) * KVW; vdst = P.out + O_PWV + (size_t)(b * WIN + t - (SEQ_P - WIN)) * KVW; } }
        else if (r < ROW_M) { pos = NMETA + PAST + ((r - ROW_S) & (SEQ_S - 1)); kdst = P.out + O_SWK + (size_t)(r - ROW_S) * KVW; vdst = P.out + O_SWV + (size_t)(r - ROW_S) * KVW; }
        else { pos = r - ROW_M; kdst = P.out + O_PMK + (size_t)pos * KVW; vdst = P.out + O_PMV + (size_t)pos * KVW; ncp = NB_P; }
        const bf16* hrow = HIN + (size_t)r * DINP;
        const f32x2v cs = ((const GAS f32x2v*)P.ROPE)[pos * 64 + lane];
#pragma unroll
        for (int kh = 0; kh < KVH; ++kh) { const float x1 = bf2f(hrow[C_K + kh * HD + lane]), x2 = bf2f(hrow[C_K + kh * HD + 64 + lane]);
            const float o1 = x1 * cs.x - x2 * cs.y, o2 = x2 * cs.x + x1 * cs.y;
            P.KB[(size_t)r * KVW + kh * HD + lane] = (bf16)f2bf(o1); P.KB[(size_t)r * KVW + kh * HD + 64 + lane] = (bf16)f2bf(o2);
            if (kdst) for (int cp = 0; cp < ncp; ++cp) { kdst[(size_t)cp * NMETA * KVW + kh * HD + lane] = o1; kdst[(size_t)cp * NMETA * KVW + kh * HD + 64 + lane] = o2; } }
        const v4u vv = *(const GAS v4u*)(hrow + C_V + 8 * lane);
        *(GAS v4u*)(P.VB + (size_t)r * KVW + 8 * lane) = vv;
        if (vdst) { const f32x4 a = {bf2f(vv.x & 0xffffu), bf2f(vv.x >> 16), bf2f(vv.y & 0xffffu), bf2f(vv.y >> 16)}, c = {bf2f(vv.z & 0xffffu), bf2f(vv.z >> 16), bf2f(vv.w & 0xffffu), bf2f(vv.w >> 16)};
            for (int cp = 0; cp < ncp; ++cp) { *(GAS f32x4*)(vdst + (size_t)cp * NMETA * KVW + 8 * lane) = a; *(GAS f32x4*)(vdst + (size_t)cp * NMETA * KVW + 8 * lane + 4) = c; } }
    }
    for (int it = gw; it < (NB_P + NB_S) * 3 * (DCONV / 512); it += NGW) {
        const int part = it % (DCONV / 512), rj = it / (DCONV / 512), j = rj % 3, sb = rj / 3;
        const int srow = sb < NB_P ? sb * SEQ_P + SEQ_P - 3 + j : ROW_S + (sb - NB_P) * SEQ_S + SEQ_S - 3 + j;
        float* dst = (sb < NB_P ? P.out + O_PCONV + (size_t)(sb * 3 + j) * DCONV : P.out + O_SCONV + (size_t)((sb - NB_P) * 3 + j) * DCONV) + part * 512 + 8 * lane;
        const v4u vv = *(const GAS v4u*)(HIN + (size_t)srow * DINP + C_CONV + part * 512 + 8 * lane);
        *(GAS f32x4*)dst = (f32x4){bf2f(vv.x & 0xffffu), bf2f(vv.x >> 16), bf2f(vv.y & 0xffffu), bf2f(vv.y >> 16)};
        *(GAS f32x4*)(dst + 4) = (f32x4){bf2f(vv.z & 0xffffu), bf2f(vv.z >> 16), bf2f(vv.w & 0xffffu), bf2f(vv.w >> 16)};
    }
}

constexpr int QS_ST = 132, AM_ST = 68;
constexpr int L_AM = 0, L_BETA = L_AM + 64 * AM_ST * 4, L_GG = L_BETA + 256, L_GC = L_GG + 256, L_EG = L_GC + 256, L_EK = L_EG + 256, L_QS = L_EK + 256, L_KS = L_QS + 64 * QS_ST * 4, L_VS = L_KS + 64 * QS_ST * 4, L_PREP_END = L_VS + 64 * QS_ST * 4;
static_assert(L_PREP_END <= RING_BYTES, "GDN prep LDS");
__device__ __forceinline__ void gdn_prep_unit(Frame& F, const Ptrs& P, int uidx) {
    LAS float* qs = (LAS float*)(F.lds + L_QS); LAS float* ks = (LAS float*)(F.lds + L_KS); LAS float* vs = (LAS float*)(F.lds + L_VS); LAS float* am = (LAS float*)(F.lds + L_AM);
    LAS float* beta = (LAS float*)(F.lds + L_BETA); LAS float* gg = (LAS float*)(F.lds + L_GG); LAS float* gc = (LAS float*)(F.lds + L_GC); LAS float* eg = (LAS float*)(F.lds + L_EG); LAS float* ek = (LAS float*)(F.lds + L_EK);
    int tid_ = F.tid; asm volatile("" : "+v"(tid_));
    const int tid = tid_, lane = tid & 63;
    int kind, b = 0, h, n = 0;
    if (uidx < 2048) { kind = 0; b = uidx >> 9; h = (uidx >> 5) & 15; n = uidx & 31; }
    else if (uidx < 2064) { kind = 1; h = uidx - 2048; }
    else { kind = 2; b = (uidx - 2064) >> 4; h = (uidx - 2064) & 15; }
    const int row0 = kind == 0 ? b * SEQ_P + 64 * n : (kind == 2 ? ROW_S + b * SEQ_S : ROW_M - 48);
    const bf16* HIN = P.H; unsigned char* ud = P.GDN + (size_t)uidx * GU_BYTES;
    if (tid < 384) {
        const int part = tid >> 7, c = tid & 127, ch = part * 2048 + h * 128 + c; const bf16* col = HIN + C_CONV + ch;
        const float* cw = P.in[I_CONVW]; const float w0 = cw[ch], w1 = cw[DCONV + ch], w2 = cw[2 * DCONV + ch], w3 = cw[3 * DCONV + ch];
        float xm3 = 0.f, xm2 = 0.f, xm1 = 0.f;
        if (kind == 0) { if (n == 0) { xm3 = bf2f(col[(size_t)(ROW_M + 13) * DINP]); xm2 = bf2f(col[(size_t)(ROW_M + 14) * DINP]); xm1 = bf2f(col[(size_t)(ROW_M + 15) * DINP]); }
                         else { xm3 = bf2f(col[(size_t)(row0 - 3) * DINP]); xm2 = bf2f(col[(size_t)(row0 - 2) * DINP]); xm1 = bf2f(col[(size_t)(row0 - 1) * DINP]); } }
        else if (kind == 2) { const float* sc = P.in[I_SCONV] + (size_t)b * 3 * DCONV + ch; xm3 = sc[0]; xm2 = sc[DCONV]; xm1 = sc[2 * DCONV]; }
        LAS float* dst = (part == 0 ? qs : (part == 1 ? ks : vs)) + c;
        const int i0 = kind == 1 ? 48 : 0;
        for (int i = 0; i < i0; ++i) dst[i * QS_ST] = 0.f;
#pragma unroll 8
        for (int i = i0; i < 64; ++i) { const float x = bf2f(col[(size_t)(row0 + i) * DINP]);
            const float y = w0 * xm3 + w1 * xm2 + w2 * xm1 + w3 * x; dst[i * QS_ST] = silu1(y); xm3 = xm2; xm2 = xm1; xm1 = x; }
    } else if (tid < 448) {
        const int i = tid - 384; float be = 0.f, g = 0.f;
        if (!(kind == 1 && i < 48)) { const bf16* hr = HIN + (size_t)(row0 + i) * DINP; const float bl = bf2f(hr[C_B + h]), al = bf2f(hr[C_A + h]);
            be = 1.f / (1.f + expf(-bl)); const float x = al + P.in[I_DTB][h]; const float sp = fmaxf(x, 0.f) + log1pf(expf(-fabsf(x))); g = -expf(P.in[I_ALOG][h]) * sp; }
        beta[i] = be; gg[i] = g;
    }
    __syncthreads();
    if (F.wave == 0) { float v = gg[lane];
#pragma unroll
        for (int o = 1; o < 64; o <<= 1) { const float t = __shfl_up(v, o); if (lane >= o) v += t; }
        gc[lane] = v; eg[lane] = expf(v); const float last = __shfl(v, 63); ek[lane] = expf(last - v); }
#pragma unroll
    for (int rr = 0; rr < 8; ++rr) { const int i = 8 * F.wave + rr;
        { const float a = qs[i * QS_ST + lane], c = qs[i * QS_ST + 64 + lane]; const float r = rsqrtf(wave_sum(a * a + c * c) + RMS_EPS) * 0.08838834764831845f; qs[i * QS_ST + lane] = a * r; qs[i * QS_ST + 64 + lane] = c * r; }
        { const float a = ks[i * QS_ST + lane], c = ks[i * QS_ST + 64 + lane]; const float r = rsqrtf(wave_sum(a * a + c * c) + RMS_EPS); ks[i * QS_ST + lane] = a * r; ks[i * QS_ST + 64 + lane] = c * r; } }
    __syncthreads();
    { const int i = tid >> 3, jg = tid & 7; float ak[8], aq[8];
#pragma unroll
        for (int e = 0; e < 8; ++e) { ak[e] = 0.f; aq[e] = 0.f; }
#pragma unroll 2
        for (int d4 = 0; d4 < 32; ++d4) { const f32x4 ki = *(const LAS f32x4*)(ks + i * QS_ST + 4 * d4), qi = *(const LAS f32x4*)(qs + i * QS_ST + 4 * d4);
#pragma unroll
            for (int e = 0; e < 8; ++e) { const f32x4 kj = *(const LAS f32x4*)(ks + (jg + 8 * e) * QS_ST + 4 * d4);
                ak[e] += (ki.x * kj.x + ki.y * kj.y) + (ki.z * kj.z + ki.w * kj.w); aq[e] += (qi.x * kj.x + qi.y * kj.y) + (qi.z * kj.z + qi.w * kj.w); } }
        const float gi = gc[i], bi = beta[i]; bf16* QK = (bf16*)(ud + GU_QK);
#pragma unroll
        for (int e = 0; e < 8; ++e) { const int j = jg + 8 * e; const float dec = (i >= j) ? expf(gi - gc[j]) : 0.f;
            am[i * AM_ST + j] = (i > j) ? bi * ak[e] * dec : 0.f; QK[i * 64 + j] = (bf16)f2bf(aq[e] * dec); } }
    __syncthreads();
    if (tid < 256) {
        const bool isU = tid < 128; const int cc = tid & 127; const LAS float* src = (isU ? vs : ks) + cc;
        float* U = (float*)(ud + GU_U); bf16* W = (bf16*)(ud + GU_W);
        float sol[64];
#pragma unroll
        for (int i = 0; i < 64; ++i) {
            float acc = src[i * QS_ST] * beta[i]; if (!isU) acc *= eg[i];
#pragma unroll
            for (int j4 = 0; j4 < (i + 3) / 4; ++j4) { const f32x4 a = *(const LAS f32x4*)(am + i * AM_ST + 4 * j4);
                if (4 * j4 + 0 < i) acc -= a.x * sol[4 * j4 + 0]; if (4 * j4 + 1 < i) acc -= a.y * sol[4 * j4 + 1];
                if (4 * j4 + 2 < i) acc -= a.z * sol[4 * j4 + 2]; if (4 * j4 + 3 < i) acc -= a.w * sol[4 * j4 + 3]; }
            sol[i] = acc;
            if (isU) U[i * 128 + cc] = acc; else W[i * 128 + cc] = (bf16)f2bf(acc);
        }
    } else {
        const int t = tid - 256; bf16* QD = (bf16*)(ud + GU_QD); bf16* KDT = (bf16*)(ud + GU_KDT);
#pragma unroll 4
        for (int k = 0; k < 32; ++k) { const int idx = t + 256 * k, i = idx >> 7, d = idx & 127; QD[idx] = (bf16)f2bf(qs[i * QS_ST + d] * eg[i]); }
#pragma unroll 4
        for (int k = 0; k < 32; ++k) { const int idx = t + 256 * k, d = idx >> 6, j = idx & 63; KDT[idx] = (bf16)f2bf(ks[j * QS_ST + d] * ek[j]); }
        if (t == 0) *(float*)(ud + GU_GL) = eg[63];
    }
    __syncthreads();
}

typedef float f32x16 __attribute__((ext_vector_type(16)));
typedef short s16x4 __attribute__((ext_vector_type(4)));
#define KSWZ(row, colB) ((row) * 256 + ((colB) ^ (((row) & 7) << 4)))
#define SBAR() __builtin_amdgcn_sched_barrier(0)
__device__ __forceinline__ int crow(int r, int hi) { return (r & 3) + 8 * (r >> 2) + 4 * hi; }
__device__ __forceinline__ unsigned cvtpk(float lo, float hi) { unsigned r; asm volatile("v_cvt_pk_bf16_f32 %0, %1, %2" : "=v"(r) : "v"(lo), "v"(hi)); return r; }
__device__ __forceinline__ void qkt(f32x16& p0, f32x16& p1, const LAS unsigned char* Ks, const bf16x8* qr, int r32, int hi) {
    p0 = f32x16{}; p1 = f32x16{};
#pragma unroll
    for (int d0 = 0; d0 < 8; ++d0) { const int cb = (d0 * 16 + hi * 8) * 2;
        const bf16x8 b0 = *(const LAS bf16x8*)(Ks + KSWZ(r32, cb)), b1 = *(const LAS bf16x8*)(Ks + KSWZ(32 + r32, cb));
        p0 = __builtin_amdgcn_mfma_f32_32x32x16_bf16(b0, qr[d0], p0, 0, 0, 0);
        p1 = __builtin_amdgcn_mfma_f32_32x32x16_bf16(b1, qr[d0], p1, 0, 0, 0); }
}
__device__ __forceinline__ int v_st(int k, int c) { const int kk = (k & ~0xC) | ((k & 4) << 1) | ((k & 8) >> 1); return ((kk >> 3) * 4 + (c >> 5)) * 512 + ((kk & 7) * 32 + (c & 31)) * 2; }
__device__ __forceinline__ int v_rd_base(int lane) { return ((lane & 3) << 3) | (((lane >> 2) & 3) << 6) | (((lane >> 4) & 1) << 5) | (((lane >> 5) & 1) << 8); }
constexpr int v_rd_off(int d0, int ks, int half) { return d0 * 512 + ks * 4096 + half * 2048; }
template <int OFF> __device__ __forceinline__ s16x4 tr_read(int vb) { s16x4 r; asm volatile("ds_read_b64_tr_b16 %0, %1 offset:%2" : "=&v"(r) : "v"(vb), "i"(OFF) : "memory"); return r; }
template <int D0> __device__ __forceinline__ void pv_one(f32x16& od, int vb, bf16x8 pa0, bf16x8 pa1, bf16x8 pa2, bf16x8 pa3) {
    const s16x4 l0 = tr_read<v_rd_off(D0, 0, 0)>(vb), h0 = tr_read<v_rd_off(D0, 0, 1)>(vb), l1 = tr_read<v_rd_off(D0, 1, 0)>(vb), h1 = tr_read<v_rd_off(D0, 1, 1)>(vb);
    const s16x4 l2 = tr_read<v_rd_off(D0, 2, 0)>(vb), h2 = tr_read<v_rd_off(D0, 2, 1)>(vb), l3 = tr_read<v_rd_off(D0, 3, 0)>(vb), h3 = tr_read<v_rd_off(D0, 3, 1)>(vb);
    asm volatile("s_waitcnt lgkmcnt(0)" ::: "memory"); SBAR();
#define PK(L, H) (bf16x8){L[0], L[1], L[2], L[3], H[0], H[1], H[2], H[3]}
    od = __builtin_amdgcn_mfma_f32_32x32x16_bf16(pa0, PK(l0, h0), od, 0, 0, 0);
    od = __builtin_amdgcn_mfma_f32_32x32x16_bf16(pa1, PK(l1, h1), od, 0, 0, 0);
    od = __builtin_amdgcn_mfma_f32_32x32x16_bf16(pa2, PK(l2, h2), od, 0, 0, 0);
    od = __builtin_amdgcn_mfma_f32_32x32x16_bf16(pa3, PK(l3, h3), od, 0, 0, 0);
#undef PK
}
constexpr int ATT_V = 0, ATT_K = 16384, ATT_WS = 32768;
__device__ __forceinline__ void attn_unit(Frame& F, const Ptrs& P, int a) {
    constexpr float SCALE = 0.088388347648318440f, C = SCALE * 1.4426950408889634f;
    int tid_ = F.tid; asm volatile("" : "+v"(tid_));
    const int tid = tid_, wid = F.wave, lane = tid & 63, r32 = lane & 31, hi = lane >> 5;
    const bool isp = a < 512; const int kvh = a & 3, ab = isp ? (a >> 7) : ((a - 512) >> 2), ac = isp ? ((a >> 2) & 31) : 0;
    const int qrow0 = isp ? ab * SEQ_P + 64 * ac : ROW_S + ab * SEQ_S, pos0 = isp ? NMETA + 64 * ac : NMETA + PAST;
    LAS unsigned char* V_lds = F.lds + ATT_V; LAS unsigned char* K_lds = F.lds + ATT_K;
    LAS float* ws = (LAS float*)(F.lds + ATT_WS) + wid * 64; LAS float* li_l = ws; LAS float* al_l = ws + 32;
    const int g = wid >> 1, qoff = 32 * (wid & 1), hq = kvh * 4 + g;
    bf16x8 qr[8];
    { const bf16* qp = P.H + (size_t)(qrow0 + qoff + r32) * DINP + C_Q + hq * HD + hi * 8; const GAS f32x2v* cs = (const GAS f32x2v*)P.ROPE + (size_t)(pos0 + qoff + r32) * 64 + hi * 8;
#pragma unroll
        for (int d0 = 0; d0 < 4; ++d0) { const v4u lo = *(const GAS v4u*)(qp + d0 * 16), hh = *(const GAS v4u*)(qp + 64 + d0 * 16);
            const unsigned lw[4] = {lo.x, lo.y, lo.z, lo.w}, hw[4] = {hh.x, hh.y, hh.z, hh.w}; unsigned o1[4], o2[4];
#pragma unroll
            for (int j = 0; j < 4; ++j) { const f32x2v c0 = cs[d0 * 16 + 2 * j], c1 = cs[d0 * 16 + 2 * j + 1];
                const float a0 = bf2f(lw[j] & 0xffffu), a1 = bf2f(lw[j] >> 16), b0 = bf2f(hw[j] & 0xffffu), b1 = bf2f(hw[j] >> 16);
                o1[j] = cvtpk(a0 * c0.x - b0 * c0.y, a1 * c1.x - b1 * c1.y); o2[j] = cvtpk(b0 * c0.x + a0 * c0.y, b1 * c1.x + a1 * c1.y); }
            const v4u w1 = {o1[0], o1[1], o1[2], o1[3]}, w2 = {o2[0], o2[1], o2[2], o2[3]};
            qr[d0] = __builtin_bit_cast(bf16x8, w1); qr[d0 + 4] = __builtin_bit_cast(bf16x8, w2); } }
    float m_reg = -1e30f, l_reg = 0.f; f32x16 o[4] = {};
    const int sr = tid >> 4, sc = (tid & 15) * 8, vst0 = v_st(sr, sc), vst1 = v_st(32 + sr, sc);
    const int vb0 = (int)(size_t)V_lds + v_rd_base(lane);
#pragma unroll
    for (int t = 0; t < 4; ++t) {
        int krow_t; bool kval_t = true;
        if (t == 0) krow_t = isp ? ROW_M : KVR_SMETA + ab * NMETA;
        else if (isp) { const int cc = ac - 3 + t; kval_t = cc >= 0; krow_t = ab * SEQ_P + 64 * (cc < 0 ? 0 : cc); }
        else krow_t = (t == 3) ? ROW_S + ab * SEQ_S : KVR_SWIN + ab * WIN + 64 * (t - 1);
        if (kval_t) {
        const int ra = (t == 0) ? (sr & 15) : sr, rb = (t == 0) ? (sr & 15) : 32 + sr;
        const bf16* kp = P.KB + (size_t)krow_t * KVW + kvh * HD + sc; const bf16* vp = P.VB + (size_t)krow_t * KVW + kvh * HD + sc;
        const v4u k0 = *(const GAS v4u*)(kp + (size_t)ra * KVW), k1 = *(const GAS v4u*)(kp + (size_t)rb * KVW), v0 = *(const GAS v4u*)(vp + (size_t)ra * KVW), v1 = *(const GAS v4u*)(vp + (size_t)rb * KVW);
        __syncthreads();
        *(LAS v4u*)(V_lds + vst0) = v0; *(LAS v4u*)(V_lds + vst1) = v1; *(LAS v4u*)(K_lds + KSWZ(sr, sc * 2)) = k0; *(LAS v4u*)(K_lds + KSWZ(32 + sr, sc * 2)) = k1;
        __syncthreads();
        f32x16 p0, p1; qkt(p0, p1, K_lds, qr, r32, hi);
        if (t == 0) {
#pragma unroll
            for (int r = 8; r < 16; ++r) p0[r] = -INFINITY;
#pragma unroll
            for (int r = 0; r < 16; ++r) p1[r] = -INFINITY; }
        float pmax = p0[0];
#pragma unroll
        for (int r = 1; r < 16; ++r) pmax = fmaxf(pmax, p0[r]);
#pragma unroll
        for (int r = 0; r < 16; ++r) pmax = fmaxf(pmax, p1[r]);
        { auto rr = __builtin_amdgcn_permlane32_swap(__float_as_uint(pmax), __float_as_uint(pmax), false, false); pmax = fmaxf(__uint_as_float(rr[0]), __uint_as_float(rr[1])); }
        const float mn = fmaxf(m_reg, pmax), alpha = __builtin_amdgcn_exp2f((m_reg - mn) * C), mnC = -mn * C; m_reg = mn;
        float ps = 0.f;
#pragma unroll
        for (int r = 0; r < 16; ++r) { p0[r] = __builtin_amdgcn_exp2f(fmaf(p0[r], C, mnC)); p1[r] = __builtin_amdgcn_exp2f(fmaf(p1[r], C, mnC)); ps += p0[r] + p1[r]; }
        { auto rr = __builtin_amdgcn_permlane32_swap(__float_as_uint(ps), __float_as_uint(ps), false, false); ps = __uint_as_float(rr[0]) + __uint_as_float(rr[1]); }
        l_reg = l_reg * alpha + ps;
        if (hi == 0) al_l[r32] = alpha;
        asm volatile("s_waitcnt lgkmcnt(0)" ::: "memory");
#pragma unroll
        for (int d = 0; d < 4; ++d)
#pragma unroll
            for (int r = 0; r < 16; ++r) o[d][r] *= al_l[crow(r, hi)];
        bf16x8 pa0, pa1, pa2, pa3;
#define PK4(Pv, BASE, OUT) do { unsigned a0 = cvtpk(Pv[BASE + 0], Pv[BASE + 1]), a1 = cvtpk(Pv[BASE + 2], Pv[BASE + 3]);   \
    unsigned b0 = cvtpk(Pv[BASE + 4], Pv[BASE + 5]), b1 = cvtpk(Pv[BASE + 6], Pv[BASE + 7]);                              \
    auto r0 = __builtin_amdgcn_permlane32_swap(a0, b0, false, false); auto r1 = __builtin_amdgcn_permlane32_swap(a1, b1, false, false); \
    v4u w = {r0[0], r1[0], r0[1], r1[1]}; OUT = __builtin_bit_cast(bf16x8, w); } while (0)
        PK4(p0, 0, pa0); PK4(p0, 8, pa1); PK4(p1, 0, pa2); PK4(p1, 8, pa3);
#undef PK4
        SBAR();
        pv_one<0>(o[0], vb0, pa0, pa1, pa2, pa3); pv_one<1>(o[1], vb0, pa0, pa1, pa2, pa3); pv_one<2>(o[2], vb0, pa0, pa1, pa2, pa3); pv_one<3>(o[3], vb0, pa0, pa1, pa2, pa3);
        }
    }
    l_reg += __builtin_amdgcn_exp2f(P.in[I_SINK][hq] * 1.4426950408889634f - m_reg * C);
    if (hi == 0) li_l[r32] = l_reg;
    asm volatile("s_waitcnt lgkmcnt(0)" ::: "memory");
    bf16* Ow = P.MIX + (size_t)(qrow0 + qoff) * D + hq * HD;
#pragma unroll
    for (int r = 0; r < 16; ++r) { const int orow = crow(r, hi); const float rl = __builtin_amdgcn_rcpf(li_l[orow]);
#pragma unroll
        for (int d0 = 0; d0 < 4; ++d0) Ow[(size_t)orow * D + d0 * 32 + r32] = (bf16)f2bf(o[d0][r] * rl); }
    __syncthreads();
}

constexpr int SC_WAVE_BYTES = 16 * 136 * 2 + 16 * 72 * 2, SC_SSQ_OFF = 8 * SC_WAVE_BYTES;
typedef const GAS unsigned char* gcp;
template <class T> __device__ __forceinline__ T ldg_u(gcp ubase, unsigned voff) { return *(const GAS T*)(ubase + voff); }
__device__ __forceinline__ void gdn_scan_seq(Frame& F, const Ptrs& P, int kind  , int b, int h) {
    int lane_ = F.lane; asm volatile("" : "+v"(lane_));
    const int w = F.wave, lane = lane_, c16 = lane & 15, q4 = lane >> 4;
    LAS unsigned char* wl = F.lds + w * SC_WAVE_BYTES;
    LAS bf16* ST = (LAS bf16*)wl; LAS bf16* VT = (LAS bf16*)(wl + 16 * 136 * 2); LAS float* SSQ = (LAS float*)(F.lds + SC_SSQ_OFF);
    const unsigned ecol = (unsigned)(16 * w + c16);
    const unsigned vo128 = (unsigned)(c16 * 256 + q4 * 16);
    const unsigned vo64 = (unsigned)(c16 * 128 + q4 * 16);
    const unsigned voU = (unsigned)(q4 * 2048) + ecol * 4u;
    f32x4 S[8];
    if (kind == 2) { gcp s0 = (gcp)(P.in[I_SGDN] + (size_t)(b * NHG + h) * 128 * 128);
#pragma unroll
        for (int db = 0; db < 8; ++db)
#pragma unroll
            for (int r = 0; r < 4; ++r) S[db][r] = ldg_u<float>(s0 + db * 8192, voU + r * 512); }
    else {
#pragma unroll
        for (int db = 0; db < 8; ++db) S[db] = (f32x4){0.f, 0.f, 0.f, 0.f}; }
    const int nsteps = kind == 0 ? 33 : 1;
    const float nw = P.in[I_NORMW][ecol];
    for (int step = 0; step < nsteps; ++step) {
        const int uidx = kind == 2 ? 2064 + b * NHG + h : (step == 0 ? 2048 + h : (b * NHG + h) * 32 + step - 1);
        gcp ud = (gcp)(P.GDN + (size_t)uidx * GU_BYTES);
        const float gl = *(const GAS float*)(ud + GU_GL);
        const bool has_out = !(kind == 0 && step == 0);
#pragma unroll
        for (int db = 0; db < 8; ++db) { u32x2v pk; pk.x = pk2(S[db][0], S[db][1]); pk.y = pk2(S[db][2], S[db][3]); *(LAS u32x2v*)(ST + c16 * 136 + 16 * db + 4 * q4) = pk; }
        bf16x8 Bs[4];
#pragma unroll
        for (int s = 0; s < 4; ++s) Bs[s] = *(const LAS bf16x8*)(ST + c16 * 136 + 32 * s + 8 * q4);
        f32x4 vn[4];
#pragma unroll
        for (int m = 0; m < 4; ++m) { f32x4 acc = {0.f, 0.f, 0.f, 0.f};
#pragma unroll
            for (int s = 0; s < 4; ++s) { const bf16x8 A = ldg_u<bf16x8>(ud + GU_W + m * 4096, vo128 + s * 64); acc = __builtin_amdgcn_mfma_f32_16x16x32_bf16(A, Bs[s], acc, 0, 0, 0); }
#pragma unroll
            for (int r = 0; r < 4; ++r) vn[m][r] = ldg_u<float>(ud + GU_U + m * 8192, voU + r * 512) - acc[r]; }
#pragma unroll
        for (int m = 0; m < 4; ++m) { u32x2v pk; pk.x = pk2(vn[m][0], vn[m][1]); pk.y = pk2(vn[m][2], vn[m][3]); *(LAS u32x2v*)(VT + c16 * 72 + 16 * m + 4 * q4) = pk; }
        bf16x8 Bv[2];
#pragma unroll
        for (int s = 0; s < 2; ++s) Bv[s] = *(const LAS bf16x8*)(VT + c16 * 72 + 32 * s + 8 * q4);
        f32x4 o[4];
        if (has_out) {
#pragma unroll
            for (int m = 0; m < 4; ++m) { f32x4 acc = {0.f, 0.f, 0.f, 0.f};
#pragma unroll
                for (int s = 0; s < 4; ++s) { const bf16x8 A = ldg_u<bf16x8>(ud + GU_QD + m * 4096, vo128 + s * 64); acc = __builtin_amdgcn_mfma_f32_16x16x32_bf16(A, Bs[s], acc, 0, 0, 0); }
#pragma unroll
                for (int s = 0; s < 2; ++s) { const bf16x8 A = ldg_u<bf16x8>(ud + GU_QK + m * 2048, vo64 + s * 64); acc = __builtin_amdgcn_mfma_f32_16x16x32_bf16(A, Bv[s], acc, 0, 0, 0); }
                o[m] = acc; } }
#pragma unroll
        for (int db = 0; db < 8; ++db) { f32x4 acc = S[db] * gl;
#pragma unroll
            for (int s = 0; s < 2; ++s) { const bf16x8 A = ldg_u<bf16x8>(ud + GU_KDT + db * 2048, vo64 + s * 64); acc = __builtin_amdgcn_mfma_f32_16x16x32_bf16(A, Bv[s], acc, 0, 0, 0); }
            S[db] = acc; }
        if (has_out) {
#pragma unroll
            for (int m = 0; m < 4; ++m)
#pragma unroll
                for (int r = 0; r < 4; ++r) { float p = o[m][r] * o[m][r]; p += __shfl_xor(p, 1); p += __shfl_xor(p, 2); p += __shfl_xor(p, 4); p += __shfl_xor(p, 8);
                    if (c16 == 0) SSQ[w * 64 + 16 * m + 4 * q4 + r] = p; }
            __syncthreads();
            const int rbase = kind == 0 ? b * SEQ_P + 64 * (step - 1) : ROW_S + b * SEQ_S;
            gcp zb = (gcp)(P.H + (size_t)rbase * DINP + C_Z + h * 128); GAS unsigned char* mb = (GAS unsigned char*)(P.MIX + (size_t)rbase * D + 2048 + h * 128);
#pragma unroll
            for (int m = 0; m < 4; ++m)
#pragma unroll
                for (int r = 0; r < 4; ++r) { const int i = 16 * m + 4 * q4 + r; float tot = 0.f;
#pragma unroll
                    for (int ww = 0; ww < 8; ++ww) tot += SSQ[ww * 64 + i];
                    const float rstd = rsqrtf(tot * (1.f / 128.f) + RMS_EPS);
                    const float z = bf2f(ldg_u<unsigned short>(zb, (unsigned)i * (DINP * 2) + ecol * 2u));
                    *(GAS unsigned short*)(mb + ((unsigned)i * (D * 2) + ecol * 2u)) = (unsigned short)f2bf(o[m][r] * rstd * nw * silu1(z)); }
            __syncthreads();
        }
    }
    GAS unsigned char* dst = (GAS unsigned char*)((kind == 0 ? P.out + O_PGDN : P.out + O_SGDN) + (size_t)(b * NHG + h) * 128 * 128);
#pragma unroll
    for (int db = 0; db < 8; ++db)
#pragma unroll
        for (int r = 0; r < 4; ++r) *(GAS float*)(dst + db * 8192 + (voU + r * 512)) = S[db][r];
    __syncthreads();
}

struct Args { const float* in[N_IN]; float* out; unsigned char* ws; int ph_lo, ph_hi; };
static_assert(sizeof(Args) == (N_IN + 2) * 8 + 8, "Args has no padding");
__global__ void __launch_bounds__(NWAVES * 64, 2) fwd_kernel(Args args) {
    extern __shared__ __attribute__((aligned(16))) unsigned char lds[];
    Frame F;
    F.lds = (LAS unsigned char*)lds;
    F.MISC = (volatile LAS unsigned*)(F.lds + MISC_OFF);
    F.tid = threadIdx.x; F.lane = F.tid & 63; F.wave = __builtin_amdgcn_readfirstlane(F.tid >> 6);
    F.G = gridDim.x; { const int bx = blockIdx.x; F.vcu = (F.G % 8 == 0) ? (bx % 8) * (F.G / 8) + bx / 8 : bx; }
    unsigned char* ws = args.ws;
    F.ctl = (gu32*)(ws + WS_CTL);
    Ptrs P;
#pragma unroll
    for (int i = 0; i < N_IN; ++i) P.in[i] = args.in[i];
    P.out = args.out;
    P.Wgu1 = (bf16*)(ws + WS_WGU1); P.Wd1 = (bf16*)(ws + WS_WD1); P.Wgu2 = (bf16*)(ws + WS_WGU2); P.Wd2 = (bf16*)(ws + WS_WD2); P.Win = (bf16*)(ws + WS_WIN); P.Wout = (bf16*)(ws + WS_WOUT);
    P.XN = (bf16*)(ws + WS_XN); P.MIX = (bf16*)(ws + WS_MIX); P.H = (bf16*)(ws + WS_H); P.KB = (bf16*)(ws + WS_KB); P.VB = (bf16*)(ws + WS_VB);
    P.Y = (float*)(ws + WS_Y); P.ROPE = (float*)(ws + WS_ROPE); P.GDN = ws + WS_GDN;
    for (int u = F.tid; u < (LDS_BYTES - LDSCTL_OFF) / 4; u += NWAVES * 64) ((LAS unsigned*)(F.lds + LDSCTL_OFF))[u] = 0u;
    __syncthreads();
    XcdBarrier bar; bar.bar = (unsigned*)(F.ctl + CW_BAR); bar.x = 0; bar.st = nullptr;
    if (N_LAUNCHES == 1) bar = xcd_barrier_post((unsigned*)(F.ctl + CW_BAR), F.MISC + 8);
#define GRID_BAR() do { if (N_LAUNCHES == 1) xcd_barrier(bar); } while (0)
    const int lo = args.ph_lo, hi = args.ph_hi;
#define IN(k) (lo <= (k) && (k) < hi)
#define BOTH(k) (IN(k) && IN((k) + 1))

    if (IN(0)) { p0_prologue(F, P); if (BOTH(0)) GRID_BAR(); }
    if (IN(1)) { pg8::Gemm g{P.XN, P.Wgu1, M1, NGU, D}; pg8::StaticOrder S; S.init(M1, NGU, F.G, (int)blockIdx.x);
        pg8::EpiSwiGLU E{P.H, FF};
        pg8::gemm_phase<pg8::EpiSwiGLU, pg8::StaticOrder, true, true>(F.lds + RING_OFF, g, S, E);
        if (BOTH(1)) GRID_BAR(); }
    if (IN(2)) { pg8::Gemm g{P.H, P.Wd1, M1, D, FF}; pg8::StaticOrder S; S.init(M1, D, F.G, (int)blockIdx.x);
        typedef pg8::EpiResF32<0, true> Epi; Epi E{P.Y, D, pg8::RowSrc<0>{P.in[I_XP], P.in[I_XS], P.in[I_META], ROW_S, ROW_M, M1V, D}};
        pg8::gemm_phase<Epi, pg8::StaticOrder, true, true>(F.lds + RING_OFF, g, S, E);
        if (BOTH(2)) GRID_BAR(); }
    if (IN(3)) { ln_phase(F, P.Y, P.Y, P.XN, P.in[I_LNG], P.in[I_LNB], M1V); if (BOTH(3)) GRID_BAR(); }
    if (IN(4)) { pg8::Gemm g{P.XN, P.Win, M1, DINP, D}; pg8::StaticOrder S; S.init(M1, DINP, F.G, (int)blockIdx.x);
        pg8::EpiStoreBf16 E{P.H, DINP};
        pg8::gemm_phase<pg8::EpiStoreBf16, pg8::StaticOrder, true, true>(F.lds + RING_OFF, g, S, E);
        if (BOTH(4)) GRID_BAR(); }
    if (IN(5)) { kv_prep(F, P);
        for (int u = blockIdx.x; u < N_GUNITS; u += F.G) gdn_prep_unit(F, P, u);
        if (BOTH(5)) GRID_BAR(); }
    if (IN(6)) {
        int it = blockIdx.x, st = F.G;
        if (F.G > 64) st = (it < 64) ? (1 << 20) : F.G - 64;
        for (; it < 896; it += st) {
            if (it < 320) { const int s = it < 64 ? it : it - 64; gdn_scan_seq(F, P, it < 64 ? 0 : 2, s >> 4, s & 15); }
            else attn_unit(F, P, it - 320);
        }
        if (BOTH(6)) GRID_BAR(); }
    if (IN(7)) { pg8::Gemm g{P.MIX, P.Wout, M2, D, D}; pg8::StaticOrder S; S.init(M2, D, F.G, (int)blockIdx.x);
        typedef pg8::EpiResF32<1, false> Epi; Epi E{P.Y, D, pg8::RowSrc<1>{P.Y, P.Y, P.Y, M2, M2, M2, D}};
        pg8::gemm_phase<Epi, pg8::StaticOrder, true, true>(F.lds + RING_OFF, g, S, E);
        if (BOTH(7)) GRID_BAR(); }
    if (IN(8)) { ln_phase(F, P.Y, P.Y, P.XN, P.in[I_LNG] + D, P.in[I_LNB] + D, M2); if (BOTH(8)) GRID_BAR(); }
    if (IN(9)) { pg8::Gemm g{P.XN, P.Wgu2, M2, NGU, D}; pg8::StaticOrder S; S.init(M2, NGU, F.G, (int)blockIdx.x);
        pg8::EpiSwiGLU E{P.H, FF};
        pg8::gemm_phase<pg8::EpiSwiGLU, pg8::StaticOrder, true, true>(F.lds + RING_OFF, g, S, E);
        if (BOTH(9)) GRID_BAR(); }
    if (IN(10)) { pg8::Gemm g{P.H, P.Wd2, M2, D, FF}; pg8::StaticOrder S; S.init(M2, D, F.G, (int)blockIdx.x);
        typedef pg8::EpiResF32<1, true> Epi; Epi E{P.Y, D, pg8::RowSrc<1>{P.Y, P.Y, P.Y, M2, M2, M2, D}};
        pg8::gemm_phase<Epi, pg8::StaticOrder, true, true>(F.lds + RING_OFF, g, S, E);
        if (BOTH(10)) GRID_BAR(); }
    if (IN(11)) { ln_phase(F, P.Y, P.out + O_YP, nullptr, P.in[I_LNG] + 2 * D, P.in[I_LNB] + 2 * D, M2); }
#undef IN
#undef BOTH
#undef GRID_BAR
}

extern "C" void kernel_launch(void* const* d_in, const int* in_sizes, int n_in, void* d_out, int out_size, void* d_ws, size_t ws_size, hipStream_t stream) {
    static int grid = 0;
    if (grid == 0) {
        if (n_in != N_IN || in_sizes[I_XP] != ROW_S * D || in_sizes[I_WIN] != D * DIN || (size_t)out_size != O_END || ws_size < WS_END) {
            fprintf(stderr, "kernel_launch: shape mismatch: n_in %d in0 %d out %d ws %zu (need %zu); nothing launched\n", n_in, n_in > 0 ? in_sizes[0] : -1, out_size, ws_size, (size_t)WS_END); grid = -1; return; }
        int dev = 0, cus = 0, per_cu = 0;
        if (hipGetDevice(&dev) != hipSuccess || hipDeviceGetAttribute(&cus, hipDeviceAttributeMultiprocessorCount, dev) != hipSuccess) { fprintf(stderr, "kernel_launch: device query failed\n"); grid = -1; return; }
        if (hipFuncSetAttribute((const void*)fwd_kernel, hipFuncAttributeMaxDynamicSharedMemorySize, LDS_BYTES) != hipSuccess) { fprintf(stderr, "kernel_launch: hipFuncSetAttribute failed\n"); grid = -1; return; }
        if (hipOccupancyMaxActiveBlocksPerMultiprocessor(&per_cu, (const void*)fwd_kernel, NWAVES * 64, LDS_BYTES) != hipSuccess || per_cu < 1)
            fprintf(stderr, "kernel_launch: note: occupancy query reports %d workgroups per CU\n", per_cu);
        (void)hipGetLastError();
        grid = cus;
    }
    if (grid < 0) return;
    if (hipMemsetAsync((char*)d_ws + WS_CTL, 0, CTL_ZERO_BYTES, stream) != hipSuccess) { fprintf(stderr, "kernel_launch: hipMemsetAsync failed\n"); return; }
    Args a{};
    for (int i = 0; i < N_IN; ++i) a.in[i] = (const float*)d_in[i];
    a.out = (float*)d_out; a.ws = (unsigned char*)d_ws;
    for (int li = 0; li < N_LAUNCHES; ++li) {
        a.ph_lo = (N_LAUNCHES == 1) ? 0 : li; a.ph_hi = (N_LAUNCHES == 1) ? N_PHASES : li + 1;
        hipLaunchKernelGGL(fwd_kernel, dim3(grid), dim3(NWAVES * 64), LDS_BYTES, stream, a);
        const hipError_t le = hipPeekAtLastError();
        if (le != hipSuccess) { fprintf(stderr, "kernel_launch: launch %d failed: %s\n", li, hipGetErrorName(le)); break; }
    }
}
```

```cpp
#include <hip/hip_runtime.h>
#include <cstdio>
#include <cstdint>
namespace pg8 {
#define PG8_LAS __attribute__((address_space(3)))
typedef unsigned short bf16_t;
typedef short bf16x8 __attribute__((ext_vector_type(8)));
typedef float f32x4 __attribute__((ext_vector_type(4)));
typedef unsigned u32x4 __attribute__((ext_vector_type(4)));
typedef int i32x4 __attribute__((ext_vector_type(4)));
constexpr int BM = 256, BK = 64, HALF = 128, HTB = HALF * BK * 2  , STAGE_BYTES = 8 * HTB, NXCD = 8, WGM = 8;

__host__ __device__ __forceinline__ int lds_byte(int r, int c) { const int st = (r >> 4) * 2 + (c >> 5), rr = r & 15, cc = c & 31, ob = rr * 64 + cc * 2; return st * 1024 + (ob ^ (((ob >> 9) & 1) << 5)); }
__host__ __device__ __forceinline__ void stage_rc(int b, int& R, int& C) { const int st = b / 1024, sb = b % 1024, swz = sb ^ (((sb >> 9) & 1) << 5); R = (st >> 1) * 16 + swz / 64; C = (st & 1) * 32 + (swz % 64) / 2; }
__host__ __device__ __forceinline__ int perm32(int rho) { const int n = rho >> 4, i = rho & 15; return 8 * (i >> 2) + 4 * n + (i & 3); }

struct Unit { int pm, pn, k0, nt, sl, ri; };
struct Gemm { const bf16_t* A; const bf16_t* Bt; int M, N, K; };

struct StaticOrder {
    int nM, nN, nwg, G, c, ntk, kb;
    __host__ __device__ void init(int M, int N, int K, int G_, int c_) { nM = M / BM; nN = N / BM; nwg = nM * nN; G = G_; c = c_; ntk = K / BK; kb = 0; }
    __host__ __device__ void set_k(int kb_, int ntk_) { kb = kb_; ntk = ntk_; }
    __host__ __device__ void map(int L, Unit& u) const {
        int wgid = L; { const int q = nwg / NXCD, r = nwg % NXCD, xcd = wgid % NXCD, off = wgid / NXCD; wgid = (xcd < r ? xcd * (q + 1) : r * (q + 1) + (xcd - r) * q) + off; }
        const int nig = WGM * nN, gid = wgid / nig, fm = gid * WGM, gsz = (nM - fm) < WGM ? (nM - fm) : WGM;
        u.pm = fm + ((wgid % nig) % gsz); u.pn = (wgid % nig) / gsz; }
    __host__ __device__ int inv(int pm, int pn) const {
        const int nig = WGM * nN, gid = pm / WGM, fm = gid * WGM, gsz = (nM - fm) < WGM ? (nM - fm) : WGM; const int w = gid * nig + pn * gsz + (pm - fm);
        const int q = nwg / NXCD, r = nwg % NXCD; int xcd, off;
        if (w < r * (q + 1)) { xcd = w / (q + 1); off = w - xcd * (q + 1); } else { const int w2 = w - r * (q + 1); const int t = w2 / q; xcd = r + t; off = w2 - t * q; }
        return off * NXCD + xcd; }
    __host__ __device__ bool next(int i, Unit& u) const {
        const long L = (long)i * G + c; if (L >= nwg) return false;
        map((int)L, u); u.k0 = kb; u.nt = ntk; u.sl = 0; u.ri = -1; return true;
    }
    __device__ __forceinline__ void a_ready(const Unit&) const {}
    __device__ __forceinline__ void done(const Unit&) const {}
};
struct SplitOrder : StaticOrder {
    int R, rem, S;
    __host__ __device__ void init(int M, int N, int K, int G_, int c_, int S_) { StaticOrder::init(M, N, K, G_, c_); R = nwg / G; rem = nwg - R * G; S = S_; }
    __host__ __device__ bool next(int i, Unit& u) const {
        if (i < R) { map(i * G + c, u); u.k0 = kb; u.nt = ntk; u.sl = 0; u.ri = -1; return true; }
        const int j = (i - R) * G + c; if (j >= rem * S) return false;
        const int ri = j / S, s = j - ri * S, h = ntk / 2; map(R * G + ri, u);
        const int o0 = 2 * ((h * s) / S); u.k0 = kb + o0; u.nt = 2 * ((h * (s + 1)) / S) - o0; u.sl = s; u.ri = ri; return true;
    }
};

__device__ __forceinline__ unsigned cvt_pk_bf16(float lo, float hi) { unsigned r; asm volatile("v_cvt_pk_bf16_f32 %0, %1, %2" : "=v"(r) : "v"(lo), "v"(hi)); return r; }
typedef float f32x2 __attribute__((ext_vector_type(2)));
__device__ __forceinline__ float silu_f(float g) { return g * __builtin_amdgcn_rcpf(1.0f + __builtin_amdgcn_exp2f(-1.4426950408889634f * g)); }
template <bool I8> struct EpiSwiGLU {
    static constexpr bool PERM = true, AFTER_DRAIN = false;
    bf16_t* O; int ldc; float* slab; int S; const float *sA, *sB; unsigned* rmax;
    __device__ __forceinline__ void operator()(const f32x4 (&acc)[2][2][4][2], const Unit& u, int wr, int wc, int fr, int fq) const {
        if (u.ri >= 0) { float* sb = slab + ((size_t)(u.ri * S + u.sl) << 16) + wc * 32 + 8 * fq;
#pragma unroll
            for (int ai = 0; ai < 2; ++ai)
#pragma unroll
                for (int m = 0; m < 4; ++m) { float* o = sb + (ai * HALF + wr * 64 + m * 16 + fr) * BM;
#pragma unroll
                    for (int bj = 0; bj < 2; ++bj)
#pragma unroll
                        for (int n = 0; n < 2; ++n) *(f32x4*)(o + bj * HALF + 4 * n) = acc[ai][bj][m][n]; }
            return; }
        const int row0 = u.pm * BM + wr * 64 + fr, col0 = u.pn * HALF + wc * 32 + 8 * fq;
        f32x4 sbg0 = {1.f, 1.f, 1.f, 1.f}, sbg1 = sbg0, sbu0 = sbg0, sbu1 = sbg0;
        if constexpr (I8) { const int fr0 = u.pn * BM + wc * 32 + 8 * fq;
            sbg0 = *(const f32x4*)(sB + fr0); sbg1 = *(const f32x4*)(sB + fr0 + 4); sbu0 = *(const f32x4*)(sB + fr0 + HALF); sbu1 = *(const f32x4*)(sB + fr0 + HALF + 4); }
#pragma unroll
        for (int ai = 0; ai < 2; ++ai)
#pragma unroll
            for (int m = 0; m < 4; ++m) { bf16_t* rowp = O + (size_t)(row0 + ai * HALF + m * 16) * ldc + col0;
                f32x4 g0 = acc[ai][0][m][0], g1 = acc[ai][0][m][1], u0 = acc[ai][1][m][0], u1 = acc[ai][1][m][1];
                if constexpr (I8) { const float sa = sA[row0 + ai * HALF + m * 16];
                    g0 = __builtin_convertvector(__builtin_bit_cast(i32x4, g0), f32x4) * (sbg0 * sa); g1 = __builtin_convertvector(__builtin_bit_cast(i32x4, g1), f32x4) * (sbg1 * sa);
                    u0 = __builtin_convertvector(__builtin_bit_cast(i32x4, u0), f32x4) * (sbu0 * sa); u1 = __builtin_convertvector(__builtin_bit_cast(i32x4, u1), f32x4) * (sbu1 * sa); }
                u32x4 w;
                w.x = cvt_pk_bf16(silu_f(g0[0]) * u0[0], silu_f(g0[1]) * u0[1]); w.y = cvt_pk_bf16(silu_f(g0[2]) * u0[2], silu_f(g0[3]) * u0[3]);
                w.z = cvt_pk_bf16(silu_f(g1[0]) * u1[0], silu_f(g1[1]) * u1[1]); w.w = cvt_pk_bf16(silu_f(g1[2]) * u1[2], silu_f(g1[3]) * u1[3]);
                *(u32x4*)rowp = w;
                if (rmax) { unsigned mx = 0u;
                    { const unsigned ww_[4] = {w.x, w.y, w.z, w.w};
#pragma unroll
                      for (int k_ = 0; k_ < 4; ++k_) { const unsigned lo_ = (ww_[k_] << 16) & 0x7fff0000u, hi_ = ww_[k_] & 0x7fff0000u; mx = mx > lo_ ? mx : lo_; mx = mx > hi_ ? mx : hi_; } }
                    { const unsigned o_ = (unsigned)__shfl_xor((int)mx, 16); mx = mx > o_ ? mx : o_; } { const unsigned o_ = (unsigned)__shfl_xor((int)mx, 32); mx = mx > o_ ? mx : o_; }
                    if (fq == 0) (void)__hip_atomic_fetch_max(rmax + row0 + ai * HALF + m * 16, mx, __ATOMIC_RELAXED, __HIP_MEMORY_SCOPE_AGENT); } }
    }
};
struct EpiStoreBf16 {
    static constexpr bool PERM = true, AFTER_DRAIN = false;
    bf16_t* O; int ldc;
    __device__ __forceinline__ void operator()(const f32x4 (&acc)[2][2][4][2], const Unit& u, int wr, int wc, int fr, int fq) const {
        const int row0 = u.pm * BM + wr * 64 + fr, col0 = u.pn * BM + wc * 32 + 8 * fq;
#pragma unroll
        for (int ai = 0; ai < 2; ++ai)
#pragma unroll
            for (int m = 0; m < 4; ++m) { bf16_t* rowp = O + (size_t)(row0 + ai * HALF + m * 16) * ldc + col0;
#pragma unroll
                for (int bj = 0; bj < 2; ++bj) { const f32x4 v0 = acc[ai][bj][m][0], v1 = acc[ai][bj][m][1];
                    u32x4 w; w.x = cvt_pk_bf16(v0[0], v0[1]); w.y = cvt_pk_bf16(v0[2], v0[3]); w.z = cvt_pk_bf16(v1[0], v1[1]); w.w = cvt_pk_bf16(v1[2], v1[3]);
                    *(u32x4*)(rowp + bj * HALF) = w; } }
    }
};
template <int MODE> struct RowSrc {
    const float *p0, *p1, *p2; int n0, n1, n2, ld;
    __device__ __forceinline__ const float* row(int r) const {
        if (MODE == 1) return r < n0 ? p0 + (size_t)r * ld : nullptr;
        if (r < n0) return p0 + (size_t)r * ld;
        if (r < n1) return p1 + (size_t)(r - n0) * ld;
        if (r < n2) return p2 + (size_t)(r - n1) * ld;
        return nullptr; }
};
template <int MODE, bool HALF_, bool ALPHA1 = false, bool I8 = false> struct EpiResF32 {
    static constexpr bool PERM = false, AFTER_DRAIN = false;
    float* out; int ldc; RowSrc<MODE> src; float* slab; int S;
    const float *sA, *sB;
    __device__ __forceinline__ void operator()(const f32x4 (&acc)[2][2][4][2], const Unit& u, int wr, int wc, int fr, int fq) const {
        constexpr float alpha = ALPHA1 ? 1.0f : 1.189207115002721f, scale = HALF_ ? 0.5f : 1.0f;
        f32x4 sb_[2][2];
        if constexpr (I8) { const int c0_ = u.pn * BM + wc * 32 + 4 * fq;
#pragma unroll
            for (int bj = 0; bj < 2; ++bj)
#pragma unroll
                for (int n = 0; n < 2; ++n) sb_[bj][n] = *(const f32x4*)(sB + c0_ + bj * HALF + n * 16); }
#define EPI_VAL(ai, bj, m, n, sa_) (I8 ? __builtin_convertvector(__builtin_bit_cast(i32x4, acc[ai][bj][m][n]), f32x4) * (sb_[bj][n] * (sa_)) : acc[ai][bj][m][n])
        if (u.sl > 0) {
            float* sb = slab + ((size_t)(u.ri * (S - 1) + (u.sl - 1)) << 16) + wc * 32 + 4 * fq;
#pragma unroll
            for (int ai = 0; ai < 2; ++ai)
#pragma unroll
                for (int m = 0; m < 4; ++m) { float* o = sb + (ai * HALF + wr * 64 + m * 16 + fr) * BM; float sa_ = 1.f; if constexpr (I8) sa_ = sA[u.pm * BM + ai * HALF + wr * 64 + m * 16 + fr];
#pragma unroll
                    for (int bj = 0; bj < 2; ++bj)
#pragma unroll
                        for (int n = 0; n < 2; ++n) *(f32x4*)(o + bj * HALF + n * 16) = EPI_VAL(ai, bj, m, n, sa_); }
            return; }
        const int col0 = u.pn * BM + wc * 32 + 4 * fq;
#pragma unroll
        for (int ai = 0; ai < 2; ++ai)
#pragma unroll
            for (int m = 0; m < 4; ++m) { const int r = u.pm * BM + ai * HALF + wr * 64 + m * 16 + fr; const float* b = src.row(r);
                if (b) { float* o = out + (size_t)r * ldc; float sa_ = 1.f; if constexpr (I8) sa_ = sA[r];
#pragma unroll
                    for (int bj = 0; bj < 2; ++bj)
#pragma unroll
                        for (int n = 0; n < 2; ++n) { const int c = col0 + bj * HALF + n * 16; const f32x4 bs = *(const f32x4*)(b + c);
                            *(f32x4*)(o + c) = bs * alpha + EPI_VAL(ai, bj, m, n, sa_) * scale; } } }
#undef EPI_VAL
    }
};
template <class Epi, class Sched, bool ALIGN_EPI = false, bool SP2 = false, bool I8 = false>
__device__ __forceinline__ void gemm_phase(PG8_LAS unsigned char* lds, const Gemm g, const Sched& S, const Epi& E) {
    const int tid = threadIdx.x, wid = __builtin_amdgcn_readfirstlane(tid >> 6), lane = tid & 63, wr = wid >> 2, wc = wid & 3, fr = lane & 15, fq = lane >> 4;
    const int K = g.K;
    unsigned voffA[2], voffB[2];
#pragma unroll
    for (int i = 0; i < 2; ++i) { int R, C; stage_rc(tid * 16 + i * 8192, R, C); const int Rb = Epi::PERM ? ((R & ~31) + perm32(R & 31)) : R;
        voffA[i] = (unsigned)(R * K + C) * 2u; voffB[i] = (unsigned)(Rb * K + C) * 2u; }
    const size_t kstep = (size_t)(BK * 2);
    const size_t hstep = (size_t)HALF * K * 2;
    const size_t tstep = 2 * hstep;
    const unsigned ldsw = (unsigned)wid * 1024u;
    const int aoff = lds_byte(wr * 64 + fr, fq * 8), boff = lds_byte(wc * 32 + fr, fq * 8);
#define PG8_SA(b, h) (((b) * 2 + (h)) * HTB)
#define PG8_SB(b, h) ((4 + (b) * 2 + (h)) * HTB)
#define PG8_STAGE(bufoff, gbase, voff) do { _Pragma("unroll") for (int _i = 0; _i < 2; ++_i) \
        __builtin_amdgcn_global_load_lds((const unsigned*)((const char*)(gbase) + (voff)[_i]), (PG8_LAS unsigned*)(lds + (bufoff) + ldsw + _i * 8192), 16, 0, 0); } while (0)
#define PG8_LDA(dst, b, h) do { _Pragma("unroll") for (int m = 0; m < 4; ++m) _Pragma("unroll") for (int k = 0; k < 2; ++k) dst[m][k] = *(const PG8_LAS bf16x8*)(lds + PG8_SA(b, h) + aoff + m * 2048 + k * 1024); } while (0)
#define PG8_LDB(dst, b, h) do { _Pragma("unroll") for (int n = 0; n < 2; ++n) _Pragma("unroll") for (int k = 0; k < 2; ++k) dst[n][k] = *(const PG8_LAS bf16x8*)(lds + PG8_SB(b, h) + boff + n * 2048 + k * 1024); } while (0)
#define PG8_MMA(ai, bj, At, Bt) do { __builtin_amdgcn_s_setprio(1); _Pragma("unroll") for (int m = 0; m < 4; ++m) _Pragma("unroll") for (int n = 0; n < 2; ++n) _Pragma("unroll") for (int k = 0; k < 2; ++k) \
        { if constexpr (I8) acc[ai][bj][m][n] = __builtin_bit_cast(f32x4, __builtin_amdgcn_mfma_i32_16x16x64_i8(__builtin_bit_cast(i32x4, Bt[n][k]), __builtin_bit_cast(i32x4, At[m][k]), __builtin_bit_cast(i32x4, acc[ai][bj][m][n]), 0, 0, 0)); \
          else acc[ai][bj][m][n] = __builtin_amdgcn_mfma_f32_16x16x32_bf16(Bt[n][k], At[m][k], acc[ai][bj][m][n], 0, 0, 0); } __builtin_amdgcn_s_setprio(0); } while (0)
#define PG8_WAIT_V(n) asm volatile("s_waitcnt vmcnt(" #n ")" ::: "memory")
#define PG8_WAIT_L(n) asm volatile("s_waitcnt lgkmcnt(" #n ")" ::: "memory")
#define PG8_BAR __builtin_amdgcn_s_barrier()
#define PG8_SCHED __builtin_amdgcn_sched_barrier(0)
    Unit cur, nxt; int ui = 0;
    if (!S.next(0, cur)) return;
    f32x4 acc[2][2][4][2];
#pragma unroll
    for (int a = 0; a < 2; ++a)
#pragma unroll
        for (int b = 0; b < 2; ++b)
#pragma unroll
            for (int m = 0; m < 4; ++m)
#pragma unroll
                for (int n = 0; n < 2; ++n) acc[a][b][m][n] = (f32x4){0.f, 0.f, 0.f, 0.f};
    bf16x8 At[4][2], B0[2][2], B1[2][2];
    const char* cA = (const char*)g.A + (size_t)cur.pm * tstep + (size_t)cur.k0 * kstep; const char* cB = (const char*)g.Bt + (size_t)cur.pn * tstep + (size_t)cur.k0 * kstep; int nt = cur.nt;
    S.a_ready(cur);
    if constexpr (SP2) {
        PG8_STAGE(PG8_SB(0, 0), cB, voffB); PG8_STAGE(PG8_SB(0, 1), cB + hstep, voffB); PG8_STAGE(PG8_SA(0, 0), cA, voffA); PG8_STAGE(PG8_SA(0, 1), cA + hstep, voffA);
        if (wr == 1) PG8_BAR;
        PG8_WAIT_V(2); PG8_BAR;
        PG8_STAGE(PG8_SB(1, 0), cB + kstep, voffB); PG8_STAGE(PG8_SA(1, 0), cA + kstep, voffA); PG8_STAGE(PG8_SB(1, 1), cB + hstep + kstep, voffB);
        PG8_WAIT_V(6); PG8_BAR;
    } else {
        PG8_STAGE(PG8_SB(0, 0), cB, voffB); PG8_STAGE(PG8_SA(0, 0), cA, voffA); PG8_STAGE(PG8_SB(0, 1), cB + hstep, voffB); PG8_STAGE(PG8_SA(0, 1), cA + hstep, voffA);
        if (wr == 1) PG8_BAR;
        PG8_WAIT_V(4); PG8_BAR;
        PG8_STAGE(PG8_SB(1, 0), cB + kstep, voffB); PG8_STAGE(PG8_SA(1, 0), cA + kstep, voffA); PG8_STAGE(PG8_SB(1, 1), cB + hstep + kstep, voffB);
        PG8_WAIT_V(6); PG8_BAR;
    }
    for (;;) {
        const bool has_next = S.next(ui + 1, nxt);
        const char* nA = has_next ? (const char*)g.A + (size_t)nxt.pm * tstep + (size_t)nxt.k0 * kstep : cA; const char* nB = has_next ? (const char*)g.Bt + (size_t)nxt.pn * tstep + (size_t)nxt.k0 * kstep : cB;
        for (int t = 0; t < nt; t += 2) {
            const bool last = (t == nt - 2);
            const char* a1 = cA + (size_t)(t + 1) * kstep;
            const char* a2 = last ? nA : cA + (size_t)(t + 2) * kstep; const char* b2 = last ? nB : cB + (size_t)(t + 2) * kstep;
            const char* a3 = a2 + kstep; const char* b3 = b2 + kstep;
            if (last && has_next) S.a_ready(nxt);
            if constexpr (SP2) {
            PG8_LDB(B0, 0, 0); PG8_LDB(B1, 0, 1); PG8_SCHED; PG8_LDA(At, 0, 0); PG8_STAGE(PG8_SA(1, 1), a1 + hstep, voffA);
            PG8_WAIT_V(8); PG8_WAIT_L(0); PG8_BAR; PG8_MMA(0, 0, At, B0); PG8_MMA(0, 1, At, B1); PG8_BAR; PG8_SCHED;
            PG8_LDA(At, 0, 1); PG8_STAGE(PG8_SB(0, 0), b2, voffB); PG8_STAGE(PG8_SB(0, 1), b2 + hstep, voffB); PG8_STAGE(PG8_SA(0, 0), a2, voffA);
            PG8_WAIT_V(8); PG8_WAIT_L(0); PG8_BAR; PG8_MMA(1, 0, At, B0); PG8_MMA(1, 1, At, B1); PG8_BAR; PG8_SCHED;
            PG8_LDB(B0, 1, 0); PG8_LDB(B1, 1, 1); PG8_SCHED; PG8_LDA(At, 1, 0); PG8_STAGE(PG8_SA(0, 1), a2 + hstep, voffA);
            PG8_WAIT_V(8); PG8_WAIT_L(0); PG8_BAR; PG8_MMA(0, 0, At, B0); PG8_MMA(0, 1, At, B1); PG8_BAR; PG8_SCHED;
            PG8_LDA(At, 1, 1); PG8_STAGE(PG8_SB(1, 0), b3, voffB); PG8_STAGE(PG8_SB(1, 1), b3 + hstep, voffB); PG8_STAGE(PG8_SA(1, 0), a3, voffA);
            PG8_WAIT_V(8); PG8_WAIT_L(0); PG8_BAR; PG8_MMA(1, 0, At, B0); PG8_MMA(1, 1, At, B1); PG8_BAR; PG8_SCHED;
            } else {
            PG8_LDB(B0, 0, 0); PG8_SCHED; PG8_LDA(At, 0, 0); PG8_STAGE(PG8_SA(1, 1), a1 + hstep, voffA);
            PG8_WAIT_L(8); PG8_BAR; PG8_WAIT_L(0); PG8_MMA(0, 0, At, B0); PG8_BAR; PG8_SCHED;
            PG8_LDB(B1, 0, 1); PG8_STAGE(PG8_SB(0, 0), b2, voffB);
            PG8_BAR; PG8_WAIT_L(0); PG8_MMA(0, 1, At, B1); PG8_BAR;
            PG8_LDA(At, 0, 1); PG8_STAGE(PG8_SA(0, 0), a2, voffA);
            PG8_BAR; PG8_WAIT_L(0); PG8_MMA(1, 0, At, B0); PG8_BAR; PG8_SCHED;
            PG8_STAGE(PG8_SB(0, 1), b2 + hstep, voffB);
            PG8_WAIT_V(6); PG8_BAR; PG8_MMA(1, 1, At, B1); PG8_BAR;
            PG8_LDB(B0, 1, 0); PG8_SCHED; PG8_LDA(At, 1, 0); PG8_STAGE(PG8_SA(0, 1), a2 + hstep, voffA);
            PG8_WAIT_L(8); PG8_BAR; PG8_WAIT_L(0); PG8_MMA(0, 0, At, B0); PG8_BAR; PG8_SCHED;
            PG8_LDB(B1, 1, 1); PG8_STAGE(PG8_SB(1, 0), b3, voffB);
            PG8_BAR; PG8_WAIT_L(0); PG8_MMA(0, 1, At, B1); PG8_BAR;
            PG8_LDA(At, 1, 1); PG8_STAGE(PG8_SA(1, 0), a3, voffA);
            PG8_BAR; PG8_WAIT_L(0); PG8_MMA(1, 0, At, B0); PG8_BAR; PG8_SCHED;
            PG8_STAGE(PG8_SB(1, 1), b3 + hstep, voffB);
            PG8_WAIT_V(6); PG8_BAR; PG8_MMA(1, 1, At, B1); PG8_BAR;
            }
        }
        if constexpr (ALIGN_EPI) { if (wr == 0) PG8_BAR; }
        if constexpr (!Epi::AFTER_DRAIN) { E(acc, cur, wr, wc, fr, fq); S.done(cur); }
        if (!has_next) break;
#pragma unroll
        for (int a = 0; a < 2; ++a)
#pragma unroll
            for (int b = 0; b < 2; ++b)
#pragma unroll
                for (int m = 0; m < 4; ++m)
#pragma unroll
                    for (int n = 0; n < 2; ++n) acc[a][b][m][n] = (f32x4){0.f, 0.f, 0.f, 0.f};
        cur = nxt; cA = nA; cB = nB; nt = cur.nt; ++ui;
        if constexpr (ALIGN_EPI) { if (wr == 1) PG8_BAR; }
    }
    PG8_WAIT_V(0);
    if constexpr (!ALIGN_EPI) { if (wr == 0) PG8_BAR; }
    PG8_BAR;
    if constexpr (Epi::AFTER_DRAIN) { E.fused(acc, cur, wr, wc, fr, fq, lds, wid, lane); S.done(cur); }
#undef PG8_SA
#undef PG8_SB
#undef PG8_STAGE
#undef PG8_LDA
#undef PG8_LDB
#undef PG8_MMA
#undef PG8_WAIT_V
#undef PG8_WAIT_L
#undef PG8_BAR
#undef PG8_SCHED
}
}
#define GAS __attribute__((address_space(1)))
#define LAS __attribute__((address_space(3)))
typedef unsigned short bf16;
typedef unsigned v4u __attribute__((ext_vector_type(4)));
typedef float f32x4 __attribute__((ext_vector_type(4)));
typedef short bf16x8 __attribute__((ext_vector_type(8)));
typedef GAS unsigned gu32;
typedef GAS unsigned long long gu64;
#define RLX_AGENT __ATOMIC_RELAXED, __HIP_MEMORY_SCOPE_AGENT
#define LDS_WAIT() asm volatile("s_waitcnt lgkmcnt(0)" ::: "memory")
#define VM_WAIT() asm volatile("s_waitcnt vmcnt(0)" ::: "memory")
__device__ __forceinline__ unsigned long long rt() { return __builtin_amdgcn_s_memrealtime(); }
__device__ __forceinline__ unsigned f2bf(float f) { unsigned u = __builtin_bit_cast(unsigned, f); return (u + 0x7fffu + ((u >> 16) & 1u)) >> 16; }
__device__ __forceinline__ unsigned pk2(float lo, float hi) { return f2bf(lo) | (f2bf(hi) << 16); }

#define XB_TMO      128
#define XB_XCNT(j)  (256  + 64 * (j))
#define XB_XSUB(j)  (1280 + 64 * (j))
#define XB_XGEN(j)  (2304 + 64 * (j))
#define XB_TOP      3328
#define XB_TOPGEN   3392
#define XCD_BAR_WORDS 3456
#define XB_SPIN_CAP (1u << 18)

__device__ __forceinline__ unsigned xb_ld(unsigned* p)              { return __hip_atomic_load(p, __ATOMIC_RELAXED, __HIP_MEMORY_SCOPE_AGENT); }
__device__ __forceinline__ unsigned xb_add(unsigned* p, unsigned v) { return __hip_atomic_fetch_add(p, v, __ATOMIC_RELAXED, __HIP_MEMORY_SCOPE_AGENT); }
__device__ __forceinline__ unsigned xb_xcc_id() { return (unsigned)__builtin_amdgcn_s_getreg((3 << 11) | 20) & 0xFu; }
#define XB_SPIN(cond, bar) do { unsigned _sp = 0; while (cond) { __builtin_amdgcn_s_sleep(1); \
    if ((++_sp & 255u) == 0u) { if (xb_ld(&(bar)[XB_TMO])) break; if (_sp > XB_SPIN_CAP) { atomicAdd(&(bar)[XB_TMO], 1u); break; } } } } while (0)

struct XcdBarrier {
    unsigned* bar; unsigned x;
    volatile LAS unsigned* st;
};

__device__ __forceinline__ XcdBarrier xcd_barrier_post(unsigned* bar, volatile LAS unsigned* st) {
    XcdBarrier b; b.bar = bar; b.x = xb_xcc_id(); b.st = st;
    if (threadIdx.x == 0) (void)xb_add(&bar[XB_XCNT(b.x)], 1u);
    return b;
}
__device__ __forceinline__ void xcd_barrier_complete(unsigned* bar, unsigned x, unsigned& nloc, unsigned& nx) {
    const unsigned G = gridDim.x * gridDim.y * gridDim.z;
    unsigned sum, cnt, mine, sp = 0u;
    for (;;) {
        sum = 0u; cnt = 0u; mine = 0u;
#pragma unroll
        for (unsigned j = 0; j < 16; ++j) { const unsigned c = xb_ld(&bar[XB_XCNT(j)]); sum += c; cnt += (c > 0u) ? 1u : 0u; mine = (j == x) ? c : mine; }
        if (sum == G) break;
        __builtin_amdgcn_s_sleep(1);
        if ((++sp & 255u) == 0u) { if (xb_ld(&bar[XB_TMO])) break; if (sp > XB_SPIN_CAP) { atomicAdd(&bar[XB_TMO], 1u); break; } }
    }
    nloc = mine > 0u ? mine : 1u; nx = cnt > 0u ? cnt : 1u;
}

__device__ __forceinline__ void xcd_barrier(const XcdBarrier& b) {
    asm volatile("s_waitcnt vmcnt(0)" ::: "memory");
    __syncthreads();
    if (threadIdx.x == 0) {
        unsigned* bar = b.bar;
        __builtin_amdgcn_s_waitcnt(0);
        unsigned nloc = b.st[0], nx = b.st[1];
        if (nloc == 0u) { xcd_barrier_complete(bar, b.x, nloc, nx); b.st[0] = nloc; b.st[1] = nx; }
        const unsigned old = xb_add(&bar[XB_XSUB(b.x)], 1u);
        const unsigned gen = old / nloc;
        if (old + 1u == (gen + 1u) * nloc) {
            __builtin_amdgcn_fence(__ATOMIC_RELEASE, "agent");
            asm volatile("s_waitcnt vmcnt(0)" ::: "memory");
            const unsigned og = xb_add(&bar[XB_TOP], 1u);
            const unsigned tg = og / nx;
            if (og + 1u == (tg + 1u) * nx) xb_add(&bar[XB_TOPGEN], 1u);
            else XB_SPIN(xb_ld(&bar[XB_TOPGEN]) == tg, bar);
            __builtin_amdgcn_fence(__ATOMIC_ACQUIRE, "agent");
            xb_add(&bar[XB_XGEN(b.x)], 1u);
            asm volatile("s_waitcnt vmcnt(0)" ::: "memory");
        } else {
            XB_SPIN(xb_ld(&bar[XB_XGEN(b.x)]) == gen, bar);
            __builtin_amdgcn_fence(__ATOMIC_ACQUIRE, "agent");
            asm volatile("s_waitcnt vmcnt(0)" ::: "memory");
        }
    }
    __syncthreads();
}


constexpr int NWAVES = 8;
#ifndef MK_N_LAUNCHES
#define MK_N_LAUNCHES 1
#endif
constexpr int N_PHASES = 12;
constexpr int N_LAUNCHES = MK_N_LAUNCHES;
static_assert(N_LAUNCHES == 1 || N_LAUNCHES == N_PHASES, "MK_N_LAUNCHES is 1 or 12");

constexpr int D = 4096, FF = 11008, NGU = 2 * FF, DIN = 11296, DINP = 11520;
constexpr int NB_P = 4, SEQ_P = 2048, NB_S = 16, SEQ_S = 64, NMETA = 16, PAST = 2048;
constexpr int ROW_S = NB_P * SEQ_P  , ROW_M = ROW_S + NB_S * SEQ_S  , M1V = ROW_M + NMETA  , M1 = 9472  , M2 = ROW_M  ;
constexpr int KVH = 4, HD = 128, KVW = KVH * HD  , NHQ = 16, NHG = 16, WIN = 128;
constexpr int KVR_SMETA = M1, KVR_SWIN = M1 + NB_S * NMETA  , KV_ROWS = KVR_SWIN + NB_S * WIN  ;
constexpr int NPOS = NMETA + PAST + SEQ_S;
constexpr int C_Q = 0, C_K = 2048, C_V = 2560, C_CONV = 3072, C_Z = 9216, C_B = 11264, C_A = 11280, DCONV = 6144;
constexpr float LN_EPS = 1e-5f, RMS_EPS = 1e-6f, ALPHA = 1.189207115002721f;
enum { I_XP = 0, I_XS, I_CMK, I_CMV, I_CWK, I_CWV, I_SCONV, I_SGDN, I_META, I_LNG, I_LNB, I_WG, I_WU, I_WD, I_WIN, I_WOUT, I_SINK, I_CONVW, I_ALOG, I_DTB, I_NORMW, N_IN };
constexpr size_t O_YP = 0, O_YS = O_YP + (size_t)ROW_S * D, O_PMK = O_YS + (size_t)NB_S * SEQ_S * D, O_PMV = O_PMK + (size_t)NB_P * NMETA * KVW, O_PWK = O_PMV + (size_t)NB_P * NMETA * KVW,
                 O_PWV = O_PWK + (size_t)NB_P * WIN * KVW, O_PCONV = O_PWV + (size_t)NB_P * WIN * KVW, O_PGDN = O_PCONV + (size_t)NB_P * 3 * DCONV, O_SWK = O_PGDN + (size_t)NB_P * NHG * 128 * 128,
                 O_SWV = O_SWK + (size_t)NB_S * SEQ_S * KVW, O_SCONV = O_SWV + (size_t)NB_S * SEQ_S * KVW, O_SGDN = O_SCONV + (size_t)NB_S * 3 * DCONV, O_END = O_SGDN + (size_t)NB_S * NHG * 128 * 128;
static_assert(O_END == 44998656, "output map");

constexpr size_t AL(size_t x) { return (x + 4095) / 4096 * 4096; }
constexpr size_t WS_CTL = 0, CTL_ZERO_BYTES = 1u << 20;
constexpr size_t WS_WGU1 = CTL_ZERO_BYTES, SZ_WGU = (size_t)NGU * D * 2, SZ_WD = (size_t)D * FF * 2;
constexpr size_t WS_WD1 = WS_WGU1 + AL(SZ_WGU), WS_WGU2 = WS_WD1 + AL(SZ_WD), WS_WD2 = WS_WGU2 + AL(SZ_WGU), WS_WIN = WS_WD2 + AL(SZ_WD), WS_WOUT = WS_WIN + AL((size_t)DINP * D * 2);
constexpr size_t WS_XN = WS_WOUT + AL((size_t)D * D * 2), WS_MIX = WS_XN + AL((size_t)M1 * D * 2), WS_H = WS_MIX + AL((size_t)M2 * D * 2);
constexpr size_t WS_Y = WS_H + AL((size_t)M1 * DINP * 2), WS_KB = WS_Y + AL((size_t)M1 * D * 4), WS_VB = WS_KB + AL((size_t)KV_ROWS * KVW * 2), WS_ROPE = WS_VB + AL((size_t)KV_ROWS * KVW * 2);
constexpr size_t WS_SLAB = WS_ROPE + AL((size_t)NPOS * 64 * 8), N_SLABS = 224, WS_XQ = WS_SLAB + N_SLABS * 262144, WS_SA = WS_XQ + AL((size_t)M1 * D), WS_SB = WS_SA + AL((size_t)M1 * 4), WS_SH = WS_SB + 2 * AL((size_t)NGU * 4), WS_SBD = WS_SH + AL((size_t)M1 * 4), WS_HQ = WS_SBD + 2 * AL((size_t)D * 4), WS_END = WS_HQ + AL((size_t)M1 * FF);
static_assert((size_t)M1 * FF <= (WS_H - WS_XN), "the int8 copy of h fits over the XN | MIX region");
constexpr int GU_U = 0, GU_W = 32768, GU_QD = GU_W + 16384, GU_KDT = GU_QD + 16384, GU_QK = GU_KDT + 16384, GU_GL = GU_QK + 8192, GU_BYTES = GU_GL + 256;
constexpr int N_GUNITS = NB_P * NHG * 32 + NHG + NB_S * NHG;
constexpr size_t WS_GDN = WS_WGU1;
static_assert((size_t)N_GUNITS * GU_BYTES <= WS_WGU2 - WS_WGU1, "GDN chunk data fits in the FFN1 weight region");
constexpr int CW_TMO = 0, CW_CODE = 1, CW_BAR = 4096, CW_CMAX = 131072, CW_CMAXD = CW_CMAX + 2 * NGU, CW_RMAX = CW_CMAXD + 2 * D;
static_assert((CW_RMAX + 2 * M1) * 4 <= (int)CTL_ZERO_BYTES, "column maxima inside the per-call memset");

constexpr int RING_OFF = 0, RING_BYTES = 139264;
constexpr int LDSCTL_OFF = RING_BYTES, MISC_OFF = LDSCTL_OFF + 320;
constexpr int LDS_BYTES = 147456;
static_assert(MISC_OFF + 128 <= LDS_BYTES, "LDS map");

struct Frame {
    LAS unsigned char* lds;
    volatile LAS unsigned* MISC;
    gu32* ctl;
    int tid, lane, wave;
    int vcu, G;
};
struct Ptrs {
    const float* in[N_IN]; float* out;
    bf16 *Wgu1, *Wd1, *Wgu2, *Wd2, *Win, *Wout, *XN, *MIX, *H, *KB, *VB;
    float* Y; float* ROPE; unsigned char* GDN; float* SLAB;
    signed char* XQ; float *SA, *SB1, *SB2; unsigned* CMAX;
    signed char* HQ; float *SH, *SBD1, *SBD2; unsigned *CMAXD, *RMAX;
};
__host__ __device__ constexpr int kpos32(int kk) { return 8 * ((kk & 15) >> 2) + (kk & 3) + 4 * (kk >> 4); }
__host__ __device__ constexpr int a256_off(int r, int k) { return r * 256 + ((((k >> 5) * 4 + (kpos32(k & 31) >> 3)) ^ (r & 15)) * 16) + (kpos32(k & 31) & 7) * 2; }
__host__ __device__ constexpr int a128_off(int r, int k) { return r * 128 + ((((k >> 5) * 4 + (kpos32(k & 31) >> 3)) ^ ((r >> 1) & 7)) * 16) + (kpos32(k & 31) & 7) * 2; }
typedef short s16x4 __attribute__((ext_vector_type(4)));
__device__ __forceinline__ unsigned pkbf(float lo, float hi) { unsigned r; asm volatile("v_cvt_pk_bf16_f32 %0, %1, %2" : "=v"(r) : "v"(lo), "v"(hi)); return r; }
typedef float f32x2v __attribute__((ext_vector_type(2)));
typedef unsigned u32x2v __attribute__((ext_vector_type(2)));
__device__ __forceinline__ float bf2f(unsigned b) { return __uint_as_float(b << 16); }
__device__ __forceinline__ float wave_sum(float v) {
#pragma unroll
    for (int o = 1; o < 64; o <<= 1) v += __shfl_xor(v, o);
    return v;
}
__device__ __forceinline__ float silu1(float g) { return g * __builtin_amdgcn_rcpf(1.0f + __builtin_amdgcn_exp2f(-1.4426950408889634f * g)); }

template <int NB, int MODE>
__device__ __forceinline__ void p0_transpose_item(const float* W, int K, int N, bf16* WT, LAS float* scr, int item, int lane) {
    constexpr int LPR = NB / 4, RPI = 64 / LPR, NIT = 64 / RPI, ST = NB + 1;
    const int nblk = N / NB, kb = item / nblk, nb = item - kb * nblk, k0 = 64 * kb, n0 = NB * nb;
    const int lr = lane / LPR, lc = 4 * (lane % LPR);
#pragma unroll
    for (int i = 0; i < NIT; ++i) { const int kk = RPI * i + lr; const f32x4 v = __builtin_nontemporal_load((const GAS f32x4*)(W + (size_t)(k0 + kk) * N + n0 + lc));
        LAS float* s = scr + kk * ST + lc; s[0] = v.x; s[1] = v.y; s[2] = v.z; s[3] = v.w; }
    LDS_WAIT(); asm volatile("" ::: "memory");
    const int c = lane & 7;
#pragma unroll
    for (int j = 0; j < NB / 8; ++j) { const int n = (lane >> 3) + 8 * j; const LAS float* s = scr + (8 * c) * ST + n;
        v4u o; o.x = pk2(s[0 * ST], s[1 * ST]); o.y = pk2(s[2 * ST], s[3 * ST]); o.z = pk2(s[4 * ST], s[5 * ST]); o.w = pk2(s[6 * ST], s[7 * ST]);
        const int nn = n0 + n; const int r = (MODE == 0) ? nn : ((nn >> 7) * 256 + (nn & 127) + (MODE == 2 ? 128 : 0));
        *(GAS v4u*)(WT + (size_t)r * K + k0 + 8 * c) = o; }
    LDS_WAIT(); asm volatile("" ::: "memory");
}
__device__ __forceinline__ void cvt_flat(const float* src, bf16* dst, int n8, int gt, int NGT) {
    for (int i = gt; i < n8; i += NGT) { const f32x4 a = *(const GAS f32x4*)(src + (size_t)i * 8), b = *(const GAS f32x4*)(src + (size_t)i * 8 + 4);
        v4u o; o.x = pk2(a.x, a.y); o.y = pk2(a.z, a.w); o.z = pk2(b.x, b.y); o.w = pk2(b.z, b.w); *(GAS v4u*)(dst + (size_t)i * 8) = o; }
}
__device__ __forceinline__ unsigned pack_i8x4(f32x4 v, float inv) {
    const int a = (int)__builtin_rintf(v.x * inv), b = (int)__builtin_rintf(v.y * inv), c = (int)__builtin_rintf(v.z * inv), d = (int)__builtin_rintf(v.w * inv);
    return (unsigned)(a & 255) | ((unsigned)(b & 255) << 8) | ((unsigned)(c & 255) << 16) | ((unsigned)d << 24); }
__device__ __forceinline__ float wave_max(float v) {
#pragma unroll
    for (int o = 1; o < 64; o <<= 1) v = fmaxf(v, __shfl_xor(v, o));
    return v; }
__device__ __forceinline__ void quant_row_i8(const f32x4 (&v)[16], signed char* dst, float* sa, int lane) {
    float m = 0.f;
#pragma unroll
    for (int j = 0; j < 16; ++j) m = fmaxf(fmaxf(m, fmaxf(fabsf(v[j].x), fabsf(v[j].y))), fmaxf(fabsf(v[j].z), fabsf(v[j].w)));
    m = wave_max(m); const float inv = m > 0.f ? 127.f / m : 0.f;
    if (lane == 0) *sa = m * (1.f / 127.f);
#pragma unroll
    for (int j = 0; j < 16; ++j) ((GAS unsigned*)dst)[lane + 64 * j] = pack_i8x4(v[j], inv);
}
__device__ __forceinline__ int gu_row(int mode, int nn) { return mode == 0 ? nn : (nn >> 7) * 256 + (nn & 127) + (mode == 2 ? 128 : 0); }
__device__ __forceinline__ void p0_colmax_item(const float* W, int N, unsigned* cmax, int mode, int item, int lane) {
    const int nblk = N / 64, kb = item / nblk, nb = item - kb * nblk, k0 = 64 * kb, n0 = 64 * nb, lr = lane >> 4, lc = 4 * (lane & 15);
    f32x4 m = {0.f, 0.f, 0.f, 0.f};
#pragma unroll
    for (int i = 0; i < 16; ++i) { const f32x4 v = __builtin_nontemporal_load((const GAS f32x4*)(W + (size_t)(k0 + 4 * i + lr) * N + n0 + lc));
        m.x = fmaxf(m.x, fabsf(v.x)); m.y = fmaxf(m.y, fabsf(v.y)); m.z = fmaxf(m.z, fabsf(v.z)); m.w = fmaxf(m.w, fabsf(v.w)); }
    m.x = fmaxf(m.x, __shfl_xor(m.x, 16)); m.y = fmaxf(m.y, __shfl_xor(m.y, 16)); m.z = fmaxf(m.z, __shfl_xor(m.z, 16)); m.w = fmaxf(m.w, __shfl_xor(m.w, 16));
    m.x = fmaxf(m.x, __shfl_xor(m.x, 32)); m.y = fmaxf(m.y, __shfl_xor(m.y, 32)); m.z = fmaxf(m.z, __shfl_xor(m.z, 32)); m.w = fmaxf(m.w, __shfl_xor(m.w, 32));
    if (lane < 16) { const int r = gu_row(mode, n0 + lc);
        (void)__hip_atomic_fetch_max(cmax + r + 0, __float_as_uint(m.x), RLX_AGENT); (void)__hip_atomic_fetch_max(cmax + r + 1, __float_as_uint(m.y), RLX_AGENT);
        (void)__hip_atomic_fetch_max(cmax + r + 2, __float_as_uint(m.z), RLX_AGENT); (void)__hip_atomic_fetch_max(cmax + r + 3, __float_as_uint(m.w), RLX_AGENT); }
}
__device__ __forceinline__ void p0_quant_item(const float* W, int K, int N, signed char* WT, const unsigned* cmax, float* sB, int mode, LAS float* scr, int item, int lane) {
    const int nblk = N / 64, kb = item / nblk, nb = item - kb * nblk, k0 = 64 * kb, n0 = 64 * nb, lr = lane >> 4, lc = 4 * (lane & 15);
#pragma unroll
    for (int i = 0; i < 16; ++i) { const int kk = 4 * i + lr; const f32x4 v = __builtin_nontemporal_load((const GAS f32x4*)(W + (size_t)(k0 + kk) * N + n0 + lc));
        LAS float* s = scr + kk * 65 + lc; s[0] = v.x; s[1] = v.y; s[2] = v.z; s[3] = v.w; }
    LDS_WAIT(); asm volatile("" ::: "memory");
    const int r = gu_row(mode, n0 + lane); const float am = __uint_as_float(__hip_atomic_load(cmax + r, RLX_AGENT)), inv = am > 0.f ? 127.f / am : 0.f;
    if (kb == 0) sB[r] = am * (1.f / 127.f);
    const LAS float* s = scr + lane;
#pragma unroll
    for (int c = 0; c < 4; ++c) { v4u o;
        o.x = pack_i8x4((f32x4){s[(16 * c + 0) * 65], s[(16 * c + 1) * 65], s[(16 * c + 2) * 65], s[(16 * c + 3) * 65]}, inv); o.y = pack_i8x4((f32x4){s[(16 * c + 4) * 65], s[(16 * c + 5) * 65], s[(16 * c + 6) * 65], s[(16 * c + 7) * 65]}, inv);
        o.z = pack_i8x4((f32x4){s[(16 * c + 8) * 65], s[(16 * c + 9) * 65], s[(16 * c + 10) * 65], s[(16 * c + 11) * 65]}, inv); o.w = pack_i8x4((f32x4){s[(16 * c + 12) * 65], s[(16 * c + 13) * 65], s[(16 * c + 14) * 65], s[(16 * c + 15) * 65]}, inv);
        *(GAS v4u*)(WT + (size_t)r * K + k0 + 16 * c) = o; }
    LDS_WAIT(); asm volatile("" ::: "memory");
}
__device__ __forceinline__ void quant_h(Frame& F, const bf16* H, signed char* HQ, const unsigned* rmax, float* SH, int nrows) {
    const int gw = F.vcu * NWAVES + F.wave, NGW = F.G * NWAVES;
    for (int r = gw; r < nrows; r += NGW) {
        const GAS v4u* src = (const GAS v4u*)(H + (size_t)r * FF); GAS u32x2v* dst = (GAS u32x2v*)(HQ + (size_t)r * FF);
        unsigned mx = 0u;
#pragma unroll 4
        for (int c = F.lane; c < FF / 8; c += 64) { const v4u w = src[c]; const unsigned ww_[4] = {w.x, w.y, w.z, w.w};
#pragma unroll
            for (int k_ = 0; k_ < 4; ++k_) { const unsigned lo_ = (ww_[k_] << 16) & 0x7fff0000u, hi_ = ww_[k_] & 0x7fff0000u; mx = mx > lo_ ? mx : lo_; mx = mx > hi_ ? mx : hi_; } }
#pragma unroll
        for (int o = 1; o < 64; o <<= 1) { const unsigned t_ = (unsigned)__shfl_xor((int)mx, o); mx = mx > t_ ? mx : t_; }
        const float am = __uint_as_float(mx), inv = am > 0.f ? 127.f / am : 0.f;
        if (F.lane == 0) SH[r] = am * (1.f / 127.f);
#pragma unroll 4
        for (int c = F.lane; c < FF / 8; c += 64) { const v4u w = src[c]; u32x2v o;
            o.x = pack_i8x4((f32x4){bf2f(w.x & 0xffffu), bf2f(w.x >> 16), bf2f(w.y & 0xffffu), bf2f(w.y >> 16)}, inv); o.y = pack_i8x4((f32x4){bf2f(w.z & 0xffffu), bf2f(w.z >> 16), bf2f(w.w & 0xffffu), bf2f(w.w >> 16)}, inv);
            dst[c] = o; } }
}
constexpr int IT_GU = (D / 64) * (FF / 64), IT_IN = (D / 64) * (DIN / 32), IT_OUT = (D / 64) * (D / 64);
constexpr int Q_E1 = IT_GU  , Q_E2 = Q_E1 + IT_IN  , Q_E3 = Q_E2 + IT_OUT  , Q_E4 = Q_E3 + 2 * IT_GU  , Q_E5 = Q_E4 + IT_GU  ;
constexpr int QCH = 8;
constexpr int CW_QCTR = 2048, CW_DONE = 2112;
__device__ __forceinline__ void conv_item(const Ptrs& P, LAS float* scr, int q, int lane) {
    const float* wg = P.in[I_WG] + (size_t)D * FF; const float* wu = P.in[I_WU] + (size_t)D * FF; const float* wd = P.in[I_WD];
    if (q < Q_E1) p0_quant_item(wd, FF, D, (signed char*)P.Wd1, P.CMAXD, P.SBD1, 0, scr, q, lane);
    else if (q < Q_E2) p0_transpose_item<32, 0>(P.in[I_WIN], D, DIN, P.Win, scr, q - Q_E1, lane);
    else if (q < Q_E3) p0_transpose_item<64, 0>(P.in[I_WOUT], D, D, P.Wout, scr, q - Q_E2, lane);
    else if (q < Q_E3 + IT_GU) p0_quant_item(wg, D, FF, (signed char*)P.Wgu2, P.CMAX + NGU, P.SB2, 1, scr, q - Q_E3, lane);
    else if (q < Q_E4) p0_quant_item(wu, D, FF, (signed char*)P.Wgu2, P.CMAX + NGU, P.SB2, 2, scr, q - Q_E3 - IT_GU, lane);
    else p0_quant_item(wd + (size_t)D * FF, FF, D, (signed char*)P.Wd2, P.CMAXD + D, P.SBD2, 0, scr, q - Q_E4, lane);
}
__device__ __forceinline__ int q_take(Frame& F) { int i = 0; if (F.lane == 0) i = (int)__hip_atomic_fetch_add(F.ctl + CW_QCTR, (unsigned)QCH, RLX_AGENT); return __builtin_amdgcn_readfirstlane(i); }
__device__ __forceinline__ int q_head(Frame& F) { return (int)__builtin_amdgcn_readfirstlane(__hip_atomic_load(F.ctl + CW_QCTR, RLX_AGENT)); }
__device__ __forceinline__ void q_catch_up(Frame& F, const Ptrs& P, int E) {
    LAS float* scr = (LAS float*)(F.lds + RING_OFF + F.wave * 16640);
    for (;;) { if (q_head(F) >= E) break; const int i = q_take(F);
        for (int k = 0; k < QCH; ++k) if (i + k < Q_E5) conv_item(P, scr, i + k, F.lane); }
}
__device__ __forceinline__ void q_fill(Frame& F, const Ptrs& P, int ph) {
    LAS float* scr = (LAS float*)(F.lds + RING_OFF + F.wave * 16640);
    gu32* done = F.ctl + CW_DONE + 64 * ph;
    for (;;) {
        if ((int)__builtin_amdgcn_readfirstlane(__hip_atomic_load(done, RLX_AGENT)) >= F.G || q_head(F) >= Q_E5) break;
        const int i = q_take(F); if (i >= Q_E5) break;
        for (int k = 0; k < QCH; ++k) if (i + k < Q_E5) conv_item(P, scr, i + k, F.lane); }
}
__device__ __forceinline__ void sub_barrier(Frame& F, gu32* ctr, unsigned n) {
    asm volatile("s_waitcnt vmcnt(0) lgkmcnt(0)" ::: "memory"); __syncthreads();
    if (F.tid == 0) {
        __builtin_amdgcn_fence(__ATOMIC_RELEASE, "agent"); asm volatile("s_waitcnt vmcnt(0)" ::: "memory");
        (void)__hip_atomic_fetch_add(ctr, 1u, RLX_AGENT);
        unsigned sp = 0; while (__hip_atomic_load(ctr, RLX_AGENT) < n) { __builtin_amdgcn_s_sleep(2); if (++sp > (1u << 22)) { __hip_atomic_store(F.ctl + CW_TMO, 1u, RLX_AGENT); break; } }
        __builtin_amdgcn_fence(__ATOMIC_ACQUIRE, "agent"); asm volatile("s_waitcnt vmcnt(0)" ::: "memory");
    }
    __syncthreads();
}
constexpr int CW_SUB = 3072;
#define PHASE_DONE(ph) do { if (F.tid == 0) (void)__hip_atomic_fetch_add(F.ctl + CW_DONE + 64 * (ph), 1u, RLX_AGENT); } while (0)
__device__ __forceinline__ void p0_quant_wgu1(Frame& F, const Ptrs& P) {
    LAS float* scr = (LAS float*)(F.lds + RING_OFF + F.wave * 16640);
    const int gw = F.vcu * NWAVES + F.wave, NGW = F.G * NWAVES;
    for (int it = gw; it < 2 * IT_GU; it += NGW) {
        if (it < IT_GU) p0_quant_item(P.in[I_WG], D, FF, (signed char*)P.Wgu1, P.CMAX, P.SB1, 1, scr, it, F.lane);
        else p0_quant_item(P.in[I_WU], D, FF, (signed char*)P.Wgu1, P.CMAX, P.SB1, 2, scr, it - IT_GU, F.lane);
    }
}
__device__ __forceinline__ void p0_prologue(Frame& F, const Ptrs& P) {
    const int gw = F.vcu * NWAVES + F.wave, NGW = F.G * NWAVES;
    for (int it = gw; it < 4 * IT_GU; it += NGW) { const int mtx = it / IT_GU, r = it - mtx * IT_GU;
        p0_colmax_item((mtx & 1 ? P.in[I_WU] : P.in[I_WG]) + (size_t)(mtx >> 1) * D * FF, FF, P.CMAX + (mtx >> 1) * NGU, 1 + (mtx & 1), r, F.lane); }
    for (int it = gw; it < 2 * IT_GU; it += NGW) { const int mtx = it / IT_GU, r = it - mtx * IT_GU;
        p0_colmax_item(P.in[I_WD] + (size_t)mtx * D * FF, D, P.CMAXD + mtx * D, 0, r, F.lane); }
    for (int m = gw; m < M1V; m += NGW) {
        const float* src = m < ROW_S ? P.in[I_XP] + (size_t)m * D : (m < ROW_M ? P.in[I_XS] + (size_t)(m - ROW_S) * D : P.in[I_META] + (size_t)(m - ROW_M) * D);
        const GAS f32x4* xr = (const GAS f32x4*)src + F.lane; f32x4 v[16];
#pragma unroll
        for (int j = 0; j < 16; ++j) v[j] = xr[64 * j];
        quant_row_i8(v, P.XQ + (size_t)m * D, P.SA + m, F.lane);
    }
    const int gt = gw * 64 + F.lane, NGT = NGW * 64;
    for (int i = gt; i < NPOS * 64; i += NGT) { const int pos = i >> 6, k = i & 63;
        const double inv = exp2(-(double)k * (13.287712379549449 / 64.0)); const float ang = (float)((double)pos * inv);
        float s, c; sincosf(ang, &s, &c); ((GAS f32x2v*)P.ROPE)[i] = (f32x2v){c, s}; }
    cvt_flat(P.in[I_CMK], P.KB + (size_t)KVR_SMETA * KVW, NB_S * NMETA * KVW / 8, gt, NGT);
    cvt_flat(P.in[I_CMV], P.VB + (size_t)KVR_SMETA * KVW, NB_S * NMETA * KVW / 8, gt, NGT);
    cvt_flat(P.in[I_CWK], P.KB + (size_t)KVR_SWIN * KVW, NB_S * WIN * KVW / 8, gt, NGT);
    cvt_flat(P.in[I_CWV], P.VB + (size_t)KVR_SWIN * KVW, NB_S * WIN * KVW / 8, gt, NGT);
}

__device__ __forceinline__ void swiglu_combine(Frame& F, const pg8::SplitOrder& SO, const float* slab, bf16* H, const float* sA, const float* sB) {
    const int tid = F.tid, row = tid >> 4, c8 = (tid & 15) * 8;
    for (int it = blockIdx.x; it < SO.rem * 8; it += F.G) { const int ri = it >> 3, r0 = (it & 7) * 32 + row; pg8::Unit u; SO.map(SO.R * SO.G + ri, u);
        typedef int i32x4 __attribute__((ext_vector_type(4)));
        i32x4 ig0 = {0, 0, 0, 0}, ig1 = ig0, iu0 = ig0, iu1 = ig0;
        for (int s2 = 0; s2 < SO.S; ++s2) { const GAS i32x4* sp = (const GAS i32x4*)(slab + ((size_t)(ri * SO.S + s2) << 16) + r0 * 256 + c8);
            ig0 = ig0 + sp[0]; ig1 = ig1 + sp[1]; iu0 = iu0 + sp[32]; iu1 = iu1 + sp[33]; }
        const float sa = sA[u.pm * 256 + r0]; const float* sbp = sB + u.pn * 256 + c8;
        const f32x4 g0 = __builtin_convertvector(ig0, f32x4) * (*(const GAS f32x4*)(sbp) * sa), g1 = __builtin_convertvector(ig1, f32x4) * (*(const GAS f32x4*)(sbp + 4) * sa);
        const f32x4 u0 = __builtin_convertvector(iu0, f32x4) * (*(const GAS f32x4*)(sbp + 128) * sa), u1 = __builtin_convertvector(iu1, f32x4) * (*(const GAS f32x4*)(sbp + 132) * sa);
        v4u o; o.x = pkbf(silu1(g0.x) * u0.x, silu1(g0.y) * u0.y); o.y = pkbf(silu1(g0.z) * u0.z, silu1(g0.w) * u0.w);
        o.z = pkbf(silu1(g1.x) * u1.x, silu1(g1.y) * u1.y); o.w = pkbf(silu1(g1.z) * u1.z, silu1(g1.w) * u1.w);
        *(GAS v4u*)(H + (size_t)(u.pm * 256 + r0) * FF + u.pn * 128 + c8) = o; }
}
__device__ __forceinline__ void ln_phase(Frame& F, const float* Y, float* Xo, bf16* XN, const float* g, const float* b, int nrows, const pg8::SplitOrder& SO, const float* slab, float sscale, signed char* XQ, float* SA) {
    const int gw = F.vcu * NWAVES + F.wave, NGW = F.G * NWAVES;
    for (int r = gw; r < nrows; r += NGW) {
        const GAS f32x4* yr = (const GAS f32x4*)(Y + (size_t)r * D) + F.lane;
        f32x4 v[16];
#pragma unroll
        for (int j = 0; j < 16; ++j) v[j] = yr[64 * j];
        if (SO.rem > 0 && SO.S > 1) { const int pm = r >> 8, rr = r & 255;
#pragma unroll
            for (int j = 0; j < 16; ++j) { const int ri = SO.inv(pm, j) - SO.R * SO.G;
                if (ri >= 0) { const GAS f32x4* sp = (const GAS f32x4*)(slab + ((size_t)(ri * (SO.S - 1)) << 16) + rr * 256) + F.lane; f32x4 a = sp[0];
                    for (int s2 = 1; s2 < SO.S - 1; ++s2) a = a + sp[(size_t)s2 << 14];
                    v[j] = v[j] + a * sscale; } } }
        float s = 0.f;
#pragma unroll
        for (int j = 0; j < 16; ++j) s += (v[j].x + v[j].y) + (v[j].z + v[j].w);
        const float mean = wave_sum(s) * (1.f / D); float s2 = 0.f;
#pragma unroll
        for (int j = 0; j < 16; ++j) { v[j] = v[j] - mean; s2 += (v[j].x * v[j].x + v[j].y * v[j].y) + (v[j].z * v[j].z + v[j].w * v[j].w); }
        const float rstd = 1.f / sqrtf(wave_sum(s2) * (1.f / D) + LN_EPS);
#pragma unroll
        for (int j = 0; j < 16; ++j) { const f32x4 gg = ((const GAS f32x4*)g)[F.lane + 64 * j], bb = ((const GAS f32x4*)b)[F.lane + 64 * j];
            const f32x4 o = v[j] * rstd * gg + bb; v[j] = o;
            if (Xo) ((GAS f32x4*)(Xo + (size_t)r * D))[F.lane + 64 * j] = o;
            if (XN) { u32x2v w; w.x = pk2(o.x, o.y); w.y = pk2(o.z, o.w); ((GAS u32x2v*)(XN + (size_t)r * D))[F.lane + 64 * j] = w; } }
        if (XQ) quant_row_i8(v, XQ + (size_t)r * D, SA + r, F.lane);
    }
}

__device__ __forceinline__ void kv_prep(Frame& F, const Ptrs& P) {
    const int gw = F.vcu * NWAVES + F.wave, NGW = F.G * NWAVES, lane = F.lane;
    const bf16* HIN = P.H;
    for (int r = gw; r < M1V; r += NGW) {
        int pos; float* kdst = nullptr; float* vdst = nullptr; int ncp = 1;
        if (r < ROW_S) { const int t = r & (SEQ_P - 1), b = r >> 11; pos = NMETA + t;
            if (t >= SEQ_P - WIN) { kdst = P.out + O_PWK + (size_t)(b * WIN + t - (SEQ_P - WIN)) * KVW; vdst = P.out + O_PWV + (size_t)(b * WIN + t - (SEQ_P - WIN)) * KVW; } }
        else if (r < ROW_M) { pos = NMETA + PAST + ((r - ROW_S) & (SEQ_S - 1)); kdst = P.out + O_SWK + (size_t)(r - ROW_S) * KVW; vdst = P.out + O_SWV + (size_t)(r - ROW_S) * KVW; }
        else { pos = r - ROW_M; kdst = P.out + O_PMK + (size_t)pos * KVW; vdst = P.out + O_PMV + (size_t)pos * KVW; ncp = NB_P; }
        const bf16* hrow = HIN + (size_t)r * DINP;
        const f32x2v cs = ((const GAS f32x2v*)P.ROPE)[pos * 64 + lane];
#pragma unroll
        for (int kh = 0; kh < KVH; ++kh) { const float x1 = bf2f(hrow[C_K + kh * HD + lane]), x2 = bf2f(hrow[C_K + kh * HD + 64 + lane]);
            const float o1 = x1 * cs.x - x2 * cs.y, o2 = x2 * cs.x + x1 * cs.y;
            P.KB[(size_t)r * KVW + kh * HD + lane] = (bf16)f2bf(o1); P.KB[(size_t)r * KVW + kh * HD + 64 + lane] = (bf16)f2bf(o2);
            if (kdst) for (int cp = 0; cp < ncp; ++cp) { kdst[(size_t)cp * NMETA * KVW + kh * HD + lane] = o1; kdst[(size_t)cp * NMETA * KVW + kh * HD + 64 + lane] = o2; } }
        const v4u vv = *(const GAS v4u*)(hrow + C_V + 8 * lane);
        *(GAS v4u*)(P.VB + (size_t)r * KVW + 8 * lane) = vv;
        if (vdst) { const f32x4 a = {bf2f(vv.x & 0xffffu), bf2f(vv.x >> 16), bf2f(vv.y & 0xffffu), bf2f(vv.y >> 16)}, c = {bf2f(vv.z & 0xffffu), bf2f(vv.z >> 16), bf2f(vv.w & 0xffffu), bf2f(vv.w >> 16)};
            for (int cp = 0; cp < ncp; ++cp) { *(GAS f32x4*)(vdst + (size_t)cp * NMETA * KVW + 8 * lane) = a; *(GAS f32x4*)(vdst + (size_t)cp * NMETA * KVW + 8 * lane + 4) = c; } }
    }
    for (int it = gw; it < (NB_P + NB_S) * 3 * (DCONV / 512); it += NGW) {
        const int part = it % (DCONV / 512), rj = it / (DCONV / 512), j = rj % 3, sb = rj / 3;
        const int srow = sb < NB_P ? sb * SEQ_P + SEQ_P - 3 + j : ROW_S + (sb - NB_P) * SEQ_S + SEQ_S - 3 + j;
        float* dst = (sb < NB_P ? P.out + O_PCONV + (size_t)(sb * 3 + j) * DCONV : P.out + O_SCONV + (size_t)((sb - NB_P) * 3 + j) * DCONV) + part * 512 + 8 * lane;
        const v4u vv = *(const GAS v4u*)(HIN + (size_t)srow * DINP + C_CONV + part * 512 + 8 * lane);
        *(GAS f32x4*)dst = (f32x4){bf2f(vv.x & 0xffffu), bf2f(vv.x >> 16), bf2f(vv.y & 0xffffu), bf2f(vv.y >> 16)};
        *(GAS f32x4*)(dst + 4) = (f32x4){bf2f(vv.z & 0xffffu), bf2f(vv.z >> 16), bf2f(vv.w & 0xffffu), bf2f(vv.w >> 16)};
    }
}

constexpr int PB_ST = 136;
constexpr int L_AT = 0, L_TAB = L_AT + 64 * 68 * 4, L_QKR = L_TAB + 12 * 256, L_QB = L_QKR + 64 * 68 * 4, L_KB = L_QB + 64 * PB_ST * 2, L_VB = L_KB + 64 * PB_ST * 2, L_XR = L_VB + 64 * PB_ST * 2, L_PREP_END = L_XR + 64 * 768;
static_assert(L_PREP_END <= RING_BYTES && (L_XR % 1024) == 0, "GDN prep LDS");
enum { T_BETA = 0, T_GC, T_EG, T_EK, T_RK2, T_RQ2, T_SU, T_SW, T_SKD, T_SQD, T_N };
struct PrepUnit { int kind, b, h, n, row0; };
__device__ __forceinline__ PrepUnit prep_decode(int uidx) {
    PrepUnit u; u.b = 0; u.n = 0;
    if (uidx < 2048) { u.kind = 0; u.b = uidx >> 9; u.h = (uidx >> 5) & 15; u.n = uidx & 31; u.row0 = u.b * SEQ_P + 64 * u.n; }
    else if (uidx < 2064) { u.kind = 1; u.h = uidx - 2048; u.row0 = ROW_M - 48; }
    else { u.kind = 2; u.b = (uidx - 2064) >> 4; u.h = (uidx - 2064) & 15; u.row0 = ROW_S + u.b * SEQ_S; }
    return u;
}
__device__ __forceinline__ float dpp_sum16(float p) {
    p += __builtin_bit_cast(float, __builtin_amdgcn_update_dpp(0, __builtin_bit_cast(int, p), 0xB1, 0xF, 0xF, true));
    p += __builtin_bit_cast(float, __builtin_amdgcn_update_dpp(0, __builtin_bit_cast(int, p), 0x4E, 0xF, 0xF, true));
    p += __builtin_bit_cast(float, __builtin_amdgcn_update_dpp(0, __builtin_bit_cast(int, p), 0x141, 0xF, 0xF, true));
    p += __builtin_bit_cast(float, __builtin_amdgcn_update_dpp(0, __builtin_bit_cast(int, p), 0x140, 0xF, 0xF, true));
    return p;
}
template <bool ISU> __device__ __forceinline__ void prep_solve(LAS float* AT, LAS float* TAB, LAS unsigned char* VB, LAS unsigned char* KB, LAS unsigned char* OUTW, unsigned char* ud, int tid) {
    const int cc = tid & 127; const LAS unsigned char* src = (ISU ? VB : KB) + cc * 2; const LAS float* sc = TAB + (ISU ? T_SU : T_SW) * 64;
    float* U = (float*)(ud + GU_U);
    const int cslot = (cc >> 5) * 4 + (kpos32(cc & 31) >> 3), cpos2 = (kpos32(cc & 31) & 7) * 2;
    float r[64];
#pragma unroll
    for (int i = 0; i < 64; ++i) r[i] = bf2f(*(const LAS unsigned short*)(src + i * (PB_ST * 2))) * sc[i];
    const LAS float* atp = AT;
#pragma unroll
    for (int j = 0; j < 64; ++j) { float sol = r[j]; asm volatile("" : "+v"(atp), "+v"(sol));
        if (ISU) U[j * 128 + cc] = sol; else *(LAS unsigned short*)(OUTW + j * 256 + ((cslot ^ (j & 15)) << 4) + cpos2) = (unsigned short)f2bf(sol);
#pragma unroll
        for (int q = (j + 1) / 4; q < 16; ++q) { const f32x4 a = *(const LAS f32x4*)(atp + j * 68 + 4 * q);
            if (4 * q + 0 > j) r[4 * q + 0] -= a.x * sol; if (4 * q + 1 > j) r[4 * q + 1] -= a.y * sol;
            if (4 * q + 2 > j) r[4 * q + 2] -= a.z * sol; if (4 * q + 3 > j) r[4 * q + 3] -= a.w * sol; }
        __builtin_amdgcn_sched_barrier(0); }
}
struct Solve2State { float r0[32], r1[32]; f32x4 a[2][8]; const LAS float* atp; float* U; LAS unsigned char* ow; int pi, cslot; };
template <bool ISU, int J> __device__ __forceinline__ void prep_solve2_step(Solve2State& st) {
    if constexpr (J < 64) {
        constexpr int pj = (J >> 2) & 1, kj = 4 * (J >> 3) + (J & 3);
        asm volatile("" : "+v"(st.atp), "+v"(st.r0[kj]));
        if constexpr (J + 1 < 64) {
#pragma unroll
            for (int kk = (J + 1) >> 3; kk < 8; ++kk) st.a[(J + 1) & 1][kk] = *(const LAS f32x4*)(st.atp + (J + 1) * 68 + 8 * kk); }
        const float m0 = st.r0[kj], m1 = st.r1[kj];
        const float o0 = __builtin_bit_cast(float, __builtin_amdgcn_update_dpp(0, __builtin_bit_cast(int, m0), 0xB1, 0xF, 0xF, true)), o1 = __builtin_bit_cast(float, __builtin_amdgcn_update_dpp(0, __builtin_bit_cast(int, m1), 0xB1, 0xF, 0xF, true));
        const float s0 = (st.pi == pj) ? m0 : o0, s1 = (st.pi == pj) ? m1 : o1;
        if (ISU) *(GAS f32x2v*)(st.U + J * 128) = (f32x2v){s0, s1}; else *(LAS unsigned*)(st.ow + J * 256 + ((st.cslot ^ (J & 15)) << 4)) = pkbf(s0, s1);
#pragma unroll
        for (int kk = J >> 3; kk < 8; ++kk) { const f32x4 av = st.a[J & 1][kk];
            st.r0[4 * kk + 0] -= av.x * s0; st.r0[4 * kk + 1] -= av.y * s0; st.r0[4 * kk + 2] -= av.z * s0; st.r0[4 * kk + 3] -= av.w * s0;
            st.r1[4 * kk + 0] -= av.x * s1; st.r1[4 * kk + 1] -= av.y * s1; st.r1[4 * kk + 2] -= av.z * s1; st.r1[4 * kk + 3] -= av.w * s1; }
        __builtin_amdgcn_sched_barrier(0);
        prep_solve2_step<ISU, J + 1>(st);
    }
}
template <bool ISU> __device__ __forceinline__ void prep_solve2(LAS float* AT, LAS float* TAB, LAS unsigned char* VB, LAS unsigned char* KB, LAS unsigned char* OUTW, unsigned char* ud, int tid) {
    Solve2State st; st.pi = tid & 1; const int c0 = (tid & 127) & ~1;
    const LAS unsigned char* src = (ISU ? VB : KB) + c0 * 2 + st.pi * (4 * PB_ST * 2); const LAS float* sc = TAB + (ISU ? T_SU : T_SW) * 64 + 4 * st.pi;
    st.U = (float*)(ud + GU_U) + c0; st.ow = OUTW + (kpos32(c0 & 31) & 7) * 2; st.cslot = (c0 >> 5) * 4 + (kpos32(c0 & 31) >> 3);
#pragma unroll
    for (int k = 0; k < 32; ++k) { const int rw = 8 * (k >> 2) + (k & 3); const unsigned w_ = *(const LAS unsigned*)(src + rw * (PB_ST * 2)); const float s_ = sc[rw]; st.r0[k] = bf2f(w_ & 0xffffu) * s_; st.r1[k] = bf2f(w_ >> 16) * s_; }
    st.atp = AT + 4 * st.pi;
#pragma unroll
    for (int kk = 0; kk < 8; ++kk) st.a[0][kk] = *(const LAS f32x4*)(st.atp + 8 * kk);
    prep_solve2_step<ISU, 0>(st);
}
#define PB_BAR() do { asm volatile("s_waitcnt lgkmcnt(0)" ::: "memory"); __builtin_amdgcn_s_barrier(); asm volatile("" ::: "memory"); } while (0)
__device__ __forceinline__ void gdn_prep_all(Frame& F, const Ptrs& P, int abl  ) {
    int tid_ = F.tid; asm volatile("" : "+v"(tid_));
    const int tid = tid_, wv = F.wave;
    LAS unsigned char* L = F.lds;
    LAS float* AT = (LAS float*)(L + L_AT); LAS float* TAB = (LAS float*)(L + L_TAB); LAS float* QKR = (LAS float*)(L + L_QKR);
    LAS unsigned char* QB = L + L_QB; LAS unsigned char* KB = L + L_KB; LAS unsigned char* VB = L + L_VB; LAS unsigned char* XR = L + L_XR; LAS unsigned char* OUTW = L + L_QKR;
    const bf16* HIN = P.H;
    const int part = wv >> 1, half = wv & 1;
    f32x2v cwn[4], hxn[3]; float bln = 0.f, aln = 0.f;
#define PB_PREFETCH(U) do { const PrepUnit& u_ = (U); int lane = tid; asm volatile("" : "+v"(lane)); lane &= 63; \
          \
        _Pragma("unroll") for (int k_ = 0; k_ < 6; ++k_) { const int p_ = (6 * wv + k_) * 64 + lane, t_ = p_ >> 4, r_ = (t_ * 171) >> 9, pt_ = t_ - 3 * r_; \
            const int rr_ = (u_.kind == 1 && r_ < 48) ? 48 : r_; \
            __builtin_amdgcn_global_load_lds((const GAS unsigned*)(HIN + (size_t)(u_.row0 + rr_) * DINP + C_CONV + pt_ * 2048 + u_.h * 128 + (p_ & 15) * 8), (LAS unsigned*)(XR + (6 * wv + k_) * 1024), 16, 0, 0); } \
        if (wv < 6) { const int ch_ = part * 2048 + u_.h * 128 + 2 * lane; const float* cw_ = P.in[I_CONVW] + ch_; \
            _Pragma("unroll") for (int j_ = 0; j_ < 4; ++j_) cwn[j_] = *(const GAS f32x2v*)(cw_ + j_ * DCONV); \
            _Pragma("unroll") for (int j_ = 0; j_ < 3; ++j_) hxn[j_] = (f32x2v){0.f, 0.f}; \
            if (half == 0) { \
                if (u_.kind == 0) { const int hr_ = (u_.n == 0) ? ROW_M + 13 : u_.row0 - 3; \
                    _Pragma("unroll") for (int j_ = 0; j_ < 3; ++j_) { const unsigned w_ = *(const GAS unsigned*)(HIN + (size_t)(hr_ + j_) * DINP + C_CONV + ch_); hxn[j_] = (f32x2v){bf2f(w_ & 0xffffu), bf2f(w_ >> 16)}; } } \
                else if (u_.kind == 2) { const float* sc_ = P.in[I_SCONV] + (size_t)u_.b * 3 * DCONV + ch_; \
                    _Pragma("unroll") for (int j_ = 0; j_ < 3; ++j_) hxn[j_] = *(const GAS f32x2v*)(sc_ + j_ * DCONV); } } } \
        else if (wv == 6) { const bf16* hr_ = HIN + (size_t)(u_.row0 + ((u_.kind == 1 && lane < 48) ? 48 : lane)) * DINP; bln = bf2f(hr_[C_B + u_.h]); aln = bf2f(hr_[C_A + u_.h]); } } while (0)
    int uidx = blockIdx.x;
    if (uidx >= N_GUNITS) return;
    PrepUnit un_ = prep_decode(uidx);
    PB_PREFETCH(un_);
    for (; uidx < N_GUNITS; uidx += F.G) {
        const PrepUnit u = prep_decode(uidx);
        unsigned char* ud = P.GDN + (size_t)uidx * GU_BYTES;
        asm volatile("s_waitcnt vmcnt(0) lgkmcnt(0)" ::: "memory"); __builtin_amdgcn_s_barrier(); asm volatile("" ::: "memory");
        f32x2v cw[4], hx[3]; float bl = bln, al = aln;
#pragma unroll
        for (int j = 0; j < 4; ++j) cw[j] = cwn[j];
#pragma unroll
        for (int j = 0; j < 3; ++j) hx[j] = hxn[j];
        asm volatile("" : "+v"(cw[0]), "+v"(cw[1]), "+v"(cw[2]), "+v"(cw[3]), "+v"(hx[0]), "+v"(hx[1]), "+v"(hx[2]), "+v"(bl), "+v"(al));
        { int tl_ = tid; asm volatile("" : "+v"(tl_)); const int lane = tl_ & 63;
        if (wv < 6) {
            const LAS unsigned char* xr = XR + part * 256 + lane * 4; LAS unsigned char* dst = (part == 0 ? QB : (part == 1 ? KB : VB)) + lane * 4;
            const int i0 = 32 * half;
            f32x2v xm3 = hx[0], xm2 = hx[1], xm1 = hx[2];
            if (half == 1) { const unsigned a_ = *(const LAS unsigned*)(xr + 29 * 768), b_ = *(const LAS unsigned*)(xr + 30 * 768), c_ = *(const LAS unsigned*)(xr + 31 * 768);
                xm3 = (f32x2v){bf2f(a_ & 0xffffu), bf2f(a_ >> 16)}; xm2 = (f32x2v){bf2f(b_ & 0xffffu), bf2f(b_ >> 16)}; xm1 = (f32x2v){bf2f(c_ & 0xffffu), bf2f(c_ >> 16)};
                if (u.kind == 1) { xm3 = (f32x2v){0.f, 0.f}; xm2 = xm3; xm1 = xm3; } }
#pragma unroll 8
            for (int ii = 0; ii < 32; ++ii) { const int i = i0 + ii; const unsigned w_ = *(const LAS unsigned*)(xr + i * 768);
                f32x2v x = (f32x2v){bf2f(w_ & 0xffffu), bf2f(w_ >> 16)};
                if (u.kind == 1 && i < 48) x = (f32x2v){0.f, 0.f};
                const f32x2v y = cw[0] * xm3 + cw[1] * xm2 + cw[2] * xm1 + cw[3] * x;
                *(LAS unsigned*)(dst + i * (PB_ST * 2)) = pkbf(silu1(y.x), silu1(y.y)); xm3 = xm2; xm2 = xm1; xm1 = x; }
        } else if (wv == 6) {
            float be = 0.f, g = 0.f;
            if (!(u.kind == 1 && lane < 48)) { be = 1.f / (1.f + expf(-bl)); const float x = al + P.in[I_DTB][u.h]; const float sp = fmaxf(x, 0.f) + log1pf(expf(-fabsf(x))); g = -expf(P.in[I_ALOG][u.h]) * sp; }
            float v = g;
#pragma unroll
            for (int o = 1; o < 64; o <<= 1) { const float t = __shfl_up(v, o); if (lane >= o) v += t; }
            const float last = __shfl(v, 63);
            TAB[T_BETA * 64 + lane] = be; TAB[T_GC * 64 + lane] = v; TAB[T_EG * 64 + lane] = expf(v); TAB[T_EK * 64 + lane] = expf(last - v);
        } }
        PB_BAR();
        if (uidx + F.G < N_GUNITS) { un_ = prep_decode(uidx + F.G); PB_PREFETCH(un_); }
        __builtin_amdgcn_sched_barrier(0);
        if (!(abl & 4)) { int tl_ = tid; asm volatile("" : "+v"(tl_)); const int lane = tl_ & 63, c16 = lane & 15, q4 = lane >> 4;
#pragma unroll
        for (int tk = 0; tk < 3; ++tk) { const int task = wv + 8 * tk;
            int rb, cb; const LAS unsigned char *Ap, *Bp;
            if (task < 20) { const int t10 = task < 10 ? task : task - 10; int a = 0, b = t10;
                if (b >= 1) { a = 1; b -= 1; if (b >= 2) { a = 2; b -= 2; if (b >= 3) { a = 3; b -= 3; } } }
                if (task < 10) { rb = a; cb = b; Ap = KB; Bp = KB; } else { rb = b; cb = a; Ap = KB; Bp = QB; } }
            else { rb = task - 20; cb = rb; Ap = QB; Bp = QB; }
            f32x4 acc = {0.f, 0.f, 0.f, 0.f};
#pragma unroll
            for (int s = 0; s < 4; ++s) { const bf16x8 A = *(const LAS bf16x8*)(Ap + (16 * rb + c16) * (PB_ST * 2) + 64 * s + 16 * q4), B = *(const LAS bf16x8*)(Bp + (16 * cb + c16) * (PB_ST * 2) + 64 * s + 16 * q4);
                acc = __builtin_amdgcn_mfma_f32_16x16x32_bf16(A, B, acc, 0, 0, 0); }
            if (task < 10) { *(LAS f32x4*)(AT + (16 * cb + c16) * 68 + 16 * rb + 4 * q4) = acc;
                if (rb == cb) {
#pragma unroll
                    for (int r = 0; r < 4; ++r) if (c16 == 4 * q4 + r) TAB[T_RK2 * 64 + 16 * rb + c16] = acc[r]; } }
            else if (task < 20) { *(LAS f32x4*)(QKR + (16 * cb + c16) * 68 + 16 * rb + 4 * q4) = acc; }
            else {
#pragma unroll
                for (int r = 0; r < 4; ++r) if (c16 == 4 * q4 + r) TAB[T_RQ2 * 64 + 16 * rb + c16] = acc[r]; }
        } }
        PB_BAR();
        if (!(abl & 4)) { int tid = tid_; asm volatile("" : "+v"(tid));
        { const int j = tid >> 3, i8 = (tid & 7) * 8;
            const float rkj = rsqrtf(TAB[T_RK2 * 64 + j] + RMS_EPS), gcj = TAB[T_GC * 64 + j];
#pragma unroll
            for (int e = 0; e < 8; ++e) { const int i = i8 + e; const float v = AT[j * 68 + i];
                const float sc = TAB[T_BETA * 64 + i] * rsqrtf(TAB[T_RK2 * 64 + i] + RMS_EPS) * rkj * expf(fminf(TAB[T_GC * 64 + i] - gcj, 0.f));
                AT[j * 68 + i] = (i > j) ? v * sc : 0.f; } }
        { const int i = tid >> 3, sl = tid & 7, g = sl >> 2, qq = sl & 3;
            const float rqi = rsqrtf(TAB[T_RQ2 * 64 + i] + RMS_EPS) * 0.08838834764831845f, gci = TAB[T_GC * 64 + i];
            float v[8];
#pragma unroll
            for (int e = 0; e < 8; ++e) { const int j = 32 * g + 4 * qq + (e & 3) + 16 * (e >> 2); const float raw = QKR[i * 68 + j];
                v[e] = (i >= j) ? raw * rqi * rsqrtf(TAB[T_RK2 * 64 + j] + RMS_EPS) * expf(fminf(gci - TAB[T_GC * 64 + j], 0.f)) : 0.f; }
            v4u o; o.x = pkbf(v[0], v[1]); o.y = pkbf(v[2], v[3]); o.z = pkbf(v[4], v[5]); o.w = pkbf(v[6], v[7]);
            *(GAS v4u*)(ud + GU_QK + i * 128 + ((sl ^ ((i >> 1) & 7)) * 16)) = o; }
        if (tid < 64) { const int i = tid; const float rk = rsqrtf(TAB[T_RK2 * 64 + i] + RMS_EPS), rq = rsqrtf(TAB[T_RQ2 * 64 + i] + RMS_EPS) * 0.08838834764831845f, be = TAB[T_BETA * 64 + i], eg = TAB[T_EG * 64 + i];
            TAB[T_SU * 64 + i] = be; TAB[T_SW * 64 + i] = be * eg * rk; TAB[T_SKD * 64 + i] = TAB[T_EK * 64 + i] * rk; TAB[T_SQD * 64 + i] = eg * rq;
            if (i == 63) *(GAS float*)(ud + GU_GL) = eg; } }
        PB_BAR();
        { int tid = tid_; asm volatile("" : "+v"(tid)); const int lane = tid & 63, c16 = lane & 15, q4 = lane >> 4;
        if (tid < 128) { if (!(abl & 1)) prep_solve2<true>(AT, TAB, VB, KB, OUTW, ud, tid); }
        else if (tid < 256) { if (!(abl & 1)) prep_solve2<false>(AT, TAB, VB, KB, OUTW, ud, tid); }
        else if (!(abl & 2)) {
            const int t = tid - 256;
#pragma unroll
            for (int k = 0; k < 4; ++k) { const int id = t + 256 * k, i = id >> 4, sl = id & 15, g = sl >> 2, qq = sl & 3; const float sc = TAB[T_SQD * 64 + i];
                const u32x2v lo = *(const LAS u32x2v*)(QB + i * (PB_ST * 2) + (32 * g + 4 * qq) * 2), hi = *(const LAS u32x2v*)(QB + i * (PB_ST * 2) + (32 * g + 16 + 4 * qq) * 2);
                v4u o; o.x = pkbf(bf2f(lo.x & 0xffffu) * sc, bf2f(lo.x >> 16) * sc); o.y = pkbf(bf2f(lo.y & 0xffffu) * sc, bf2f(lo.y >> 16) * sc);
                o.z = pkbf(bf2f(hi.x & 0xffffu) * sc, bf2f(hi.x >> 16) * sc); o.w = pkbf(bf2f(hi.y & 0xffffu) * sc, bf2f(hi.y >> 16) * sc);
                *(GAS v4u*)(ud + GU_QD + i * 256 + ((sl ^ (i & 15)) * 16)) = o; }
            const int w4 = wv - 4;
#pragma unroll
            for (int k = 0; k < 4; ++k) { const int task = w4 * 4 + k, db = task >> 1, g = task & 1;
                const int addr = (int)(size_t)KB + (32 * g + 4 * q4 + ((lane & 15) >> 2)) * (PB_ST * 2) + (16 * db + 4 * (lane & 3)) * 2;
                const f32x4 s0 = *(const LAS f32x4*)(TAB + T_SKD * 64 + 32 * g + 4 * q4), s1 = *(const LAS f32x4*)(TAB + T_SKD * 64 + 32 * g + 16 + 4 * q4);
                s16x4 lo, hi;
                asm volatile("ds_read_b64_tr_b16 %0, %2\n\tds_read_b64_tr_b16 %1, %2 offset:4352\n\ts_waitcnt lgkmcnt(0)" : "=&v"(lo), "=&v"(hi) : "v"(addr) : "memory");
                v4u o; o.x = pkbf(bf2f((unsigned short)lo[0]) * s0.x, bf2f((unsigned short)lo[1]) * s0.y); o.y = pkbf(bf2f((unsigned short)lo[2]) * s0.z, bf2f((unsigned short)lo[3]) * s0.w);
                o.z = pkbf(bf2f((unsigned short)hi[0]) * s1.x, bf2f((unsigned short)hi[1]) * s1.y); o.w = pkbf(bf2f((unsigned short)hi[2]) * s1.z, bf2f((unsigned short)hi[3]) * s1.w);
                const int d = 16 * db + c16;
                *(GAS v4u*)(ud + GU_KDT + d * 128 + (((4 * g + q4) ^ ((d >> 1) & 7)) * 16)) = o; }
        } }
        PB_BAR();
        if (!(abl & 1)) { int tid = tid_; asm volatile("" : "+v"(tid));
#pragma unroll
        for (int k = 0; k < 2; ++k) { const int o16 = (tid + 512 * k) * 16; *(GAS v4u*)(ud + GU_W + o16) = *(const LAS v4u*)(OUTW + o16); } }
    }
    asm volatile("s_waitcnt vmcnt(0) lgkmcnt(0)" ::: "memory"); __syncthreads();
#undef PB_PREFETCH
}
#undef PB_BAR

typedef float f32x16 __attribute__((ext_vector_type(16)));
#define KSWZ(row, colB) ((row) * 256 + ((colB) ^ (((row) & 7) << 4)))
#define SBAR() __builtin_amdgcn_sched_barrier(0)
__device__ __forceinline__ int crow(int r, int hi) { return (r & 3) + 8 * (r >> 2) + 4 * hi; }
__device__ __forceinline__ unsigned cvtpk(float lo, float hi) { unsigned r; asm volatile("v_cvt_pk_bf16_f32 %0, %1, %2" : "=v"(r) : "v"(lo), "v"(hi)); return r; }
__device__ __forceinline__ void qkt(f32x16& p0, f32x16& p1, const LAS unsigned char* Ks, const bf16x8* qr, int r32, int hi) {
    p0 = f32x16{}; p1 = f32x16{};
#pragma unroll
    for (int d0 = 0; d0 < 8; ++d0) { const int cb = (d0 * 16 + hi * 8) * 2;
        const bf16x8 b0 = *(const LAS bf16x8*)(Ks + KSWZ(r32, cb)), b1 = *(const LAS bf16x8*)(Ks + KSWZ(32 + r32, cb));
        p0 = __builtin_amdgcn_mfma_f32_32x32x16_bf16(b0, qr[d0], p0, 0, 0, 0);
        p1 = __builtin_amdgcn_mfma_f32_32x32x16_bf16(b1, qr[d0], p1, 0, 0, 0); }
}
__device__ __forceinline__ int v_st(int k, int c) { const int kk = (k & ~0xC) | ((k & 4) << 1) | ((k & 8) >> 1); return ((kk >> 3) * 4 + (c >> 5)) * 512 + ((kk & 7) * 32 + (c & 31)) * 2; }
__device__ __forceinline__ int v_rd_base(int lane) { return ((lane & 3) << 3) | (((lane >> 2) & 3) << 6) | (((lane >> 4) & 1) << 5) | (((lane >> 5) & 1) << 8); }
constexpr int v_rd_off(int d0, int ks, int half) { return d0 * 512 + ks * 4096 + half * 2048; }
template <int OFF> __device__ __forceinline__ s16x4 tr_read(int vb) { s16x4 r; asm volatile("ds_read_b64_tr_b16 %0, %1 offset:%2" : "=&v"(r) : "v"(vb), "i"(OFF) : "memory"); return r; }
template <int D0> __device__ __forceinline__ void pv_one(f32x16& od, int vb, bf16x8 pa0, bf16x8 pa1, bf16x8 pa2, bf16x8 pa3) {
    const s16x4 l0 = tr_read<v_rd_off(D0, 0, 0)>(vb), h0 = tr_read<v_rd_off(D0, 0, 1)>(vb), l1 = tr_read<v_rd_off(D0, 1, 0)>(vb), h1 = tr_read<v_rd_off(D0, 1, 1)>(vb);
    const s16x4 l2 = tr_read<v_rd_off(D0, 2, 0)>(vb), h2 = tr_read<v_rd_off(D0, 2, 1)>(vb), l3 = tr_read<v_rd_off(D0, 3, 0)>(vb), h3 = tr_read<v_rd_off(D0, 3, 1)>(vb);
    asm volatile("s_waitcnt lgkmcnt(0)" ::: "memory"); SBAR();
#define PK(L, H) (bf16x8){L[0], L[1], L[2], L[3], H[0], H[1], H[2], H[3]}
    od = __builtin_amdgcn_mfma_f32_32x32x16_bf16(pa0, PK(l0, h0), od, 0, 0, 0);
    od = __builtin_amdgcn_mfma_f32_32x32x16_bf16(pa1, PK(l1, h1), od, 0, 0, 0);
    od = __builtin_amdgcn_mfma_f32_32x32x16_bf16(pa2, PK(l2, h2), od, 0, 0, 0);
    od = __builtin_amdgcn_mfma_f32_32x32x16_bf16(pa3, PK(l3, h3), od, 0, 0, 0);
#undef PK
}
constexpr int ATT_V = 0, ATT_K = 16384, ATT_WS = 32768;
__device__ __forceinline__ void attn_unit(Frame& F, const Ptrs& P, int a) {
    constexpr float SCALE = 0.088388347648318440f, C = SCALE * 1.4426950408889634f;
    int tid_ = F.tid; asm volatile("" : "+v"(tid_));
    const int tid = tid_, wid = F.wave, lane = tid & 63, r32 = lane & 31, hi = lane >> 5;
    const bool isp = a < 512; const int kvh = a & 3, ab = isp ? (a >> 7) : ((a - 512) >> 2), ac = isp ? ((a >> 2) & 31) : 0;
    const int qrow0 = isp ? ab * SEQ_P + 64 * ac : ROW_S + ab * SEQ_S, pos0 = isp ? NMETA + 64 * ac : NMETA + PAST;
    LAS unsigned char* V_lds = F.lds + ATT_V; LAS unsigned char* K_lds = F.lds + ATT_K;
    LAS float* ws = (LAS float*)(F.lds + ATT_WS) + wid * 64; LAS float* li_l = ws; LAS float* al_l = ws + 32;
    const int g = wid >> 1, qoff = 32 * (wid & 1), hq = kvh * 4 + g;
    bf16x8 qr[8];
    { const bf16* qp = P.H + (size_t)(qrow0 + qoff + r32) * DINP + C_Q + hq * HD + hi * 8; const GAS f32x2v* cs = (const GAS f32x2v*)P.ROPE + (size_t)(pos0 + qoff + r32) * 64 + hi * 8;
#pragma unroll
        for (int d0 = 0; d0 < 4; ++d0) { const v4u lo = *(const GAS v4u*)(qp + d0 * 16), hh = *(const GAS v4u*)(qp + 64 + d0 * 16);
            const unsigned lw[4] = {lo.x, lo.y, lo.z, lo.w}, hw[4] = {hh.x, hh.y, hh.z, hh.w}; unsigned o1[4], o2[4];
#pragma unroll
            for (int j = 0; j < 4; ++j) { const f32x2v c0 = cs[d0 * 16 + 2 * j], c1 = cs[d0 * 16 + 2 * j + 1];
                const float a0 = bf2f(lw[j] & 0xffffu), a1 = bf2f(lw[j] >> 16), b0 = bf2f(hw[j] & 0xffffu), b1 = bf2f(hw[j] >> 16);
                o1[j] = cvtpk(a0 * c0.x - b0 * c0.y, a1 * c1.x - b1 * c1.y); o2[j] = cvtpk(b0 * c0.x + a0 * c0.y, b1 * c1.x + a1 * c1.y); }
            const v4u w1 = {o1[0], o1[1], o1[2], o1[3]}, w2 = {o2[0], o2[1], o2[2], o2[3]};
            qr[d0] = __builtin_bit_cast(bf16x8, w1); qr[d0 + 4] = __builtin_bit_cast(bf16x8, w2); } }
    float m_reg = -1e30f, l_reg = 0.f; f32x16 o[4] = {};
    const int sr = tid >> 4, sc = (tid & 15) * 8, vst0 = v_st(sr, sc), vst1 = v_st(32 + sr, sc);
    const int vb0 = (int)(size_t)V_lds + v_rd_base(lane);
    const int tmin = isp ? (ac >= 2 ? 1 : 3 - ac) : 1;
#define ATT_KROW(t) ((t) == 0 ? (isp ? ROW_M : KVR_SMETA + ab * NMETA) : (isp ? ab * SEQ_P + 64 * (ac - 3 + (t)) : ((t) == 3 ? ROW_S + ab * SEQ_S : KVR_SWIN + ab * WIN + 64 * ((t) - 1))))
#define ATT_LOAD(t) do { const int ra_ = ((t) == 0) ? (sr & 15) : sr, rb_ = ((t) == 0) ? (sr & 15) : 32 + sr;     \
        const bf16* kp_ = P.KB + (size_t)ATT_KROW(t) * KVW + kvh * HD + sc; const bf16* vp_ = P.VB + (size_t)ATT_KROW(t) * KVW + kvh * HD + sc; \
        nk0 = *(const GAS v4u*)(kp_ + (size_t)ra_ * KVW); nk1 = *(const GAS v4u*)(kp_ + (size_t)rb_ * KVW); nv0 = *(const GAS v4u*)(vp_ + (size_t)ra_ * KVW); nv1 = *(const GAS v4u*)(vp_ + (size_t)rb_ * KVW); } while (0)
    v4u nk0, nk1, nv0, nv1; ATT_LOAD(0);
#pragma unroll
    for (int t = 0; t < 4; ++t) {
        const bool kval_t = (t == 0) || (t >= tmin);
        if (kval_t) {
        const v4u k0 = nk0, k1 = nk1, v0 = nv0, v1 = nv1;
        __syncthreads();
        *(LAS v4u*)(V_lds + vst0) = v0; *(LAS v4u*)(V_lds + vst1) = v1; *(LAS v4u*)(K_lds + KSWZ(sr, sc * 2)) = k0; *(LAS v4u*)(K_lds + KSWZ(32 + sr, sc * 2)) = k1;
        __syncthreads();
        { const int nt_ = (t == 0) ? tmin : t + 1; if (nt_ <= 3) { if (nt_ == 1) ATT_LOAD(1); else if (nt_ == 2) ATT_LOAD(2); else ATT_LOAD(3); } }
        f32x16 p0, p1; qkt(p0, p1, K_lds, qr, r32, hi);
        if (t == 0) {
#pragma unroll
            for (int r = 8; r < 16; ++r) p0[r] = -INFINITY;
#pragma unroll
            for (int r = 0; r < 16; ++r) p1[r] = -INFINITY; }
        float pmax = p0[0];
#pragma unroll
        for (int r = 1; r < 16; ++r) pmax = fmaxf(pmax, p0[r]);
#pragma unroll
        for (int r = 0; r < 16; ++r) pmax = fmaxf(pmax, p1[r]);
        { auto rr = __builtin_amdgcn_permlane32_swap(__float_as_uint(pmax), __float_as_uint(pmax), false, false); pmax = fmaxf(__uint_as_float(rr[0]), __uint_as_float(rr[1])); }
        const float mn = fmaxf(m_reg, pmax), alpha = __builtin_amdgcn_exp2f((m_reg - mn) * C), mnC = -mn * C; m_reg = mn;
        float ps = 0.f;
#pragma unroll
        for (int r = 0; r < 16; ++r) { p0[r] = __builtin_amdgcn_exp2f(fmaf(p0[r], C, mnC)); p1[r] = __builtin_amdgcn_exp2f(fmaf(p1[r], C, mnC)); ps += p0[r] + p1[r]; }
        { auto rr = __builtin_amdgcn_permlane32_swap(__float_as_uint(ps), __float_as_uint(ps), false, false); ps = __uint_as_float(rr[0]) + __uint_as_float(rr[1]); }
        l_reg = l_reg * alpha + ps;
        if (hi == 0) al_l[r32] = alpha;
        asm volatile("s_waitcnt lgkmcnt(0)" ::: "memory");
#pragma unroll
        for (int d = 0; d < 4; ++d)
#pragma unroll
            for (int r = 0; r < 16; ++r) o[d][r] *= al_l[crow(r, hi)];
        bf16x8 pa0, pa1, pa2, pa3;
#define PK4(Pv, BASE, OUT) do { unsigned a0 = cvtpk(Pv[BASE + 0], Pv[BASE + 1]), a1 = cvtpk(Pv[BASE + 2], Pv[BASE + 3]);   \
    unsigned b0 = cvtpk(Pv[BASE + 4], Pv[BASE + 5]), b1 = cvtpk(Pv[BASE + 6], Pv[BASE + 7]);                              \
    auto r0 = __builtin_amdgcn_permlane32_swap(a0, b0, false, false); auto r1 = __builtin_amdgcn_permlane32_swap(a1, b1, false, false); \
    v4u w = {r0[0], r1[0], r0[1], r1[1]}; OUT = __builtin_bit_cast(bf16x8, w); } while (0)
        PK4(p0, 0, pa0); PK4(p0, 8, pa1); PK4(p1, 0, pa2); PK4(p1, 8, pa3);
#undef PK4
        SBAR();
        pv_one<0>(o[0], vb0, pa0, pa1, pa2, pa3); pv_one<1>(o[1], vb0, pa0, pa1, pa2, pa3); pv_one<2>(o[2], vb0, pa0, pa1, pa2, pa3); pv_one<3>(o[3], vb0, pa0, pa1, pa2, pa3);
        }
    }
#undef ATT_KROW
#undef ATT_LOAD
    l_reg += __builtin_amdgcn_exp2f(P.in[I_SINK][hq] * 1.4426950408889634f - m_reg * C);
    if (hi == 0) li_l[r32] = l_reg;
    asm volatile("s_waitcnt lgkmcnt(0)" ::: "memory");
    bf16* Ow = P.MIX + (size_t)(qrow0 + qoff) * D + hq * HD;
#pragma unroll
    for (int r = 0; r < 16; ++r) { const int orow = crow(r, hi); const float rl = __builtin_amdgcn_rcpf(li_l[orow]);
#pragma unroll
        for (int d0 = 0; d0 < 4; ++d0) Ow[(size_t)orow * D + d0 * 32 + r32] = (bf16)f2bf(o[d0][r] * rl); }
    __syncthreads();
}

typedef const GAS unsigned char* gcp;
template <class T> __device__ __forceinline__ T ldg_u(gcp ubase, unsigned voff) { return *(const GAS T*)(ubase + voff); }
constexpr int SC_ABUF = 57344, SC_SSQ_OFF = 2 * SC_ABUF;
template <int MODE  > __device__ __forceinline__ void gdn_scan_seq(Frame& F, const Ptrs& P, int kind  , int b, int h) {
    int lane_ = F.lane; asm volatile("" : "+v"(lane_));
    const int w = F.wave, lane = lane_, c16 = lane & 15, q4 = lane >> 4;
    LAS float* SSQ = (LAS float*)(F.lds + SC_SSQ_OFF);
    const unsigned ecol = (unsigned)(16 * w + c16);
    const unsigned voU = (unsigned)(q4 * 2048) + ecol * 4u;
    const unsigned voZ = (unsigned)(q4 * 4 * DINP * 2) + ecol * 2u;
    const unsigned voM = (unsigned)(q4 * 4 * D * 2) + ecol * 2u;
    unsigned fo256[4], fo128[2];
#pragma unroll
    for (int s = 0; s < 4; ++s) fo256[s] = (unsigned)(c16 * 256 + (((4 * s + q4) ^ c16) * 16));
#pragma unroll
    for (int s = 0; s < 2; ++s) fo128[s] = (unsigned)(c16 * 128 + (((4 * s + q4) ^ ((c16 >> 1) & 7)) * 16));
    const unsigned dma_lane = (unsigned)(w * 7168 + lane * 16);
    f32x4 S[8];
    if (kind == 2) { gcp s0 = (gcp)(P.in[I_SGDN] + (size_t)(b * NHG + h) * 128 * 128);
#pragma unroll
        for (int db = 0; db < 8; ++db)
#pragma unroll
            for (int r = 0; r < 4; ++r) S[db][r] = ldg_u<float>(s0 + db * 8192, voU + r * 512); }
    else {
#pragma unroll
        for (int db = 0; db < 8; ++db) S[db] = (f32x4){0.f, 0.f, 0.f, 0.f}; }
    const int nsteps = kind == 0 ? 33 : 1;
    const float nw = P.in[I_NORMW][ecol];
    const int seq = b * NHG + h;
#define SC_UD(t) ((gcp)(P.GDN + (size_t)(kind == 2 ? 2064 + seq : ((t) == 0 ? 2048 + h : seq * 32 + (t) - 1)) * GU_BYTES))
#define SC_ROW0(t) (kind == 0 ? b * SEQ_P + 64 * ((t) - 1) : ROW_S + b * SEQ_S)
#define SC_DMA(ud, buf) do { _Pragma("unroll") for (int _i = 0; _i < 7; ++_i) \
        __builtin_amdgcn_global_load_lds((const GAS unsigned*)((ud) + GU_W + dma_lane + _i * 1024), (LAS unsigned*)(F.lds + (buf) * SC_ABUF + w * 7168 + _i * 1024), 16, 0, 0); } while (0)
    float un[4][4], gln; unsigned zn[4][4];
#define SC_PREFETCH(udp) do { gln = *(const GAS float*)((udp) + GU_GL); \
        _Pragma("unroll") for (int m = 0; m < 4; ++m) _Pragma("unroll") for (int r = 0; r < 4; ++r) un[m][r] = ldg_u<float>((udp) + GU_U + m * 8192, voU + r * 512); } while (0)
#define SC_LD256(dst, off, m0) do { _Pragma("unroll") for (int mm = 0; mm < 2; ++mm) _Pragma("unroll") for (int s = 0; s < 4; ++s) dst[mm * 4 + s] = *(const LAS bf16x8*)(img + (off) + ((m0) + mm) * 4096 + fo256[s]); } while (0)
#define SC_LD128(dst, off, r0) do { _Pragma("unroll") for (int rr = 0; rr < 4; ++rr) _Pragma("unroll") for (int s = 0; s < 2; ++s) dst[rr * 2 + s] = *(const LAS bf16x8*)(img + (off) + ((r0) + rr) * 2048 + fo128[s]); } while (0)
#define SC_SCHED __builtin_amdgcn_sched_barrier(0)
#define SC_EPI(t, ov, zv) do { const LAS float* sq_ = SSQ + ((t) & 1) * 512; GAS unsigned char* mb_ = (GAS unsigned char*)((MODE == 0 ? P.MIX : P.XN) + (size_t)SC_ROW0(t) * D + 2048 + h * 128); \
        _Pragma("unroll") for (int m = 0; m < 4; ++m) _Pragma("unroll") for (int r = 0; r < 4; ++r) { const int i_ = 16 * m + 4 * q4 + r; \
            const f32x4 t0_ = *(const LAS f32x4*)(sq_ + i_ * 8), t1_ = *(const LAS f32x4*)(sq_ + i_ * 8 + 4); const float tot_ = ((t0_.x + t0_.y) + (t0_.z + t0_.w)) + ((t1_.x + t1_.y) + (t1_.z + t1_.w)); \
            const float rstd_ = rsqrtf(tot_ * (1.f / 128.f) + RMS_EPS); \
            *(GAS unsigned short*)(mb_ + (16 * m + r) * (D * 2) + voM) = (unsigned short)f2bf(ov[m][r] * rstd_ * nw * silu1(bf2f(zv[m][r]))); } } while (0)
    { gcp ud0 = SC_UD(0); if (MODE != 1) { SC_DMA(ud0, 0); } SC_PREFETCH(ud0); }
#pragma unroll
    for (int m = 0; m < 4; ++m)
#pragma unroll
        for (int r = 0; r < 4; ++r) zn[m][r] = 0u;
    f32x4 op[4]; unsigned zp[4][4];
#pragma unroll
    for (int m = 0; m < 4; ++m) { op[m] = (f32x4){0.f, 0.f, 0.f, 0.f};
#pragma unroll
        for (int r = 0; r < 4; ++r) zp[m][r] = 0u; }
    for (int step = 0; step < nsteps; ++step) {
        const bool has_out = !(kind == 0 && step == 0), prev_out = step > 0 && !(kind == 0 && step == 1);
        asm volatile("s_waitcnt vmcnt(0) lgkmcnt(0)" ::: "memory"); __builtin_amdgcn_s_barrier(); asm volatile("" ::: "memory");
        float uc[4][4], gl = gln;
#pragma unroll
        for (int m = 0; m < 4; ++m) {
#pragma unroll
            for (int r = 0; r < 4; ++r) { uc[m][r] = un[m][r]; zp[m][r] = zn[m][r]; }
            asm volatile("" : "+v"(uc[m][0]), "+v"(uc[m][1]), "+v"(uc[m][2]), "+v"(uc[m][3]), "+v"(zp[m][0]), "+v"(zp[m][1]), "+v"(zp[m][2]), "+v"(zp[m][3])); }
        asm volatile("" : "+v"(gl));
        SC_SCHED;
        if (has_out && MODE != 1) { gcp zb_ = (gcp)(P.H + (size_t)SC_ROW0(step) * DINP + C_Z + h * 128);
#pragma unroll
            for (int m = 0; m < 4; ++m)
#pragma unroll
                for (int r = 0; r < 4; ++r) zn[m][r] = ldg_u<unsigned short>(zb_ + (16 * m + r) * (DINP * 2), voZ); }
        if (step + 1 < nsteps && MODE != 1) { gcp udn = SC_UD(step + 1); SC_DMA(udn, (step + 1) & 1); SC_PREFETCH(udn); }
        SC_SCHED;
        if (prev_out) SC_EPI(step - 1, op, zp);
        SC_SCHED;
        if (MODE != 2) {
        const LAS unsigned char* img = F.lds + (step & 1) * SC_ABUF;
        bf16x8 X[8], Y[8];
        SC_LD256(X, GU_W - GU_W, 0); SC_LD256(Y, GU_W - GU_W, 2); SC_SCHED;
        bf16x8 Bs[4];
#pragma unroll
        for (int s = 0; s < 4; ++s) { const v4u t = {pkbf(S[2 * s][0], S[2 * s][1]), pkbf(S[2 * s][2], S[2 * s][3]), pkbf(S[2 * s + 1][0], S[2 * s + 1][1]), pkbf(S[2 * s + 1][2], S[2 * s + 1][3])}; Bs[s] = __builtin_bit_cast(bf16x8, t); }
        f32x4 vn[4], o[4];
#pragma unroll
        for (int mm = 0; mm < 2; ++mm) { f32x4 acc = {0.f, 0.f, 0.f, 0.f};
#pragma unroll
            for (int s = 0; s < 4; ++s) acc = __builtin_amdgcn_mfma_f32_16x16x32_bf16(X[mm * 4 + s], Bs[s], acc, 0, 0, 0);
#pragma unroll
            for (int r = 0; r < 4; ++r) vn[mm][r] = uc[mm][r] - acc[r]; }
        SC_SCHED; SC_LD256(X, GU_QD - GU_W, 0); SC_SCHED;
#pragma unroll
        for (int mm = 0; mm < 2; ++mm) { f32x4 acc = {0.f, 0.f, 0.f, 0.f};
#pragma unroll
            for (int s = 0; s < 4; ++s) acc = __builtin_amdgcn_mfma_f32_16x16x32_bf16(Y[mm * 4 + s], Bs[s], acc, 0, 0, 0);
#pragma unroll
            for (int r = 0; r < 4; ++r) vn[2 + mm][r] = uc[2 + mm][r] - acc[r]; }
        SC_SCHED; SC_LD256(Y, GU_QD - GU_W, 2); SC_SCHED;
        bf16x8 Bv[2];
#pragma unroll
        for (int s = 0; s < 2; ++s) { const v4u t = {pkbf(vn[2 * s][0], vn[2 * s][1]), pkbf(vn[2 * s][2], vn[2 * s][3]), pkbf(vn[2 * s + 1][0], vn[2 * s + 1][1]), pkbf(vn[2 * s + 1][2], vn[2 * s + 1][3])}; Bv[s] = __builtin_bit_cast(bf16x8, t); }
#pragma unroll
        for (int mm = 0; mm < 2; ++mm) { f32x4 acc = {0.f, 0.f, 0.f, 0.f};
#pragma unroll
            for (int s = 0; s < 4; ++s) acc = __builtin_amdgcn_mfma_f32_16x16x32_bf16(X[mm * 4 + s], Bs[s], acc, 0, 0, 0);
            o[mm] = acc; }
        SC_SCHED; SC_LD128(X, GU_KDT - GU_W, 0); SC_SCHED;
#pragma unroll
        for (int mm = 0; mm < 2; ++mm) { f32x4 acc = {0.f, 0.f, 0.f, 0.f};
#pragma unroll
            for (int s = 0; s < 4; ++s) acc = __builtin_amdgcn_mfma_f32_16x16x32_bf16(Y[mm * 4 + s], Bs[s], acc, 0, 0, 0);
            o[2 + mm] = acc; }
        SC_SCHED; SC_LD128(Y, GU_KDT - GU_W, 4); SC_SCHED;
#pragma unroll
        for (int rr = 0; rr < 4; ++rr) { f32x4 acc = S[rr] * gl;
#pragma unroll
            for (int s = 0; s < 2; ++s) acc = __builtin_amdgcn_mfma_f32_16x16x32_bf16(X[rr * 2 + s], Bv[s], acc, 0, 0, 0);
            S[rr] = acc; }
        SC_SCHED; SC_LD128(X, GU_QK - GU_W, 0); SC_SCHED;
#pragma unroll
        for (int rr = 0; rr < 4; ++rr) { f32x4 acc = S[4 + rr] * gl;
#pragma unroll
            for (int s = 0; s < 2; ++s) acc = __builtin_amdgcn_mfma_f32_16x16x32_bf16(Y[rr * 2 + s], Bv[s], acc, 0, 0, 0);
            S[4 + rr] = acc; }
        SC_SCHED;
#pragma unroll
        for (int m = 0; m < 4; ++m)
#pragma unroll
            for (int s = 0; s < 2; ++s) o[m] = __builtin_amdgcn_mfma_f32_16x16x32_bf16(X[m * 2 + s], Bv[s], o[m], 0, 0, 0);
        if (has_out) { LAS float* sq = SSQ + (step & 1) * 512;
#pragma unroll
            for (int m = 0; m < 4; ++m)
#pragma unroll
                for (int r = 0; r < 4; ++r) { float p = o[m][r] * o[m][r];
                    p += __builtin_bit_cast(float, __builtin_amdgcn_update_dpp(0, __builtin_bit_cast(int, p), 0xB1, 0xF, 0xF, true));
                    p += __builtin_bit_cast(float, __builtin_amdgcn_update_dpp(0, __builtin_bit_cast(int, p), 0x4E, 0xF, 0xF, true));
                    p += __builtin_bit_cast(float, __builtin_amdgcn_update_dpp(0, __builtin_bit_cast(int, p), 0x141, 0xF, 0xF, true));
                    p += __builtin_bit_cast(float, __builtin_amdgcn_update_dpp(0, __builtin_bit_cast(int, p), 0x140, 0xF, 0xF, true));
                    if (c16 == 0) sq[(16 * m + 4 * q4 + r) * 8 + w] = p; op[m][r] = o[m][r]; } }
            }
    }
    asm volatile("s_waitcnt vmcnt(0) lgkmcnt(0)" ::: "memory"); __builtin_amdgcn_s_barrier(); asm volatile("" ::: "memory");
    { const int t = nsteps - 1;
#pragma unroll
      for (int m = 0; m < 4; ++m) {
#pragma unroll
        for (int r = 0; r < 4; ++r) zp[m][r] = zn[m][r]; }
      if (!(kind == 0 && t == 0)) SC_EPI(t, op, zp); }
#undef SC_PREFETCH
#undef SC_LD256
#undef SC_LD128
#undef SC_SCHED
#undef SC_EPI
#undef SC_UD
#undef SC_ROW0
#undef SC_DMA
    GAS unsigned char* dst = (GAS unsigned char*)((MODE != 0 ? (float*)(P.GDN + (size_t)N_GUNITS * GU_BYTES) : (kind == 0 ? P.out + O_PGDN : P.out + O_SGDN)) + (size_t)(b * NHG + h) * 128 * 128);
#pragma unroll
    for (int db = 0; db < 8; ++db)
#pragma unroll
        for (int r = 0; r < 4; ++r) *(GAS float*)(dst + db * 8192 + (voU + r * 512)) = S[db][r];
    asm volatile("s_waitcnt vmcnt(0) lgkmcnt(0)" ::: "memory"); __syncthreads();
}

#ifndef SPLIT_P1
#define SPLIT_P1 2
#endif
#ifndef SPLIT_P9
#define SPLIT_P9 8
#endif
#ifndef SPLIT_P2
#define SPLIT_P2 3
#endif
#ifndef G_P1
#define G_P1 248
#endif
#ifndef G_P4
#define G_P4 240
#endif
#ifndef SPLIT_P7
#define SPLIT_P7 4
#endif
#ifndef SPLIT_P10
#define SPLIT_P10 4
#endif
struct Args { const float* in[N_IN]; float* out; unsigned char* ws; int ph_lo, ph_hi, li, pad; };
static_assert(sizeof(Args) == (N_IN + 2) * 8 + 16, "Args has no padding");
__global__ void __launch_bounds__(NWAVES * 64, 2) fwd_kernel(Args args) {
    extern __shared__ __attribute__((aligned(16))) unsigned char lds[];
    Frame F;
    F.lds = (LAS unsigned char*)lds;
    F.MISC = (volatile LAS unsigned*)(F.lds + MISC_OFF);
    F.tid = threadIdx.x; F.lane = F.tid & 63; F.wave = __builtin_amdgcn_readfirstlane(F.tid >> 6);
    F.G = gridDim.x; { const int bx = blockIdx.x; F.vcu = (F.G % 8 == 0) ? (bx % 8) * (F.G / 8) + bx / 8 : bx; }
    unsigned char* ws = args.ws;
    F.ctl = (gu32*)(ws + WS_CTL);
    Ptrs P;
#pragma unroll
    for (int i = 0; i < N_IN; ++i) P.in[i] = args.in[i];
    P.out = args.out;
    P.Wgu1 = (bf16*)(ws + WS_WGU1); P.Wd1 = (bf16*)(ws + WS_WD1); P.Wgu2 = (bf16*)(ws + WS_WGU2); P.Wd2 = (bf16*)(ws + WS_WD2); P.Win = (bf16*)(ws + WS_WIN); P.Wout = (bf16*)(ws + WS_WOUT);
    P.XN = (bf16*)(ws + WS_XN); P.MIX = (bf16*)(ws + WS_MIX); P.H = (bf16*)(ws + WS_H); P.KB = (bf16*)(ws + WS_KB); P.VB = (bf16*)(ws + WS_VB);
    P.Y = (float*)(ws + WS_Y); P.ROPE = (float*)(ws + WS_ROPE); P.GDN = ws + WS_GDN; P.SLAB = (float*)(ws + WS_SLAB); P.XQ = (signed char*)(ws + WS_XQ); P.SA = (float*)(ws + WS_SA); P.SB1 = (float*)(ws + WS_SB); P.SB2 = (float*)(ws + WS_SB + AL((size_t)NGU * 4)); P.CMAX = (unsigned*)(ws + WS_CTL) + CW_CMAX; P.HQ = (signed char*)(ws + WS_HQ); P.SH = (float*)(ws + WS_SH); P.SBD1 = (float*)(ws + WS_SBD); P.SBD2 = (float*)(ws + WS_SBD + AL((size_t)D * 4)); P.CMAXD = (unsigned*)(ws + WS_CTL) + CW_CMAXD; P.RMAX = (unsigned*)(ws + WS_CTL) + CW_RMAX;
    for (int u = F.tid; u < (LDS_BYTES - LDSCTL_OFF) / 4; u += NWAVES * 64) ((LAS unsigned*)(F.lds + LDSCTL_OFF))[u] = 0u;
    __syncthreads();
    XcdBarrier bar; bar.bar = (unsigned*)(F.ctl + CW_BAR) + args.li * XCD_BAR_WORDS; bar.x = 0; bar.st = nullptr;
    if (N_LAUNCHES == 1) bar = xcd_barrier_post((unsigned*)(F.ctl + CW_BAR) + args.li * XCD_BAR_WORDS, F.MISC + 8);
#define GRID_BAR() do { if (N_LAUNCHES == 1) xcd_barrier(bar); } while (0)
    const int lo = args.ph_lo, hi = args.ph_hi;
#define IN(k) (lo <= (k) && (k) < hi)
#define BOTH(k) (IN(k) && IN((k) + 1))

#ifndef PROBE_REPEAT
#define PROBE_REPEAT 0
#endif
#define REP(k) (((PROBE_REPEAT >> (k)) & 1) ? 2 : 1)
    if (IN(0)) { p0_prologue(F, P); GRID_BAR(); p0_quant_wgu1(F, P); if (BOTH(0)) GRID_BAR(); }
    if (IN(1)) { pg8::Gemm g{(const pg8::bf16_t*)P.XQ, (const pg8::bf16_t*)P.Wgu1, M1, NGU, D / 2}; pg8::StaticOrder S; S.init(M1, NGU, D / 2, G_P1, (int)blockIdx.x);
        pg8::EpiSwiGLU<true> E{P.H, FF, P.SLAB, 1, P.SA, P.SB1, nullptr};
        if ((int)blockIdx.x < G_P1) pg8::gemm_phase<pg8::EpiSwiGLU<true>, pg8::StaticOrder, true, true, true>(F.lds + RING_OFF, g, S, E);
        PHASE_DONE(1); q_fill(F, P, 1); q_catch_up(F, P, Q_E1);
        GRID_BAR(); quant_h(F, P.H, P.HQ, P.RMAX, P.SH, M1V);
        if (BOTH(1)) GRID_BAR(); }
    if (IN(2)) { pg8::Gemm g{(const pg8::bf16_t*)P.HQ, (const pg8::bf16_t*)P.Wd1, M1, D, FF / 2}; pg8::SplitOrder S; S.init(M1, D, FF / 2, F.G, (int)blockIdx.x, SPLIT_P2);
        typedef pg8::EpiResF32<0, true, false, true> Epi; Epi E{P.Y, D, pg8::RowSrc<0>{P.in[I_XP], P.in[I_XS], P.in[I_META], ROW_S, ROW_M, M1V, D}, P.SLAB, SPLIT_P2, P.SH, P.SBD1};
        pg8::gemm_phase<Epi, pg8::SplitOrder, true, true, true>(F.lds + RING_OFF, g, S, E);
        PHASE_DONE(2); q_fill(F, P, 2); q_catch_up(F, P, Q_E2);
        if (BOTH(2)) GRID_BAR(); }
    if (IN(3)) { pg8::SplitOrder SO; SO.init(M1, D, FF / 2, F.G, 0, SPLIT_P2); ln_phase(F, P.Y, P.Y, P.XN, P.in[I_LNG], P.in[I_LNB], M1V, SO, P.SLAB, 0.5f, nullptr, nullptr); q_catch_up(F, P, Q_E2); if (BOTH(3)) GRID_BAR(); }
    if (IN(4)) { pg8::Gemm g{P.XN, P.Win, M1, DINP, D}; pg8::StaticOrder S; S.init(M1, DINP, D, G_P4, (int)blockIdx.x);
        pg8::EpiStoreBf16 E{P.H, DINP};
        if ((int)blockIdx.x < G_P4) pg8::gemm_phase<pg8::EpiStoreBf16, pg8::StaticOrder, true, true>(F.lds + RING_OFF, g, S, E);
        PHASE_DONE(4); q_fill(F, P, 4);
        if (BOTH(4)) GRID_BAR(); }
#ifndef PROBE_ABL5
#define PROBE_ABL5 0
#endif
    if (IN(5)) { for (int rep = 0; rep < REP(5); ++rep) { const int abl = (args.li == 1) ? PROBE_ABL5 : 0;
        if (!(abl & 8)) kv_prep(F, P);
        gdn_prep_all(F, P, abl);
        q_catch_up(F, P, Q_E3);
        if (BOTH(5)) GRID_BAR(); } }
    if (IN(6)) {
        int it = blockIdx.x, st = (it < 64) ? (1 << 20) : F.G - 64;
        for (; it < 896; it += st) {
            if (it < 320) { const int s = it < 64 ? it : it - 64; gdn_scan_seq<0>(F, P, it < 64 ? 0 : 2, s >> 4, s & 15); }
            else attn_unit(F, P, it - 320);
        }
        if ((int)blockIdx.x >= 64) {
            sub_barrier(F, F.ctl + CW_SUB, (unsigned)(F.G - 64));
            pg8::Gemm g{P.MIX, P.Wout, M2, D, D}; pg8::StaticOrder S; S.init(M2, D, D, F.G - 64, (int)blockIdx.x - 64); S.set_k(0, 32);
            typedef pg8::EpiResF32<1, false> Epi; Epi E{P.Y, D, pg8::RowSrc<1>{P.Y, P.Y, P.Y, M2, M2, M2, D}, P.SLAB, 1, nullptr, nullptr};
            pg8::gemm_phase<Epi, pg8::StaticOrder, true, true>(F.lds + RING_OFF, g, S, E);
        }
        PHASE_DONE(6); q_fill(F, P, 6);
        if (BOTH(6)) GRID_BAR(); }
    if (IN(7)) {
        pg8::Gemm g{P.MIX, P.Wout, M2, D, D}; pg8::SplitOrder S; S.init(M2, D, D, F.G, (int)blockIdx.x, SPLIT_P7); S.set_k(32, 32);
        typedef pg8::EpiResF32<1, false, true> Epi; Epi E{P.Y, D, pg8::RowSrc<1>{P.Y, P.Y, P.Y, M2, M2, M2, D}, P.SLAB, SPLIT_P7, nullptr, nullptr};
        pg8::gemm_phase<Epi, pg8::SplitOrder, true, true>(F.lds + RING_OFF, g, S, E);
        PHASE_DONE(7); q_fill(F, P, 7);
        if (BOTH(7)) GRID_BAR(); }
    if (IN(8)) { pg8::SplitOrder SO; SO.init(M2, D, D, F.G, 0, SPLIT_P7); ln_phase(F, P.Y, P.Y, nullptr, P.in[I_LNG] + D, P.in[I_LNB] + D, M2, SO, P.SLAB, 1.0f, P.XQ, P.SA); q_catch_up(F, P, Q_E4); if (BOTH(8)) GRID_BAR(); }
    if (IN(9)) { pg8::Gemm g{(const pg8::bf16_t*)P.XQ, (const pg8::bf16_t*)P.Wgu2, M2, NGU, D / 2}; pg8::StaticOrder S; S.init(M2, NGU, D / 2, F.G, (int)blockIdx.x);
        pg8::EpiSwiGLU<true> E{P.H, FF, P.SLAB, 1, P.SA, P.SB2, nullptr};
        pg8::gemm_phase<pg8::EpiSwiGLU<true>, pg8::StaticOrder, true, true, true>(F.lds + RING_OFF, g, S, E);
        PHASE_DONE(9); q_fill(F, P, 9); q_catch_up(F, P, Q_E5);
        GRID_BAR(); quant_h(F, P.H, P.HQ, P.RMAX + M1, P.SH, M2);
        if (BOTH(9)) GRID_BAR(); }
    if (IN(10)) { pg8::Gemm g{(const pg8::bf16_t*)P.HQ, (const pg8::bf16_t*)P.Wd2, M2, D, FF / 2}; pg8::SplitOrder S; S.init(M2, D, FF / 2, F.G, (int)blockIdx.x, SPLIT_P10);
        typedef pg8::EpiResF32<1, true, false, true> Epi; Epi E{P.Y, D, pg8::RowSrc<1>{P.Y, P.Y, P.Y, M2, M2, M2, D}, P.SLAB, SPLIT_P10, P.SH, P.SBD2};
        pg8::gemm_phase<Epi, pg8::SplitOrder, true, true, true>(F.lds + RING_OFF, g, S, E);
        if (BOTH(10)) GRID_BAR(); }
    if (IN(11)) { for (int rep = 0; rep < REP(11); ++rep) { pg8::SplitOrder SO; SO.init(M2, D, FF / 2, F.G, 0, SPLIT_P10); ln_phase(F, P.Y, P.out + O_YP, nullptr, P.in[I_LNG] + 2 * D, P.in[I_LNB] + 2 * D, M2, SO, P.SLAB, 0.5f, nullptr, nullptr); if (rep + 1 < REP(11)) GRID_BAR(); } }
#undef IN
#undef BOTH
#undef GRID_BAR
}

extern "C" void kernel_launch(void* const* d_in, const int* in_sizes, int n_in, void* d_out, int out_size, void* d_ws, size_t ws_size, hipStream_t stream) {
    static int grid = 0;
    if (grid == 0) {
        if (n_in != N_IN || in_sizes[I_XP] != ROW_S * D || in_sizes[I_WIN] != D * DIN || (size_t)out_size != O_END || ws_size < WS_END) {
            fprintf(stderr, "kernel_launch: shape mismatch: n_in %d in0 %d out %d ws %zu (need %zu); nothing launched\n", n_in, n_in > 0 ? in_sizes[0] : -1, out_size, ws_size, (size_t)WS_END); grid = -1; return; }
        int dev = 0, cus = 0, per_cu = 0;
        if (hipGetDevice(&dev) != hipSuccess || hipDeviceGetAttribute(&cus, hipDeviceAttributeMultiprocessorCount, dev) != hipSuccess) { fprintf(stderr, "kernel_launch: device query failed\n"); grid = -1; return; }
        if (hipFuncSetAttribute((const void*)fwd_kernel, hipFuncAttributeMaxDynamicSharedMemorySize, LDS_BYTES) != hipSuccess) { fprintf(stderr, "kernel_launch: hipFuncSetAttribute failed\n"); grid = -1; return; }
        if (hipOccupancyMaxActiveBlocksPerMultiprocessor(&per_cu, (const void*)fwd_kernel, NWAVES * 64, LDS_BYTES) != hipSuccess || per_cu < 1)
            fprintf(stderr, "kernel_launch: note: occupancy query reports %d workgroups per CU\n", per_cu);
        (void)hipGetLastError();
        if (cus <= 64) { fprintf(stderr, "kernel_launch: %d CUs: this program needs more than 64 workgroups (64 of them run the GDN scans while the others start w_out); nothing launched\n", cus); grid = -1; return; }
        grid = cus;
    }
    if (grid < 0) return;
    if (hipMemsetAsync((char*)d_ws + WS_CTL, 0, CTL_ZERO_BYTES, stream) != hipSuccess) { fprintf(stderr, "kernel_launch: hipMemsetAsync failed\n"); return; }
    Args a{};
    for (int i = 0; i < N_IN; ++i) a.in[i] = (const float*)d_in[i];
    a.out = (float*)d_out; a.ws = (unsigned char*)d_ws;
#ifndef PROBE_PLAN
#define PROBE_PLAN {0, N_PHASES}
#endif
    const int plan[][2] = { PROBE_PLAN }; const int n_plan = (N_LAUNCHES == 1) ? (int)(sizeof(plan) / sizeof(plan[0])) : N_LAUNCHES;
    for (int li = 0; li < n_plan; ++li) {
        a.ph_lo = (N_LAUNCHES == 1) ? plan[li][0] : li; a.ph_hi = (N_LAUNCHES == 1) ? plan[li][1] : li + 1; a.li = (N_LAUNCHES == 1) ? li : 0;
        hipLaunchKernelGGL(fwd_kernel, dim3(grid), dim3(NWAVES * 64), LDS_BYTES, stream, a);
        const hipError_t le = hipPeekAtLastError();
        if (le != hipSuccess) { fprintf(stderr, "kernel_launch: launch %d failed: %s\n", li, hipGetErrorName(le)); break; }
    }
}
```

```cpp
#include <hip/hip_runtime.h>
#include <cstdio>
#include <cstdint>
namespace pg8 {
#define PG8_LAS __attribute__((address_space(3)))
typedef unsigned short bf16_t;
typedef short bf16x8 __attribute__((ext_vector_type(8)));
typedef float f32x4 __attribute__((ext_vector_type(4)));
typedef unsigned u32x4 __attribute__((ext_vector_type(4)));
typedef int i32x4 __attribute__((ext_vector_type(4)));
constexpr int BM = 256, BK = 64, HALF = 128, HTB = HALF * BK * 2  , STAGE_BYTES = 8 * HTB, NXCD = 8, WGM = 4;

__host__ __device__ __forceinline__ int lds_byte(int r, int c) { const int st = (r >> 4) * 2 + (c >> 5), rr = r & 15, cc = c & 31, ob = rr * 64 + cc * 2; return st * 1024 + (ob ^ (((ob >> 9) & 1) << 5)); }
__host__ __device__ __forceinline__ void stage_rc(int b, int& R, int& C) { const int st = b / 1024, sb = b % 1024, swz = sb ^ (((sb >> 9) & 1) << 5); R = (st >> 1) * 16 + swz / 64; C = (st & 1) * 32 + (swz % 64) / 2; }
__host__ __device__ __forceinline__ int perm32(int rho) { const int n = rho >> 4, i = rho & 15; return 8 * (i >> 2) + 4 * n + (i & 3); }

struct Unit { int pm, pn, k0, nt, sl, ri; };
struct Gemm { const bf16_t* A; const bf16_t* Bt; int M, N, K; };

struct StaticOrder {
    int nM, nN, nwg, G, c, ntk, kb;
    __host__ __device__ void init(int M, int N, int K, int G_, int c_) { nM = M / BM; nN = N / BM; nwg = nM * nN; G = G_; c = c_; ntk = K / BK; kb = 0; }
    __host__ __device__ void set_k(int kb_, int ntk_) { kb = kb_; ntk = ntk_; }
    __host__ __device__ void map(int L, Unit& u) const {
        int wgid = L; { const int q = nwg / NXCD, r = nwg % NXCD, xcd = wgid % NXCD, off = wgid / NXCD; wgid = (xcd < r ? xcd * (q + 1) : r * (q + 1) + (xcd - r) * q) + off; }
        const int nig = WGM * nN, gid = wgid / nig, fm = gid * WGM, gsz = (nM - fm) < WGM ? (nM - fm) : WGM;
        u.pm = fm + ((wgid % nig) % gsz); u.pn = (wgid % nig) / gsz; }
    __host__ __device__ int inv(int pm, int pn) const {
        const int nig = WGM * nN, gid = pm / WGM, fm = gid * WGM, gsz = (nM - fm) < WGM ? (nM - fm) : WGM; const int w = gid * nig + pn * gsz + (pm - fm);
        const int q = nwg / NXCD, r = nwg % NXCD; int xcd, off;
        if (w < r * (q + 1)) { xcd = w / (q + 1); off = w - xcd * (q + 1); } else { const int w2 = w - r * (q + 1); const int t = w2 / q; xcd = r + t; off = w2 - t * q; }
        return off * NXCD + xcd; }
    __host__ __device__ bool next(int i, Unit& u) const {
        const long L = (long)i * G + c; if (L >= nwg) return false;
        map((int)L, u); u.k0 = kb; u.nt = ntk; u.sl = 0; u.ri = -1; return true;
    }
    __device__ __forceinline__ void a_ready(const Unit&) const {}
    __device__ __forceinline__ void done(const Unit&) const {}
};
struct SplitOrder : StaticOrder {
    int R, rem, S;
    __host__ __device__ void init(int M, int N, int K, int G_, int c_, int S_) { StaticOrder::init(M, N, K, G_, c_); R = nwg / G; rem = nwg - R * G; S = S_; }
    __host__ __device__ bool next(int i, Unit& u) const {
        if (i < R) { map(i * G + c, u); u.k0 = kb; u.nt = ntk; u.sl = 0; u.ri = -1; return true; }
        const int j = (i - R) * G + c; if (j >= rem * S) return false;
        const int ri = j / S, s = j - ri * S, h = ntk / 2; map(R * G + ri, u);
        const int o0 = 2 * ((h * s) / S); u.k0 = kb + o0; u.nt = 2 * ((h * (s + 1)) / S) - o0; u.sl = s; u.ri = ri; return true;
    }
};

__device__ __forceinline__ unsigned cvt_pk_bf16(float lo, float hi) { unsigned r; asm volatile("v_cvt_pk_bf16_f32 %0, %1, %2" : "=v"(r) : "v"(lo), "v"(hi)); return r; }
typedef float f32x2 __attribute__((ext_vector_type(2)));
__device__ __forceinline__ float silu_f(float g) { return g * __builtin_amdgcn_rcpf(1.0f + __builtin_amdgcn_exp2f(-1.4426950408889634f * g)); }
template <bool I8> struct EpiSwiGLU {
    static constexpr bool PERM = true, AFTER_DRAIN = false;
    bf16_t* O; int ldc; float* slab; int S; const float *sA, *sB; unsigned* rmax;
    __device__ __forceinline__ void operator()(const f32x4 (&acc)[2][2][4][2], const Unit& u, int wr, int wc, int fr, int fq) const {
        if (u.ri >= 0) { float* sb = slab + ((size_t)(u.ri * S + u.sl) << 16) + wc * 32 + 8 * fq;
#pragma unroll
            for (int ai = 0; ai < 2; ++ai)
#pragma unroll
                for (int m = 0; m < 4; ++m) { float* o = sb + (ai * HALF + wr * 64 + m * 16 + fr) * BM;
#pragma unroll
                    for (int bj = 0; bj < 2; ++bj)
#pragma unroll
                        for (int n = 0; n < 2; ++n) *(f32x4*)(o + bj * HALF + 4 * n) = acc[ai][bj][m][n]; }
            return; }
        const int row0 = u.pm * BM + wr * 64 + fr, col0 = u.pn * HALF + wc * 32 + 8 * fq;
        f32x4 sbg0 = {1.f, 1.f, 1.f, 1.f}, sbg1 = sbg0, sbu0 = sbg0, sbu1 = sbg0;
        if constexpr (I8) { const int fr0 = u.pn * BM + wc * 32 + 8 * fq;
            sbg0 = *(const f32x4*)(sB + fr0); sbg1 = *(const f32x4*)(sB + fr0 + 4); sbu0 = *(const f32x4*)(sB + fr0 + HALF); sbu1 = *(const f32x4*)(sB + fr0 + HALF + 4); }
#pragma unroll
        for (int ai = 0; ai < 2; ++ai)
#pragma unroll
            for (int m = 0; m < 4; ++m) { bf16_t* rowp = O + (size_t)(row0 + ai * HALF + m * 16) * ldc + col0;
                f32x4 g0 = acc[ai][0][m][0], g1 = acc[ai][0][m][1], u0 = acc[ai][1][m][0], u1 = acc[ai][1][m][1];
                if constexpr (I8) { const float sa = sA[row0 + ai * HALF + m * 16];
                    g0 = __builtin_convertvector(__builtin_bit_cast(i32x4, g0), f32x4) * (sbg0 * sa); g1 = __builtin_convertvector(__builtin_bit_cast(i32x4, g1), f32x4) * (sbg1 * sa);
                    u0 = __builtin_convertvector(__builtin_bit_cast(i32x4, u0), f32x4) * (sbu0 * sa); u1 = __builtin_convertvector(__builtin_bit_cast(i32x4, u1), f32x4) * (sbu1 * sa); }
                u32x4 w;
                w.x = cvt_pk_bf16(silu_f(g0[0]) * u0[0], silu_f(g0[1]) * u0[1]); w.y = cvt_pk_bf16(silu_f(g0[2]) * u0[2], silu_f(g0[3]) * u0[3]);
                w.z = cvt_pk_bf16(silu_f(g1[0]) * u1[0], silu_f(g1[1]) * u1[1]); w.w = cvt_pk_bf16(silu_f(g1[2]) * u1[2], silu_f(g1[3]) * u1[3]);
                *(u32x4*)rowp = w;
                if (rmax) { unsigned mx = 0u;
                    { const unsigned ww_[4] = {w.x, w.y, w.z, w.w};
#pragma unroll
                      for (int k_ = 0; k_ < 4; ++k_) { const unsigned lo_ = (ww_[k_] << 16) & 0x7fff0000u, hi_ = ww_[k_] & 0x7fff0000u; mx = mx > lo_ ? mx : lo_; mx = mx > hi_ ? mx : hi_; } }
                    { const unsigned o_ = (unsigned)__shfl_xor((int)mx, 16); mx = mx > o_ ? mx : o_; } { const unsigned o_ = (unsigned)__shfl_xor((int)mx, 32); mx = mx > o_ ? mx : o_; }
                    if (fq == 0) (void)__hip_atomic_fetch_max(rmax + row0 + ai * HALF + m * 16, mx, __ATOMIC_RELAXED, __HIP_MEMORY_SCOPE_AGENT); } }
    }
};
struct EpiStoreBf16 {
    static constexpr bool PERM = true, AFTER_DRAIN = false;
    bf16_t* O; int ldc;
    __device__ __forceinline__ void operator()(const f32x4 (&acc)[2][2][4][2], const Unit& u, int wr, int wc, int fr, int fq) const {
        const int row0 = u.pm * BM + wr * 64 + fr, col0 = u.pn * BM + wc * 32 + 8 * fq;
#pragma unroll
        for (int ai = 0; ai < 2; ++ai)
#pragma unroll
            for (int m = 0; m < 4; ++m) { bf16_t* rowp = O + (size_t)(row0 + ai * HALF + m * 16) * ldc + col0;
#pragma unroll
                for (int bj = 0; bj < 2; ++bj) { const f32x4 v0 = acc[ai][bj][m][0], v1 = acc[ai][bj][m][1];
                    u32x4 w; w.x = cvt_pk_bf16(v0[0], v0[1]); w.y = cvt_pk_bf16(v0[2], v0[3]); w.z = cvt_pk_bf16(v1[0], v1[1]); w.w = cvt_pk_bf16(v1[2], v1[3]);
                    *(u32x4*)(rowp + bj * HALF) = w; } }
    }
};
template <int MODE> struct RowSrc {
    const float *p0, *p1, *p2; int n0, n1, n2, ld;
    __device__ __forceinline__ const float* row(int r) const {
        if (MODE == 1) return r < n0 ? p0 + (size_t)r * ld : nullptr;
        if (r < n0) return p0 + (size_t)r * ld;
        if (r < n1) return p1 + (size_t)(r - n0) * ld;
        if (r < n2) return p2 + (size_t)(r - n1) * ld;
        return nullptr; }
};
template <int MODE, bool HALF_, bool ALPHA1 = false, bool I8 = false> struct EpiResF32 {
    static constexpr bool PERM = false, AFTER_DRAIN = false;
    float* out; int ldc; RowSrc<MODE> src; float* slab; int S;
    const float *sA, *sB;
    __device__ __forceinline__ void operator()(const f32x4 (&acc)[2][2][4][2], const Unit& u, int wr, int wc, int fr, int fq) const {
        constexpr float alpha = ALPHA1 ? 1.0f : 1.189207115002721f, scale = HALF_ ? 0.5f : 1.0f;
        f32x4 sb_[2][2];
        if constexpr (I8) { const int c0_ = u.pn * BM + wc * 32 + 4 * fq;
#pragma unroll
            for (int bj = 0; bj < 2; ++bj)
#pragma unroll
                for (int n = 0; n < 2; ++n) sb_[bj][n] = *(const f32x4*)(sB + c0_ + bj * HALF + n * 16); }
#define EPI_VAL(ai, bj, m, n, sa_) (I8 ? __builtin_convertvector(__builtin_bit_cast(i32x4, acc[ai][bj][m][n]), f32x4) * (sb_[bj][n] * (sa_)) : acc[ai][bj][m][n])
        if (u.sl > 0) {
            float* sb = slab + ((size_t)(u.ri * (S - 1) + (u.sl - 1)) << 16) + wc * 32 + 4 * fq;
#pragma unroll
            for (int ai = 0; ai < 2; ++ai)
#pragma unroll
                for (int m = 0; m < 4; ++m) { float* o = sb + (ai * HALF + wr * 64 + m * 16 + fr) * BM; float sa_ = 1.f; if constexpr (I8) sa_ = sA[u.pm * BM + ai * HALF + wr * 64 + m * 16 + fr];
#pragma unroll
                    for (int bj = 0; bj < 2; ++bj)
#pragma unroll
                        for (int n = 0; n < 2; ++n) *(f32x4*)(o + bj * HALF + n * 16) = EPI_VAL(ai, bj, m, n, sa_); }
            return; }
        const int col0 = u.pn * BM + wc * 32 + 4 * fq;
#pragma unroll
        for (int ai = 0; ai < 2; ++ai)
#pragma unroll
            for (int m = 0; m < 4; ++m) { const int r = u.pm * BM + ai * HALF + wr * 64 + m * 16 + fr; const float* b = src.row(r);
                if (b) { float* o = out + (size_t)r * ldc; float sa_ = 1.f; if constexpr (I8) sa_ = sA[r];
#pragma unroll
                    for (int bj = 0; bj < 2; ++bj)
#pragma unroll
                        for (int n = 0; n < 2; ++n) { const int c = col0 + bj * HALF + n * 16; const f32x4 bs = *(const f32x4*)(b + c);
                            *(f32x4*)(o + c) = bs * alpha + EPI_VAL(ai, bj, m, n, sa_) * scale; } } }
#undef EPI_VAL
    }
};
template <class Epi, class Sched, bool ALIGN_EPI = false, bool SP2 = false, bool I8 = false>
__device__ __forceinline__ void gemm_phase(PG8_LAS unsigned char* lds, const Gemm g, const Sched& S, const Epi& E) {
    const int tid = threadIdx.x, wid = __builtin_amdgcn_readfirstlane(tid >> 6), lane = tid & 63, wr = wid >> 2, wc = wid & 3, fr = lane & 15, fq = lane >> 4;
    const int K = g.K;
    unsigned voffA[2], voffB[2];
#pragma unroll
    for (int i = 0; i < 2; ++i) { int R, C; stage_rc(tid * 16 + i * 8192, R, C); const int Rb = Epi::PERM ? ((R & ~31) + perm32(R & 31)) : R;
        voffA[i] = (unsigned)(R * K + C) * 2u; voffB[i] = (unsigned)(Rb * K + C) * 2u; }
    const size_t kstep = (size_t)(BK * 2);
    const size_t hstep = (size_t)HALF * K * 2;
    const size_t tstep = 2 * hstep;
    const unsigned ldsw = (unsigned)wid * 1024u;
    const int aoff = lds_byte(wr * 64 + fr, fq * 8), boff = lds_byte(wc * 32 + fr, fq * 8);
#define PG8_SA(b, h) (((b) * 2 + (h)) * HTB)
#define PG8_SB(b, h) ((4 + (b) * 2 + (h)) * HTB)
#define PG8_STAGE(bufoff, gbase, voff) do { _Pragma("unroll") for (int _i = 0; _i < 2; ++_i) \
        __builtin_amdgcn_global_load_lds((const unsigned*)((const char*)(gbase) + (voff)[_i]), (PG8_LAS unsigned*)(lds + (bufoff) + ldsw + _i * 8192), 16, 0, 0); } while (0)
#define PG8_LDA(dst, b, h) do { _Pragma("unroll") for (int m = 0; m < 4; ++m) _Pragma("unroll") for (int k = 0; k < 2; ++k) dst[m][k] = *(const PG8_LAS bf16x8*)(lds + PG8_SA(b, h) + aoff + m * 2048 + k * 1024); } while (0)
#define PG8_LDB(dst, b, h) do { _Pragma("unroll") for (int n = 0; n < 2; ++n) _Pragma("unroll") for (int k = 0; k < 2; ++k) dst[n][k] = *(const PG8_LAS bf16x8*)(lds + PG8_SB(b, h) + boff + n * 2048 + k * 1024); } while (0)
#define PG8_MMA(ai, bj, At, Bt) do { __builtin_amdgcn_s_setprio(1); _Pragma("unroll") for (int m = 0; m < 4; ++m) _Pragma("unroll") for (int n = 0; n < 2; ++n) _Pragma("unroll") for (int k = 0; k < 2; ++k) \
        { if constexpr (I8) acc[ai][bj][m][n] = __builtin_bit_cast(f32x4, __builtin_amdgcn_mfma_i32_16x16x64_i8(__builtin_bit_cast(i32x4, Bt[n][k]), __builtin_bit_cast(i32x4, At[m][k]), __builtin_bit_cast(i32x4, acc[ai][bj][m][n]), 0, 0, 0)); \
          else acc[ai][bj][m][n] = __builtin_amdgcn_mfma_f32_16x16x32_bf16(Bt[n][k], At[m][k], acc[ai][bj][m][n], 0, 0, 0); } __builtin_amdgcn_s_setprio(0); } while (0)
#define PG8_WAIT_V(n) asm volatile("s_waitcnt vmcnt(" #n ")" ::: "memory")
#define PG8_WAIT_L(n) asm volatile("s_waitcnt lgkmcnt(" #n ")" ::: "memory")
#define PG8_BAR __builtin_amdgcn_s_barrier()
#define PG8_SCHED __builtin_amdgcn_sched_barrier(0)
    Unit cur, nxt; int ui = 0;
    if (!S.next(0, cur)) return;
    f32x4 acc[2][2][4][2];
#pragma unroll
    for (int a = 0; a < 2; ++a)
#pragma unroll
        for (int b = 0; b < 2; ++b)
#pragma unroll
            for (int m = 0; m < 4; ++m)
#pragma unroll
                for (int n = 0; n < 2; ++n) acc[a][b][m][n] = (f32x4){0.f, 0.f, 0.f, 0.f};
    bf16x8 At[4][2], B0[2][2], B1[2][2];
    const char* cA = (const char*)g.A + (size_t)cur.pm * tstep + (size_t)cur.k0 * kstep; const char* cB = (const char*)g.Bt + (size_t)cur.pn * tstep + (size_t)cur.k0 * kstep; int nt = cur.nt;
    S.a_ready(cur);
    if constexpr (SP2) {
        PG8_STAGE(PG8_SB(0, 0), cB, voffB); PG8_STAGE(PG8_SB(0, 1), cB + hstep, voffB); PG8_STAGE(PG8_SA(0, 0), cA, voffA); PG8_STAGE(PG8_SA(0, 1), cA + hstep, voffA);
        if (wr == 1) PG8_BAR;
        PG8_WAIT_V(2); PG8_BAR;
        PG8_STAGE(PG8_SB(1, 0), cB + kstep, voffB); PG8_STAGE(PG8_SA(1, 0), cA + kstep, voffA); PG8_STAGE(PG8_SB(1, 1), cB + hstep + kstep, voffB);
        PG8_WAIT_V(6); PG8_BAR;
    } else {
        PG8_STAGE(PG8_SB(0, 0), cB, voffB); PG8_STAGE(PG8_SA(0, 0), cA, voffA); PG8_STAGE(PG8_SB(0, 1), cB + hstep, voffB); PG8_STAGE(PG8_SA(0, 1), cA + hstep, voffA);
        if (wr == 1) PG8_BAR;
        PG8_WAIT_V(4); PG8_BAR;
        PG8_STAGE(PG8_SB(1, 0), cB + kstep, voffB); PG8_STAGE(PG8_SA(1, 0), cA + kstep, voffA); PG8_STAGE(PG8_SB(1, 1), cB + hstep + kstep, voffB);
        PG8_WAIT_V(6); PG8_BAR;
    }
    for (;;) {
        const bool has_next = S.next(ui + 1, nxt);
        const char* nA = has_next ? (const char*)g.A + (size_t)nxt.pm * tstep + (size_t)nxt.k0 * kstep : cA; const char* nB = has_next ? (const char*)g.Bt + (size_t)nxt.pn * tstep + (size_t)nxt.k0 * kstep : cB;
        for (int t = 0; t < nt; t += 2) {
            const bool last = (t == nt - 2);
            const char* a1 = cA + (size_t)(t + 1) * kstep;
            const char* a2 = last ? nA : cA + (size_t)(t + 2) * kstep; const char* b2 = last ? nB : cB + (size_t)(t + 2) * kstep;
            const char* a3 = a2 + kstep; const char* b3 = b2 + kstep;
            if (last && has_next) S.a_ready(nxt);
            if constexpr (SP2) {
            PG8_LDB(B0, 0, 0); PG8_LDB(B1, 0, 1); PG8_SCHED; PG8_LDA(At, 0, 0); PG8_STAGE(PG8_SA(1, 1), a1 + hstep, voffA);
            PG8_WAIT_V(8); PG8_WAIT_L(0); PG8_BAR; PG8_MMA(0, 0, At, B0); PG8_MMA(0, 1, At, B1); PG8_BAR; PG8_SCHED;
            PG8_LDA(At, 0, 1); PG8_STAGE(PG8_SB(0, 0), b2, voffB); PG8_STAGE(PG8_SB(0, 1), b2 + hstep, voffB); PG8_STAGE(PG8_SA(0, 0), a2, voffA);
            PG8_WAIT_V(8); PG8_WAIT_L(0); PG8_BAR; PG8_MMA(1, 0, At, B0); PG8_MMA(1, 1, At, B1); PG8_BAR; PG8_SCHED;
            PG8_LDB(B0, 1, 0); PG8_LDB(B1, 1, 1); PG8_SCHED; PG8_LDA(At, 1, 0); PG8_STAGE(PG8_SA(0, 1), a2 + hstep, voffA);
            PG8_WAIT_V(8); PG8_WAIT_L(0); PG8_BAR; PG8_MMA(0, 0, At, B0); PG8_MMA(0, 1, At, B1); PG8_BAR; PG8_SCHED;
            PG8_LDA(At, 1, 1); PG8_STAGE(PG8_SB(1, 0), b3, voffB); PG8_STAGE(PG8_SB(1, 1), b3 + hstep, voffB); PG8_STAGE(PG8_SA(1, 0), a3, voffA);
            PG8_WAIT_V(8); PG8_WAIT_L(0); PG8_BAR; PG8_MMA(1, 0, At, B0); PG8_MMA(1, 1, At, B1); PG8_BAR; PG8_SCHED;
            } else {
            PG8_LDB(B0, 0, 0); PG8_SCHED; PG8_LDA(At, 0, 0); PG8_STAGE(PG8_SA(1, 1), a1 + hstep, voffA);
            PG8_WAIT_L(8); PG8_BAR; PG8_WAIT_L(0); PG8_MMA(0, 0, At, B0); PG8_BAR; PG8_SCHED;
            PG8_LDB(B1, 0, 1); PG8_STAGE(PG8_SB(0, 0), b2, voffB);
            PG8_BAR; PG8_WAIT_L(0); PG8_MMA(0, 1, At, B1); PG8_BAR;
            PG8_LDA(At, 0, 1); PG8_STAGE(PG8_SA(0, 0), a2, voffA);
            PG8_BAR; PG8_WAIT_L(0); PG8_MMA(1, 0, At, B0); PG8_BAR; PG8_SCHED;
            PG8_STAGE(PG8_SB(0, 1), b2 + hstep, voffB);
            PG8_WAIT_V(6); PG8_BAR; PG8_MMA(1, 1, At, B1); PG8_BAR;
            PG8_LDB(B0, 1, 0); PG8_SCHED; PG8_LDA(At, 1, 0); PG8_STAGE(PG8_SA(0, 1), a2 + hstep, voffA);
            PG8_WAIT_L(8); PG8_BAR; PG8_WAIT_L(0); PG8_MMA(0, 0, At, B0); PG8_BAR; PG8_SCHED;
            PG8_LDB(B1, 1, 1); PG8_STAGE(PG8_SB(1, 0), b3, voffB);
            PG8_BAR; PG8_WAIT_L(0); PG8_MMA(0, 1, At, B1); PG8_BAR;
            PG8_LDA(At, 1, 1); PG8_STAGE(PG8_SA(1, 0), a3, voffA);
            PG8_BAR; PG8_WAIT_L(0); PG8_MMA(1, 0, At, B0); PG8_BAR; PG8_SCHED;
            PG8_STAGE(PG8_SB(1, 1), b3 + hstep, voffB);
            PG8_WAIT_V(6); PG8_BAR; PG8_MMA(1, 1, At, B1); PG8_BAR;
            }
        }
        if constexpr (ALIGN_EPI) { if (wr == 0) PG8_BAR; }
        if constexpr (!Epi::AFTER_DRAIN) { E(acc, cur, wr, wc, fr, fq); S.done(cur); }
        if (!has_next) break;
#pragma unroll
        for (int a = 0; a < 2; ++a)
#pragma unroll
            for (int b = 0; b < 2; ++b)
#pragma unroll
                for (int m = 0; m < 4; ++m)
#pragma unroll
                    for (int n = 0; n < 2; ++n) acc[a][b][m][n] = (f32x4){0.f, 0.f, 0.f, 0.f};
        cur = nxt; cA = nA; cB = nB; nt = cur.nt; ++ui;
        if constexpr (ALIGN_EPI) { if (wr == 1) PG8_BAR; }
    }
    PG8_WAIT_V(0);
    if constexpr (!ALIGN_EPI) { if (wr == 0) PG8_BAR; }
    PG8_BAR;
    if constexpr (Epi::AFTER_DRAIN) { E.fused(acc, cur, wr, wc, fr, fq, lds, wid, lane); S.done(cur); }
#undef PG8_SA
#undef PG8_SB
#undef PG8_STAGE
#undef PG8_LDA
#undef PG8_LDB
#undef PG8_MMA
#undef PG8_WAIT_V
#undef PG8_WAIT_L
#undef PG8_BAR
#undef PG8_SCHED
}
}
#define GAS __attribute__((address_space(1)))
#define LAS __attribute__((address_space(3)))
typedef unsigned short bf16;
typedef unsigned v4u __attribute__((ext_vector_type(4)));
typedef float f32x4 __attribute__((ext_vector_type(4)));
typedef short bf16x8 __attribute__((ext_vector_type(8)));
typedef GAS unsigned gu32;
typedef GAS unsigned long long gu64;
#define RLX_AGENT __ATOMIC_RELAXED, __HIP_MEMORY_SCOPE_AGENT
#define LDS_WAIT() asm volatile("s_waitcnt lgkmcnt(0)" ::: "memory")
#define VM_WAIT() asm volatile("s_waitcnt vmcnt(0)" ::: "memory")
__device__ __forceinline__ unsigned long long rt() { return __builtin_amdgcn_s_memrealtime(); }
__device__ __forceinline__ unsigned f2bf(float f) { unsigned u = __builtin_bit_cast(unsigned, f); return (u + 0x7fffu + ((u >> 16) & 1u)) >> 16; }
__device__ __forceinline__ unsigned pk2(float lo, float hi) { return f2bf(lo) | (f2bf(hi) << 16); }

#define XB_TMO      128
#define XB_XCNT(j)  (256  + 64 * (j))
#define XB_XSUB(j)  (1280 + 64 * (j))
#define XB_XGEN(j)  (2304 + 64 * (j))
#define XB_TOP      3328
#define XB_TOPGEN   3392
#define XCD_BAR_WORDS 3456
#define XB_SPIN_CAP (1u << 18)

__device__ __forceinline__ unsigned xb_ld(unsigned* p)              { return __hip_atomic_load(p, __ATOMIC_RELAXED, __HIP_MEMORY_SCOPE_AGENT); }
__device__ __forceinline__ unsigned xb_add(unsigned* p, unsigned v) { return __hip_atomic_fetch_add(p, v, __ATOMIC_RELAXED, __HIP_MEMORY_SCOPE_AGENT); }
__device__ __forceinline__ unsigned xb_xcc_id() { return (unsigned)__builtin_amdgcn_s_getreg((3 << 11) | 20) & 0xFu; }
#define XB_SPIN(cond, bar) do { unsigned _sp = 0; while (cond) { __builtin_amdgcn_s_sleep(1); \
    if ((++_sp & 255u) == 0u) { if (xb_ld(&(bar)[XB_TMO])) break; if (_sp > XB_SPIN_CAP) { atomicAdd(&(bar)[XB_TMO], 1u); break; } } } } while (0)

struct XcdBarrier {
    unsigned* bar; unsigned x;
    volatile LAS unsigned* st;
};

__device__ __forceinline__ XcdBarrier xcd_barrier_post(unsigned* bar, volatile LAS unsigned* st) {
    XcdBarrier b; b.bar = bar; b.x = xb_xcc_id(); b.st = st;
    if (threadIdx.x == 0) (void)xb_add(&bar[XB_XCNT(b.x)], 1u);
    return b;
}
__device__ __forceinline__ void xcd_barrier_complete(unsigned* bar, unsigned x, unsigned& nloc, unsigned& nx) {
    const unsigned G = gridDim.x * gridDim.y * gridDim.z;
    unsigned sum, cnt, mine, sp = 0u;
    for (;;) {
        sum = 0u; cnt = 0u; mine = 0u;
#pragma unroll
        for (unsigned j = 0; j < 16; ++j) { const unsigned c = xb_ld(&bar[XB_XCNT(j)]); sum += c; cnt += (c > 0u) ? 1u : 0u; mine = (j == x) ? c : mine; }
        if (sum == G) break;
        __builtin_amdgcn_s_sleep(1);
        if ((++sp & 255u) == 0u) { if (xb_ld(&bar[XB_TMO])) break; if (sp > XB_SPIN_CAP) { atomicAdd(&bar[XB_TMO], 1u); break; } }
    }
    nloc = mine > 0u ? mine : 1u; nx = cnt > 0u ? cnt : 1u;
}

__device__ __forceinline__ void xcd_barrier(const XcdBarrier& b) {
    asm volatile("s_waitcnt vmcnt(0)" ::: "memory");
    __syncthreads();
    if (threadIdx.x == 0) {
        unsigned* bar = b.bar;
        __builtin_amdgcn_s_waitcnt(0);
        unsigned nloc = b.st[0], nx = b.st[1];
        if (nloc == 0u) { xcd_barrier_complete(bar, b.x, nloc, nx); b.st[0] = nloc; b.st[1] = nx; }
        const unsigned old = xb_add(&bar[XB_XSUB(b.x)], 1u);
        const unsigned gen = old / nloc;
        if (old + 1u == (gen + 1u) * nloc) {
            __builtin_amdgcn_fence(__ATOMIC_RELEASE, "agent");
            asm volatile("s_waitcnt vmcnt(0)" ::: "memory");
            const unsigned og = xb_add(&bar[XB_TOP], 1u);
            const unsigned tg = og / nx;
            if (og + 1u == (tg + 1u) * nx) xb_add(&bar[XB_TOPGEN], 1u);
            else XB_SPIN(xb_ld(&bar[XB_TOPGEN]) == tg, bar);
            __builtin_amdgcn_fence(__ATOMIC_ACQUIRE, "agent");
            xb_add(&bar[XB_XGEN(b.x)], 1u);
            asm volatile("s_waitcnt vmcnt(0)" ::: "memory");
        } else {
            XB_SPIN(xb_ld(&bar[XB_XGEN(b.x)]) == gen, bar);
            __builtin_amdgcn_fence(__ATOMIC_ACQUIRE, "agent");
            asm volatile("s_waitcnt vmcnt(0)" ::: "memory");
        }
    }
    __syncthreads();
}


constexpr int NWAVES = 8;
#ifndef MK_N_LAUNCHES
#define MK_N_LAUNCHES 1
#endif
constexpr int N_PHASES = 12;
constexpr int N_LAUNCHES = MK_N_LAUNCHES;
static_assert(N_LAUNCHES == 1 || N_LAUNCHES == N_PHASES, "MK_N_LAUNCHES is 1 or 12");

constexpr int D = 4096, FF = 11008, NGU = 2 * FF, DIN = 11296, DINP = 11520;
constexpr int NB_P = 4, SEQ_P = 2048, NB_S = 16, SEQ_S = 64, NMETA = 16, PAST = 2048;
constexpr int ROW_S = NB_P * SEQ_P  , ROW_M = ROW_S + NB_S * SEQ_S  , M1V = ROW_M + NMETA  , M1 = 9472  , M2 = ROW_M  ;
constexpr int KVH = 4, HD = 128, KVW = KVH * HD  , NHQ = 16, NHG = 16, WIN = 128;
constexpr int KVR_SMETA = M1, KVR_SWIN = M1 + NB_S * NMETA  , KV_ROWS = KVR_SWIN + NB_S * WIN  ;
constexpr int NPOS = NMETA + PAST + SEQ_S;
constexpr int C_Q = 0, C_K = 2048, C_V = 2560, C_CONV = 3072, C_Z = 9216, C_B = 11264, C_A = 11280, DCONV = 6144;
constexpr float LN_EPS = 1e-5f, RMS_EPS = 1e-6f, ALPHA = 1.189207115002721f;
enum { I_XP = 0, I_XS, I_CMK, I_CMV, I_CWK, I_CWV, I_SCONV, I_SGDN, I_META, I_LNG, I_LNB, I_WG, I_WU, I_WD, I_WIN, I_WOUT, I_SINK, I_CONVW, I_ALOG, I_DTB, I_NORMW, N_IN };
constexpr size_t O_YP = 0, O_YS = O_YP + (size_t)ROW_S * D, O_PMK = O_YS + (size_t)NB_S * SEQ_S * D, O_PMV = O_PMK + (size_t)NB_P * NMETA * KVW, O_PWK = O_PMV + (size_t)NB_P * NMETA * KVW,
                 O_PWV = O_PWK + (size_t)NB_P * WIN * KVW, O_PCONV = O_PWV + (size_t)NB_P * WIN * KVW, O_PGDN = O_PCONV + (size_t)NB_P * 3 * DCONV, O_SWK = O_PGDN + (size_t)NB_P * NHG * 128 * 128,
                 O_SWV = O_SWK + (size_t)NB_S * SEQ_S * KVW, O_SCONV = O_SWV + (size_t)NB_S * SEQ_S * KVW, O_SGDN = O_SCONV + (size_t)NB_S * 3 * DCONV, O_END = O_SGDN + (size_t)NB_S * NHG * 128 * 128;
static_assert(O_END == 44998656, "output map");

constexpr size_t AL(size_t x) { return (x + 4095) / 4096 * 4096; }
constexpr size_t WS_CTL = 0, CTL_ZERO_BYTES = 1u << 20;
constexpr size_t WS_WGU1 = CTL_ZERO_BYTES, SZ_WGU = (size_t)NGU * D * 2, SZ_WD = (size_t)D * FF * 2;
constexpr size_t WS_WD1 = WS_WGU1 + AL(SZ_WGU), WS_WGU2 = WS_WD1 + AL(SZ_WD), WS_WD2 = WS_WGU2 + AL(SZ_WGU), WS_WIN = WS_WD2 + AL(SZ_WD), WS_WOUT = WS_WIN + AL((size_t)DINP * D * 2);
constexpr size_t WS_XN = WS_WOUT + AL((size_t)D * D * 2), WS_MIX = WS_XN + AL((size_t)M1 * D * 2), WS_H = WS_MIX + AL((size_t)M2 * D * 2);
constexpr size_t WS_Y = WS_H + AL((size_t)M1 * DINP * 2), WS_KB = WS_Y + AL((size_t)M1 * D * 4), WS_VB = WS_KB + AL((size_t)KV_ROWS * KVW * 2), WS_ROPE = WS_VB + AL((size_t)KV_ROWS * KVW * 2);
constexpr size_t WS_SLAB = WS_ROPE + AL((size_t)NPOS * 64 * 8), N_SLABS = 224, WS_XQ = WS_SLAB + N_SLABS * 262144, WS_SA = WS_XQ + AL((size_t)M1 * D), WS_SB = WS_SA + AL((size_t)M1 * 4), WS_SH = WS_SB + 2 * AL((size_t)NGU * 4), WS_SBD = WS_SH + AL((size_t)M1 * 4), WS_HQ = WS_SBD + 2 * AL((size_t)D * 4), WS_END = WS_HQ + AL((size_t)M1 * FF);
static_assert((size_t)M1 * FF <= (WS_H - WS_XN), "the int8 copy of h fits over the XN | MIX region");
constexpr int GU_U = 0, GU_W = 32768, GU_QD = GU_W + 16384, GU_KDT = GU_QD + 16384, GU_QK = GU_KDT + 16384, GU_GL = GU_QK + 8192, GU_BYTES = GU_GL + 256;
constexpr int N_GUNITS = NB_P * NHG * 32 + NHG + NB_S * NHG;
constexpr size_t WS_GDN = WS_WGU1;
static_assert((size_t)N_GUNITS * GU_BYTES <= WS_WGU2 - WS_WGU1, "GDN chunk data fits in the FFN1 weight region");
constexpr int CW_TMO = 0, CW_CODE = 1, CW_BAR = 4096, CW_CMAX = 131072, CW_CMAXD = CW_CMAX + 2 * NGU, CW_RMAX = CW_CMAXD + 2 * D;
static_assert((CW_RMAX + 2 * M1) * 4 <= (int)CTL_ZERO_BYTES, "column maxima inside the per-call memset");

constexpr int RING_OFF = 0, RING_BYTES = 139264;
constexpr int LDSCTL_OFF = RING_BYTES, MISC_OFF = LDSCTL_OFF + 320;
constexpr int LDS_BYTES = 147456;
static_assert(MISC_OFF + 128 <= LDS_BYTES, "LDS map");

struct Frame {
    LAS unsigned char* lds;
    volatile LAS unsigned* MISC;
    gu32* ctl;
    int tid, lane, wave;
    int vcu, G;
};
struct Ptrs {
    const float* in[N_IN]; float* out;
    bf16 *Wgu1, *Wd1, *Wgu2, *Wd2, *Win, *Wout, *XN, *MIX, *H, *KB, *VB;
    float* Y; float* ROPE; unsigned char* GDN; float* SLAB;
    signed char* XQ; float *SA, *SB1, *SB2; unsigned* CMAX;
    signed char* HQ; float *SH, *SBD1, *SBD2; unsigned *CMAXD, *RMAX;
};
__host__ __device__ constexpr int kpos32(int kk) { return 8 * ((kk & 15) >> 2) + (kk & 3) + 4 * (kk >> 4); }
__host__ __device__ constexpr int a256_off(int r, int k) { return r * 256 + ((((k >> 5) * 4 + (kpos32(k & 31) >> 3)) ^ (r & 15)) * 16) + (kpos32(k & 31) & 7) * 2; }
__host__ __device__ constexpr int a128_off(int r, int k) { return r * 128 + ((((k >> 5) * 4 + (kpos32(k & 31) >> 3)) ^ ((r >> 1) & 7)) * 16) + (kpos32(k & 31) & 7) * 2; }
typedef short s16x4 __attribute__((ext_vector_type(4)));
__device__ __forceinline__ unsigned pkbf(float lo, float hi) { unsigned r; asm volatile("v_cvt_pk_bf16_f32 %0, %1, %2" : "=v"(r) : "v"(lo), "v"(hi)); return r; }
typedef float f32x2v __attribute__((ext_vector_type(2)));
typedef unsigned u32x2v __attribute__((ext_vector_type(2)));
__device__ __forceinline__ float bf2f(unsigned b) { return __uint_as_float(b << 16); }
__device__ __forceinline__ float wave_sum(float v) {
#pragma unroll
    for (int o = 1; o < 64; o <<= 1) v += __shfl_xor(v, o);
    return v;
}
__device__ __forceinline__ float silu1(float g) { return g * __builtin_amdgcn_rcpf(1.0f + __builtin_amdgcn_exp2f(-1.4426950408889634f * g)); }

template <int NB, int MODE>
__device__ __forceinline__ void p0_transpose_item(const float* W, int K, int N, bf16* WT, LAS float* scr, int item, int lane) {
    constexpr int LPR = NB / 4, RPI = 64 / LPR, NIT = 64 / RPI, ST = NB + 1;
    const int nblk = N / NB, kb = item / nblk, nb = item - kb * nblk, k0 = 64 * kb, n0 = NB * nb;
    const int lr = lane / LPR, lc = 4 * (lane % LPR);
#pragma unroll
    for (int i = 0; i < NIT; ++i) { const int kk = RPI * i + lr; const f32x4 v = __builtin_nontemporal_load((const GAS f32x4*)(W + (size_t)(k0 + kk) * N + n0 + lc));
        LAS float* s = scr + kk * ST + lc; s[0] = v.x; s[1] = v.y; s[2] = v.z; s[3] = v.w; }
    LDS_WAIT(); asm volatile("" ::: "memory");
    const int c = lane & 7;
#pragma unroll
    for (int j = 0; j < NB / 8; ++j) { const int n = (lane >> 3) + 8 * j; const LAS float* s = scr + (8 * c) * ST + n;
        v4u o; o.x = pk2(s[0 * ST], s[1 * ST]); o.y = pk2(s[2 * ST], s[3 * ST]); o.z = pk2(s[4 * ST], s[5 * ST]); o.w = pk2(s[6 * ST], s[7 * ST]);
        const int nn = n0 + n; const int r = (MODE == 0) ? nn : ((nn >> 7) * 256 + (nn & 127) + (MODE == 2 ? 128 : 0));
        *(GAS v4u*)(WT + (size_t)r * K + k0 + 8 * c) = o; }
    LDS_WAIT(); asm volatile("" ::: "memory");
}
__device__ __forceinline__ void cvt_flat(const float* src, bf16* dst, int n8, int gt, int NGT) {
    for (int i = gt; i < n8; i += NGT) { const f32x4 a = *(const GAS f32x4*)(src + (size_t)i * 8), b = *(const GAS f32x4*)(src + (size_t)i * 8 + 4);
        v4u o; o.x = pk2(a.x, a.y); o.y = pk2(a.z, a.w); o.z = pk2(b.x, b.y); o.w = pk2(b.z, b.w); *(GAS v4u*)(dst + (size_t)i * 8) = o; }
}
__device__ __forceinline__ unsigned pack_i8x4(f32x4 v, float inv) {
    const int a = (int)__builtin_rintf(v.x * inv), b = (int)__builtin_rintf(v.y * inv), c = (int)__builtin_rintf(v.z * inv), d = (int)__builtin_rintf(v.w * inv);
    return (unsigned)(a & 255) | ((unsigned)(b & 255) << 8) | ((unsigned)(c & 255) << 16) | ((unsigned)d << 24); }
__device__ __forceinline__ float wave_max(float v) {
#pragma unroll
    for (int o = 1; o < 64; o <<= 1) v = fmaxf(v, __shfl_xor(v, o));
    return v; }
__device__ __forceinline__ void quant_row_i8(const f32x4 (&v)[16], signed char* dst, float* sa, int lane) {
    float m = 0.f;
#pragma unroll
    for (int j = 0; j < 16; ++j) m = fmaxf(fmaxf(m, fmaxf(fabsf(v[j].x), fabsf(v[j].y))), fmaxf(fabsf(v[j].z), fabsf(v[j].w)));
    m = wave_max(m); const float inv = m > 0.f ? 127.f / m : 0.f;
    if (lane == 0) *sa = m * (1.f / 127.f);
#pragma unroll
    for (int j = 0; j < 16; ++j) ((GAS unsigned*)dst)[lane + 64 * j] = pack_i8x4(v[j], inv);
}
__device__ __forceinline__ int gu_row(int mode, int nn) { return mode == 0 ? nn : (nn >> 7) * 256 + (nn & 127) + (mode == 2 ? 128 : 0); }
__device__ __forceinline__ void p0_colmax_item(const float* W, int N, unsigned* cmax, int mode, int item, int lane) {
    const int nblk = N / 64, kb = item / nblk, nb = item - kb * nblk, k0 = 64 * kb, n0 = 64 * nb, lr = lane >> 4, lc = 4 * (lane & 15);
    f32x4 m = {0.f, 0.f, 0.f, 0.f};
#pragma unroll
    for (int i = 0; i < 16; ++i) { const f32x4 v = __builtin_nontemporal_load((const GAS f32x4*)(W + (size_t)(k0 + 4 * i + lr) * N + n0 + lc));
        m.x = fmaxf(m.x, fabsf(v.x)); m.y = fmaxf(m.y, fabsf(v.y)); m.z = fmaxf(m.z, fabsf(v.z)); m.w = fmaxf(m.w, fabsf(v.w)); }
    m.x = fmaxf(m.x, __shfl_xor(m.x, 16)); m.y = fmaxf(m.y, __shfl_xor(m.y, 16)); m.z = fmaxf(m.z, __shfl_xor(m.z, 16)); m.w = fmaxf(m.w, __shfl_xor(m.w, 16));
    m.x = fmaxf(m.x, __shfl_xor(m.x, 32)); m.y = fmaxf(m.y, __shfl_xor(m.y, 32)); m.z = fmaxf(m.z, __shfl_xor(m.z, 32)); m.w = fmaxf(m.w, __shfl_xor(m.w, 32));
    if (lane < 16) { const int r = gu_row(mode, n0 + lc);
        (void)__hip_atomic_fetch_max(cmax + r + 0, __float_as_uint(m.x), RLX_AGENT); (void)__hip_atomic_fetch_max(cmax + r + 1, __float_as_uint(m.y), RLX_AGENT);
        (void)__hip_atomic_fetch_max(cmax + r + 2, __float_as_uint(m.z), RLX_AGENT); (void)__hip_atomic_fetch_max(cmax + r + 3, __float_as_uint(m.w), RLX_AGENT); }
}
__device__ __forceinline__ void p0_quant_item(const float* W, int K, int N, signed char* WT, const unsigned* cmax, float* sB, int mode, LAS float* scr, int item, int lane) {
    const int nblk = N / 64, kb = item / nblk, nb = item - kb * nblk, k0 = 64 * kb, n0 = 64 * nb, lr = lane >> 4, lc = 4 * (lane & 15);
#pragma unroll
    for (int i = 0; i < 16; ++i) { const int kk = 4 * i + lr; const f32x4 v = __builtin_nontemporal_load((const GAS f32x4*)(W + (size_t)(k0 + kk) * N + n0 + lc));
        LAS float* s = scr + kk * 65 + lc; s[0] = v.x; s[1] = v.y; s[2] = v.z; s[3] = v.w; }
    LDS_WAIT(); asm volatile("" ::: "memory");
    const int r = gu_row(mode, n0 + lane); const float am = __uint_as_float(__hip_atomic_load(cmax + r, RLX_AGENT)), inv = am > 0.f ? 127.f / am : 0.f;
    if (kb == 0) sB[r] = am * (1.f / 127.f);
    const LAS float* s = scr + lane;
#pragma unroll
    for (int c = 0; c < 4; ++c) { v4u o;
        o.x = pack_i8x4((f32x4){s[(16 * c + 0) * 65], s[(16 * c + 1) * 65], s[(16 * c + 2) * 65], s[(16 * c + 3) * 65]}, inv); o.y = pack_i8x4((f32x4){s[(16 * c + 4) * 65], s[(16 * c + 5) * 65], s[(16 * c + 6) * 65], s[(16 * c + 7) * 65]}, inv);
        o.z = pack_i8x4((f32x4){s[(16 * c + 8) * 65], s[(16 * c + 9) * 65], s[(16 * c + 10) * 65], s[(16 * c + 11) * 65]}, inv); o.w = pack_i8x4((f32x4){s[(16 * c + 12) * 65], s[(16 * c + 13) * 65], s[(16 * c + 14) * 65], s[(16 * c + 15) * 65]}, inv);
        *(GAS v4u*)(WT + (size_t)r * K + k0 + 16 * c) = o; }
    LDS_WAIT(); asm volatile("" ::: "memory");
}
__device__ __forceinline__ void quant_h(Frame& F, const bf16* H, signed char* HQ, const unsigned* rmax, float* SH, int nrows) {
    const int gw = F.vcu * NWAVES + F.wave, NGW = F.G * NWAVES;
    for (int r = gw; r < nrows; r += NGW) {
        const GAS v4u* src = (const GAS v4u*)(H + (size_t)r * FF); GAS u32x2v* dst = (GAS u32x2v*)(HQ + (size_t)r * FF);
        unsigned mx = 0u;
#pragma unroll 4
        for (int c = F.lane; c < FF / 8; c += 64) { const v4u w = src[c]; const unsigned ww_[4] = {w.x, w.y, w.z, w.w};
#pragma unroll
            for (int k_ = 0; k_ < 4; ++k_) { const unsigned lo_ = (ww_[k_] << 16) & 0x7fff0000u, hi_ = ww_[k_] & 0x7fff0000u; mx = mx > lo_ ? mx : lo_; mx = mx > hi_ ? mx : hi_; } }
#pragma unroll
        for (int o = 1; o < 64; o <<= 1) { const unsigned t_ = (unsigned)__shfl_xor((int)mx, o); mx = mx > t_ ? mx : t_; }
        const float am = __uint_as_float(mx), inv = am > 0.f ? 127.f / am : 0.f;
        if (F.lane == 0) SH[r] = am * (1.f / 127.f);
#pragma unroll 4
        for (int c = F.lane; c < FF / 8; c += 64) { const v4u w = src[c]; u32x2v o;
            o.x = pack_i8x4((f32x4){bf2f(w.x & 0xffffu), bf2f(w.x >> 16), bf2f(w.y & 0xffffu), bf2f(w.y >> 16)}, inv); o.y = pack_i8x4((f32x4){bf2f(w.z & 0xffffu), bf2f(w.z >> 16), bf2f(w.w & 0xffffu), bf2f(w.w >> 16)}, inv);
            dst[c] = o; } }
}
constexpr int IT_GU = (D / 64) * (FF / 64), IT_IN = (D / 64) * (DIN / 32), IT_OUT = (D / 64) * (D / 64);
constexpr int Q_E1 = IT_GU  , Q_E2 = Q_E1 + IT_IN  , Q_E3 = Q_E2 + IT_OUT  , Q_E4 = Q_E3 + 2 * IT_GU  , Q_E5 = Q_E4 + IT_GU  ;
constexpr int QCH = 8;
constexpr int CW_QCTR = 2048, CW_DONE = 2112;
__device__ __forceinline__ void conv_item(const Ptrs& P, LAS float* scr, int q, int lane) {
    const float* wg = P.in[I_WG] + (size_t)D * FF; const float* wu = P.in[I_WU] + (size_t)D * FF; const float* wd = P.in[I_WD];
    if (q < Q_E1) p0_quant_item(wd, FF, D, (signed char*)P.Wd1, P.CMAXD, P.SBD1, 0, scr, q, lane);
    else if (q < Q_E2) p0_transpose_item<32, 0>(P.in[I_WIN], D, DIN, P.Win, scr, q - Q_E1, lane);
    else if (q < Q_E3) p0_transpose_item<64, 0>(P.in[I_WOUT], D, D, P.Wout, scr, q - Q_E2, lane);
    else if (q < Q_E3 + IT_GU) p0_quant_item(wg, D, FF, (signed char*)P.Wgu2, P.CMAX + NGU, P.SB2, 1, scr, q - Q_E3, lane);
    else if (q < Q_E4) p0_quant_item(wu, D, FF, (signed char*)P.Wgu2, P.CMAX + NGU, P.SB2, 2, scr, q - Q_E3 - IT_GU, lane);
    else p0_quant_item(wd + (size_t)D * FF, FF, D, (signed char*)P.Wd2, P.CMAXD + D, P.SBD2, 0, scr, q - Q_E4, lane);
}
__device__ __forceinline__ int q_take(Frame& F) { int i = 0; if (F.lane == 0) i = (int)__hip_atomic_fetch_add(F.ctl + CW_QCTR, (unsigned)QCH, RLX_AGENT); return __builtin_amdgcn_readfirstlane(i); }
__device__ __forceinline__ int q_head(Frame& F) { return (int)__builtin_amdgcn_readfirstlane(__hip_atomic_load(F.ctl + CW_QCTR, RLX_AGENT)); }
__device__ __forceinline__ void q_catch_up(Frame& F, const Ptrs& P, int E) {
    LAS float* scr = (LAS float*)(F.lds + RING_OFF + F.wave * 16640);
    for (;;) { if (q_head(F) >= E) break; const int i = q_take(F);
        for (int k = 0; k < QCH; ++k) if (i + k < Q_E5) conv_item(P, scr, i + k, F.lane); }
}
__device__ __forceinline__ void q_fill(Frame& F, const Ptrs& P, int ph) {
    LAS float* scr = (LAS float*)(F.lds + RING_OFF + F.wave * 16640);
    gu32* done = F.ctl + CW_DONE + 64 * ph;
    for (;;) {
        if ((int)__builtin_amdgcn_readfirstlane(__hip_atomic_load(done, RLX_AGENT)) >= F.G || q_head(F) >= Q_E5) break;
        const int i = q_take(F); if (i >= Q_E5) break;
        for (int k = 0; k < QCH; ++k) if (i + k < Q_E5) conv_item(P, scr, i + k, F.lane); }
}
__device__ __forceinline__ void sub_barrier(Frame& F, gu32* ctr, unsigned n) {
    asm volatile("s_waitcnt vmcnt(0) lgkmcnt(0)" ::: "memory"); __syncthreads();
    if (F.tid == 0) {
        __builtin_amdgcn_fence(__ATOMIC_RELEASE, "agent"); asm volatile("s_waitcnt vmcnt(0)" ::: "memory");
        (void)__hip_atomic_fetch_add(ctr, 1u, RLX_AGENT);
        unsigned sp = 0; while (__hip_atomic_load(ctr, RLX_AGENT) < n) { __builtin_amdgcn_s_sleep(2); if (++sp > (1u << 22)) { __hip_atomic_store(F.ctl + CW_TMO, 1u, RLX_AGENT); break; } }
        __builtin_amdgcn_fence(__ATOMIC_ACQUIRE, "agent"); asm volatile("s_waitcnt vmcnt(0)" ::: "memory");
    }
    __syncthreads();
}
constexpr int CW_SUB = 3072;
#define PHASE_DONE(ph) do { if (F.tid == 0) (void)__hip_atomic_fetch_add(F.ctl + CW_DONE + 64 * (ph), 1u, RLX_AGENT); } while (0)
__device__ __forceinline__ void p0_quant_wgu1(Frame& F, const Ptrs& P) {
    LAS float* scr = (LAS float*)(F.lds + RING_OFF + F.wave * 16640);
    const int gw = F.vcu * NWAVES + F.wave, NGW = F.G * NWAVES;
    for (int it = gw; it < 2 * IT_GU; it += NGW) {
        if (it < IT_GU) p0_quant_item(P.in[I_WG], D, FF, (signed char*)P.Wgu1, P.CMAX, P.SB1, 1, scr, it, F.lane);
        else p0_quant_item(P.in[I_WU], D, FF, (signed char*)P.Wgu1, P.CMAX, P.SB1, 2, scr, it - IT_GU, F.lane);
    }
}
__device__ __forceinline__ void p0_prologue(Frame& F, const Ptrs& P) {
    const int gw = F.vcu * NWAVES + F.wave, NGW = F.G * NWAVES;
    for (int it = gw; it < 4 * IT_GU; it += NGW) { const int mtx = it / IT_GU, r = it - mtx * IT_GU;
        p0_colmax_item((mtx & 1 ? P.in[I_WU] : P.in[I_WG]) + (size_t)(mtx >> 1) * D * FF, FF, P.CMAX + (mtx >> 1) * NGU, 1 + (mtx & 1), r, F.lane); }
    for (int it = gw; it < 2 * IT_GU; it += NGW) { const int mtx = it / IT_GU, r = it - mtx * IT_GU;
        p0_colmax_item(P.in[I_WD] + (size_t)mtx * D * FF, D, P.CMAXD + mtx * D, 0, r, F.lane); }
    for (int m = gw; m < M1V; m += NGW) {
        const float* src = m < ROW_S ? P.in[I_XP] + (size_t)m * D : (m < ROW_M ? P.in[I_XS] + (size_t)(m - ROW_S) * D : P.in[I_META] + (size_t)(m - ROW_M) * D);
        const GAS f32x4* xr = (const GAS f32x4*)src + F.lane; f32x4 v[16];
#pragma unroll
        for (int j = 0; j < 16; ++j) v[j] = xr[64 * j];
        quant_row_i8(v, P.XQ + (size_t)m * D, P.SA + m, F.lane);
    }
    const int gt = gw * 64 + F.lane, NGT = NGW * 64;
    for (int i = gt; i < NPOS * 64; i += NGT) { const int pos = i >> 6, k = i & 63;
        const double inv = exp2(-(double)k * (13.287712379549449 / 64.0)); const float ang = (float)((double)pos * inv);
        float s, c; sincosf(ang, &s, &c); ((GAS f32x2v*)P.ROPE)[i] = (f32x2v){c, s}; }
    cvt_flat(P.in[I_CMK], P.KB + (size_t)KVR_SMETA * KVW, NB_S * NMETA * KVW / 8, gt, NGT);
    cvt_flat(P.in[I_CMV], P.VB + (size_t)KVR_SMETA * KVW, NB_S * NMETA * KVW / 8, gt, NGT);
    cvt_flat(P.in[I_CWK], P.KB + (size_t)KVR_SWIN * KVW, NB_S * WIN * KVW / 8, gt, NGT);
    cvt_flat(P.in[I_CWV], P.VB + (size_t)KVR_SWIN * KVW, NB_S * WIN * KVW / 8, gt, NGT);
}

__device__ __forceinline__ void swiglu_combine(Frame& F, const pg8::SplitOrder& SO, const float* slab, bf16* H, const float* sA, const float* sB) {
    const int tid = F.tid, row = tid >> 4, c8 = (tid & 15) * 8;
    for (int it = blockIdx.x; it < SO.rem * 8; it += F.G) { const int ri = it >> 3, r0 = (it & 7) * 32 + row; pg8::Unit u; SO.map(SO.R * SO.G + ri, u);
        typedef int i32x4 __attribute__((ext_vector_type(4)));
        i32x4 ig0 = {0, 0, 0, 0}, ig1 = ig0, iu0 = ig0, iu1 = ig0;
        for (int s2 = 0; s2 < SO.S; ++s2) { const GAS i32x4* sp = (const GAS i32x4*)(slab + ((size_t)(ri * SO.S + s2) << 16) + r0 * 256 + c8);
            ig0 = ig0 + sp[0]; ig1 = ig1 + sp[1]; iu0 = iu0 + sp[32]; iu1 = iu1 + sp[33]; }
        const float sa = sA[u.pm * 256 + r0]; const float* sbp = sB + u.pn * 256 + c8;
        const f32x4 g0 = __builtin_convertvector(ig0, f32x4) * (*(const GAS f32x4*)(sbp) * sa), g1 = __builtin_convertvector(ig1, f32x4) * (*(const GAS f32x4*)(sbp + 4) * sa);
        const f32x4 u0 = __builtin_convertvector(iu0, f32x4) * (*(const GAS f32x4*)(sbp + 128) * sa), u1 = __builtin_convertvector(iu1, f32x4) * (*(const GAS f32x4*)(sbp + 132) * sa);
        v4u o; o.x = pkbf(silu1(g0.x) * u0.x, silu1(g0.y) * u0.y); o.y = pkbf(silu1(g0.z) * u0.z, silu1(g0.w) * u0.w);
        o.z = pkbf(silu1(g1.x) * u1.x, silu1(g1.y) * u1.y); o.w = pkbf(silu1(g1.z) * u1.z, silu1(g1.w) * u1.w);
        *(GAS v4u*)(H + (size_t)(u.pm * 256 + r0) * FF + u.pn * 128 + c8) = o; }
}
__device__ __forceinline__ void ln_phase(Frame& F, const float* Y, float* Xo, bf16* XN, const float* g, const float* b, int nrows, const pg8::SplitOrder& SO, const float* slab, float sscale, signed char* XQ, float* SA) {
    const int gw = F.vcu * NWAVES + F.wave, NGW = F.G * NWAVES;
    for (int r = gw; r < nrows; r += NGW) {
        const GAS f32x4* yr = (const GAS f32x4*)(Y + (size_t)r * D) + F.lane;
        f32x4 v[16];
#pragma unroll
        for (int j = 0; j < 16; ++j) v[j] = yr[64 * j];
        if (SO.rem > 0 && SO.S > 1) { const int pm = r >> 8, rr = r & 255;
#pragma unroll
            for (int j = 0; j < 16; ++j) { const int ri = SO.inv(pm, j) - SO.R * SO.G;
                if (ri >= 0) { const GAS f32x4* sp = (const GAS f32x4*)(slab + ((size_t)(ri * (SO.S - 1)) << 16) + rr * 256) + F.lane; f32x4 a = sp[0];
                    for (int s2 = 1; s2 < SO.S - 1; ++s2) a = a + sp[(size_t)s2 << 14];
                    v[j] = v[j] + a * sscale; } } }
        float s = 0.f;
#pragma unroll
        for (int j = 0; j < 16; ++j) s += (v[j].x + v[j].y) + (v[j].z + v[j].w);
        const float mean = wave_sum(s) * (1.f / D); float s2 = 0.f;
#pragma unroll
        for (int j = 0; j < 16; ++j) { v[j] = v[j] - mean; s2 += (v[j].x * v[j].x + v[j].y * v[j].y) + (v[j].z * v[j].z + v[j].w * v[j].w); }
        const float rstd = 1.f / sqrtf(wave_sum(s2) * (1.f / D) + LN_EPS);
#pragma unroll
        for (int j = 0; j < 16; ++j) { const f32x4 gg = ((const GAS f32x4*)g)[F.lane + 64 * j], bb = ((const GAS f32x4*)b)[F.lane + 64 * j];
            const f32x4 o = v[j] * rstd * gg + bb; v[j] = o;
            if (Xo) ((GAS f32x4*)(Xo + (size_t)r * D))[F.lane + 64 * j] = o;
            if (XN) { u32x2v w; w.x = pk2(o.x, o.y); w.y = pk2(o.z, o.w); ((GAS u32x2v*)(XN + (size_t)r * D))[F.lane + 64 * j] = w; } }
        if (XQ) quant_row_i8(v, XQ + (size_t)r * D, SA + r, F.lane);
    }
}

__device__ __forceinline__ void kv_prep(Frame& F, const Ptrs& P) {
    const int gw = F.vcu * NWAVES + F.wave, NGW = F.G * NWAVES, lane = F.lane;
    const bf16* HIN = P.H;
    for (int r = gw; r < M1V; r += NGW) {
        int pos; float* kdst = nullptr; float* vdst = nullptr; int ncp = 1;
        if (r < ROW_S) { const int t = r & (SEQ_P - 1), b = r >> 11; pos = NMETA + t;
            if (t >= SEQ_P - WIN) { kdst = P.out + O_PWK + (size_t)(b * WIN + t - (SEQ_P - WIN)) * KVW; vdst = P.out + O_PWV + (size_t)(b * WIN + t - (SEQ_P - WIN)) * KVW; } }
        else if (r < ROW_M) { pos = NMETA + PAST + ((r - ROW_S) & (SEQ_S - 1)); kdst = P.out + O_SWK + (size_t)(r - ROW_S) * KVW; vdst = P.out + O_SWV + (size_t)(r - ROW_S) * KVW; }
        else { pos = r - ROW_M; kdst = P.out + O_PMK + (size_t)pos * KVW; vdst = P.out + O_PMV + (size_t)pos * KVW; ncp = NB_P; }
        const bf16* hrow = HIN + (size_t)r * DINP;
        const f32x2v cs = ((const GAS f32x2v*)P.ROPE)[pos * 64 + lane];
#pragma unroll
        for (int kh = 0; kh < KVH; ++kh) { const float x1 = bf2f(hrow[C_K + kh * HD + lane]), x2 = bf2f(hrow[C_K + kh * HD + 64 + lane]);
            const float o1 = x1 * cs.x - x2 * cs.y, o2 = x2 * cs.x + x1 * cs.y;
            P.KB[(size_t)r * KVW + kh * HD + lane] = (bf16)f2bf(o1); P.KB[(size_t)r * KVW + kh * HD + 64 + lane] = (bf16)f2bf(o2);
            if (kdst) for (int cp = 0; cp < ncp; ++cp) { kdst[(size_t)cp * NMETA * KVW + kh * HD + lane] = o1; kdst[(size_t)cp * NMETA * KVW + kh * HD + 64 + lane] = o2; } }
        const v4u vv = *(const GAS v4u*)(hrow + C_V + 8 * lane);
        *(GAS v4u*)(P.VB + (size_t)r * KVW + 8 * lane) = vv;
        if (vdst) { const f32x4 a = {bf2f(vv.x & 0xffffu), bf2f(vv.x >> 16), bf2f(vv.y & 0xffffu), bf2f(vv.y >> 16)}, c = {bf2f(vv.z & 0xffffu), bf2f(vv.z >> 16), bf2f(vv.w & 0xffffu), bf2f(vv.w >> 16)};
            for (int cp = 0; cp < ncp; ++cp) { *(GAS f32x4*)(vdst + (size_t)cp * NMETA * KVW + 8 * lane) = a; *(GAS f32x4*)(vdst + (size_t)cp * NMETA * KVW + 8 * lane + 4) = c; } }
    }
    for (int it = gw; it < (NB_P + NB_S) * 3 * (DCONV / 512); it += NGW) {
        const int part = it % (DCONV / 512), rj = it / (DCONV / 512), j = rj % 3, sb = rj / 3;
        const int srow = sb < NB_P ? sb * SEQ_P + SEQ_P - 3 + j : ROW_S + (sb - NB_P) * SEQ_S + SEQ_S - 3 + j;
        float* dst = (sb < NB_P ? P.out + O_PCONV + (size_t)(sb * 3 + j) * DCONV : P.out + O_SCONV + (size_t)((sb - NB_P) * 3 + j) * DCONV) + part * 512 + 8 * lane;
        const v4u vv = *(const GAS v4u*)(HIN + (size_t)srow * DINP + C_CONV + part * 512 + 8 * lane);
        *(GAS f32x4*)dst = (f32x4){bf2f(vv.x & 0xffffu), bf2f(vv.x >> 16), bf2f(vv.y & 0xffffu), bf2f(vv.y >> 16)};
        *(GAS f32x4*)(dst + 4) = (f32x4){bf2f(vv.z & 0xffffu), bf2f(vv.z >> 16), bf2f(vv.w & 0xffffu), bf2f(vv.w >> 16)};
    }
}

constexpr int PB_ST = 136;
constexpr int L_AT = 0, L_TAB = L_AT + 64 * 68 * 4, L_QKR = L_TAB + 12 * 256, L_QB = L_QKR + 64 * 68 * 4, L_KB = L_QB + 64 * PB_ST * 2, L_VB = L_KB + 64 * PB_ST * 2, L_XR = L_VB + 64 * PB_ST * 2, L_PREP_END = L_XR + 64 * 768;
static_assert(L_PREP_END <= RING_BYTES && (L_XR % 1024) == 0, "GDN prep LDS");
enum { T_BETA = 0, T_GC, T_EG, T_EK, T_RK2, T_RQ2, T_SU, T_SW, T_SKD, T_SQD, T_N };
struct PrepUnit { int kind, b, h, n, row0; };
__device__ __forceinline__ PrepUnit prep_decode(int uidx) {
    PrepUnit u; u.b = 0; u.n = 0;
    if (uidx < 2048) { u.kind = 0; u.b = uidx >> 9; u.h = (uidx >> 5) & 15; u.n = uidx & 31; u.row0 = u.b * SEQ_P + 64 * u.n; }
    else if (uidx < 2064) { u.kind = 1; u.h = uidx - 2048; u.row0 = ROW_M - 48; }
    else { u.kind = 2; u.b = (uidx - 2064) >> 4; u.h = (uidx - 2064) & 15; u.row0 = ROW_S + u.b * SEQ_S; }
    return u;
}
__device__ __forceinline__ float dpp_sum16(float p) {
    p += __builtin_bit_cast(float, __builtin_amdgcn_update_dpp(0, __builtin_bit_cast(int, p), 0xB1, 0xF, 0xF, true));
    p += __builtin_bit_cast(float, __builtin_amdgcn_update_dpp(0, __builtin_bit_cast(int, p), 0x4E, 0xF, 0xF, true));
    p += __builtin_bit_cast(float, __builtin_amdgcn_update_dpp(0, __builtin_bit_cast(int, p), 0x141, 0xF, 0xF, true));
    p += __builtin_bit_cast(float, __builtin_amdgcn_update_dpp(0, __builtin_bit_cast(int, p), 0x140, 0xF, 0xF, true));
    return p;
}
template <bool ISU> __device__ __forceinline__ void prep_solve(LAS float* AT, LAS float* TAB, LAS unsigned char* VB, LAS unsigned char* KB, LAS unsigned char* OUTW, unsigned char* ud, int tid) {
    const int cc = tid & 127; const LAS unsigned char* src = (ISU ? VB : KB) + cc * 2; const LAS float* sc = TAB + (ISU ? T_SU : T_SW) * 64;
    float* U = (float*)(ud + GU_U);
    const int cslot = (cc >> 5) * 4 + (kpos32(cc & 31) >> 3), cpos2 = (kpos32(cc & 31) & 7) * 2;
    float r[64];
#pragma unroll
    for (int i = 0; i < 64; ++i) r[i] = bf2f(*(const LAS unsigned short*)(src + i * (PB_ST * 2))) * sc[i];
    const LAS float* atp = AT;
#pragma unroll
    for (int j = 0; j < 64; ++j) { float sol = r[j]; asm volatile("" : "+v"(atp), "+v"(sol));
        if (ISU) U[j * 128 + cc] = sol; else *(LAS unsigned short*)(OUTW + j * 256 + ((cslot ^ (j & 15)) << 4) + cpos2) = (unsigned short)f2bf(sol);
#pragma unroll
        for (int q = (j + 1) / 4; q < 16; ++q) { const f32x4 a = *(const LAS f32x4*)(atp + j * 68 + 4 * q);
            if (4 * q + 0 > j) r[4 * q + 0] -= a.x * sol; if (4 * q + 1 > j) r[4 * q + 1] -= a.y * sol;
            if (4 * q + 2 > j) r[4 * q + 2] -= a.z * sol; if (4 * q + 3 > j) r[4 * q + 3] -= a.w * sol; }
        __builtin_amdgcn_sched_barrier(0); }
}
struct Solve2State { float r0[32], r1[32]; f32x4 a[2][8]; const LAS float* atp; float* U; LAS unsigned char* ow; int pi, cslot; };
template <bool ISU, int J> __device__ __forceinline__ void prep_solve2_step(Solve2State& st) {
    if constexpr (J < 64) {
        constexpr int pj = (J >> 2) & 1, kj = 4 * (J >> 3) + (J & 3);
        asm volatile("" : "+v"(st.atp), "+v"(st.r0[kj]));
        if constexpr (J + 1 < 64) {
#pragma unroll
            for (int kk = (J + 1) >> 3; kk < 8; ++kk) st.a[(J + 1) & 1][kk] = *(const LAS f32x4*)(st.atp + (J + 1) * 68 + 8 * kk); }
        const float m0 = st.r0[kj], m1 = st.r1[kj];
        const float o0 = __builtin_bit_cast(float, __builtin_amdgcn_update_dpp(0, __builtin_bit_cast(int, m0), 0xB1, 0xF, 0xF, true)), o1 = __builtin_bit_cast(float, __builtin_amdgcn_update_dpp(0, __builtin_bit_cast(int, m1), 0xB1, 0xF, 0xF, true));
        const float s0 = (st.pi == pj) ? m0 : o0, s1 = (st.pi == pj) ? m1 : o1;
        if (ISU) *(GAS f32x2v*)(st.U + J * 128) = (f32x2v){s0, s1}; else *(LAS unsigned*)(st.ow + J * 256 + ((st.cslot ^ (J & 15)) << 4)) = pkbf(s0, s1);
#pragma unroll
        for (int kk = J >> 3; kk < 8; ++kk) { const f32x4 av = st.a[J & 1][kk];
            st.r0[4 * kk + 0] -= av.x * s0; st.r0[4 * kk + 1] -= av.y * s0; st.r0[4 * kk + 2] -= av.z * s0; st.r0[4 * kk + 3] -= av.w * s0;
            st.r1[4 * kk + 0] -= av.x * s1; st.r1[4 * kk + 1] -= av.y * s1; st.r1[4 * kk + 2] -= av.z * s1; st.r1[4 * kk + 3] -= av.w * s1; }
        __builtin_amdgcn_sched_barrier(0);
        prep_solve2_step<ISU, J + 1>(st);
    }
}
template <bool ISU> __device__ __forceinline__ void prep_solve2(LAS float* AT, LAS float* TAB, LAS unsigned char* VB, LAS unsigned char* KB, LAS unsigned char* OUTW, unsigned char* ud, int tid) {
    Solve2State st; st.pi = tid & 1; const int c0 = (tid & 127) & ~1;
    const LAS unsigned char* src = (ISU ? VB : KB) + c0 * 2 + st.pi * (4 * PB_ST * 2); const LAS float* sc = TAB + (ISU ? T_SU : T_SW) * 64 + 4 * st.pi;
    st.U = (float*)(ud + GU_U) + c0; st.ow = OUTW + (kpos32(c0 & 31) & 7) * 2; st.cslot = (c0 >> 5) * 4 + (kpos32(c0 & 31) >> 3);
#pragma unroll
    for (int k = 0; k < 32; ++k) { const int rw = 8 * (k >> 2) + (k & 3); const unsigned w_ = *(const LAS unsigned*)(src + rw * (PB_ST * 2)); const float s_ = sc[rw]; st.r0[k] = bf2f(w_ & 0xffffu) * s_; st.r1[k] = bf2f(w_ >> 16) * s_; }
    st.atp = AT + 4 * st.pi;
#pragma unroll
    for (int kk = 0; kk < 8; ++kk) st.a[0][kk] = *(const LAS f32x4*)(st.atp + 8 * kk);
    prep_solve2_step<ISU, 0>(st);
}
#define PB_BAR() do { asm volatile("s_waitcnt lgkmcnt(0)" ::: "memory"); __builtin_amdgcn_s_barrier(); asm volatile("" ::: "memory"); } while (0)
__device__ __forceinline__ void gdn_prep_all(Frame& F, const Ptrs& P, int abl  ) {
    int tid_ = F.tid; asm volatile("" : "+v"(tid_));
    const int tid = tid_, wv = F.wave;
    LAS unsigned char* L = F.lds;
    LAS float* AT = (LAS float*)(L + L_AT); LAS float* TAB = (LAS float*)(L + L_TAB); LAS float* QKR = (LAS float*)(L + L_QKR);
    LAS unsigned char* QB = L + L_QB; LAS unsigned char* KB = L + L_KB; LAS unsigned char* VB = L + L_VB; LAS unsigned char* XR = L + L_XR; LAS unsigned char* OUTW = L + L_QKR;
    const bf16* HIN = P.H;
    const int part = wv >> 1, half = wv & 1;
    f32x2v cwn[4], hxn[3]; float bln = 0.f, aln = 0.f;
#define PB_PREFETCH(U) do { const PrepUnit& u_ = (U); int lane = tid; asm volatile("" : "+v"(lane)); lane &= 63; \
          \
        _Pragma("unroll") for (int k_ = 0; k_ < 6; ++k_) { const int p_ = (6 * wv + k_) * 64 + lane, t_ = p_ >> 4, r_ = (t_ * 171) >> 9, pt_ = t_ - 3 * r_; \
            const int rr_ = (u_.kind == 1 && r_ < 48) ? 48 : r_; \
            __builtin_amdgcn_global_load_lds((const GAS unsigned*)(HIN + (size_t)(u_.row0 + rr_) * DINP + C_CONV + pt_ * 2048 + u_.h * 128 + (p_ & 15) * 8), (LAS unsigned*)(XR + (6 * wv + k_) * 1024), 16, 0, 0); } \
        if (wv < 6) { const int ch_ = part * 2048 + u_.h * 128 + 2 * lane; const float* cw_ = P.in[I_CONVW] + ch_; \
            _Pragma("unroll") for (int j_ = 0; j_ < 4; ++j_) cwn[j_] = *(const GAS f32x2v*)(cw_ + j_ * DCONV); \
            _Pragma("unroll") for (int j_ = 0; j_ < 3; ++j_) hxn[j_] = (f32x2v){0.f, 0.f}; \
            if (half == 0) { \
                if (u_.kind == 0) { const int hr_ = (u_.n == 0) ? ROW_M + 13 : u_.row0 - 3; \
                    _Pragma("unroll") for (int j_ = 0; j_ < 3; ++j_) { const unsigned w_ = *(const GAS unsigned*)(HIN + (size_t)(hr_ + j_) * DINP + C_CONV + ch_); hxn[j_] = (f32x2v){bf2f(w_ & 0xffffu), bf2f(w_ >> 16)}; } } \
                else if (u_.kind == 2) { const float* sc_ = P.in[I_SCONV] + (size_t)u_.b * 3 * DCONV + ch_; \
                    _Pragma("unroll") for (int j_ = 0; j_ < 3; ++j_) hxn[j_] = *(const GAS f32x2v*)(sc_ + j_ * DCONV); } } } \
        else if (wv == 6) { const bf16* hr_ = HIN + (size_t)(u_.row0 + ((u_.kind == 1 && lane < 48) ? 48 : lane)) * DINP; bln = bf2f(hr_[C_B + u_.h]); aln = bf2f(hr_[C_A + u_.h]); } } while (0)
    int uidx = blockIdx.x;
    if (uidx >= N_GUNITS) return;
    PrepUnit un_ = prep_decode(uidx);
    PB_PREFETCH(un_);
    for (; uidx < N_GUNITS; uidx += F.G) {
        const PrepUnit u = prep_decode(uidx);
        unsigned char* ud = P.GDN + (size_t)uidx * GU_BYTES;
        asm volatile("s_waitcnt vmcnt(0) lgkmcnt(0)" ::: "memory"); __builtin_amdgcn_s_barrier(); asm volatile("" ::: "memory");
        f32x2v cw[4], hx[3]; float bl = bln, al = aln;
#pragma unroll
        for (int j = 0; j < 4; ++j) cw[j] = cwn[j];
#pragma unroll
        for (int j = 0; j < 3; ++j) hx[j] = hxn[j];
        asm volatile("" : "+v"(cw[0]), "+v"(cw[1]), "+v"(cw[2]), "+v"(cw[3]), "+v"(hx[0]), "+v"(hx[1]), "+v"(hx[2]), "+v"(bl), "+v"(al));
        { int tl_ = tid; asm volatile("" : "+v"(tl_)); const int lane = tl_ & 63;
        if (wv < 6) {
            const LAS unsigned char* xr = XR + part * 256 + lane * 4; LAS unsigned char* dst = (part == 0 ? QB : (part == 1 ? KB : VB)) + lane * 4;
            const int i0 = 32 * half;
            f32x2v xm3 = hx[0], xm2 = hx[1], xm1 = hx[2];
            if (half == 1) { const unsigned a_ = *(const LAS unsigned*)(xr + 29 * 768), b_ = *(const LAS unsigned*)(xr + 30 * 768), c_ = *(const LAS unsigned*)(xr + 31 * 768);
                xm3 = (f32x2v){bf2f(a_ & 0xffffu), bf2f(a_ >> 16)}; xm2 = (f32x2v){bf2f(b_ & 0xffffu), bf2f(b_ >> 16)}; xm1 = (f32x2v){bf2f(c_ & 0xffffu), bf2f(c_ >> 16)};
                if (u.kind == 1) { xm3 = (f32x2v){0.f, 0.f}; xm2 = xm3; xm1 = xm3; } }
#pragma unroll 8
            for (int ii = 0; ii < 32; ++ii) { const int i = i0 + ii; const unsigned w_ = *(const LAS unsigned*)(xr + i * 768);
                f32x2v x = (f32x2v){bf2f(w_ & 0xffffu), bf2f(w_ >> 16)};
                if (u.kind == 1 && i < 48) x = (f32x2v){0.f, 0.f};
                const f32x2v y = cw[0] * xm3 + cw[1] * xm2 + cw[2] * xm1 + cw[3] * x;
                *(LAS unsigned*)(dst + i * (PB_ST * 2)) = pkbf(silu1(y.x), silu1(y.y)); xm3 = xm2; xm2 = xm1; xm1 = x; }
        } else if (wv == 6) {
            float be = 0.f, g = 0.f;
            if (!(u.kind == 1 && lane < 48)) { be = 1.f / (1.f + expf(-bl)); const float x = al + P.in[I_DTB][u.h]; const float sp = fmaxf(x, 0.f) + log1pf(expf(-fabsf(x))); g = -expf(P.in[I_ALOG][u.h]) * sp; }
            float v = g;
#pragma unroll
            for (int o = 1; o < 64; o <<= 1) { const float t = __shfl_up(v, o); if (lane >= o) v += t; }
            const float last = __shfl(v, 63);
            TAB[T_BETA * 64 + lane] = be; TAB[T_GC * 64 + lane] = v; TAB[T_EG * 64 + lane] = expf(v); TAB[T_EK * 64 + lane] = expf(last - v);
        } }
        PB_BAR();
        if (uidx + F.G < N_GUNITS) { un_ = prep_decode(uidx + F.G); PB_PREFETCH(un_); }
        __builtin_amdgcn_sched_barrier(0);
        if (!(abl & 4)) { int tl_ = tid; asm volatile("" : "+v"(tl_)); const int lane = tl_ & 63, c16 = lane & 15, q4 = lane >> 4;
#pragma unroll
        for (int tk = 0; tk < 3; ++tk) { const int task = wv + 8 * tk;
            int rb, cb; const LAS unsigned char *Ap, *Bp;
            if (task < 20) { const int t10 = task < 10 ? task : task - 10; int a = 0, b = t10;
                if (b >= 1) { a = 1; b -= 1; if (b >= 2) { a = 2; b -= 2; if (b >= 3) { a = 3; b -= 3; } } }
                if (task < 10) { rb = a; cb = b; Ap = KB; Bp = KB; } else { rb = b; cb = a; Ap = KB; Bp = QB; } }
            else { rb = task - 20; cb = rb; Ap = QB; Bp = QB; }
            f32x4 acc = {0.f, 0.f, 0.f, 0.f};
#pragma unroll
            for (int s = 0; s < 4; ++s) { const bf16x8 A = *(const LAS bf16x8*)(Ap + (16 * rb + c16) * (PB_ST * 2) + 64 * s + 16 * q4), B = *(const LAS bf16x8*)(Bp + (16 * cb + c16) * (PB_ST * 2) + 64 * s + 16 * q4);
                acc = __builtin_amdgcn_mfma_f32_16x16x32_bf16(A, B, acc, 0, 0, 0); }
            if (task < 10) { *(LAS f32x4*)(AT + (16 * cb + c16) * 68 + 16 * rb + 4 * q4) = acc;
                if (rb == cb) {
#pragma unroll
                    for (int r = 0; r < 4; ++r) if (c16 == 4 * q4 + r) TAB[T_RK2 * 64 + 16 * rb + c16] = acc[r]; } }
            else if (task < 20) { *(LAS f32x4*)(QKR + (16 * cb + c16) * 68 + 16 * rb + 4 * q4) = acc; }
            else {
#pragma unroll
                for (int r = 0; r < 4; ++r) if (c16 == 4 * q4 + r) TAB[T_RQ2 * 64 + 16 * rb + c16] = acc[r]; }
        } }
        PB_BAR();
        if (!(abl & 4)) { int tid = tid_; asm volatile("" : "+v"(tid));
        { const int j = tid >> 3, i8 = (tid & 7) * 8;
            const float rkj = rsqrtf(TAB[T_RK2 * 64 + j] + RMS_EPS), gcj = TAB[T_GC * 64 + j];
#pragma unroll
            for (int e = 0; e < 8; ++e) { const int i = i8 + e; const float v = AT[j * 68 + i];
                const float sc = TAB[T_BETA * 64 + i] * rsqrtf(TAB[T_RK2 * 64 + i] + RMS_EPS) * rkj * expf(fminf(TAB[T_GC * 64 + i] - gcj, 0.f));
                AT[j * 68 + i] = (i > j) ? v * sc : 0.f; } }
        { const int i = tid >> 3, sl = tid & 7, g = sl >> 2, qq = sl & 3;
            const float rqi = rsqrtf(TAB[T_RQ2 * 64 + i] + RMS_EPS) * 0.08838834764831845f, gci = TAB[T_GC * 64 + i];
            float v[8];
#pragma unroll
            for (int e = 0; e < 8; ++e) { const int j = 32 * g + 4 * qq + (e & 3) + 16 * (e >> 2); const float raw = QKR[i * 68 + j];
                v[e] = (i >= j) ? raw * rqi * rsqrtf(TAB[T_RK2 * 64 + j] + RMS_EPS) * expf(fminf(gci - TAB[T_GC * 64 + j], 0.f)) : 0.f; }
            v4u o; o.x = pkbf(v[0], v[1]); o.y = pkbf(v[2], v[3]); o.z = pkbf(v[4], v[5]); o.w = pkbf(v[6], v[7]);
            *(GAS v4u*)(ud + GU_QK + i * 128 + ((sl ^ ((i >> 1) & 7)) * 16)) = o; }
        if (tid < 64) { const int i = tid; const float rk = rsqrtf(TAB[T_RK2 * 64 + i] + RMS_EPS), rq = rsqrtf(TAB[T_RQ2 * 64 + i] + RMS_EPS) * 0.08838834764831845f, be = TAB[T_BETA * 64 + i], eg = TAB[T_EG * 64 + i];
            TAB[T_SU * 64 + i] = be; TAB[T_SW * 64 + i] = be * eg * rk; TAB[T_SKD * 64 + i] = TAB[T_EK * 64 + i] * rk; TAB[T_SQD * 64 + i] = eg * rq;
            if (i == 63) *(GAS float*)(ud + GU_GL) = eg; } }
        PB_BAR();
        { int tid = tid_; asm volatile("" : "+v"(tid)); const int lane = tid & 63, c16 = lane & 15, q4 = lane >> 4;
        if (tid < 128) { if (!(abl & 1)) prep_solve2<true>(AT, TAB, VB, KB, OUTW, ud, tid); }
        else if (tid < 256) { if (!(abl & 1)) prep_solve2<false>(AT, TAB, VB, KB, OUTW, ud, tid); }
        else if (!(abl & 2)) {
            const int t = tid - 256;
#pragma unroll
            for (int k = 0; k < 4; ++k) { const int id = t + 256 * k, i = id >> 4, sl = id & 15, g = sl >> 2, qq = sl & 3; const float sc = TAB[T_SQD * 64 + i];
                const u32x2v lo = *(const LAS u32x2v*)(QB + i * (PB_ST * 2) + (32 * g + 4 * qq) * 2), hi = *(const LAS u32x2v*)(QB + i * (PB_ST * 2) + (32 * g + 16 + 4 * qq) * 2);
                v4u o; o.x = pkbf(bf2f(lo.x & 0xffffu) * sc, bf2f(lo.x >> 16) * sc); o.y = pkbf(bf2f(lo.y & 0xffffu) * sc, bf2f(lo.y >> 16) * sc);
                o.z = pkbf(bf2f(hi.x & 0xffffu) * sc, bf2f(hi.x >> 16) * sc); o.w = pkbf(bf2f(hi.y & 0xffffu) * sc, bf2f(hi.y >> 16) * sc);
                *(GAS v4u*)(ud + GU_QD + i * 256 + ((sl ^ (i & 15)) * 16)) = o; }
            const int w4 = wv - 4;
#pragma unroll
            for (int k = 0; k < 4; ++k) { const int task = w4 * 4 + k, db = task >> 1, g = task & 1;
                const int addr = (int)(size_t)KB + (32 * g + 4 * q4 + ((lane & 15) >> 2)) * (PB_ST * 2) + (16 * db + 4 * (lane & 3)) * 2;
                const f32x4 s0 = *(const LAS f32x4*)(TAB + T_SKD * 64 + 32 * g + 4 * q4), s1 = *(const LAS f32x4*)(TAB + T_SKD * 64 + 32 * g + 16 + 4 * q4);
                s16x4 lo, hi;
                asm volatile("ds_read_b64_tr_b16 %0, %2\n\tds_read_b64_tr_b16 %1, %2 offset:4352\n\ts_waitcnt lgkmcnt(0)" : "=&v"(lo), "=&v"(hi) : "v"(addr) : "memory");
                v4u o; o.x = pkbf(bf2f((unsigned short)lo[0]) * s0.x, bf2f((unsigned short)lo[1]) * s0.y); o.y = pkbf(bf2f((unsigned short)lo[2]) * s0.z, bf2f((unsigned short)lo[3]) * s0.w);
                o.z = pkbf(bf2f((unsigned short)hi[0]) * s1.x, bf2f((unsigned short)hi[1]) * s1.y); o.w = pkbf(bf2f((unsigned short)hi[2]) * s1.z, bf2f((unsigned short)hi[3]) * s1.w);
                const int d = 16 * db + c16;
                *(GAS v4u*)(ud + GU_KDT + d * 128 + (((4 * g + q4) ^ ((d >> 1) & 7)) * 16)) = o; }
        } }
        PB_BAR();
        if (!(abl & 1)) { int tid = tid_; asm volatile("" : "+v"(tid));
#pragma unroll
        for (int k = 0; k < 2; ++k) { const int o16 = (tid + 512 * k) * 16; *(GAS v4u*)(ud + GU_W + o16) = *(const LAS v4u*)(OUTW + o16); } }
    }
    asm volatile("s_waitcnt vmcnt(0) lgkmcnt(0)" ::: "memory"); __syncthreads();
#undef PB_PREFETCH
}
#undef PB_BAR

typedef float f32x16 __attribute__((ext_vector_type(16)));
#define KSWZ(row, colB) ((row) * 256 + ((colB) ^ (((row) & 7) << 4)))
#define SBAR() __builtin_amdgcn_sched_barrier(0)
__device__ __forceinline__ int crow(int r, int hi) { return (r & 3) + 8 * (r >> 2) + 4 * hi; }
__device__ __forceinline__ unsigned cvtpk(float lo, float hi) { unsigned r; asm volatile("v_cvt_pk_bf16_f32 %0, %1, %2" : "=v"(r) : "v"(lo), "v"(hi)); return r; }
__device__ __forceinline__ void qkt(f32x16& p0, f32x16& p1, const LAS unsigned char* Ks, const bf16x8* qr, int r32, int hi) {
    p0 = f32x16{}; p1 = f32x16{};
#pragma unroll
    for (int d0 = 0; d0 < 8; ++d0) { const int cb = (d0 * 16 + hi * 8) * 2;
        const bf16x8 b0 = *(const LAS bf16x8*)(Ks + KSWZ(r32, cb)), b1 = *(const LAS bf16x8*)(Ks + KSWZ(32 + r32, cb));
        p0 = __builtin_amdgcn_mfma_f32_32x32x16_bf16(b0, qr[d0], p0, 0, 0, 0);
        p1 = __builtin_amdgcn_mfma_f32_32x32x16_bf16(b1, qr[d0], p1, 0, 0, 0); }
}
__device__ __forceinline__ int v_st(int k, int c) { const int kk = (k & ~0xC) | ((k & 4) << 1) | ((k & 8) >> 1); return ((kk >> 3) * 4 + (c >> 5)) * 512 + ((kk & 7) * 32 + (c & 31)) * 2; }
__device__ __forceinline__ int v_rd_base(int lane) { return ((lane & 3) << 3) | (((lane >> 2) & 3) << 6) | (((lane >> 4) & 1) << 5) | (((lane >> 5) & 1) << 8); }
constexpr int v_rd_off(int d0, int ks, int half) { return d0 * 512 + ks * 4096 + half * 2048; }
template <int OFF> __device__ __forceinline__ s16x4 tr_read(int vb) { s16x4 r; asm volatile("ds_read_b64_tr_b16 %0, %1 offset:%2" : "=&v"(r) : "v"(vb), "i"(OFF) : "memory"); return r; }
template <int D0> __device__ __forceinline__ void pv_one(f32x16& od, int vb, bf16x8 pa0, bf16x8 pa1, bf16x8 pa2, bf16x8 pa3) {
    const s16x4 l0 = tr_read<v_rd_off(D0, 0, 0)>(vb), h0 = tr_read<v_rd_off(D0, 0, 1)>(vb), l1 = tr_read<v_rd_off(D0, 1, 0)>(vb), h1 = tr_read<v_rd_off(D0, 1, 1)>(vb);
    const s16x4 l2 = tr_read<v_rd_off(D0, 2, 0)>(vb), h2 = tr_read<v_rd_off(D0, 2, 1)>(vb), l3 = tr_read<v_rd_off(D0, 3, 0)>(vb), h3 = tr_read<v_rd_off(D0, 3, 1)>(vb);
    asm volatile("s_waitcnt lgkmcnt(0)" ::: "memory"); SBAR();
#define PK(L, H) (bf16x8){L[0], L[1], L[2], L[3], H[0], H[1], H[2], H[3]}
    od = __builtin_amdgcn_mfma_f32_32x32x16_bf16(pa0, PK(l0, h0), od, 0, 0, 0);
    od = __builtin_amdgcn_mfma_f32_32x32x16_bf16(pa1, PK(l1, h1), od, 0, 0, 0);
    od = __builtin_amdgcn_mfma_f32_32x32x16_bf16(pa2, PK(l2, h2), od, 0, 0, 0);
    od = __builtin_amdgcn_mfma_f32_32x32x16_bf16(pa3, PK(l3, h3), od, 0, 0, 0);
#undef PK
}
constexpr int ATT_V = 0, ATT_K = 16384, ATT_WS = 32768;
__device__ __forceinline__ void attn_unit(Frame& F, const Ptrs& P, int a) {
    constexpr float SCALE = 0.088388347648318440f, C = SCALE * 1.4426950408889634f;
    int tid_ = F.tid; asm volatile("" : "+v"(tid_));
    const int tid = tid_, wid = F.wave, lane = tid & 63, r32 = lane & 31, hi = lane >> 5;
    const bool isp = a < 512; const int kvh = a & 3, ab = isp ? (a >> 7) : ((a - 512) >> 2), ac = isp ? ((a >> 2) & 31) : 0;
    const int qrow0 = isp ? ab * SEQ_P + 64 * ac : ROW_S + ab * SEQ_S, pos0 = isp ? NMETA + 64 * ac : NMETA + PAST;
    LAS unsigned char* V_lds = F.lds + ATT_V; LAS unsigned char* K_lds = F.lds + ATT_K;
    LAS float* ws = (LAS float*)(F.lds + ATT_WS) + wid * 64; LAS float* li_l = ws; LAS float* al_l = ws + 32;
    const int g = wid >> 1, qoff = 32 * (wid & 1), hq = kvh * 4 + g;
    bf16x8 qr[8];
    { const bf16* qp = P.H + (size_t)(qrow0 + qoff + r32) * DINP + C_Q + hq * HD + hi * 8; const GAS f32x2v* cs = (const GAS f32x2v*)P.ROPE + (size_t)(pos0 + qoff + r32) * 64 + hi * 8;
#pragma unroll
        for (int d0 = 0; d0 < 4; ++d0) { const v4u lo = *(const GAS v4u*)(qp + d0 * 16), hh = *(const GAS v4u*)(qp + 64 + d0 * 16);
            const unsigned lw[4] = {lo.x, lo.y, lo.z, lo.w}, hw[4] = {hh.x, hh.y, hh.z, hh.w}; unsigned o1[4], o2[4];
#pragma unroll
            for (int j = 0; j < 4; ++j) { const f32x2v c0 = cs[d0 * 16 + 2 * j], c1 = cs[d0 * 16 + 2 * j + 1];
                const float a0 = bf2f(lw[j] & 0xffffu), a1 = bf2f(lw[j] >> 16), b0 = bf2f(hw[j] & 0xffffu), b1 = bf2f(hw[j] >> 16);
                o1[j] = cvtpk(a0 * c0.x - b0 * c0.y, a1 * c1.x - b1 * c1.y); o2[j] = cvtpk(b0 * c0.x + a0 * c0.y, b1 * c1.x + a1 * c1.y); }
            const v4u w1 = {o1[0], o1[1], o1[2], o1[3]}, w2 = {o2[0], o2[1], o2[2], o2[3]};
            qr[d0] = __builtin_bit_cast(bf16x8, w1); qr[d0 + 4] = __builtin_bit_cast(bf16x8, w2); } }
    float m_reg = -1e30f, l_reg = 0.f; f32x16 o[4] = {};
    const int sr = tid >> 4, sc = (tid & 15) * 8, vst0 = v_st(sr, sc), vst1 = v_st(32 + sr, sc);
    const int vb0 = (int)(size_t)V_lds + v_rd_base(lane);
    const int tmin = isp ? (ac >= 2 ? 1 : 3 - ac) : 1;
#define ATT_KROW(t) ((t) == 0 ? (isp ? ROW_M : KVR_SMETA + ab * NMETA) : (isp ? ab * SEQ_P + 64 * (ac - 3 + (t)) : ((t) == 3 ? ROW_S + ab * SEQ_S : KVR_SWIN + ab * WIN + 64 * ((t) - 1))))
#define ATT_LOAD(t) do { const int ra_ = ((t) == 0) ? (sr & 15) : sr, rb_ = ((t) == 0) ? (sr & 15) : 32 + sr;     \
        const bf16* kp_ = P.KB + (size_t)ATT_KROW(t) * KVW + kvh * HD + sc; const bf16* vp_ = P.VB + (size_t)ATT_KROW(t) * KVW + kvh * HD + sc; \
        nk0 = *(const GAS v4u*)(kp_ + (size_t)ra_ * KVW); nk1 = *(const GAS v4u*)(kp_ + (size_t)rb_ * KVW); nv0 = *(const GAS v4u*)(vp_ + (size_t)ra_ * KVW); nv1 = *(const GAS v4u*)(vp_ + (size_t)rb_ * KVW); } while (0)
    v4u nk0, nk1, nv0, nv1; ATT_LOAD(0);
#pragma unroll
    for (int t = 0; t < 4; ++t) {
        const bool kval_t = (t == 0) || (t >= tmin);
        if (kval_t) {
        const v4u k0 = nk0, k1 = nk1, v0 = nv0, v1 = nv1;
        __syncthreads();
        *(LAS v4u*)(V_lds + vst0) = v0; *(LAS v4u*)(V_lds + vst1) = v1; *(LAS v4u*)(K_lds + KSWZ(sr, sc * 2)) = k0; *(LAS v4u*)(K_lds + KSWZ(32 + sr, sc * 2)) = k1;
        __syncthreads();
        { const int nt_ = (t == 0) ? tmin : t + 1; if (nt_ <= 3) { if (nt_ == 1) ATT_LOAD(1); else if (nt_ == 2) ATT_LOAD(2); else ATT_LOAD(3); } }
        f32x16 p0, p1; qkt(p0, p1, K_lds, qr, r32, hi);
        if (t == 0) {
#pragma unroll
            for (int r = 8; r < 16; ++r) p0[r] = -INFINITY;
#pragma unroll
            for (int r = 0; r < 16; ++r) p1[r] = -INFINITY; }
        float pmax = p0[0];
#pragma unroll
        for (int r = 1; r < 16; ++r) pmax = fmaxf(pmax, p0[r]);
#pragma unroll
        for (int r = 0; r < 16; ++r) pmax = fmaxf(pmax, p1[r]);
        { auto rr = __builtin_amdgcn_permlane32_swap(__float_as_uint(pmax), __float_as_uint(pmax), false, false); pmax = fmaxf(__uint_as_float(rr[0]), __uint_as_float(rr[1])); }
        const float mn = fmaxf(m_reg, pmax), alpha = __builtin_amdgcn_exp2f((m_reg - mn) * C), mnC = -mn * C; m_reg = mn;
        float ps = 0.f;
#pragma unroll
        for (int r = 0; r < 16; ++r) { p0[r] = __builtin_amdgcn_exp2f(fmaf(p0[r], C, mnC)); p1[r] = __builtin_amdgcn_exp2f(fmaf(p1[r], C, mnC)); ps += p0[r] + p1[r]; }
        { auto rr = __builtin_amdgcn_permlane32_swap(__float_as_uint(ps), __float_as_uint(ps), false, false); ps = __uint_as_float(rr[0]) + __uint_as_float(rr[1]); }
        l_reg = l_reg * alpha + ps;
        if (hi == 0) al_l[r32] = alpha;
        asm volatile("s_waitcnt lgkmcnt(0)" ::: "memory");
#pragma unroll
        for (int d = 0; d < 4; ++d)
#pragma unroll
            for (int r = 0; r < 16; ++r) o[d][r] *= al_l[crow(r, hi)];
        bf16x8 pa0, pa1, pa2, pa3;
#define PK4(Pv, BASE, OUT) do { unsigned a0 = cvtpk(Pv[BASE + 0], Pv[BASE + 1]), a1 = cvtpk(Pv[BASE + 2], Pv[BASE + 3]);   \
    unsigned b0 = cvtpk(Pv[BASE + 4], Pv[BASE + 5]), b1 = cvtpk(Pv[BASE + 6], Pv[BASE + 7]);                              \
    auto r0 = __builtin_amdgcn_permlane32_swap(a0, b0, false, false); auto r1 = __builtin_amdgcn_permlane32_swap(a1, b1, false, false); \
    v4u w = {r0[0], r1[0], r0[1], r1[1]}; OUT = __builtin_bit_cast(bf16x8, w); } while (0)
        PK4(p0, 0, pa0); PK4(p0, 8, pa1); PK4(p1, 0, pa2); PK4(p1, 8, pa3);
#undef PK4
        SBAR();
        pv_one<0>(o[0], vb0, pa0, pa1, pa2, pa3); pv_one<1>(o[1], vb0, pa0, pa1, pa2, pa3); pv_one<2>(o[2], vb0, pa0, pa1, pa2, pa3); pv_one<3>(o[3], vb0, pa0, pa1, pa2, pa3);
        }
    }
#undef ATT_KROW
#undef ATT_LOAD
    l_reg += __builtin_amdgcn_exp2f(P.in[I_SINK][hq] * 1.4426950408889634f - m_reg * C);
    if (hi == 0) li_l[r32] = l_reg;
    asm volatile("s_waitcnt lgkmcnt(0)" ::: "memory");
    bf16* Ow = P.MIX + (size_t)(qrow0 + qoff) * D + hq * HD;
#pragma unroll
    for (int r = 0; r < 16; ++r) { const int orow = crow(r, hi); const float rl = __builtin_amdgcn_rcpf(li_l[orow]);
#pragma unroll
        for (int d0 = 0; d0 < 4; ++d0) Ow[(size_t)orow * D + d0 * 32 + r32] = (bf16)f2bf(o[d0][r] * rl); }
    __syncthreads();
}

typedef const GAS unsigned char* gcp;
template <class T> __device__ __forceinline__ T ldg_u(gcp ubase, unsigned voff) { return *(const GAS T*)(ubase + voff); }
constexpr int SC_ABUF = 57344, SC_SSQ_OFF = 2 * SC_ABUF;
template <int MODE  > __device__ __forceinline__ void gdn_scan_seq(Frame& F, const Ptrs& P, int kind  , int b, int h) {
    int lane_ = F.lane; asm volatile("" : "+v"(lane_));
    const int w = F.wave, lane = lane_, c16 = lane & 15, q4 = lane >> 4;
    LAS float* SSQ = (LAS float*)(F.lds + SC_SSQ_OFF);
    const unsigned ecol = (unsigned)(16 * w + c16);
    const unsigned voU = (unsigned)(q4 * 2048) + ecol * 4u;
    const unsigned voZ = (unsigned)(q4 * 4 * DINP * 2) + ecol * 2u;
    const unsigned voM = (unsigned)(q4 * 4 * D * 2) + ecol * 2u;
    unsigned fo256[4], fo128[2];
#pragma unroll
    for (int s = 0; s < 4; ++s) fo256[s] = (unsigned)(c16 * 256 + (((4 * s + q4) ^ c16) * 16));
#pragma unroll
    for (int s = 0; s < 2; ++s) fo128[s] = (unsigned)(c16 * 128 + (((4 * s + q4) ^ ((c16 >> 1) & 7)) * 16));
    const unsigned dma_lane = (unsigned)(w * 7168 + lane * 16);
    f32x4 S[8];
    if (kind == 2) { gcp s0 = (gcp)(P.in[I_SGDN] + (size_t)(b * NHG + h) * 128 * 128);
#pragma unroll
        for (int db = 0; db < 8; ++db)
#pragma unroll
            for (int r = 0; r < 4; ++r) S[db][r] = ldg_u<float>(s0 + db * 8192, voU + r * 512); }
    else {
#pragma unroll
        for (int db = 0; db < 8; ++db) S[db] = (f32x4){0.f, 0.f, 0.f, 0.f}; }
    const int nsteps = kind == 0 ? 33 : 1;
    const float nw = P.in[I_NORMW][ecol];
    const int seq = b * NHG + h;
#define SC_UD(t) ((gcp)(P.GDN + (size_t)(kind == 2 ? 2064 + seq : ((t) == 0 ? 2048 + h : seq * 32 + (t) - 1)) * GU_BYTES))
#define SC_ROW0(t) (kind == 0 ? b * SEQ_P + 64 * ((t) - 1) : ROW_S + b * SEQ_S)
#define SC_DMA(ud, buf) do { _Pragma("unroll") for (int _i = 0; _i < 7; ++_i) \
        __builtin_amdgcn_global_load_lds((const GAS unsigned*)((ud) + GU_W + dma_lane + _i * 1024), (LAS unsigned*)(F.lds + (buf) * SC_ABUF + w * 7168 + _i * 1024), 16, 0, 0); } while (0)
    float un[4][4], gln; unsigned zn[4][4];
#define SC_PREFETCH(udp) do { gln = *(const GAS float*)((udp) + GU_GL); \
        _Pragma("unroll") for (int m = 0; m < 4; ++m) _Pragma("unroll") for (int r = 0; r < 4; ++r) un[m][r] = ldg_u<float>((udp) + GU_U + m * 8192, voU + r * 512); } while (0)
#define SC_LD256(dst, off, m0) do { _Pragma("unroll") for (int mm = 0; mm < 2; ++mm) _Pragma("unroll") for (int s = 0; s < 4; ++s) dst[mm * 4 + s] = *(const LAS bf16x8*)(img + (off) + ((m0) + mm) * 4096 + fo256[s]); } while (0)
#define SC_LD128(dst, off, r0) do { _Pragma("unroll") for (int rr = 0; rr < 4; ++rr) _Pragma("unroll") for (int s = 0; s < 2; ++s) dst[rr * 2 + s] = *(const LAS bf16x8*)(img + (off) + ((r0) + rr) * 2048 + fo128[s]); } while (0)
#define SC_SCHED __builtin_amdgcn_sched_barrier(0)
#define SC_EPI(t, ov, zv) do { const LAS float* sq_ = SSQ + ((t) & 1) * 512; GAS unsigned char* mb_ = (GAS unsigned char*)((MODE == 0 ? P.MIX : P.XN) + (size_t)SC_ROW0(t) * D + 2048 + h * 128); \
        _Pragma("unroll") for (int m = 0; m < 4; ++m) _Pragma("unroll") for (int r = 0; r < 4; ++r) { const int i_ = 16 * m + 4 * q4 + r; \
            const f32x4 t0_ = *(const LAS f32x4*)(sq_ + i_ * 8), t1_ = *(const LAS f32x4*)(sq_ + i_ * 8 + 4); const float tot_ = ((t0_.x + t0_.y) + (t0_.z + t0_.w)) + ((t1_.x + t1_.y) + (t1_.z + t1_.w)); \
            const float rstd_ = rsqrtf(tot_ * (1.f / 128.f) + RMS_EPS); \
            *(GAS unsigned short*)(mb_ + (16 * m + r) * (D * 2) + voM) = (unsigned short)f2bf(ov[m][r] * rstd_ * nw * silu1(bf2f(zv[m][r]))); } } while (0)
    { gcp ud0 = SC_UD(0); if (MODE != 1) { SC_DMA(ud0, 0); } SC_PREFETCH(ud0); }
#pragma unroll
    for (int m = 0; m < 4; ++m)
#pragma unroll
        for (int r = 0; r < 4; ++r) zn[m][r] = 0u;
    f32x4 op[4]; unsigned zp[4][4];
#pragma unroll
    for (int m = 0; m < 4; ++m) { op[m] = (f32x4){0.f, 0.f, 0.f, 0.f};
#pragma unroll
        for (int r = 0; r < 4; ++r) zp[m][r] = 0u; }
    for (int step = 0; step < nsteps; ++step) {
        const bool has_out = !(kind == 0 && step == 0), prev_out = step > 0 && !(kind == 0 && step == 1);
        asm volatile("s_waitcnt vmcnt(0) lgkmcnt(0)" ::: "memory"); __builtin_amdgcn_s_barrier(); asm volatile("" ::: "memory");
        float uc[4][4], gl = gln;
#pragma unroll
        for (int m = 0; m < 4; ++m) {
#pragma unroll
            for (int r = 0; r < 4; ++r) { uc[m][r] = un[m][r]; zp[m][r] = zn[m][r]; }
            asm volatile("" : "+v"(uc[m][0]), "+v"(uc[m][1]), "+v"(uc[m][2]), "+v"(uc[m][3]), "+v"(zp[m][0]), "+v"(zp[m][1]), "+v"(zp[m][2]), "+v"(zp[m][3])); }
        asm volatile("" : "+v"(gl));
        SC_SCHED;
        if (has_out && MODE != 1) { gcp zb_ = (gcp)(P.H + (size_t)SC_ROW0(step) * DINP + C_Z + h * 128);
#pragma unroll
            for (int m = 0; m < 4; ++m)
#pragma unroll
                for (int r = 0; r < 4; ++r) zn[m][r] = ldg_u<unsigned short>(zb_ + (16 * m + r) * (DINP * 2), voZ); }
        if (step + 1 < nsteps && MODE != 1) { gcp udn = SC_UD(step + 1); SC_DMA(udn, (step + 1) & 1); SC_PREFETCH(udn); }
        SC_SCHED;
        if (prev_out) SC_EPI(step - 1, op, zp);
        SC_SCHED;
        if (MODE != 2) {
        const LAS unsigned char* img = F.lds + (step & 1) * SC_ABUF;
        bf16x8 X[8], Y[8];
        SC_LD256(X, GU_W - GU_W, 0); SC_LD256(Y, GU_W - GU_W, 2); SC_SCHED;
        bf16x8 Bs[4];
#pragma unroll
        for (int s = 0; s < 4; ++s) { const v4u t = {pkbf(S[2 * s][0], S[2 * s][1]), pkbf(S[2 * s][2], S[2 * s][3]), pkbf(S[2 * s + 1][0], S[2 * s + 1][1]), pkbf(S[2 * s + 1][2], S[2 * s + 1][3])}; Bs[s] = __builtin_bit_cast(bf16x8, t); }
        f32x4 vn[4], o[4];
#pragma unroll
        for (int mm = 0; mm < 2; ++mm) { f32x4 acc = {0.f, 0.f, 0.f, 0.f};
#pragma unroll
            for (int s = 0; s < 4; ++s) acc = __builtin_amdgcn_mfma_f32_16x16x32_bf16(X[mm * 4 + s], Bs[s], acc, 0, 0, 0);
#pragma unroll
            for (int r = 0; r < 4; ++r) vn[mm][r] = uc[mm][r] - acc[r]; }
        SC_SCHED; SC_LD256(X, GU_QD - GU_W, 0); SC_SCHED;
#pragma unroll
        for (int mm = 0; mm < 2; ++mm) { f32x4 acc = {0.f, 0.f, 0.f, 0.f};
#pragma unroll
            for (int s = 0; s < 4; ++s) acc = __builtin_amdgcn_mfma_f32_16x16x32_bf16(Y[mm * 4 + s], Bs[s], acc, 0, 0, 0);
#pragma unroll
            for (int r = 0; r < 4; ++r) vn[2 + mm][r] = uc[2 + mm][r] - acc[r]; }
        SC_SCHED; SC_LD256(Y, GU_QD - GU_W, 2); SC_SCHED;
        bf16x8 Bv[2];
#pragma unroll
        for (int s = 0; s < 2; ++s) { const v4u t = {pkbf(vn[2 * s][0], vn[2 * s][1]), pkbf(vn[2 * s][2], vn[2 * s][3]), pkbf(vn[2 * s + 1][0], vn[2 * s + 1][1]), pkbf(vn[2 * s + 1][2], vn[2 * s + 1][3])}; Bv[s] = __builtin_bit_cast(bf16x8, t); }
#pragma unroll
        for (int mm = 0; mm < 2; ++mm) { f32x4 acc = {0.f, 0.f, 0.f, 0.f};
#pragma unroll
            for (int s = 0; s < 4; ++s) acc = __builtin_amdgcn_mfma_f32_16x16x32_bf16(X[mm * 4 + s], Bs[s], acc, 0, 0, 0);
            o[mm] = acc; }
        SC_SCHED; SC_LD128(X, GU_KDT - GU_W, 0); SC_SCHED;
#pragma unroll
        for (int mm = 0; mm < 2; ++mm) { f32x4 acc = {0.f, 0.f, 0.f, 0.f};
#pragma unroll
            for (int s = 0; s < 4; ++s) acc = __builtin_amdgcn_mfma_f32_16x16x32_bf16(Y[mm * 4 + s], Bs[s], acc, 0, 0, 0);
            o[2 + mm] = acc; }
        SC_SCHED; SC_LD128(Y, GU_KDT - GU_W, 4); SC_SCHED;
#pragma unroll
        for (int rr = 0; rr < 4; ++rr) { f32x4 acc = S[rr] * gl;
#pragma unroll
            for (int s = 0; s < 2; ++s) acc = __builtin_amdgcn_mfma_f32_16x16x32_bf16(X[rr * 2 + s], Bv[s], acc, 0, 0, 0);
            S[rr] = acc; }
        SC_SCHED; SC_LD128(X, GU_QK - GU_W, 0); SC_SCHED;
#pragma unroll
        for (int rr = 0; rr < 4; ++rr) { f32x4 acc = S[4 + rr] * gl;
#pragma unroll
            for (int s = 0; s < 2; ++s) acc = __builtin_amdgcn_mfma_f32_16x16x32_bf16(Y[rr * 2 + s], Bv[s], acc, 0, 0, 0);
            S[4 + rr] = acc; }
        SC_SCHED;
#pragma unroll
        for (int m = 0; m < 4; ++m)
#pragma unroll
            for (int s = 0; s < 2; ++s) o[m] = __builtin_amdgcn_mfma_f32_16x16x32_bf16(X[m * 2 + s], Bv[s], o[m], 0, 0, 0);
        if (has_out) { LAS float* sq = SSQ + (step & 1) * 512;
#pragma unroll
            for (int m = 0; m < 4; ++m)
#pragma unroll
                for (int r = 0; r < 4; ++r) { float p = o[m][r] * o[m][r];
                    p += __builtin_bit_cast(float, __builtin_amdgcn_update_dpp(0, __builtin_bit_cast(int, p), 0xB1, 0xF, 0xF, true));
                    p += __builtin_bit_cast(float, __builtin_amdgcn_update_dpp(0, __builtin_bit_cast(int, p), 0x4E, 0xF, 0xF, true));
                    p += __builtin_bit_cast(float, __builtin_amdgcn_update_dpp(0, __builtin_bit_cast(int, p), 0x141, 0xF, 0xF, true));
                    p += __builtin_bit_cast(float, __builtin_amdgcn_update_dpp(0, __builtin_bit_cast(int, p), 0x140, 0xF, 0xF, true));
                    if (c16 == 0) sq[(16 * m + 4 * q4 + r) * 8 + w] = p; op[m][r] = o[m][r]; } }
            }
    }
    asm volatile("s_waitcnt vmcnt(0) lgkmcnt(0)" ::: "memory"); __builtin_amdgcn_s_barrier(); asm volatile("" ::: "memory");
    { const int t = nsteps - 1;
#pragma unroll
      for (int m = 0; m < 4; ++m) {
#pragma unroll
        for (int r = 0; r < 4; ++r) zp[m][r] = zn[m][r]; }
      if (!(kind == 0 && t == 0)) SC_EPI(t, op, zp); }
#undef SC_PREFETCH
#undef SC_LD256
#undef SC_LD128
#undef SC_SCHED
#undef SC_EPI
#undef SC_UD
#undef SC_ROW0
#undef SC_DMA
    GAS unsigned char* dst = (GAS unsigned char*)((MODE != 0 ? (float*)(P.GDN + (size_t)N_GUNITS * GU_BYTES) : (kind == 0 ? P.out + O_PGDN : P.out + O_SGDN)) + (size_t)(b * NHG + h) * 128 * 128);
#pragma unroll
    for (int db = 0; db < 8; ++db)
#pragma unroll
        for (int r = 0; r < 4; ++r) *(GAS float*)(dst + db * 8192 + (voU + r * 512)) = S[db][r];
    asm volatile("s_waitcnt vmcnt(0) lgkmcnt(0)" ::: "memory"); __syncthreads();
}

#ifndef SPLIT_P1
#define SPLIT_P1 2
#endif
#ifndef SPLIT_P9
#define SPLIT_P9 8
#endif
#ifndef SPLIT_P2
#define SPLIT_P2 3
#endif
#ifndef SPLIT_P7
#define SPLIT_P7 4
#endif
#ifndef SPLIT_P10
#define SPLIT_P10 4
#endif
struct Args { const float* in[N_IN]; float* out; unsigned char* ws; int ph_lo, ph_hi, li, pad; };
static_assert(sizeof(Args) == (N_IN + 2) * 8 + 16, "Args has no padding");
__global__ void __launch_bounds__(NWAVES * 64, 2) fwd_kernel(Args args) {
    extern __shared__ __attribute__((aligned(16))) unsigned char lds[];
    Frame F;
    F.lds = (LAS unsigned char*)lds;
    F.MISC = (volatile LAS unsigned*)(F.lds + MISC_OFF);
    F.tid = threadIdx.x; F.lane = F.tid & 63; F.wave = __builtin_amdgcn_readfirstlane(F.tid >> 6);
    F.G = gridDim.x; { const int bx = blockIdx.x; F.vcu = (F.G % 8 == 0) ? (bx % 8) * (F.G / 8) + bx / 8 : bx; }
    unsigned char* ws = args.ws;
    F.ctl = (gu32*)(ws + WS_CTL);
    Ptrs P;
#pragma unroll
    for (int i = 0; i < N_IN; ++i) P.in[i] = args.in[i];
    P.out = args.out;
    P.Wgu1 = (bf16*)(ws + WS_WGU1); P.Wd1 = (bf16*)(ws + WS_WD1); P.Wgu2 = (bf16*)(ws + WS_WGU2); P.Wd2 = (bf16*)(ws + WS_WD2); P.Win = (bf16*)(ws + WS_WIN); P.Wout = (bf16*)(ws + WS_WOUT);
    P.XN = (bf16*)(ws + WS_XN); P.MIX = (bf16*)(ws + WS_MIX); P.H = (bf16*)(ws + WS_H); P.KB = (bf16*)(ws + WS_KB); P.VB = (bf16*)(ws + WS_VB);
    P.Y = (float*)(ws + WS_Y); P.ROPE = (float*)(ws + WS_ROPE); P.GDN = ws + WS_GDN; P.SLAB = (float*)(ws + WS_SLAB); P.XQ = (signed char*)(ws + WS_XQ); P.SA = (float*)(ws + WS_SA); P.SB1 = (float*)(ws + WS_SB); P.SB2 = (float*)(ws + WS_SB + AL((size_t)NGU * 4)); P.CMAX = (unsigned*)(ws + WS_CTL) + CW_CMAX; P.HQ = (signed char*)(ws + WS_HQ); P.SH = (float*)(ws + WS_SH); P.SBD1 = (float*)(ws + WS_SBD); P.SBD2 = (float*)(ws + WS_SBD + AL((size_t)D * 4)); P.CMAXD = (unsigned*)(ws + WS_CTL) + CW_CMAXD; P.RMAX = (unsigned*)(ws + WS_CTL) + CW_RMAX;
    for (int u = F.tid; u < (LDS_BYTES - LDSCTL_OFF) / 4; u += NWAVES * 64) ((LAS unsigned*)(F.lds + LDSCTL_OFF))[u] = 0u;
    __syncthreads();
    XcdBarrier bar; bar.bar = (unsigned*)(F.ctl + CW_BAR) + args.li * XCD_BAR_WORDS; bar.x = 0; bar.st = nullptr;
    if (N_LAUNCHES == 1) bar = xcd_barrier_post((unsigned*)(F.ctl + CW_BAR) + args.li * XCD_BAR_WORDS, F.MISC + 8);
#define GRID_BAR() do { if (N_LAUNCHES == 1) xcd_barrier(bar); } while (0)
    const int lo = args.ph_lo, hi = args.ph_hi;
#define IN(k) (lo <= (k) && (k) < hi)
#define BOTH(k) (IN(k) && IN((k) + 1))

#ifndef PROBE_REPEAT
#define PROBE_REPEAT 0
#endif
#define REP(k) (((PROBE_REPEAT >> (k)) & 1) ? 2 : 1)
    if (IN(0)) { p0_prologue(F, P); GRID_BAR(); p0_quant_wgu1(F, P); if (BOTH(0)) GRID_BAR(); }
    if (IN(1)) { pg8::Gemm g{(const pg8::bf16_t*)P.XQ, (const pg8::bf16_t*)P.Wgu1, M1, NGU, D / 2}; pg8::StaticOrder S; S.init(M1, NGU, D / 2, F.G, (int)blockIdx.x);
        pg8::EpiSwiGLU<true> E{P.H, FF, P.SLAB, 1, P.SA, P.SB1, nullptr};
        pg8::gemm_phase<pg8::EpiSwiGLU<true>, pg8::StaticOrder, true, true, true>(F.lds + RING_OFF, g, S, E);
        PHASE_DONE(1); q_fill(F, P, 1); q_catch_up(F, P, Q_E1);
        GRID_BAR(); quant_h(F, P.H, P.HQ, P.RMAX, P.SH, M1V);
        if (BOTH(1)) GRID_BAR(); }
    if (IN(2)) { pg8::Gemm g{(const pg8::bf16_t*)P.HQ, (const pg8::bf16_t*)P.Wd1, M1, D, FF / 2}; pg8::SplitOrder S; S.init(M1, D, FF / 2, F.G, (int)blockIdx.x, SPLIT_P2);
        typedef pg8::EpiResF32<0, true, false, true> Epi; Epi E{P.Y, D, pg8::RowSrc<0>{P.in[I_XP], P.in[I_XS], P.in[I_META], ROW_S, ROW_M, M1V, D}, P.SLAB, SPLIT_P2, P.SH, P.SBD1};
        pg8::gemm_phase<Epi, pg8::SplitOrder, true, true, true>(F.lds + RING_OFF, g, S, E);
        PHASE_DONE(2); q_fill(F, P, 2); q_catch_up(F, P, Q_E2);
        if (BOTH(2)) GRID_BAR(); }
    if (IN(3)) { pg8::SplitOrder SO; SO.init(M1, D, FF / 2, F.G, 0, SPLIT_P2); ln_phase(F, P.Y, P.Y, P.XN, P.in[I_LNG], P.in[I_LNB], M1V, SO, P.SLAB, 0.5f, nullptr, nullptr); q_catch_up(F, P, Q_E2); if (BOTH(3)) GRID_BAR(); }
    if (IN(4)) { pg8::Gemm g{P.XN, P.Win, M1, DINP, D}; pg8::StaticOrder S; S.init(M1, DINP, D, F.G, (int)blockIdx.x);
        pg8::EpiStoreBf16 E{P.H, DINP};
        pg8::gemm_phase<pg8::EpiStoreBf16, pg8::StaticOrder, true, true>(F.lds + RING_OFF, g, S, E);
        PHASE_DONE(4); q_fill(F, P, 4);
        if (BOTH(4)) GRID_BAR(); }
#ifndef PROBE_ABL5
#define PROBE_ABL5 0
#endif
    if (IN(5)) { for (int rep = 0; rep < REP(5); ++rep) { const int abl = (args.li == 1) ? PROBE_ABL5 : 0;
        if (!(abl & 8)) kv_prep(F, P);
        gdn_prep_all(F, P, abl);
        q_catch_up(F, P, Q_E3);
        if (BOTH(5)) GRID_BAR(); } }
    if (IN(6)) {
        int it = blockIdx.x, st = (it < 64) ? (1 << 20) : F.G - 64;
        for (; it < 896; it += st) {
            if (it < 320) { const int s = it < 64 ? it : it - 64; gdn_scan_seq<0>(F, P, it < 64 ? 0 : 2, s >> 4, s & 15); }
            else attn_unit(F, P, it - 320);
        }
        if ((int)blockIdx.x >= 64) {
            sub_barrier(F, F.ctl + CW_SUB, (unsigned)(F.G - 64));
            pg8::Gemm g{P.MIX, P.Wout, M2, D, D}; pg8::StaticOrder S; S.init(M2, D, D, F.G - 64, (int)blockIdx.x - 64); S.set_k(0, 32);
            typedef pg8::EpiResF32<1, false> Epi; Epi E{P.Y, D, pg8::RowSrc<1>{P.Y, P.Y, P.Y, M2, M2, M2, D}, P.SLAB, 1, nullptr, nullptr};
            pg8::gemm_phase<Epi, pg8::StaticOrder, true, true>(F.lds + RING_OFF, g, S, E);
        }
        PHASE_DONE(6); q_fill(F, P, 6);
        if (BOTH(6)) GRID_BAR(); }
    if (IN(7)) {
        pg8::Gemm g{P.MIX, P.Wout, M2, D, D}; pg8::SplitOrder S; S.init(M2, D, D, F.G, (int)blockIdx.x, SPLIT_P7); S.set_k(32, 32);
        typedef pg8::EpiResF32<1, false, true> Epi; Epi E{P.Y, D, pg8::RowSrc<1>{P.Y, P.Y, P.Y, M2, M2, M2, D}, P.SLAB, SPLIT_P7, nullptr, nullptr};
        pg8::gemm_phase<Epi, pg8::SplitOrder, true, true>(F.lds + RING_OFF, g, S, E);
        PHASE_DONE(7); q_fill(F, P, 7);
        if (BOTH(7)) GRID_BAR(); }
    if (IN(8)) { pg8::SplitOrder SO; SO.init(M2, D, D, F.G, 0, SPLIT_P7); ln_phase(F, P.Y, P.Y, nullptr, P.in[I_LNG] + D, P.in[I_LNB] + D, M2, SO, P.SLAB, 1.0f, P.XQ, P.SA); q_catch_up(F, P, Q_E4); if (BOTH(8)) GRID_BAR(); }
    if (IN(9)) { pg8::Gemm g{(const pg8::bf16_t*)P.XQ, (const pg8::bf16_t*)P.Wgu2, M2, NGU, D / 2}; pg8::StaticOrder S; S.init(M2, NGU, D / 2, F.G, (int)blockIdx.x);
        pg8::EpiSwiGLU<true> E{P.H, FF, P.SLAB, 1, P.SA, P.SB2, nullptr};
        pg8::gemm_phase<pg8::EpiSwiGLU<true>, pg8::StaticOrder, true, true, true>(F.lds + RING_OFF, g, S, E);
        PHASE_DONE(9); q_fill(F, P, 9); q_catch_up(F, P, Q_E5);
        GRID_BAR(); quant_h(F, P.H, P.HQ, P.RMAX + M1, P.SH, M2);
        if (BOTH(9)) GRID_BAR(); }
    if (IN(10)) { pg8::Gemm g{(const pg8::bf16_t*)P.HQ, (const pg8::bf16_t*)P.Wd2, M2, D, FF / 2}; pg8::SplitOrder S; S.init(M2, D, FF / 2, F.G, (int)blockIdx.x, SPLIT_P10);
        typedef pg8::EpiResF32<1, true, false, true> Epi; Epi E{P.Y, D, pg8::RowSrc<1>{P.Y, P.Y, P.Y, M2, M2, M2, D}, P.SLAB, SPLIT_P10, P.SH, P.SBD2};
        pg8::gemm_phase<Epi, pg8::SplitOrder, true, true, true>(F.lds + RING_OFF, g, S, E);
        if (BOTH(10)) GRID_BAR(); }
    if (IN(11)) { for (int rep = 0; rep < REP(11); ++rep) { pg8::SplitOrder SO; SO.init(M2, D, FF / 2, F.G, 0, SPLIT_P10); ln_phase(F, P.Y, P.out + O_YP, nullptr, P.in[I_LNG] + 2 * D, P.in[I_LNB] + 2 * D, M2, SO, P.SLAB, 0.5f, nullptr, nullptr); if (rep + 1 < REP(11)) GRID_BAR(); } }
#undef IN
#undef BOTH
#undef GRID_BAR
}

extern "C" void kernel_launch(void* const* d_in, const int* in_sizes, int n_in, void* d_out, int out_size, void* d_ws, size_t ws_size, hipStream_t stream) {
    static int grid = 0;
    if (grid == 0) {
        if (n_in != N_IN || in_sizes[I_XP] != ROW_S * D || in_sizes[I_WIN] != D * DIN || (size_t)out_size != O_END || ws_size < WS_END) {
            fprintf(stderr, "kernel_launch: shape mismatch: n_in %d in0 %d out %d ws %zu (need %zu); nothing launched\n", n_in, n_in > 0 ? in_sizes[0] : -1, out_size, ws_size, (size_t)WS_END); grid = -1; return; }
        int dev = 0, cus = 0, per_cu = 0;
        if (hipGetDevice(&dev) != hipSuccess || hipDeviceGetAttribute(&cus, hipDeviceAttributeMultiprocessorCount, dev) != hipSuccess) { fprintf(stderr, "kernel_launch: device query failed\n"); grid = -1; return; }
        if (hipFuncSetAttribute((const void*)fwd_kernel, hipFuncAttributeMaxDynamicSharedMemorySize, LDS_BYTES) != hipSuccess) { fprintf(stderr, "kernel_launch: hipFuncSetAttribute failed\n"); grid = -1; return; }
        if (hipOccupancyMaxActiveBlocksPerMultiprocessor(&per_cu, (const void*)fwd_kernel, NWAVES * 64, LDS_BYTES) != hipSuccess || per_cu < 1)
            fprintf(stderr, "kernel_launch: note: occupancy query reports %d workgroups per CU\n", per_cu);
        (void)hipGetLastError();
        if (cus <= 64) { fprintf(stderr, "kernel_launch: %d CUs: this program needs more than 64 workgroups (64 of them run the GDN scans while the others start w_out); nothing launched\n", cus); grid = -1; return; }
        grid = cus;
    }
    if (grid < 0) return;
    if (hipMemsetAsync((char*)d_ws + WS_CTL, 0, CTL_ZERO_BYTES, stream) != hipSuccess) { fprintf(stderr, "kernel_launch: hipMemsetAsync failed\n"); return; }
    Args a{};
    for (int i = 0; i < N_IN; ++i) a.in[i] = (const float*)d_in[i];
    a.out = (float*)d_out; a.ws = (unsigned char*)d_ws;
#ifndef PROBE_PLAN
#define PROBE_PLAN {0, N_PHASES}
#endif
    const int plan[][2] = { PROBE_PLAN }; const int n_plan = (N_LAUNCHES == 1) ? (int)(sizeof(plan) / sizeof(plan[0])) : N_LAUNCHES;
    for (int li = 0; li < n_plan; ++li) {
        a.ph_lo = (N_LAUNCHES == 1) ? plan[li][0] : li; a.ph_hi = (N_LAUNCHES == 1) ? plan[li][1] : li + 1; a.li = (N_LAUNCHES == 1) ? li : 0;
        hipLaunchKernelGGL(fwd_kernel, dim3(grid), dim3(NWAVES * 64), LDS_BYTES, stream, a);
        const hipError_t le = hipPeekAtLastError();
        if (le != hipSuccess) { fprintf(stderr, "kernel_launch: launch %d failed: %s\n", li, hipGetErrorName(le)); break; }
    }
}
```

```cpp
#include <hip/hip_runtime.h>
#include <cstdio>
#include <cstdint>
namespace pg8 {
#define PG8_LAS __attribute__((address_space(3)))
typedef unsigned short bf16_t;
typedef short bf16x8 __attribute__((ext_vector_type(8)));
typedef float f32x4 __attribute__((ext_vector_type(4)));
typedef unsigned u32x4 __attribute__((ext_vector_type(4)));
typedef int i32x4 __attribute__((ext_vector_type(4)));
constexpr int BM = 256, BK = 64, HALF = 128, HTB = HALF * BK * 2  , STAGE_BYTES = 8 * HTB, NXCD = 8, WGM = 8;

__host__ __device__ __forceinline__ int lds_byte(int r, int c) { const int st = (r >> 4) * 2 + (c >> 5), rr = r & 15, cc = c & 31, ob = rr * 64 + cc * 2; return st * 1024 + (ob ^ (((ob >> 9) & 1) << 5)); }
__host__ __device__ __forceinline__ void stage_rc(int b, int& R, int& C) { const int st = b / 1024, sb = b % 1024, swz = sb ^ (((sb >> 9) & 1) << 5); R = (st >> 1) * 16 + swz / 64; C = (st & 1) * 32 + (swz % 64) / 2; }
__host__ __device__ __forceinline__ int perm32(int rho) { const int n = rho >> 4, i = rho & 15; return 8 * (i >> 2) + 4 * n + (i & 3); }

struct Unit { int pm, pn, k0, nt, sl, ri; };
struct Gemm { const bf16_t* A; const bf16_t* Bt; int M, N, K; };

struct StaticOrder {
    int nM, nN, nwg, G, c, ntk, kb;
    __host__ __device__ void init(int M, int N, int K, int G_, int c_) { nM = M / BM; nN = N / BM; nwg = nM * nN; G = G_; c = c_; ntk = K / BK; kb = 0; }
    __host__ __device__ void set_k(int kb_, int ntk_) { kb = kb_; ntk = ntk_; }
    __host__ __device__ void map(int L, Unit& u) const {
        int wgid = L; { const int q = nwg / NXCD, r = nwg % NXCD, xcd = wgid % NXCD, off = wgid / NXCD; wgid = (xcd < r ? xcd * (q + 1) : r * (q + 1) + (xcd - r) * q) + off; }
        const int nig = WGM * nN, gid = wgid / nig, fm = gid * WGM, gsz = (nM - fm) < WGM ? (nM - fm) : WGM;
        u.pm = fm + ((wgid % nig) % gsz); u.pn = (wgid % nig) / gsz; }
    __host__ __device__ int inv(int pm, int pn) const {
        const int nig = WGM * nN, gid = pm / WGM, fm = gid * WGM, gsz = (nM - fm) < WGM ? (nM - fm) : WGM; const int w = gid * nig + pn * gsz + (pm - fm);
        const int q = nwg / NXCD, r = nwg % NXCD; int xcd, off;
        if (w < r * (q + 1)) { xcd = w / (q + 1); off = w - xcd * (q + 1); } else { const int w2 = w - r * (q + 1); const int t = w2 / q; xcd = r + t; off = w2 - t * q; }
        return off * NXCD + xcd; }
    __host__ __device__ bool next(int i, Unit& u) const {
        const long L = (long)i * G + c; if (L >= nwg) return false;
        map((int)L, u); u.k0 = kb; u.nt = ntk; u.sl = 0; u.ri = -1; return true;
    }
    __device__ __forceinline__ void a_ready(const Unit&) const {}
    __device__ __forceinline__ void done(const Unit&) const {}
};
struct SplitOrder : StaticOrder {
    int R, rem, S;
    __host__ __device__ void init(int M, int N, int K, int G_, int c_, int S_) { StaticOrder::init(M, N, K, G_, c_); R = nwg / G; rem = nwg - R * G; S = S_; }
    __host__ __device__ bool next(int i, Unit& u) const {
        if (i < R) { map(i * G + c, u); u.k0 = kb; u.nt = ntk; u.sl = 0; u.ri = -1; return true; }
        const int j = (i - R) * G + c; if (j >= rem * S) return false;
        const int ri = j / S, s = j - ri * S, h = ntk / 2; map(R * G + ri, u);
        const int o0 = 2 * ((h * s) / S); u.k0 = kb + o0; u.nt = 2 * ((h * (s + 1)) / S) - o0; u.sl = s; u.ri = ri; return true;
    }
};

__device__ __forceinline__ unsigned cvt_pk_bf16(float lo, float hi) { unsigned r; asm volatile("v_cvt_pk_bf16_f32 %0, %1, %2" : "=v"(r) : "v"(lo), "v"(hi)); return r; }
typedef float f32x2 __attribute__((ext_vector_type(2)));
__device__ __forceinline__ float silu_f(float g) { return g * __builtin_amdgcn_rcpf(1.0f + __builtin_amdgcn_exp2f(-1.4426950408889634f * g)); }
template <bool I8> struct EpiSwiGLU {
    static constexpr bool PERM = true, AFTER_DRAIN = false;
    bf16_t* O; int ldc; float* slab; int S; const float *sA, *sB; unsigned* rmax;
    __device__ __forceinline__ void operator()(const f32x4 (&acc)[2][2][4][2], const Unit& u, int wr, int wc, int fr, int fq) const {
        if (u.ri >= 0) { float* sb = slab + ((size_t)(u.ri * S + u.sl) << 16) + wc * 32 + 8 * fq;
#pragma unroll
            for (int ai = 0; ai < 2; ++ai)
#pragma unroll
                for (int m = 0; m < 4; ++m) { float* o = sb + (ai * HALF + wr * 64 + m * 16 + fr) * BM;
#pragma unroll
                    for (int bj = 0; bj < 2; ++bj)
#pragma unroll
                        for (int n = 0; n < 2; ++n) *(f32x4*)(o + bj * HALF + 4 * n) = acc[ai][bj][m][n]; }
            return; }
        const int row0 = u.pm * BM + wr * 64 + fr, col0 = u.pn * HALF + wc * 32 + 8 * fq;
        f32x4 sbg0 = {1.f, 1.f, 1.f, 1.f}, sbg1 = sbg0, sbu0 = sbg0, sbu1 = sbg0;
        if constexpr (I8) { const int fr0 = u.pn * BM + wc * 32 + 8 * fq;
            sbg0 = *(const f32x4*)(sB + fr0); sbg1 = *(const f32x4*)(sB + fr0 + 4); sbu0 = *(const f32x4*)(sB + fr0 + HALF); sbu1 = *(const f32x4*)(sB + fr0 + HALF + 4); }
#pragma unroll
        for (int ai = 0; ai < 2; ++ai)
#pragma unroll
            for (int m = 0; m < 4; ++m) { bf16_t* rowp = O + (size_t)(row0 + ai * HALF + m * 16) * ldc + col0;
                f32x4 g0 = acc[ai][0][m][0], g1 = acc[ai][0][m][1], u0 = acc[ai][1][m][0], u1 = acc[ai][1][m][1];
                if constexpr (I8) { const float sa = sA[row0 + ai * HALF + m * 16];
                    g0 = __builtin_convertvector(__builtin_bit_cast(i32x4, g0), f32x4) * (sbg0 * sa); g1 = __builtin_convertvector(__builtin_bit_cast(i32x4, g1), f32x4) * (sbg1 * sa);
                    u0 = __builtin_convertvector(__builtin_bit_cast(i32x4, u0), f32x4) * (sbu0 * sa); u1 = __builtin_convertvector(__builtin_bit_cast(i32x4, u1), f32x4) * (sbu1 * sa); }
                u32x4 w;
                w.x = cvt_pk_bf16(silu_f(g0[0]) * u0[0], silu_f(g0[1]) * u0[1]); w.y = cvt_pk_bf16(silu_f(g0[2]) * u0[2], silu_f(g0[3]) * u0[3]);
                w.z = cvt_pk_bf16(silu_f(g1[0]) * u1[0], silu_f(g1[1]) * u1[1]); w.w = cvt_pk_bf16(silu_f(g1[2]) * u1[2], silu_f(g1[3]) * u1[3]);
                *(u32x4*)rowp = w;
                if (rmax) { unsigned mx = 0u;
                    { const unsigned ww_[4] = {w.x, w.y, w.z, w.w};
#pragma unroll
                      for (int k_ = 0; k_ < 4; ++k_) { const unsigned lo_ = (ww_[k_] << 16) & 0x7fff0000u, hi_ = ww_[k_] & 0x7fff0000u; mx = mx > lo_ ? mx : lo_; mx = mx > hi_ ? mx : hi_; } }
                    { const unsigned o_ = (unsigned)__shfl_xor((int)mx, 16); mx = mx > o_ ? mx : o_; } { const unsigned o_ = (unsigned)__shfl_xor((int)mx, 32); mx = mx > o_ ? mx : o_; }
                    if (fq == 0) (void)__hip_atomic_fetch_max(rmax + row0 + ai * HALF + m * 16, mx, __ATOMIC_RELAXED, __HIP_MEMORY_SCOPE_AGENT); } }
    }
};
struct EpiStoreBf16 {
    static constexpr bool PERM = true, AFTER_DRAIN = false;
    bf16_t* O; int ldc;
    __device__ __forceinline__ void operator()(const f32x4 (&acc)[2][2][4][2], const Unit& u, int wr, int wc, int fr, int fq) const {
        const int row0 = u.pm * BM + wr * 64 + fr, col0 = u.pn * BM + wc * 32 + 8 * fq;
#pragma unroll
        for (int ai = 0; ai < 2; ++ai)
#pragma unroll
            for (int m = 0; m < 4; ++m) { bf16_t* rowp = O + (size_t)(row0 + ai * HALF + m * 16) * ldc + col0;
#pragma unroll
                for (int bj = 0; bj < 2; ++bj) { const f32x4 v0 = acc[ai][bj][m][0], v1 = acc[ai][bj][m][1];
                    u32x4 w; w.x = cvt_pk_bf16(v0[0], v0[1]); w.y = cvt_pk_bf16(v0[2], v0[3]); w.z = cvt_pk_bf16(v1[0], v1[1]); w.w = cvt_pk_bf16(v1[2], v1[3]);
                    *(u32x4*)(rowp + bj * HALF) = w; } }
    }
};
template <int MODE> struct RowSrc {
    const float *p0, *p1, *p2; int n0, n1, n2, ld;
    __device__ __forceinline__ const float* row(int r) const {
        if (MODE == 1) return r < n0 ? p0 + (size_t)r * ld : nullptr;
        if (r < n0) return p0 + (size_t)r * ld;
        if (r < n1) return p1 + (size_t)(r - n0) * ld;
        if (r < n2) return p2 + (size_t)(r - n1) * ld;
        return nullptr; }
};
typedef unsigned u32x2e __attribute__((ext_vector_type(2)));
template <int MODE, bool HALF_, bool ALPHA1 = false, bool I8 = false, bool R16 = false> struct EpiResF32 {
    static constexpr bool PERM = false, AFTER_DRAIN = false;
    float* out; int ldc; RowSrc<MODE> src; float* slab; int S;
    const float *sA, *sB;
    __device__ __forceinline__ void operator()(const f32x4 (&acc)[2][2][4][2], const Unit& u, int wr, int wc, int fr, int fq) const {
        constexpr float alpha = ALPHA1 ? 1.0f : 1.189207115002721f, scale = HALF_ ? 0.5f : 1.0f;
        f32x4 sb_[2][2];
        if constexpr (I8) { const int c0_ = u.pn * BM + wc * 32 + 4 * fq;
#pragma unroll
            for (int bj = 0; bj < 2; ++bj)
#pragma unroll
                for (int n = 0; n < 2; ++n) sb_[bj][n] = *(const f32x4*)(sB + c0_ + bj * HALF + n * 16); }
#define EPI_VAL(ai, bj, m, n, sa_) (I8 ? __builtin_convertvector(__builtin_bit_cast(i32x4, acc[ai][bj][m][n]), f32x4) * (sb_[bj][n] * (sa_)) : acc[ai][bj][m][n])
        if (u.sl > 0) {
            float* sb = slab + ((size_t)(u.ri * (S - 1) + (u.sl - 1)) << 16) + wc * 32 + 4 * fq;
#pragma unroll
            for (int ai = 0; ai < 2; ++ai)
#pragma unroll
                for (int m = 0; m < 4; ++m) { float* o = sb + (ai * HALF + wr * 64 + m * 16 + fr) * BM; float sa_ = 1.f; if constexpr (I8) sa_ = sA[u.pm * BM + ai * HALF + wr * 64 + m * 16 + fr];
#pragma unroll
                    for (int bj = 0; bj < 2; ++bj)
#pragma unroll
                        for (int n = 0; n < 2; ++n) *(f32x4*)(o + bj * HALF + n * 16) = EPI_VAL(ai, bj, m, n, sa_); }
            return; }
        const int col0 = u.pn * BM + wc * 32 + 4 * fq;
#pragma unroll
        for (int ai = 0; ai < 2; ++ai)
#pragma unroll
            for (int m = 0; m < 4; ++m) { const int r = u.pm * BM + ai * HALF + wr * 64 + m * 16 + fr; const float* b = src.row(r);
                if (b) { float* o = out + (size_t)r * ldc; float sa_ = 1.f; if constexpr (I8) sa_ = sA[r];
#pragma unroll
                    for (int bj = 0; bj < 2; ++bj)
#pragma unroll
                        for (int n = 0; n < 2; ++n) { const int c = col0 + bj * HALF + n * 16; f32x4 bs;
                            if constexpr (R16 && MODE == 1) { const u32x2e w_ = *(const u32x2e*)((const bf16_t*)src.p0 + (size_t)r * src.ld + c);
                                bs = (f32x4){__uint_as_float(w_.x << 16), __uint_as_float(w_.x & 0xffff0000u), __uint_as_float(w_.y << 16), __uint_as_float(w_.y & 0xffff0000u)}; }
                            else bs = *(const f32x4*)(b + c);
                            const f32x4 v_ = bs * alpha + EPI_VAL(ai, bj, m, n, sa_) * scale;
                            if constexpr (R16) { u32x2e o_; o_.x = cvt_pk_bf16(v_[0], v_[1]); o_.y = cvt_pk_bf16(v_[2], v_[3]); *(u32x2e*)((bf16_t*)out + (size_t)r * ldc + c) = o_; }
                            else *(f32x4*)(o + c) = v_; } } }
#undef EPI_VAL
    }
};
template <class Epi, class Sched, bool ALIGN_EPI = false, bool SP2 = false, bool I8 = false>
__device__ __forceinline__ void gemm_phase(PG8_LAS unsigned char* lds, const Gemm g, const Sched& S, const Epi& E) {
    const int tid = threadIdx.x, wid = __builtin_amdgcn_readfirstlane(tid >> 6), lane = tid & 63, wr = wid >> 2, wc = wid & 3, fr = lane & 15, fq = lane >> 4;
    const int K = g.K;
    unsigned voffA[2], voffB[2];
#pragma unroll
    for (int i = 0; i < 2; ++i) { int R, C; stage_rc(tid * 16 + i * 8192, R, C); const int Rb = Epi::PERM ? ((R & ~31) + perm32(R & 31)) : R;
        voffA[i] = (unsigned)(R * K + C) * 2u; voffB[i] = (unsigned)(Rb * K + C) * 2u; }
    const size_t kstep = (size_t)(BK * 2);
    const size_t hstep = (size_t)HALF * K * 2;
    const size_t tstep = 2 * hstep;
    const unsigned ldsw = (unsigned)wid * 1024u;
    const int aoff = lds_byte(wr * 64 + fr, fq * 8), boff = lds_byte(wc * 32 + fr, fq * 8);
#define PG8_SA(b, h) (((b) * 2 + (h)) * HTB)
#define PG8_SB(b, h) ((4 + (b) * 2 + (h)) * HTB)
#define PG8_STAGE(bufoff, gbase, voff) do { _Pragma("unroll") for (int _i = 0; _i < 2; ++_i) \
        __builtin_amdgcn_global_load_lds((const unsigned*)((const char*)(gbase) + (voff)[_i]), (PG8_LAS unsigned*)(lds + (bufoff) + ldsw + _i * 8192), 16, 0, 0); } while (0)
#define PG8_LDA(dst, b, h) do { _Pragma("unroll") for (int m = 0; m < 4; ++m) _Pragma("unroll") for (int k = 0; k < 2; ++k) dst[m][k] = *(const PG8_LAS bf16x8*)(lds + PG8_SA(b, h) + aoff + m * 2048 + k * 1024); } while (0)
#define PG8_LDB(dst, b, h) do { _Pragma("unroll") for (int n = 0; n < 2; ++n) _Pragma("unroll") for (int k = 0; k < 2; ++k) dst[n][k] = *(const PG8_LAS bf16x8*)(lds + PG8_SB(b, h) + boff + n * 2048 + k * 1024); } while (0)
#define PG8_MMA(ai, bj, At, Bt) do { __builtin_amdgcn_s_setprio(1); _Pragma("unroll") for (int m = 0; m < 4; ++m) _Pragma("unroll") for (int n = 0; n < 2; ++n) _Pragma("unroll") for (int k = 0; k < 2; ++k) \
        { if constexpr (I8) acc[ai][bj][m][n] = __builtin_bit_cast(f32x4, __builtin_amdgcn_mfma_i32_16x16x64_i8(__builtin_bit_cast(i32x4, Bt[n][k]), __builtin_bit_cast(i32x4, At[m][k]), __builtin_bit_cast(i32x4, acc[ai][bj][m][n]), 0, 0, 0)); \
          else acc[ai][bj][m][n] = __builtin_amdgcn_mfma_f32_16x16x32_bf16(Bt[n][k], At[m][k], acc[ai][bj][m][n], 0, 0, 0); } __builtin_amdgcn_s_setprio(0); } while (0)
#define PG8_WAIT_V(n) asm volatile("s_waitcnt vmcnt(" #n ")" ::: "memory")
#define PG8_WAIT_L(n) asm volatile("s_waitcnt lgkmcnt(" #n ")" ::: "memory")
#define PG8_BAR __builtin_amdgcn_s_barrier()
#define PG8_SCHED __builtin_amdgcn_sched_barrier(0)
    Unit cur, nxt; int ui = 0;
    if (!S.next(0, cur)) return;
    f32x4 acc[2][2][4][2];
#pragma unroll
    for (int a = 0; a < 2; ++a)
#pragma unroll
        for (int b = 0; b < 2; ++b)
#pragma unroll
            for (int m = 0; m < 4; ++m)
#pragma unroll
                for (int n = 0; n < 2; ++n) acc[a][b][m][n] = (f32x4){0.f, 0.f, 0.f, 0.f};
    bf16x8 At[4][2], B0[2][2], B1[2][2];
    const char* cA = (const char*)g.A + (size_t)cur.pm * tstep + (size_t)cur.k0 * kstep; const char* cB = (const char*)g.Bt + (size_t)cur.pn * tstep + (size_t)cur.k0 * kstep; int nt = cur.nt;
    S.a_ready(cur);
    if constexpr (SP2) {
        PG8_STAGE(PG8_SB(0, 0), cB, voffB); PG8_STAGE(PG8_SB(0, 1), cB + hstep, voffB); PG8_STAGE(PG8_SA(0, 0), cA, voffA); PG8_STAGE(PG8_SA(0, 1), cA + hstep, voffA);
        if (wr == 1) PG8_BAR;
        PG8_WAIT_V(2); PG8_BAR;
        PG8_STAGE(PG8_SB(1, 0), cB + kstep, voffB); PG8_STAGE(PG8_SA(1, 0), cA + kstep, voffA); PG8_STAGE(PG8_SB(1, 1), cB + hstep + kstep, voffB);
        PG8_WAIT_V(6); PG8_BAR;
    } else {
        PG8_STAGE(PG8_SB(0, 0), cB, voffB); PG8_STAGE(PG8_SA(0, 0), cA, voffA); PG8_STAGE(PG8_SB(0, 1), cB + hstep, voffB); PG8_STAGE(PG8_SA(0, 1), cA + hstep, voffA);
        if (wr == 1) PG8_BAR;
        PG8_WAIT_V(4); PG8_BAR;
        PG8_STAGE(PG8_SB(1, 0), cB + kstep, voffB); PG8_STAGE(PG8_SA(1, 0), cA + kstep, voffA); PG8_STAGE(PG8_SB(1, 1), cB + hstep + kstep, voffB);
        PG8_WAIT_V(6); PG8_BAR;
    }
    for (;;) {
        const bool has_next = S.next(ui + 1, nxt);
        const char* nA = has_next ? (const char*)g.A + (size_t)nxt.pm * tstep + (size_t)nxt.k0 * kstep : cA; const char* nB = has_next ? (const char*)g.Bt + (size_t)nxt.pn * tstep + (size_t)nxt.k0 * kstep : cB;
        for (int t = 0; t < nt; t += 2) {
            const bool last = (t == nt - 2);
            const char* a1 = cA + (size_t)(t + 1) * kstep;
            const char* a2 = last ? nA : cA + (size_t)(t + 2) * kstep; const char* b2 = last ? nB : cB + (size_t)(t + 2) * kstep;
            const char* a3 = a2 + kstep; const char* b3 = b2 + kstep;
            if (last && has_next) S.a_ready(nxt);
            if constexpr (SP2) {
            PG8_LDB(B0, 0, 0); PG8_LDB(B1, 0, 1); PG8_SCHED; PG8_LDA(At, 0, 0); PG8_STAGE(PG8_SA(1, 1), a1 + hstep, voffA);
            PG8_WAIT_V(8); PG8_WAIT_L(0); PG8_BAR; PG8_MMA(0, 0, At, B0); PG8_MMA(0, 1, At, B1); PG8_BAR; PG8_SCHED;
            PG8_LDA(At, 0, 1); PG8_STAGE(PG8_SB(0, 0), b2, voffB); PG8_STAGE(PG8_SB(0, 1), b2 + hstep, voffB); PG8_STAGE(PG8_SA(0, 0), a2, voffA);
            PG8_WAIT_V(8); PG8_WAIT_L(0); PG8_BAR; PG8_MMA(1, 0, At, B0); PG8_MMA(1, 1, At, B1); PG8_BAR; PG8_SCHED;
            PG8_LDB(B0, 1, 0); PG8_LDB(B1, 1, 1); PG8_SCHED; PG8_LDA(At, 1, 0); PG8_STAGE(PG8_SA(0, 1), a2 + hstep, voffA);
            PG8_WAIT_V(8); PG8_WAIT_L(0); PG8_BAR; PG8_MMA(0, 0, At, B0); PG8_MMA(0, 1, At, B1); PG8_BAR; PG8_SCHED;
            PG8_LDA(At, 1, 1); PG8_STAGE(PG8_SB(1, 0), b3, voffB); PG8_STAGE(PG8_SB(1, 1), b3 + hstep, voffB); PG8_STAGE(PG8_SA(1, 0), a3, voffA);
            PG8_WAIT_V(8); PG8_WAIT_L(0); PG8_BAR; PG8_MMA(1, 0, At, B0); PG8_MMA(1, 1, At, B1); PG8_BAR; PG8_SCHED;
            } else {
            PG8_LDB(B0, 0, 0); PG8_SCHED; PG8_LDA(At, 0, 0); PG8_STAGE(PG8_SA(1, 1), a1 + hstep, voffA);
            PG8_WAIT_L(8); PG8_BAR; PG8_WAIT_L(0); PG8_MMA(0, 0, At, B0); PG8_BAR; PG8_SCHED;
            PG8_LDB(B1, 0, 1); PG8_STAGE(PG8_SB(0, 0), b2, voffB);
            PG8_BAR; PG8_WAIT_L(0); PG8_MMA(0, 1, At, B1); PG8_BAR;
            PG8_LDA(At, 0, 1); PG8_STAGE(PG8_SA(0, 0), a2, voffA);
            PG8_BAR; PG8_WAIT_L(0); PG8_MMA(1, 0, At, B0); PG8_BAR; PG8_SCHED;
            PG8_STAGE(PG8_SB(0, 1), b2 + hstep, voffB);
            PG8_WAIT_V(6); PG8_BAR; PG8_MMA(1, 1, At, B1); PG8_BAR;
            PG8_LDB(B0, 1, 0); PG8_SCHED; PG8_LDA(At, 1, 0); PG8_STAGE(PG8_SA(0, 1), a2 + hstep, voffA);
            PG8_WAIT_L(8); PG8_BAR; PG8_WAIT_L(0); PG8_MMA(0, 0, At, B0); PG8_BAR; PG8_SCHED;
            PG8_LDB(B1, 1, 1); PG8_STAGE(PG8_SB(1, 0), b3, voffB);
            PG8_BAR; PG8_WAIT_L(0); PG8_MMA(0, 1, At, B1); PG8_BAR;
            PG8_LDA(At, 1, 1); PG8_STAGE(PG8_SA(1, 0), a3, voffA);
            PG8_BAR; PG8_WAIT_L(0); PG8_MMA(1, 0, At, B0); PG8_BAR; PG8_SCHED;
            PG8_STAGE(PG8_SB(1, 1), b3 + hstep, voffB);
            PG8_WAIT_V(6); PG8_BAR; PG8_MMA(1, 1, At, B1); PG8_BAR;
            }
        }
        if constexpr (ALIGN_EPI) { if (wr == 0) PG8_BAR; }
        if constexpr (!Epi::AFTER_DRAIN) { E(acc, cur, wr, wc, fr, fq); S.done(cur); }
        if (!has_next) break;
#pragma unroll
        for (int a = 0; a < 2; ++a)
#pragma unroll
            for (int b = 0; b < 2; ++b)
#pragma unroll
                for (int m = 0; m < 4; ++m)
#pragma unroll
                    for (int n = 0; n < 2; ++n) acc[a][b][m][n] = (f32x4){0.f, 0.f, 0.f, 0.f};
        cur = nxt; cA = nA; cB = nB; nt = cur.nt; ++ui;
        if constexpr (ALIGN_EPI) { if (wr == 1) PG8_BAR; }
    }
    PG8_WAIT_V(0);
    if constexpr (!ALIGN_EPI) { if (wr == 0) PG8_BAR; }
    PG8_BAR;
    if constexpr (Epi::AFTER_DRAIN) { E.fused(acc, cur, wr, wc, fr, fq, lds, wid, lane); S.done(cur); }
#undef PG8_SA
#undef PG8_SB
#undef PG8_STAGE
#undef PG8_LDA
#undef PG8_LDB
#undef PG8_MMA
#undef PG8_WAIT_V
#undef PG8_WAIT_L
#undef PG8_BAR
#undef PG8_SCHED
}
}
#define GAS __attribute__((address_space(1)))
#define LAS __attribute__((address_space(3)))
typedef unsigned short bf16;
typedef unsigned v4u __attribute__((ext_vector_type(4)));
typedef float f32x4 __attribute__((ext_vector_type(4)));
typedef short bf16x8 __attribute__((ext_vector_type(8)));
typedef GAS unsigned gu32;
typedef GAS unsigned long long gu64;
#define RLX_AGENT __ATOMIC_RELAXED, __HIP_MEMORY_SCOPE_AGENT
#define LDS_WAIT() asm volatile("s_waitcnt lgkmcnt(0)" ::: "memory")
#define VM_WAIT() asm volatile("s_waitcnt vmcnt(0)" ::: "memory")
__device__ __forceinline__ unsigned long long rt() { return __builtin_amdgcn_s_memrealtime(); }
__device__ __forceinline__ unsigned f2bf(float f) { unsigned u = __builtin_bit_cast(unsigned, f); return (u + 0x7fffu + ((u >> 16) & 1u)) >> 16; }
__device__ __forceinline__ unsigned pk2(float lo, float hi) { return f2bf(lo) | (f2bf(hi) << 16); }

#define XB_TMO      128
#define XB_XCNT(j)  (256  + 64 * (j))
#define XB_XSUB(j)  (1280 + 64 * (j))
#define XB_XGEN(j)  (2304 + 64 * (j))
#define XB_TOP      3328
#define XB_TOPGEN   3392
#define XCD_BAR_WORDS 3456
#define XB_SPIN_CAP (1u << 18)

__device__ __forceinline__ unsigned xb_ld(unsigned* p)              { return __hip_atomic_load(p, __ATOMIC_RELAXED, __HIP_MEMORY_SCOPE_AGENT); }
__device__ __forceinline__ unsigned xb_add(unsigned* p, unsigned v) { return __hip_atomic_fetch_add(p, v, __ATOMIC_RELAXED, __HIP_MEMORY_SCOPE_AGENT); }
__device__ __forceinline__ unsigned xb_xcc_id() { return (unsigned)__builtin_amdgcn_s_getreg((3 << 11) | 20) & 0xFu; }
#define XB_SPIN(cond, bar) do { unsigned _sp = 0; while (cond) { __builtin_amdgcn_s_sleep(1); \
    if ((++_sp & 255u) == 0u) { if (xb_ld(&(bar)[XB_TMO])) break; if (_sp > XB_SPIN_CAP) { atomicAdd(&(bar)[XB_TMO], 1u); break; } } } } while (0)

struct XcdBarrier {
    unsigned* bar; unsigned x;
    volatile LAS unsigned* st;
};

__device__ __forceinline__ XcdBarrier xcd_barrier_post(unsigned* bar, volatile LAS unsigned* st) {
    XcdBarrier b; b.bar = bar; b.x = xb_xcc_id(); b.st = st;
    if (threadIdx.x == 0) (void)xb_add(&bar[XB_XCNT(b.x)], 1u);
    return b;
}
__device__ __forceinline__ void xcd_barrier_complete(unsigned* bar, unsigned x, unsigned& nloc, unsigned& nx) {
    const unsigned G = gridDim.x * gridDim.y * gridDim.z;
    unsigned sum, cnt, mine, sp = 0u;
    for (;;) {
        sum = 0u; cnt = 0u; mine = 0u;
#pragma unroll
        for (unsigned j = 0; j < 16; ++j) { const unsigned c = xb_ld(&bar[XB_XCNT(j)]); sum += c; cnt += (c > 0u) ? 1u : 0u; mine = (j == x) ? c : mine; }
        if (sum == G) break;
        __builtin_amdgcn_s_sleep(1);
        if ((++sp & 255u) == 0u) { if (xb_ld(&bar[XB_TMO])) break; if (sp > XB_SPIN_CAP) { atomicAdd(&bar[XB_TMO], 1u); break; } }
    }
    nloc = mine > 0u ? mine : 1u; nx = cnt > 0u ? cnt : 1u;
}

__device__ __forceinline__ void xcd_barrier(const XcdBarrier& b) {
    asm volatile("s_waitcnt vmcnt(0)" ::: "memory");
    __syncthreads();
    if (threadIdx.x == 0) {
        unsigned* bar = b.bar;
        __builtin_amdgcn_s_waitcnt(0);
        unsigned nloc = b.st[0], nx = b.st[1];
        if (nloc == 0u) { xcd_barrier_complete(bar, b.x, nloc, nx); b.st[0] = nloc; b.st[1] = nx; }
        const unsigned old = xb_add(&bar[XB_XSUB(b.x)], 1u);
        const unsigned gen = old / nloc;
        if (old + 1u == (gen + 1u) * nloc) {
            __builtin_amdgcn_fence(__ATOMIC_RELEASE, "agent");
            asm volatile("s_waitcnt vmcnt(0)" ::: "memory");
            const unsigned og = xb_add(&bar[XB_TOP], 1u);
            const unsigned tg = og / nx;
            if (og + 1u == (tg + 1u) * nx) xb_add(&bar[XB_TOPGEN], 1u);
            else XB_SPIN(xb_ld(&bar[XB_TOPGEN]) == tg, bar);
            __builtin_amdgcn_fence(__ATOMIC_ACQUIRE, "agent");
            xb_add(&bar[XB_XGEN(b.x)], 1u);
            asm volatile("s_waitcnt vmcnt(0)" ::: "memory");
        } else {
            XB_SPIN(xb_ld(&bar[XB_XGEN(b.x)]) == gen, bar);
            __builtin_amdgcn_fence(__ATOMIC_ACQUIRE, "agent");
            asm volatile("s_waitcnt vmcnt(0)" ::: "memory");
        }
    }
    __syncthreads();
}


constexpr int NWAVES = 8;
#ifndef MK_N_LAUNCHES
#define MK_N_LAUNCHES 1
#endif
constexpr int N_PHASES = 12;
constexpr int N_LAUNCHES = MK_N_LAUNCHES;
static_assert(N_LAUNCHES == 1 || N_LAUNCHES == N_PHASES, "MK_N_LAUNCHES is 1 or 12");

constexpr int D = 4096, FF = 11008, NGU = 2 * FF, DIN = 11296, DINP = 11520;
constexpr int NB_P = 4, SEQ_P = 2048, NB_S = 16, SEQ_S = 64, NMETA = 16, PAST = 2048;
constexpr int ROW_S = NB_P * SEQ_P  , ROW_M = ROW_S + NB_S * SEQ_S  , M1V = ROW_M + NMETA  , M1 = 9472  , M2 = ROW_M  ;
constexpr int KVH = 4, HD = 128, KVW = KVH * HD  , NHQ = 16, NHG = 16, WIN = 128;
constexpr int KVR_SMETA = M1, KVR_SWIN = M1 + NB_S * NMETA  , KV_ROWS = KVR_SWIN + NB_S * WIN  ;
constexpr int NPOS = NMETA + PAST + SEQ_S;
constexpr int C_Q = 0, C_K = 2048, C_V = 2560, C_CONV = 3072, C_Z = 9216, C_B = 11264, C_A = 11280, DCONV = 6144;
constexpr float LN_EPS = 1e-5f, RMS_EPS = 1e-6f, ALPHA = 1.189207115002721f;
enum { I_XP = 0, I_XS, I_CMK, I_CMV, I_CWK, I_CWV, I_SCONV, I_SGDN, I_META, I_LNG, I_LNB, I_WG, I_WU, I_WD, I_WIN, I_WOUT, I_SINK, I_CONVW, I_ALOG, I_DTB, I_NORMW, N_IN };
constexpr size_t O_YP = 0, O_YS = O_YP + (size_t)ROW_S * D, O_PMK = O_YS + (size_t)NB_S * SEQ_S * D, O_PMV = O_PMK + (size_t)NB_P * NMETA * KVW, O_PWK = O_PMV + (size_t)NB_P * NMETA * KVW,
                 O_PWV = O_PWK + (size_t)NB_P * WIN * KVW, O_PCONV = O_PWV + (size_t)NB_P * WIN * KVW, O_PGDN = O_PCONV + (size_t)NB_P * 3 * DCONV, O_SWK = O_PGDN + (size_t)NB_P * NHG * 128 * 128,
                 O_SWV = O_SWK + (size_t)NB_S * SEQ_S * KVW, O_SCONV = O_SWV + (size_t)NB_S * SEQ_S * KVW, O_SGDN = O_SCONV + (size_t)NB_S * 3 * DCONV, O_END = O_SGDN + (size_t)NB_S * NHG * 128 * 128;
static_assert(O_END == 44998656, "output map");

constexpr size_t AL(size_t x) { return (x + 4095) / 4096 * 4096; }
constexpr size_t WS_CTL = 0, CTL_ZERO_BYTES = 1u << 20;
constexpr size_t WS_WGU1 = CTL_ZERO_BYTES, SZ_WGU = (size_t)NGU * D * 2, SZ_WD = (size_t)D * FF * 2;
constexpr size_t WS_WD1 = WS_WGU1 + AL(SZ_WGU), WS_WGU2 = WS_WD1 + AL(SZ_WD), WS_WD2 = WS_WGU2 + AL(SZ_WGU), WS_WIN = WS_WD2 + AL(SZ_WD), WS_WOUT = WS_WIN + AL((size_t)DINP * D * 2);
constexpr size_t WS_XN = WS_WOUT + AL((size_t)D * D * 2), WS_MIX = WS_XN + AL((size_t)M1 * D * 2), WS_H = WS_MIX + AL((size_t)M2 * D * 2);
constexpr size_t WS_Y = WS_H + AL((size_t)M1 * DINP * 2), WS_KB = WS_Y + AL((size_t)M1 * D * 4), WS_VB = WS_KB + AL((size_t)KV_ROWS * KVW * 2), WS_ROPE = WS_VB + AL((size_t)KV_ROWS * KVW * 2);
constexpr size_t WS_SLAB = WS_ROPE + AL((size_t)NPOS * 64 * 8), N_SLABS = 224, WS_XQ = WS_SLAB + N_SLABS * 262144, WS_SA = WS_XQ + AL((size_t)M1 * D), WS_SB = WS_SA + AL((size_t)M1 * 4), WS_SH = WS_SB + 2 * AL((size_t)NGU * 4), WS_SBD = WS_SH + AL((size_t)M1 * 4), WS_HQ = WS_SBD + 2 * AL((size_t)D * 4), WS_END = WS_HQ + AL((size_t)M1 * FF);
static_assert((size_t)M1 * FF <= (WS_H - WS_XN), "the int8 copy of h fits over the XN | MIX region");
constexpr int GU_U = 0, GU_W = 32768, GU_QD = GU_W + 16384, GU_KDT = GU_QD + 16384, GU_QK = GU_KDT + 16384, GU_GL = GU_QK + 8192, GU_BYTES = GU_GL + 256;
constexpr int N_GUNITS = NB_P * NHG * 32 + NHG + NB_S * NHG;
constexpr size_t WS_GDN = WS_WGU1;
static_assert((size_t)N_GUNITS * GU_BYTES <= WS_WGU2 - WS_WGU1, "GDN chunk data fits in the FFN1 weight region");
constexpr int CW_TMO = 0, CW_CODE = 1, CW_BAR = 4096, CW_CMAX = 131072, CW_CMAXD = CW_CMAX + 2 * NGU, CW_RMAX = CW_CMAXD + 2 * D;
static_assert((CW_RMAX + 2 * M1) * 4 <= (int)CTL_ZERO_BYTES, "column maxima inside the per-call memset");

constexpr int RING_OFF = 0, RING_BYTES = 139264;
constexpr int LDSCTL_OFF = RING_BYTES, MISC_OFF = LDSCTL_OFF + 320;
constexpr int LDS_BYTES = 147456;
static_assert(MISC_OFF + 128 <= LDS_BYTES, "LDS map");

struct Frame {
    LAS unsigned char* lds;
    volatile LAS unsigned* MISC;
    gu32* ctl;
    int tid, lane, wave;
    int vcu, G;
};
struct Ptrs {
    const float* in[N_IN]; float* out;
    bf16 *Wgu1, *Wd1, *Wgu2, *Wd2, *Win, *Wout, *XN, *MIX, *H, *KB, *VB;
    float* Y; float* ROPE; unsigned char* GDN; float* SLAB;
    signed char* XQ; float *SA, *SB1, *SB2; unsigned* CMAX;
    signed char* HQ; float *SH, *SBD1, *SBD2; unsigned *CMAXD, *RMAX;
};
__host__ __device__ constexpr int kpos32(int kk) { return 8 * ((kk & 15) >> 2) + (kk & 3) + 4 * (kk >> 4); }
__host__ __device__ constexpr int a256_off(int r, int k) { return r * 256 + ((((k >> 5) * 4 + (kpos32(k & 31) >> 3)) ^ (r & 15)) * 16) + (kpos32(k & 31) & 7) * 2; }
__host__ __device__ constexpr int a128_off(int r, int k) { return r * 128 + ((((k >> 5) * 4 + (kpos32(k & 31) >> 3)) ^ ((r >> 1) & 7)) * 16) + (kpos32(k & 31) & 7) * 2; }
typedef short s16x4 __attribute__((ext_vector_type(4)));
__device__ __forceinline__ unsigned pkbf(float lo, float hi) { unsigned r; asm volatile("v_cvt_pk_bf16_f32 %0, %1, %2" : "=v"(r) : "v"(lo), "v"(hi)); return r; }
typedef float f32x2v __attribute__((ext_vector_type(2)));
typedef unsigned u32x2v __attribute__((ext_vector_type(2)));
__device__ __forceinline__ float bf2f(unsigned b) { return __uint_as_float(b << 16); }
__device__ __forceinline__ float wave_sum(float v) {
#pragma unroll
    for (int o = 1; o < 64; o <<= 1) v += __shfl_xor(v, o);
    return v;
}
__device__ __forceinline__ float silu1(float g) { return g * __builtin_amdgcn_rcpf(1.0f + __builtin_amdgcn_exp2f(-1.4426950408889634f * g)); }

template <int NB, int MODE>
__device__ __forceinline__ void p0_transpose_item(const float* W, int K, int N, bf16* WT, LAS float* scr, int item, int lane) {
    constexpr int LPR = NB / 4, RPI = 64 / LPR, NIT = 64 / RPI, ST = NB + 1;
    const int nblk = N / NB, kb = item / nblk, nb = item - kb * nblk, k0 = 64 * kb, n0 = NB * nb;
    const int lr = lane / LPR, lc = 4 * (lane % LPR);
#pragma unroll
    for (int i = 0; i < NIT; ++i) { const int kk = RPI * i + lr; const f32x4 v = __builtin_nontemporal_load((const GAS f32x4*)(W + (size_t)(k0 + kk) * N + n0 + lc));
        LAS float* s = scr + kk * ST + lc; s[0] = v.x; s[1] = v.y; s[2] = v.z; s[3] = v.w; }
    LDS_WAIT(); asm volatile("" ::: "memory");
    const int c = lane & 7;
#pragma unroll
    for (int j = 0; j < NB / 8; ++j) { const int n = (lane >> 3) + 8 * j; const LAS float* s = scr + (8 * c) * ST + n;
        v4u o; o.x = pk2(s[0 * ST], s[1 * ST]); o.y = pk2(s[2 * ST], s[3 * ST]); o.z = pk2(s[4 * ST], s[5 * ST]); o.w = pk2(s[6 * ST], s[7 * ST]);
        const int nn = n0 + n; const int r = (MODE == 0) ? nn : ((nn >> 7) * 256 + (nn & 127) + (MODE == 2 ? 128 : 0));
        *(GAS v4u*)(WT + (size_t)r * K + k0 + 8 * c) = o; }
    LDS_WAIT(); asm volatile("" ::: "memory");
}
__device__ __forceinline__ void cvt_flat(const float* src, bf16* dst, int n8, int gt, int NGT) {
    for (int i = gt; i < n8; i += NGT) { const f32x4 a = *(const GAS f32x4*)(src + (size_t)i * 8), b = *(const GAS f32x4*)(src + (size_t)i * 8 + 4);
        v4u o; o.x = pk2(a.x, a.y); o.y = pk2(a.z, a.w); o.z = pk2(b.x, b.y); o.w = pk2(b.z, b.w); *(GAS v4u*)(dst + (size_t)i * 8) = o; }
}
__device__ __forceinline__ unsigned pack_i8x4(f32x4 v, float inv) {
    const int a = (int)__builtin_rintf(v.x * inv), b = (int)__builtin_rintf(v.y * inv), c = (int)__builtin_rintf(v.z * inv), d = (int)__builtin_rintf(v.w * inv);
    return (unsigned)(a & 255) | ((unsigned)(b & 255) << 8) | ((unsigned)(c & 255) << 16) | ((unsigned)d << 24); }
__device__ __forceinline__ float wave_max(float v) {
#pragma unroll
    for (int o = 1; o < 64; o <<= 1) v = fmaxf(v, __shfl_xor(v, o));
    return v; }
__device__ __forceinline__ void quant_row_i8(const f32x4 (&v)[16], signed char* dst, float* sa, int lane) {
    float m = 0.f;
#pragma unroll
    for (int j = 0; j < 16; ++j) m = fmaxf(fmaxf(m, fmaxf(fabsf(v[j].x), fabsf(v[j].y))), fmaxf(fabsf(v[j].z), fabsf(v[j].w)));
    m = wave_max(m); const float inv = m > 0.f ? 127.f / m : 0.f;
    if (lane == 0) *sa = m * (1.f / 127.f);
#pragma unroll
    for (int j = 0; j < 16; ++j) ((GAS unsigned*)dst)[lane + 64 * j] = pack_i8x4(v[j], inv);
}
__device__ __forceinline__ int gu_row(int mode, int nn) { return mode == 0 ? nn : (nn >> 7) * 256 + (nn & 127) + (mode == 2 ? 128 : 0); }
__device__ __forceinline__ void p0_colmax_item(const float* W, int N, unsigned* cmax, int mode, int item, int lane) {
    const int nblk = N / 64, kb = item / nblk, nb = item - kb * nblk, k0 = 64 * kb, n0 = 64 * nb, lr = lane >> 4, lc = 4 * (lane & 15);
    f32x4 m = {0.f, 0.f, 0.f, 0.f};
#pragma unroll
    for (int i = 0; i < 16; ++i) { const f32x4 v = __builtin_nontemporal_load((const GAS f32x4*)(W + (size_t)(k0 + 4 * i + lr) * N + n0 + lc));
        m.x = fmaxf(m.x, fabsf(v.x)); m.y = fmaxf(m.y, fabsf(v.y)); m.z = fmaxf(m.z, fabsf(v.z)); m.w = fmaxf(m.w, fabsf(v.w)); }
    m.x = fmaxf(m.x, __shfl_xor(m.x, 16)); m.y = fmaxf(m.y, __shfl_xor(m.y, 16)); m.z = fmaxf(m.z, __shfl_xor(m.z, 16)); m.w = fmaxf(m.w, __shfl_xor(m.w, 16));
    m.x = fmaxf(m.x, __shfl_xor(m.x, 32)); m.y = fmaxf(m.y, __shfl_xor(m.y, 32)); m.z = fmaxf(m.z, __shfl_xor(m.z, 32)); m.w = fmaxf(m.w, __shfl_xor(m.w, 32));
    if (lane < 16) { const int r = gu_row(mode, n0 + lc);
        (void)__hip_atomic_fetch_max(cmax + r + 0, __float_as_uint(m.x), RLX_AGENT); (void)__hip_atomic_fetch_max(cmax + r + 1, __float_as_uint(m.y), RLX_AGENT);
        (void)__hip_atomic_fetch_max(cmax + r + 2, __float_as_uint(m.z), RLX_AGENT); (void)__hip_atomic_fetch_max(cmax + r + 3, __float_as_uint(m.w), RLX_AGENT); }
}
__device__ __forceinline__ void p0_quant_item(const float* W, int K, int N, signed char* WT, const unsigned* cmax, float* sB, int mode, LAS float* scr, int item, int lane) {
    const int nblk = N / 64, kb = item / nblk, nb = item - kb * nblk, k0 = 64 * kb, n0 = 64 * nb, lr = lane >> 4, lc = 4 * (lane & 15);
#pragma unroll
    for (int i = 0; i < 16; ++i) { const int kk = 4 * i + lr; const f32x4 v = __builtin_nontemporal_load((const GAS f32x4*)(W + (size_t)(k0 + kk) * N + n0 + lc));
        LAS float* s = scr + kk * 65 + lc; s[0] = v.x; s[1] = v.y; s[2] = v.z; s[3] = v.w; }
    LDS_WAIT(); asm volatile("" ::: "memory");
    const int r = gu_row(mode, n0 + lane); const float am = __uint_as_float(__hip_atomic_load(cmax + r, RLX_AGENT)), inv = am > 0.f ? 127.f / am : 0.f;
    if (kb == 0) sB[r] = am * (1.f / 127.f);
    const LAS float* s = scr + lane;
#pragma unroll
    for (int c = 0; c < 4; ++c) { v4u o;
        o.x = pack_i8x4((f32x4){s[(16 * c + 0) * 65], s[(16 * c + 1) * 65], s[(16 * c + 2) * 65], s[(16 * c + 3) * 65]}, inv); o.y = pack_i8x4((f32x4){s[(16 * c + 4) * 65], s[(16 * c + 5) * 65], s[(16 * c + 6) * 65], s[(16 * c + 7) * 65]}, inv);
        o.z = pack_i8x4((f32x4){s[(16 * c + 8) * 65], s[(16 * c + 9) * 65], s[(16 * c + 10) * 65], s[(16 * c + 11) * 65]}, inv); o.w = pack_i8x4((f32x4){s[(16 * c + 12) * 65], s[(16 * c + 13) * 65], s[(16 * c + 14) * 65], s[(16 * c + 15) * 65]}, inv);
        *(GAS v4u*)(WT + (size_t)r * K + k0 + 16 * c) = o; }
    LDS_WAIT(); asm volatile("" ::: "memory");
}
__device__ __forceinline__ void quant_h(Frame& F, const bf16* H, signed char* HQ, const unsigned* rmax, float* SH, int nrows) {
    const int gw = F.vcu * NWAVES + F.wave, NGW = F.G * NWAVES;
    for (int r = gw; r < nrows; r += NGW) {
        const GAS v4u* src = (const GAS v4u*)(H + (size_t)r * FF); GAS u32x2v* dst = (GAS u32x2v*)(HQ + (size_t)r * FF);
        unsigned mx = 0u;
#pragma unroll 4
        for (int c = F.lane; c < FF / 8; c += 64) { const v4u w = src[c]; const unsigned ww_[4] = {w.x, w.y, w.z, w.w};
#pragma unroll
            for (int k_ = 0; k_ < 4; ++k_) { const unsigned lo_ = (ww_[k_] << 16) & 0x7fff0000u, hi_ = ww_[k_] & 0x7fff0000u; mx = mx > lo_ ? mx : lo_; mx = mx > hi_ ? mx : hi_; } }
#pragma unroll
        for (int o = 1; o < 64; o <<= 1) { const unsigned t_ = (unsigned)__shfl_xor((int)mx, o); mx = mx > t_ ? mx : t_; }
        const float am = __uint_as_float(mx), inv = am > 0.f ? 127.f / am : 0.f;
        if (F.lane == 0) SH[r] = am * (1.f / 127.f);
#pragma unroll 4
        for (int c = F.lane; c < FF / 8; c += 64) { const v4u w = src[c]; u32x2v o;
            o.x = pack_i8x4((f32x4){bf2f(w.x & 0xffffu), bf2f(w.x >> 16), bf2f(w.y & 0xffffu), bf2f(w.y >> 16)}, inv); o.y = pack_i8x4((f32x4){bf2f(w.z & 0xffffu), bf2f(w.z >> 16), bf2f(w.w & 0xffffu), bf2f(w.w >> 16)}, inv);
            dst[c] = o; } }
}
constexpr int IT_GU = (D / 64) * (FF / 64), IT_IN = (D / 64) * (DIN / 32), IT_OUT = (D / 64) * (D / 64);
constexpr int Q_E1 = IT_GU  , Q_E2 = Q_E1 + IT_IN  , Q_E3 = Q_E2 + IT_OUT  , Q_E4 = Q_E3 + 2 * IT_GU  , Q_E5 = Q_E4 + IT_GU  ;
constexpr int QCH = 8;
constexpr int CW_QCTR = 2048, CW_DONE = 2112;
__device__ __forceinline__ void conv_item(const Ptrs& P, LAS float* scr, int q, int lane) {
    const float* wg = P.in[I_WG] + (size_t)D * FF; const float* wu = P.in[I_WU] + (size_t)D * FF; const float* wd = P.in[I_WD];
    if (q < Q_E1) p0_quant_item(wd, FF, D, (signed char*)P.Wd1, P.CMAXD, P.SBD1, 0, scr, q, lane);
    else if (q < Q_E2) p0_transpose_item<32, 0>(P.in[I_WIN], D, DIN, P.Win, scr, q - Q_E1, lane);
    else if (q < Q_E3) p0_transpose_item<64, 0>(P.in[I_WOUT], D, D, P.Wout, scr, q - Q_E2, lane);
    else if (q < Q_E3 + IT_GU) p0_quant_item(wg, D, FF, (signed char*)P.Wgu2, P.CMAX + NGU, P.SB2, 1, scr, q - Q_E3, lane);
    else if (q < Q_E4) p0_quant_item(wu, D, FF, (signed char*)P.Wgu2, P.CMAX + NGU, P.SB2, 2, scr, q - Q_E3 - IT_GU, lane);
    else p0_quant_item(wd + (size_t)D * FF, FF, D, (signed char*)P.Wd2, P.CMAXD + D, P.SBD2, 0, scr, q - Q_E4, lane);
}
__device__ __forceinline__ int q_take(Frame& F) { int i = 0; if (F.lane == 0) i = (int)__hip_atomic_fetch_add(F.ctl + CW_QCTR, (unsigned)QCH, RLX_AGENT); return __builtin_amdgcn_readfirstlane(i); }
__device__ __forceinline__ int q_head(Frame& F) { return (int)__builtin_amdgcn_readfirstlane(__hip_atomic_load(F.ctl + CW_QCTR, RLX_AGENT)); }
__device__ __forceinline__ void q_catch_up(Frame& F, const Ptrs& P, int E) {
    LAS float* scr = (LAS float*)(F.lds + RING_OFF + F.wave * 16640);
    for (;;) { if (q_head(F) >= E) break; const int i = q_take(F);
        for (int k = 0; k < QCH; ++k) if (i + k < Q_E5) conv_item(P, scr, i + k, F.lane); }
}
__device__ __forceinline__ void q_fill(Frame& F, const Ptrs& P, int ph) {
    LAS float* scr = (LAS float*)(F.lds + RING_OFF + F.wave * 16640);
    gu32* done = F.ctl + CW_DONE + 64 * ph;
    for (;;) {
        if ((int)__builtin_amdgcn_readfirstlane(__hip_atomic_load(done, RLX_AGENT)) >= F.G || q_head(F) >= Q_E5) break;
        const int i = q_take(F); if (i >= Q_E5) break;
        for (int k = 0; k < QCH; ++k) if (i + k < Q_E5) conv_item(P, scr, i + k, F.lane); }
}
__device__ __forceinline__ void sub_barrier(Frame& F, gu32* ctr, unsigned n) {
    asm volatile("s_waitcnt vmcnt(0) lgkmcnt(0)" ::: "memory"); __syncthreads();
    if (F.tid == 0) {
        __builtin_amdgcn_fence(__ATOMIC_RELEASE, "agent"); asm volatile("s_waitcnt vmcnt(0)" ::: "memory");
        (void)__hip_atomic_fetch_add(ctr, 1u, RLX_AGENT);
        unsigned sp = 0; while (__hip_atomic_load(ctr, RLX_AGENT) < n) { __builtin_amdgcn_s_sleep(2); if (++sp > (1u << 22)) { __hip_atomic_store(F.ctl + CW_TMO, 1u, RLX_AGENT); break; } }
        __builtin_amdgcn_fence(__ATOMIC_ACQUIRE, "agent"); asm volatile("s_waitcnt vmcnt(0)" ::: "memory");
    }
    __syncthreads();
}
constexpr int CW_SUB = 3072;
#define PHASE_DONE(ph) do { if (F.tid == 0) (void)__hip_atomic_fetch_add(F.ctl + CW_DONE + 64 * (ph), 1u, RLX_AGENT); } while (0)
__device__ __forceinline__ void p0_quant_wgu1(Frame& F, const Ptrs& P) {
    LAS float* scr = (LAS float*)(F.lds + RING_OFF + F.wave * 16640);
    const int gw = F.vcu * NWAVES + F.wave, NGW = F.G * NWAVES;
    for (int it = gw; it < 2 * IT_GU; it += NGW) {
        if (it < IT_GU) p0_quant_item(P.in[I_WG], D, FF, (signed char*)P.Wgu1, P.CMAX, P.SB1, 1, scr, it, F.lane);
        else p0_quant_item(P.in[I_WU], D, FF, (signed char*)P.Wgu1, P.CMAX, P.SB1, 2, scr, it - IT_GU, F.lane);
    }
}
__device__ __forceinline__ void p0_prologue(Frame& F, const Ptrs& P) {
    const int gw = F.vcu * NWAVES + F.wave, NGW = F.G * NWAVES;
    for (int it = gw; it < 4 * IT_GU; it += NGW) { const int mtx = it / IT_GU, r = it - mtx * IT_GU;
        p0_colmax_item((mtx & 1 ? P.in[I_WU] : P.in[I_WG]) + (size_t)(mtx >> 1) * D * FF, FF, P.CMAX + (mtx >> 1) * NGU, 1 + (mtx & 1), r, F.lane); }
    for (int it = gw; it < 2 * IT_GU; it += NGW) { const int mtx = it / IT_GU, r = it - mtx * IT_GU;
        p0_colmax_item(P.in[I_WD] + (size_t)mtx * D * FF, D, P.CMAXD + mtx * D, 0, r, F.lane); }
    for (int m = gw; m < M1V; m += NGW) {
        const float* src = m < ROW_S ? P.in[I_XP] + (size_t)m * D : (m < ROW_M ? P.in[I_XS] + (size_t)(m - ROW_S) * D : P.in[I_META] + (size_t)(m - ROW_M) * D);
        const GAS f32x4* xr = (const GAS f32x4*)src + F.lane; f32x4 v[16];
#pragma unroll
        for (int j = 0; j < 16; ++j) v[j] = xr[64 * j];
        quant_row_i8(v, P.XQ + (size_t)m * D, P.SA + m, F.lane);
    }
    const int gt = gw * 64 + F.lane, NGT = NGW * 64;
    for (int i = gt; i < NPOS * 64; i += NGT) { const int pos = i >> 6, k = i & 63;
        const double inv = exp2(-(double)k * (13.287712379549449 / 64.0)); const float ang = (float)((double)pos * inv);
        float s, c; sincosf(ang, &s, &c); ((GAS f32x2v*)P.ROPE)[i] = (f32x2v){c, s}; }
    cvt_flat(P.in[I_CMK], P.KB + (size_t)KVR_SMETA * KVW, NB_S * NMETA * KVW / 8, gt, NGT);
    cvt_flat(P.in[I_CMV], P.VB + (size_t)KVR_SMETA * KVW, NB_S * NMETA * KVW / 8, gt, NGT);
    cvt_flat(P.in[I_CWK], P.KB + (size_t)KVR_SWIN * KVW, NB_S * WIN * KVW / 8, gt, NGT);
    cvt_flat(P.in[I_CWV], P.VB + (size_t)KVR_SWIN * KVW, NB_S * WIN * KVW / 8, gt, NGT);
}

__device__ __forceinline__ void swiglu_combine(Frame& F, const pg8::SplitOrder& SO, const float* slab, bf16* H, const float* sA, const float* sB) {
    const int tid = F.tid, row = tid >> 4, c8 = (tid & 15) * 8;
    for (int it = blockIdx.x; it < SO.rem * 8; it += F.G) { const int ri = it >> 3, r0 = (it & 7) * 32 + row; pg8::Unit u; SO.map(SO.R * SO.G + ri, u);
        typedef int i32x4 __attribute__((ext_vector_type(4)));
        i32x4 ig0 = {0, 0, 0, 0}, ig1 = ig0, iu0 = ig0, iu1 = ig0;
        for (int s2 = 0; s2 < SO.S; ++s2) { const GAS i32x4* sp = (const GAS i32x4*)(slab + ((size_t)(ri * SO.S + s2) << 16) + r0 * 256 + c8);
            ig0 = ig0 + sp[0]; ig1 = ig1 + sp[1]; iu0 = iu0 + sp[32]; iu1 = iu1 + sp[33]; }
        const float sa = sA[u.pm * 256 + r0]; const float* sbp = sB + u.pn * 256 + c8;
        const f32x4 g0 = __builtin_convertvector(ig0, f32x4) * (*(const GAS f32x4*)(sbp) * sa), g1 = __builtin_convertvector(ig1, f32x4) * (*(const GAS f32x4*)(sbp + 4) * sa);
        const f32x4 u0 = __builtin_convertvector(iu0, f32x4) * (*(const GAS f32x4*)(sbp + 128) * sa), u1 = __builtin_convertvector(iu1, f32x4) * (*(const GAS f32x4*)(sbp + 132) * sa);
        v4u o; o.x = pkbf(silu1(g0.x) * u0.x, silu1(g0.y) * u0.y); o.y = pkbf(silu1(g0.z) * u0.z, silu1(g0.w) * u0.w);
        o.z = pkbf(silu1(g1.x) * u1.x, silu1(g1.y) * u1.y); o.w = pkbf(silu1(g1.z) * u1.z, silu1(g1.w) * u1.w);
        *(GAS v4u*)(H + (size_t)(u.pm * 256 + r0) * FF + u.pn * 128 + c8) = o; }
}
__device__ __forceinline__ void ln_phase(Frame& F, const bf16* Y, float* Xo, bf16* XN, const float* g, const float* b, int nrows, const pg8::SplitOrder& SO, const float* slab, float sscale, signed char* XQ, float* SA) {
    const int gw = F.vcu * NWAVES + F.wave, NGW = F.G * NWAVES;
    for (int r = gw; r < nrows; r += NGW) {
        const GAS u32x2v* yr = (const GAS u32x2v*)(Y + (size_t)r * D) + F.lane;
        f32x4 v[16];
#pragma unroll
        for (int j = 0; j < 16; ++j) { const u32x2v w_ = yr[64 * j]; v[j] = (f32x4){bf2f(w_.x & 0xffffu), bf2f(w_.x >> 16), bf2f(w_.y & 0xffffu), bf2f(w_.y >> 16)}; }
        if (SO.rem > 0 && SO.S > 1) { const int pm = r >> 8, rr = r & 255;
#pragma unroll
            for (int j = 0; j < 16; ++j) { const int ri = SO.inv(pm, j) - SO.R * SO.G;
                if (ri >= 0) { const GAS f32x4* sp = (const GAS f32x4*)(slab + ((size_t)(ri * (SO.S - 1)) << 16) + rr * 256) + F.lane; f32x4 a = sp[0];
                    for (int s2 = 1; s2 < SO.S - 1; ++s2) a = a + sp[(size_t)s2 << 14];
                    v[j] = v[j] + a * sscale; } } }
        float s = 0.f;
#pragma unroll
        for (int j = 0; j < 16; ++j) s += (v[j].x + v[j].y) + (v[j].z + v[j].w);
        const float mean = wave_sum(s) * (1.f / D); float s2 = 0.f;
#pragma unroll
        for (int j = 0; j < 16; ++j) { v[j] = v[j] - mean; s2 += (v[j].x * v[j].x + v[j].y * v[j].y) + (v[j].z * v[j].z + v[j].w * v[j].w); }
        const float rstd = 1.f / sqrtf(wave_sum(s2) * (1.f / D) + LN_EPS);
#pragma unroll
        for (int j = 0; j < 16; ++j) { const f32x4 gg = ((const GAS f32x4*)g)[F.lane + 64 * j], bb = ((const GAS f32x4*)b)[F.lane + 64 * j];
            const f32x4 o = v[j] * rstd * gg + bb; v[j] = o;
            if (Xo) ((GAS f32x4*)(Xo + (size_t)r * D))[F.lane + 64 * j] = o;
            if (XN) { u32x2v w; w.x = pk2(o.x, o.y); w.y = pk2(o.z, o.w); ((GAS u32x2v*)(XN + (size_t)r * D))[F.lane + 64 * j] = w; } }
        if (XQ) quant_row_i8(v, XQ + (size_t)r * D, SA + r, F.lane);
    }
}

__device__ __forceinline__ void kv_prep(Frame& F, const Ptrs& P) {
    const int gw = F.vcu * NWAVES + F.wave, NGW = F.G * NWAVES, lane = F.lane;
    const bf16* HIN = P.H;
    for (int r = gw; r < M1V; r += NGW) {
        int pos; float* kdst = nullptr; float* vdst = nullptr; int ncp = 1;
        if (r < ROW_S) { const int t = r & (SEQ_P - 1), b = r >> 11; pos = NMETA + t;
            if (t >= SEQ_P - WIN) { kdst = P.out + O_PWK + (size_t)(b * WIN + t - (SEQ_P - WIN)) * KVW; vdst = P.out + O_PWV + (size_t)(b * WIN + t - (SEQ_P - WIN)) * KVW; } }
        else if (r < ROW_M) { pos = NMETA + PAST + ((r - ROW_S) & (SEQ_S - 1)); kdst = P.out + O_SWK + (size_t)(r - ROW_S) * KVW; vdst = P.out + O_SWV + (size_t)(r - ROW_S) * KVW; }
        else { pos = r - ROW_M; kdst = P.out + O_PMK + (size_t)pos * KVW; vdst = P.out + O_PMV + (size_t)pos * KVW; ncp = NB_P; }
        const bf16* hrow = HIN + (size_t)r * DINP;
        const f32x2v cs = ((const GAS f32x2v*)P.ROPE)[pos * 64 + lane];
#pragma unroll
        for (int kh = 0; kh < KVH; ++kh) { const float x1 = bf2f(hrow[C_K + kh * HD + lane]), x2 = bf2f(hrow[C_K + kh * HD + 64 + lane]);
            const float o1 = x1 * cs.x - x2 * cs.y, o2 = x2 * cs.x + x1 * cs.y;
            P.KB[(size_t)r * KVW + kh * HD + lane] = (bf16)f2bf(o1); P.KB[(size_t)r * KVW + kh * HD + 64 + lane] = (bf16)f2bf(o2);
            if (kdst) for (int cp = 0; cp < ncp; ++cp) { kdst[(size_t)cp * NMETA * KVW + kh * HD + lane] = o1; kdst[(size_t)cp * NMETA * KVW + kh * HD + 64 + lane] = o2; } }
        const v4u vv = *(const GAS v4u*)(hrow + C_V + 8 * lane);
        *(GAS v4u*)(P.VB + (size_t)r * KVW + 8 * lane) = vv;
        if (vdst) { const f32x4 a = {bf2f(vv.x & 0xffffu), bf2f(vv.x >> 16), bf2f(vv.y & 0xffffu), bf2f(vv.y >> 16)}, c = {bf2f(vv.z & 0xffffu), bf2f(vv.z >> 16), bf2f(vv.w & 0xffffu), bf2f(vv.w >> 16)};
            for (int cp = 0; cp < ncp; ++cp) { *(GAS f32x4*)(vdst + (size_t)cp * NMETA * KVW + 8 * lane) = a; *(GAS f32x4*)(vdst + (size_t)cp * NMETA * KVW + 8 * lane + 4) = c; } }
    }
    for (int it = gw; it < (NB_P + NB_S) * 3 * (DCONV / 512); it += NGW) {
        const int part = it % (DCONV / 512), rj = it / (DCONV / 512), j = rj % 3, sb = rj / 3;
        const int srow = sb < NB_P ? sb * SEQ_P + SEQ_P - 3 + j : ROW_S + (sb - NB_P) * SEQ_S + SEQ_S - 3 + j;
        float* dst = (sb < NB_P ? P.out + O_PCONV + (size_t)(sb * 3 + j) * DCONV : P.out + O_SCONV + (size_t)((sb - NB_P) * 3 + j) * DCONV) + part * 512 + 8 * lane;
        const v4u vv = *(const GAS v4u*)(HIN + (size_t)srow * DINP + C_CONV + part * 512 + 8 * lane);
        *(GAS f32x4*)dst = (f32x4){bf2f(vv.x & 0xffffu), bf2f(vv.x >> 16), bf2f(vv.y & 0xffffu), bf2f(vv.y >> 16)};
        *(GAS f32x4*)(dst + 4) = (f32x4){bf2f(vv.z & 0xffffu), bf2f(vv.z >> 16), bf2f(vv.w & 0xffffu), bf2f(vv.w >> 16)};
    }
}

constexpr int PB_ST = 136;
constexpr int L_AT = 0, L_TAB = L_AT + 64 * 68 * 4, L_QKR = L_TAB + 12 * 256, L_QB = L_QKR + 64 * 68 * 4, L_KB = L_QB + 64 * PB_ST * 2, L_VB = L_KB + 64 * PB_ST * 2, L_XR = L_VB + 64 * PB_ST * 2, L_PREP_END = L_XR + 64 * 768;
static_assert(L_PREP_END <= RING_BYTES && (L_XR % 1024) == 0, "GDN prep LDS");
enum { T_BETA = 0, T_GC, T_EG, T_EK, T_RK2, T_RQ2, T_SU, T_SW, T_SKD, T_SQD, T_N };
struct PrepUnit { int kind, b, h, n, row0; };
__device__ __forceinline__ PrepUnit prep_decode(int uidx) {
    PrepUnit u; u.b = 0; u.n = 0;
    if (uidx < 2048) { u.kind = 0; u.b = uidx >> 9; u.h = (uidx >> 5) & 15; u.n = uidx & 31; u.row0 = u.b * SEQ_P + 64 * u.n; }
    else if (uidx < 2064) { u.kind = 1; u.h = uidx - 2048; u.row0 = ROW_M - 48; }
    else { u.kind = 2; u.b = (uidx - 2064) >> 4; u.h = (uidx - 2064) & 15; u.row0 = ROW_S + u.b * SEQ_S; }
    return u;
}
__device__ __forceinline__ float dpp_sum16(float p) {
    p += __builtin_bit_cast(float, __builtin_amdgcn_update_dpp(0, __builtin_bit_cast(int, p), 0xB1, 0xF, 0xF, true));
    p += __builtin_bit_cast(float, __builtin_amdgcn_update_dpp(0, __builtin_bit_cast(int, p), 0x4E, 0xF, 0xF, true));
    p += __builtin_bit_cast(float, __builtin_amdgcn_update_dpp(0, __builtin_bit_cast(int, p), 0x141, 0xF, 0xF, true));
    p += __builtin_bit_cast(float, __builtin_amdgcn_update_dpp(0, __builtin_bit_cast(int, p), 0x140, 0xF, 0xF, true));
    return p;
}
template <bool ISU> __device__ __forceinline__ void prep_solve(LAS float* AT, LAS float* TAB, LAS unsigned char* VB, LAS unsigned char* KB, LAS unsigned char* OUTW, unsigned char* ud, int tid) {
    const int cc = tid & 127; const LAS unsigned char* src = (ISU ? VB : KB) + cc * 2; const LAS float* sc = TAB + (ISU ? T_SU : T_SW) * 64;
    float* U = (float*)(ud + GU_U);
    const int cslot = (cc >> 5) * 4 + (kpos32(cc & 31) >> 3), cpos2 = (kpos32(cc & 31) & 7) * 2;
    float r[64];
#pragma unroll
    for (int i = 0; i < 64; ++i) r[i] = bf2f(*(const LAS unsigned short*)(src + i * (PB_ST * 2))) * sc[i];
    const LAS float* atp = AT;
#pragma unroll
    for (int j = 0; j < 64; ++j) { float sol = r[j]; asm volatile("" : "+v"(atp), "+v"(sol));
        if (ISU) U[j * 128 + cc] = sol; else *(LAS unsigned short*)(OUTW + j * 256 + ((cslot ^ (j & 15)) << 4) + cpos2) = (unsigned short)f2bf(sol);
#pragma unroll
        for (int q = (j + 1) / 4; q < 16; ++q) { const f32x4 a = *(const LAS f32x4*)(atp + j * 68 + 4 * q);
            if (4 * q + 0 > j) r[4 * q + 0] -= a.x * sol; if (4 * q + 1 > j) r[4 * q + 1] -= a.y * sol;
            if (4 * q + 2 > j) r[4 * q + 2] -= a.z * sol; if (4 * q + 3 > j) r[4 * q + 3] -= a.w * sol; }
        __builtin_amdgcn_sched_barrier(0); }
}
struct Solve2State { float r0[32], r1[32]; f32x4 a[2][8]; const LAS float* atp; float* U; LAS unsigned char* ow; int pi, cslot; };
template <bool ISU, int J> __device__ __forceinline__ void prep_solve2_step(Solve2State& st) {
    if constexpr (J < 64) {
        constexpr int pj = (J >> 2) & 1, kj = 4 * (J >> 3) + (J & 3);
        asm volatile("" : "+v"(st.atp), "+v"(st.r0[kj]));
        if constexpr (J + 1 < 64) {
#pragma unroll
            for (int kk = (J + 1) >> 3; kk < 8; ++kk) st.a[(J + 1) & 1][kk] = *(const LAS f32x4*)(st.atp + (J + 1) * 68 + 8 * kk); }
        const float m0 = st.r0[kj], m1 = st.r1[kj];
        const float o0 = __builtin_bit_cast(float, __builtin_amdgcn_update_dpp(0, __builtin_bit_cast(int, m0), 0xB1, 0xF, 0xF, true)), o1 = __builtin_bit_cast(float, __builtin_amdgcn_update_dpp(0, __builtin_bit_cast(int, m1), 0xB1, 0xF, 0xF, true));
        const float s0 = (st.pi == pj) ? m0 : o0, s1 = (st.pi == pj) ? m1 : o1;
        if (ISU) *(GAS f32x2v*)(st.U + J * 128) = (f32x2v){s0, s1}; else *(LAS unsigned*)(st.ow + J * 256 + ((st.cslot ^ (J & 15)) << 4)) = pkbf(s0, s1);
#pragma unroll
        for (int kk = J >> 3; kk < 8; ++kk) { const f32x4 av = st.a[J & 1][kk];
            st.r0[4 * kk + 0] -= av.x * s0; st.r0[4 * kk + 1] -= av.y * s0; st.r0[4 * kk + 2] -= av.z * s0; st.r0[4 * kk + 3] -= av.w * s0;
            st.r1[4 * kk + 0] -= av.x * s1; st.r1[4 * kk + 1] -= av.y * s1; st.r1[4 * kk + 2] -= av.z * s1; st.r1[4 * kk + 3] -= av.w * s1; }
        __builtin_amdgcn_sched_barrier(0);
        prep_solve2_step<ISU, J + 1>(st);
    }
}
template <bool ISU> __device__ __forceinline__ void prep_solve2(LAS float* AT, LAS float* TAB, LAS unsigned char* VB, LAS unsigned char* KB, LAS unsigned char* OUTW, unsigned char* ud, int tid) {
    Solve2State st; st.pi = tid & 1; const int c0 = (tid & 127) & ~1;
    const LAS unsigned char* src = (ISU ? VB : KB) + c0 * 2 + st.pi * (4 * PB_ST * 2); const LAS float* sc = TAB + (ISU ? T_SU : T_SW) * 64 + 4 * st.pi;
    st.U = (float*)(ud + GU_U) + c0; st.ow = OUTW + (kpos32(c0 & 31) & 7) * 2; st.cslot = (c0 >> 5) * 4 + (kpos32(c0 & 31) >> 3);
#pragma unroll
    for (int k = 0; k < 32; ++k) { const int rw = 8 * (k >> 2) + (k & 3); const unsigned w_ = *(const LAS unsigned*)(src + rw * (PB_ST * 2)); const float s_ = sc[rw]; st.r0[k] = bf2f(w_ & 0xffffu) * s_; st.r1[k] = bf2f(w_ >> 16) * s_; }
    st.atp = AT + 4 * st.pi;
#pragma unroll
    for (int kk = 0; kk < 8; ++kk) st.a[0][kk] = *(const LAS f32x4*)(st.atp + 8 * kk);
    prep_solve2_step<ISU, 0>(st);
}
#define PB_BAR() do { asm volatile("s_waitcnt lgkmcnt(0)" ::: "memory"); __builtin_amdgcn_s_barrier(); asm volatile("" ::: "memory"); } while (0)
__device__ __forceinline__ void gdn_prep_all(Frame& F, const Ptrs& P, int abl  ) {
    int tid_ = F.tid; asm volatile("" : "+v"(tid_));
    const int tid = tid_, wv = F.wave;
    LAS unsigned char* L = F.lds;
    LAS float* AT = (LAS float*)(L + L_AT); LAS float* TAB = (LAS float*)(L + L_TAB); LAS float* QKR = (LAS float*)(L + L_QKR);
    LAS unsigned char* QB = L + L_QB; LAS unsigned char* KB = L + L_KB; LAS unsigned char* VB = L + L_VB; LAS unsigned char* XR = L + L_XR; LAS unsigned char* OUTW = L + L_QKR;
    const bf16* HIN = P.H;
    const int part = wv >> 1, half = wv & 1;
    f32x2v cwn[4], hxn[3]; float bln = 0.f, aln = 0.f;
#define PB_PREFETCH(U) do { const PrepUnit& u_ = (U); int lane = tid; asm volatile("" : "+v"(lane)); lane &= 63; \
          \
        _Pragma("unroll") for (int k_ = 0; k_ < 6; ++k_) { const int p_ = (6 * wv + k_) * 64 + lane, t_ = p_ >> 4, r_ = (t_ * 171) >> 9, pt_ = t_ - 3 * r_; \
            const int rr_ = (u_.kind == 1 && r_ < 48) ? 48 : r_; \
            __builtin_amdgcn_global_load_lds((const GAS unsigned*)(HIN + (size_t)(u_.row0 + rr_) * DINP + C_CONV + pt_ * 2048 + u_.h * 128 + (p_ & 15) * 8), (LAS unsigned*)(XR + (6 * wv + k_) * 1024), 16, 0, 0); } \
        if (wv < 6) { const int ch_ = part * 2048 + u_.h * 128 + 2 * lane; const float* cw_ = P.in[I_CONVW] + ch_; \
            _Pragma("unroll") for (int j_ = 0; j_ < 4; ++j_) cwn[j_] = *(const GAS f32x2v*)(cw_ + j_ * DCONV); \
            _Pragma("unroll") for (int j_ = 0; j_ < 3; ++j_) hxn[j_] = (f32x2v){0.f, 0.f}; \
            if (half == 0) { \
                if (u_.kind == 0) { const int hr_ = (u_.n == 0) ? ROW_M + 13 : u_.row0 - 3; \
                    _Pragma("unroll") for (int j_ = 0; j_ < 3; ++j_) { const unsigned w_ = *(const GAS unsigned*)(HIN + (size_t)(hr_ + j_) * DINP + C_CONV + ch_); hxn[j_] = (f32x2v){bf2f(w_ & 0xffffu), bf2f(w_ >> 16)}; } } \
                else if (u_.kind == 2) { const float* sc_ = P.in[I_SCONV] + (size_t)u_.b * 3 * DCONV + ch_; \
                    _Pragma("unroll") for (int j_ = 0; j_ < 3; ++j_) hxn[j_] = *(const GAS f32x2v*)(sc_ + j_ * DCONV); } } } \
        else if (wv == 6) { const bf16* hr_ = HIN + (size_t)(u_.row0 + ((u_.kind == 1 && lane < 48) ? 48 : lane)) * DINP; bln = bf2f(hr_[C_B + u_.h]); aln = bf2f(hr_[C_A + u_.h]); } } while (0)
    int uidx = blockIdx.x;
    if (uidx >= N_GUNITS) return;
    PrepUnit un_ = prep_decode(uidx);
    PB_PREFETCH(un_);
    for (; uidx < N_GUNITS; uidx += F.G) {
        const PrepUnit u = prep_decode(uidx);
        unsigned char* ud = P.GDN + (size_t)uidx * GU_BYTES;
        asm volatile("s_waitcnt vmcnt(0) lgkmcnt(0)" ::: "memory"); __builtin_amdgcn_s_barrier(); asm volatile("" ::: "memory");
        f32x2v cw[4], hx[3]; float bl = bln, al = aln;
#pragma unroll
        for (int j = 0; j < 4; ++j) cw[j] = cwn[j];
#pragma unroll
        for (int j = 0; j < 3; ++j) hx[j] = hxn[j];
        asm volatile("" : "+v"(cw[0]), "+v"(cw[1]), "+v"(cw[2]), "+v"(cw[3]), "+v"(hx[0]), "+v"(hx[1]), "+v"(hx[2]), "+v"(bl), "+v"(al));
        { int tl_ = tid; asm volatile("" : "+v"(tl_)); const int lane = tl_ & 63;
        if (wv < 6) {
            const LAS unsigned char* xr = XR + part * 256 + lane * 4; LAS unsigned char* dst = (part == 0 ? QB : (part == 1 ? KB : VB)) + lane * 4;
            const int i0 = 32 * half;
            f32x2v xm3 = hx[0], xm2 = hx[1], xm1 = hx[2];
            if (half == 1) { const unsigned a_ = *(const LAS unsigned*)(xr + 29 * 768), b_ = *(const LAS unsigned*)(xr + 30 * 768), c_ = *(const LAS unsigned*)(xr + 31 * 768);
                xm3 = (f32x2v){bf2f(a_ & 0xffffu), bf2f(a_ >> 16)}; xm2 = (f32x2v){bf2f(b_ & 0xffffu), bf2f(b_ >> 16)}; xm1 = (f32x2v){bf2f(c_ & 0xffffu), bf2f(c_ >> 16)};
                if (u.kind == 1) { xm3 = (f32x2v){0.f, 0.f}; xm2 = xm3; xm1 = xm3; } }
#pragma unroll 8
            for (int ii = 0; ii < 32; ++ii) { const int i = i0 + ii; const unsigned w_ = *(const LAS unsigned*)(xr + i * 768);
                f32x2v x = (f32x2v){bf2f(w_ & 0xffffu), bf2f(w_ >> 16)};
                if (u.kind == 1 && i < 48) x = (f32x2v){0.f, 0.f};
                const f32x2v y = cw[0] * xm3 + cw[1] * xm2 + cw[2] * xm1 + cw[3] * x;
                *(LAS unsigned*)(dst + i * (PB_ST * 2)) = pkbf(silu1(y.x), silu1(y.y)); xm3 = xm2; xm2 = xm1; xm1 = x; }
        } else if (wv == 6) {
            float be = 0.f, g = 0.f;
            if (!(u.kind == 1 && lane < 48)) { be = 1.f / (1.f + expf(-bl)); const float x = al + P.in[I_DTB][u.h]; const float sp = fmaxf(x, 0.f) + log1pf(expf(-fabsf(x))); g = -expf(P.in[I_ALOG][u.h]) * sp; }
            float v = g;
#pragma unroll
            for (int o = 1; o < 64; o <<= 1) { const float t = __shfl_up(v, o); if (lane >= o) v += t; }
            const float last = __shfl(v, 63);
            TAB[T_BETA * 64 + lane] = be; TAB[T_GC * 64 + lane] = v; TAB[T_EG * 64 + lane] = expf(v); TAB[T_EK * 64 + lane] = expf(last - v);
        } }
        PB_BAR();
        if (uidx + F.G < N_GUNITS) { un_ = prep_decode(uidx + F.G); PB_PREFETCH(un_); }
        __builtin_amdgcn_sched_barrier(0);
        if (!(abl & 4)) { int tl_ = tid; asm volatile("" : "+v"(tl_)); const int lane = tl_ & 63, c16 = lane & 15, q4 = lane >> 4;
#pragma unroll
        for (int tk = 0; tk < 3; ++tk) { const int task = wv + 8 * tk;
            int rb, cb; const LAS unsigned char *Ap, *Bp;
            if (task < 20) { const int t10 = task < 10 ? task : task - 10; int a = 0, b = t10;
                if (b >= 1) { a = 1; b -= 1; if (b >= 2) { a = 2; b -= 2; if (b >= 3) { a = 3; b -= 3; } } }
                if (task < 10) { rb = a; cb = b; Ap = KB; Bp = KB; } else { rb = b; cb = a; Ap = KB; Bp = QB; } }
            else { rb = task - 20; cb = rb; Ap = QB; Bp = QB; }
            f32x4 acc = {0.f, 0.f, 0.f, 0.f};
#pragma unroll
            for (int s = 0; s < 4; ++s) { const bf16x8 A = *(const LAS bf16x8*)(Ap + (16 * rb + c16) * (PB_ST * 2) + 64 * s + 16 * q4), B = *(const LAS bf16x8*)(Bp + (16 * cb + c16) * (PB_ST * 2) + 64 * s + 16 * q4);
                acc = __builtin_amdgcn_mfma_f32_16x16x32_bf16(A, B, acc, 0, 0, 0); }
            if (task < 10) { *(LAS f32x4*)(AT + (16 * cb + c16) * 68 + 16 * rb + 4 * q4) = acc;
                if (rb == cb) {
#pragma unroll
                    for (int r = 0; r < 4; ++r) if (c16 == 4 * q4 + r) TAB[T_RK2 * 64 + 16 * rb + c16] = acc[r]; } }
            else if (task < 20) { *(LAS f32x4*)(QKR + (16 * cb + c16) * 68 + 16 * rb + 4 * q4) = acc; }
            else {
#pragma unroll
                for (int r = 0; r < 4; ++r) if (c16 == 4 * q4 + r) TAB[T_RQ2 * 64 + 16 * rb + c16] = acc[r]; }
        } }
        PB_BAR();
        if (!(abl & 4)) { int tid = tid_; asm volatile("" : "+v"(tid));
        { const int j = tid >> 3, i8 = (tid & 7) * 8;
            const float rkj = rsqrtf(TAB[T_RK2 * 64 + j] + RMS_EPS), gcj = TAB[T_GC * 64 + j];
#pragma unroll
            for (int e = 0; e < 8; ++e) { const int i = i8 + e; const float v = AT[j * 68 + i];
                const float sc = TAB[T_BETA * 64 + i] * rsqrtf(TAB[T_RK2 * 64 + i] + RMS_EPS) * rkj * expf(fminf(TAB[T_GC * 64 + i] - gcj, 0.f));
                AT[j * 68 + i] = (i > j) ? v * sc : 0.f; } }
        { const int i = tid >> 3, sl = tid & 7, g = sl >> 2, qq = sl & 3;
            const float rqi = rsqrtf(TAB[T_RQ2 * 64 + i] + RMS_EPS) * 0.08838834764831845f, gci = TAB[T_GC * 64 + i];
            float v[8];
#pragma unroll
            for (int e = 0; e < 8; ++e) { const int j = 32 * g + 4 * qq + (e & 3) + 16 * (e >> 2); const float raw = QKR[i * 68 + j];
                v[e] = (i >= j) ? raw * rqi * rsqrtf(TAB[T_RK2 * 64 + j] + RMS_EPS) * expf(fminf(gci - TAB[T_GC * 64 + j], 0.f)) : 0.f; }
            v4u o; o.x = pkbf(v[0], v[1]); o.y = pkbf(v[2], v[3]); o.z = pkbf(v[4], v[5]); o.w = pkbf(v[6], v[7]);
            *(GAS v4u*)(ud + GU_QK + i * 128 + ((sl ^ ((i >> 1) & 7)) * 16)) = o; }
        if (tid < 64) { const int i = tid; const float rk = rsqrtf(TAB[T_RK2 * 64 + i] + RMS_EPS), rq = rsqrtf(TAB[T_RQ2 * 64 + i] + RMS_EPS) * 0.08838834764831845f, be = TAB[T_BETA * 64 + i], eg = TAB[T_EG * 64 + i];
            TAB[T_SU * 64 + i] = be; TAB[T_SW * 64 + i] = be * eg * rk; TAB[T_SKD * 64 + i] = TAB[T_EK * 64 + i] * rk; TAB[T_SQD * 64 + i] = eg * rq;
            if (i == 63) *(GAS float*)(ud + GU_GL) = eg; } }
        PB_BAR();
        { int tid = tid_; asm volatile("" : "+v"(tid)); const int lane = tid & 63, c16 = lane & 15, q4 = lane >> 4;
        if (tid < 128) { if (!(abl & 1)) prep_solve2<true>(AT, TAB, VB, KB, OUTW, ud, tid); }
        else if (tid < 256) { if (!(abl & 1)) prep_solve2<false>(AT, TAB, VB, KB, OUTW, ud, tid); }
        else if (!(abl & 2)) {
            const int t = tid - 256;
#pragma unroll
            for (int k = 0; k < 4; ++k) { const int id = t + 256 * k, i = id >> 4, sl = id & 15, g = sl >> 2, qq = sl & 3; const float sc = TAB[T_SQD * 64 + i];
                const u32x2v lo = *(const LAS u32x2v*)(QB + i * (PB_ST * 2) + (32 * g + 4 * qq) * 2), hi = *(const LAS u32x2v*)(QB + i * (PB_ST * 2) + (32 * g + 16 + 4 * qq) * 2);
                v4u o; o.x = pkbf(bf2f(lo.x & 0xffffu) * sc, bf2f(lo.x >> 16) * sc); o.y = pkbf(bf2f(lo.y & 0xffffu) * sc, bf2f(lo.y >> 16) * sc);
                o.z = pkbf(bf2f(hi.x & 0xffffu) * sc, bf2f(hi.x >> 16) * sc); o.w = pkbf(bf2f(hi.y & 0xffffu) * sc, bf2f(hi.y >> 16) * sc);
                *(GAS v4u*)(ud + GU_QD + i * 256 + ((sl ^ (i & 15)) * 16)) = o; }
            const int w4 = wv - 4;
#pragma unroll
            for (int k = 0; k < 4; ++k) { const int task = w4 * 4 + k, db = task >> 1, g = task & 1;
                const int addr = (int)(size_t)KB + (32 * g + 4 * q4 + ((lane & 15) >> 2)) * (PB_ST * 2) + (16 * db + 4 * (lane & 3)) * 2;
                const f32x4 s0 = *(const LAS f32x4*)(TAB + T_SKD * 64 + 32 * g + 4 * q4), s1 = *(const LAS f32x4*)(TAB + T_SKD * 64 + 32 * g + 16 + 4 * q4);
                s16x4 lo, hi;
                asm volatile("ds_read_b64_tr_b16 %0, %2\n\tds_read_b64_tr_b16 %1, %2 offset:4352\n\ts_waitcnt lgkmcnt(0)" : "=&v"(lo), "=&v"(hi) : "v"(addr) : "memory");
                v4u o; o.x = pkbf(bf2f((unsigned short)lo[0]) * s0.x, bf2f((unsigned short)lo[1]) * s0.y); o.y = pkbf(bf2f((unsigned short)lo[2]) * s0.z, bf2f((unsigned short)lo[3]) * s0.w);
                o.z = pkbf(bf2f((unsigned short)hi[0]) * s1.x, bf2f((unsigned short)hi[1]) * s1.y); o.w = pkbf(bf2f((unsigned short)hi[2]) * s1.z, bf2f((unsigned short)hi[3]) * s1.w);
                const int d = 16 * db + c16;
                *(GAS v4u*)(ud + GU_KDT + d * 128 + (((4 * g + q4) ^ ((d >> 1) & 7)) * 16)) = o; }
        } }
        PB_BAR();
        if (!(abl & 1)) { int tid = tid_; asm volatile("" : "+v"(tid));
#pragma unroll
        for (int k = 0; k < 2; ++k) { const int o16 = (tid + 512 * k) * 16; *(GAS v4u*)(ud + GU_W + o16) = *(const LAS v4u*)(OUTW + o16); } }
    }
    asm volatile("s_waitcnt vmcnt(0) lgkmcnt(0)" ::: "memory"); __syncthreads();
#undef PB_PREFETCH
}
#undef PB_BAR

typedef float f32x16 __attribute__((ext_vector_type(16)));
#define KSWZ(row, colB) ((row) * 256 + ((colB) ^ (((row) & 7) << 4)))
#define SBAR() __builtin_amdgcn_sched_barrier(0)
__device__ __forceinline__ int crow(int r, int hi) { return (r & 3) + 8 * (r >> 2) + 4 * hi; }
__device__ __forceinline__ unsigned cvtpk(float lo, float hi) { unsigned r; asm volatile("v_cvt_pk_bf16_f32 %0, %1, %2" : "=v"(r) : "v"(lo), "v"(hi)); return r; }
__device__ __forceinline__ void qkt(f32x16& p0, f32x16& p1, const LAS unsigned char* Ks, const bf16x8* qr, int r32, int hi) {
    p0 = f32x16{}; p1 = f32x16{};
#pragma unroll
    for (int d0 = 0; d0 < 8; ++d0) { const int cb = (d0 * 16 + hi * 8) * 2;
        const bf16x8 b0 = *(const LAS bf16x8*)(Ks + KSWZ(r32, cb)), b1 = *(const LAS bf16x8*)(Ks + KSWZ(32 + r32, cb));
        p0 = __builtin_amdgcn_mfma_f32_32x32x16_bf16(b0, qr[d0], p0, 0, 0, 0);
        p1 = __builtin_amdgcn_mfma_f32_32x32x16_bf16(b1, qr[d0], p1, 0, 0, 0); }
}
__device__ __forceinline__ int v_st(int k, int c) { const int kk = (k & ~0xC) | ((k & 4) << 1) | ((k & 8) >> 1); return ((kk >> 3) * 4 + (c >> 5)) * 512 + ((kk & 7) * 32 + (c & 31)) * 2; }
__device__ __forceinline__ int v_rd_base(int lane) { return ((lane & 3) << 3) | (((lane >> 2) & 3) << 6) | (((lane >> 4) & 1) << 5) | (((lane >> 5) & 1) << 8); }
constexpr int v_rd_off(int d0, int ks, int half) { return d0 * 512 + ks * 4096 + half * 2048; }
template <int OFF> __device__ __forceinline__ s16x4 tr_read(int vb) { s16x4 r; asm volatile("ds_read_b64_tr_b16 %0, %1 offset:%2" : "=&v"(r) : "v"(vb), "i"(OFF) : "memory"); return r; }
template <int D0> __device__ __forceinline__ void pv_one(f32x16& od, int vb, bf16x8 pa0, bf16x8 pa1, bf16x8 pa2, bf16x8 pa3) {
    const s16x4 l0 = tr_read<v_rd_off(D0, 0, 0)>(vb), h0 = tr_read<v_rd_off(D0, 0, 1)>(vb), l1 = tr_read<v_rd_off(D0, 1, 0)>(vb), h1 = tr_read<v_rd_off(D0, 1, 1)>(vb);
    const s16x4 l2 = tr_read<v_rd_off(D0, 2, 0)>(vb), h2 = tr_read<v_rd_off(D0, 2, 1)>(vb), l3 = tr_read<v_rd_off(D0, 3, 0)>(vb), h3 = tr_read<v_rd_off(D0, 3, 1)>(vb);
    asm volatile("s_waitcnt lgkmcnt(0)" ::: "memory"); SBAR();
#define PK(L, H) (bf16x8){L[0], L[1], L[2], L[3], H[0], H[1], H[2], H[3]}
    od = __builtin_amdgcn_mfma_f32_32x32x16_bf16(pa0, PK(l0, h0), od, 0, 0, 0);
    od = __builtin_amdgcn_mfma_f32_32x32x16_bf16(pa1, PK(l1, h1), od, 0, 0, 0);
    od = __builtin_amdgcn_mfma_f32_32x32x16_bf16(pa2, PK(l2, h2), od, 0, 0, 0);
    od = __builtin_amdgcn_mfma_f32_32x32x16_bf16(pa3, PK(l3, h3), od, 0, 0, 0);
#undef PK
}
constexpr int ATT_V = 0, ATT_K = 16384, ATT_WS = 32768;
__device__ __forceinline__ void attn_unit(Frame& F, const Ptrs& P, int a) {
    constexpr float SCALE = 0.088388347648318440f, C = SCALE * 1.4426950408889634f;
    int tid_ = F.tid; asm volatile("" : "+v"(tid_));
    const int tid = tid_, wid = F.wave, lane = tid & 63, r32 = lane & 31, hi = lane >> 5;
    const bool isp = a < 512; const int kvh = a & 3, ab = isp ? (a >> 7) : ((a - 512) >> 2), ac = isp ? ((a >> 2) & 31) : 0;
    const int qrow0 = isp ? ab * SEQ_P + 64 * ac : ROW_S + ab * SEQ_S, pos0 = isp ? NMETA + 64 * ac : NMETA + PAST;
    LAS unsigned char* V_lds = F.lds + ATT_V; LAS unsigned char* K_lds = F.lds + ATT_K;
    LAS float* ws = (LAS float*)(F.lds + ATT_WS) + wid * 64; LAS float* li_l = ws; LAS float* al_l = ws + 32;
    const int g = wid >> 1, qoff = 32 * (wid & 1), hq = kvh * 4 + g;
    bf16x8 qr[8];
    { const bf16* qp = P.H + (size_t)(qrow0 + qoff + r32) * DINP + C_Q + hq * HD + hi * 8; const GAS f32x2v* cs = (const GAS f32x2v*)P.ROPE + (size_t)(pos0 + qoff + r32) * 64 + hi * 8;
#pragma unroll
        for (int d0 = 0; d0 < 4; ++d0) { const v4u lo = *(const GAS v4u*)(qp + d0 * 16), hh = *(const GAS v4u*)(qp + 64 + d0 * 16);
            const unsigned lw[4] = {lo.x, lo.y, lo.z, lo.w}, hw[4] = {hh.x, hh.y, hh.z, hh.w}; unsigned o1[4], o2[4];
#pragma unroll
            for (int j = 0; j < 4; ++j) { const f32x2v c0 = cs[d0 * 16 + 2 * j], c1 = cs[d0 * 16 + 2 * j + 1];
                const float a0 = bf2f(lw[j] & 0xffffu), a1 = bf2f(lw[j] >> 16), b0 = bf2f(hw[j] & 0xffffu), b1 = bf2f(hw[j] >> 16);
                o1[j] = cvtpk(a0 * c0.x - b0 * c0.y, a1 * c1.x - b1 * c1.y); o2[j] = cvtpk(b0 * c0.x + a0 * c0.y, b1 * c1.x + a1 * c1.y); }
            const v4u w1 = {o1[0], o1[1], o1[2], o1[3]}, w2 = {o2[0], o2[1], o2[2], o2[3]};
            qr[d0] = __builtin_bit_cast(bf16x8, w1); qr[d0 + 4] = __builtin_bit_cast(bf16x8, w2); } }
    float m_reg = -1e30f, l_reg = 0.f; f32x16 o[4] = {};
    const int sr = tid >> 4, sc = (tid & 15) * 8, vst0 = v_st(sr, sc), vst1 = v_st(32 + sr, sc);
    const int vb0 = (int)(size_t)V_lds + v_rd_base(lane);
    const int tmin = isp ? (ac >= 2 ? 1 : 3 - ac) : 1;
#define ATT_KROW(t) ((t) == 0 ? (isp ? ROW_M : KVR_SMETA + ab * NMETA) : (isp ? ab * SEQ_P + 64 * (ac - 3 + (t)) : ((t) == 3 ? ROW_S + ab * SEQ_S : KVR_SWIN + ab * WIN + 64 * ((t) - 1))))
#define ATT_LOAD(t) do { const int ra_ = ((t) == 0) ? (sr & 15) : sr, rb_ = ((t) == 0) ? (sr & 15) : 32 + sr;     \
        const bf16* kp_ = P.KB + (size_t)ATT_KROW(t) * KVW + kvh * HD + sc; const bf16* vp_ = P.VB + (size_t)ATT_KROW(t) * KVW + kvh * HD + sc; \
        nk0 = *(const GAS v4u*)(kp_ + (size_t)ra_ * KVW); nk1 = *(const GAS v4u*)(kp_ + (size_t)rb_ * KVW); nv0 = *(const GAS v4u*)(vp_ + (size_t)ra_ * KVW); nv1 = *(const GAS v4u*)(vp_ + (size_t)rb_ * KVW); } while (0)
    v4u nk0, nk1, nv0, nv1; ATT_LOAD(0);
#pragma unroll
    for (int t = 0; t < 4; ++t) {
        const bool kval_t = (t == 0) || (t >= tmin);
        if (kval_t) {
        const v4u k0 = nk0, k1 = nk1, v0 = nv0, v1 = nv1;
        __syncthreads();
        *(LAS v4u*)(V_lds + vst0) = v0; *(LAS v4u*)(V_lds + vst1) = v1; *(LAS v4u*)(K_lds + KSWZ(sr, sc * 2)) = k0; *(LAS v4u*)(K_lds + KSWZ(32 + sr, sc * 2)) = k1;
        __syncthreads();
        { const int nt_ = (t == 0) ? tmin : t + 1; if (nt_ <= 3) { if (nt_ == 1) ATT_LOAD(1); else if (nt_ == 2) ATT_LOAD(2); else ATT_LOAD(3); } }
        f32x16 p0, p1; qkt(p0, p1, K_lds, qr, r32, hi);
        if (t == 0) {
#pragma unroll
            for (int r = 8; r < 16; ++r) p0[r] = -INFINITY;
#pragma unroll
            for (int r = 0; r < 16; ++r) p1[r] = -INFINITY; }
        float pmax = p0[0];
#pragma unroll
        for (int r = 1; r < 16; ++r) pmax = fmaxf(pmax, p0[r]);
#pragma unroll
        for (int r = 0; r < 16; ++r) pmax = fmaxf(pmax, p1[r]);
        { auto rr = __builtin_amdgcn_permlane32_swap(__float_as_uint(pmax), __float_as_uint(pmax), false, false); pmax = fmaxf(__uint_as_float(rr[0]), __uint_as_float(rr[1])); }
        const float mn = fmaxf(m_reg, pmax), alpha = __builtin_amdgcn_exp2f((m_reg - mn) * C), mnC = -mn * C; m_reg = mn;
        float ps = 0.f;
#pragma unroll
        for (int r = 0; r < 16; ++r) { p0[r] = __builtin_amdgcn_exp2f(fmaf(p0[r], C, mnC)); p1[r] = __builtin_amdgcn_exp2f(fmaf(p1[r], C, mnC)); ps += p0[r] + p1[r]; }
        { auto rr = __builtin_amdgcn_permlane32_swap(__float_as_uint(ps), __float_as_uint(ps), false, false); ps = __uint_as_float(rr[0]) + __uint_as_float(rr[1]); }
        l_reg = l_reg * alpha + ps;
        if (hi == 0) al_l[r32] = alpha;
        asm volatile("s_waitcnt lgkmcnt(0)" ::: "memory");
#pragma unroll
        for (int d = 0; d < 4; ++d)
#pragma unroll
            for (int r = 0; r < 16; ++r) o[d][r] *= al_l[crow(r, hi)];
        bf16x8 pa0, pa1, pa2, pa3;
#define PK4(Pv, BASE, OUT) do { unsigned a0 = cvtpk(Pv[BASE + 0], Pv[BASE + 1]), a1 = cvtpk(Pv[BASE + 2], Pv[BASE + 3]);   \
    unsigned b0 = cvtpk(Pv[BASE + 4], Pv[BASE + 5]), b1 = cvtpk(Pv[BASE + 6], Pv[BASE + 7]);                              \
    auto r0 = __builtin_amdgcn_permlane32_swap(a0, b0, false, false); auto r1 = __builtin_amdgcn_permlane32_swap(a1, b1, false, false); \
    v4u w = {r0[0], r1[0], r0[1], r1[1]}; OUT = __builtin_bit_cast(bf16x8, w); } while (0)
        PK4(p0, 0, pa0); PK4(p0, 8, pa1); PK4(p1, 0, pa2); PK4(p1, 8, pa3);
#undef PK4
        SBAR();
        pv_one<0>(o[0], vb0, pa0, pa1, pa2, pa3); pv_one<1>(o[1], vb0, pa0, pa1, pa2, pa3); pv_one<2>(o[2], vb0, pa0, pa1, pa2, pa3); pv_one<3>(o[3], vb0, pa0, pa1, pa2, pa3);
        }
    }
#undef ATT_KROW
#undef ATT_LOAD
    l_reg += __builtin_amdgcn_exp2f(P.in[I_SINK][hq] * 1.4426950408889634f - m_reg * C);
    if (hi == 0) li_l[r32] = l_reg;
    asm volatile("s_waitcnt lgkmcnt(0)" ::: "memory");
    bf16* Ow = P.MIX + (size_t)(qrow0 + qoff) * D + hq * HD;
#pragma unroll
    for (int r = 0; r < 16; ++r) { const int orow = crow(r, hi); const float rl = __builtin_amdgcn_rcpf(li_l[orow]);
#pragma unroll
        for (int d0 = 0; d0 < 4; ++d0) Ow[(size_t)orow * D + d0 * 32 + r32] = (bf16)f2bf(o[d0][r] * rl); }
    __syncthreads();
}

typedef const GAS unsigned char* gcp;
template <class T> __device__ __forceinline__ T ldg_u(gcp ubase, unsigned voff) { return *(const GAS T*)(ubase + voff); }
constexpr int SC_ABUF = 57344, SC_SSQ_OFF = 2 * SC_ABUF;
template <int MODE  > __device__ __forceinline__ void gdn_scan_seq(Frame& F, const Ptrs& P, int kind  , int b, int h) {
    int lane_ = F.lane; asm volatile("" : "+v"(lane_));
    const int w = F.wave, lane = lane_, c16 = lane & 15, q4 = lane >> 4;
    LAS float* SSQ = (LAS float*)(F.lds + SC_SSQ_OFF);
    const unsigned ecol = (unsigned)(16 * w + c16);
    const unsigned voU = (unsigned)(q4 * 2048) + ecol * 4u;
    const unsigned voZ = (unsigned)(q4 * 4 * DINP * 2) + ecol * 2u;
    const unsigned voM = (unsigned)(q4 * 4 * D * 2) + ecol * 2u;
    unsigned fo256[4], fo128[2];
#pragma unroll
    for (int s = 0; s < 4; ++s) fo256[s] = (unsigned)(c16 * 256 + (((4 * s + q4) ^ c16) * 16));
#pragma unroll
    for (int s = 0; s < 2; ++s) fo128[s] = (unsigned)(c16 * 128 + (((4 * s + q4) ^ ((c16 >> 1) & 7)) * 16));
    const unsigned dma_lane = (unsigned)(w * 7168 + lane * 16);
    f32x4 S[8];
    if (kind == 2) { gcp s0 = (gcp)(P.in[I_SGDN] + (size_t)(b * NHG + h) * 128 * 128);
#pragma unroll
        for (int db = 0; db < 8; ++db)
#pragma unroll
            for (int r = 0; r < 4; ++r) S[db][r] = ldg_u<float>(s0 + db * 8192, voU + r * 512); }
    else {
#pragma unroll
        for (int db = 0; db < 8; ++db) S[db] = (f32x4){0.f, 0.f, 0.f, 0.f}; }
    const int nsteps = kind == 0 ? 33 : 1;
    const float nw = P.in[I_NORMW][ecol];
    const int seq = b * NHG + h;
#define SC_UD(t) ((gcp)(P.GDN + (size_t)(kind == 2 ? 2064 + seq : ((t) == 0 ? 2048 + h : seq * 32 + (t) - 1)) * GU_BYTES))
#define SC_ROW0(t) (kind == 0 ? b * SEQ_P + 64 * ((t) - 1) : ROW_S + b * SEQ_S)
#define SC_DMA(ud, buf) do { _Pragma("unroll") for (int _i = 0; _i < 7; ++_i) \
        __builtin_amdgcn_global_load_lds((const GAS unsigned*)((ud) + GU_W + dma_lane + _i * 1024), (LAS unsigned*)(F.lds + (buf) * SC_ABUF + w * 7168 + _i * 1024), 16, 0, 0); } while (0)
    float un[4][4], gln; unsigned zn[4][4];
#define SC_PREFETCH(udp) do { gln = *(const GAS float*)((udp) + GU_GL); \
        _Pragma("unroll") for (int m = 0; m < 4; ++m) _Pragma("unroll") for (int r = 0; r < 4; ++r) un[m][r] = ldg_u<float>((udp) + GU_U + m * 8192, voU + r * 512); } while (0)
#define SC_LD256(dst, off, m0) do { _Pragma("unroll") for (int mm = 0; mm < 2; ++mm) _Pragma("unroll") for (int s = 0; s < 4; ++s) dst[mm * 4 + s] = *(const LAS bf16x8*)(img + (off) + ((m0) + mm) * 4096 + fo256[s]); } while (0)
#define SC_LD128(dst, off, r0) do { _Pragma("unroll") for (int rr = 0; rr < 4; ++rr) _Pragma("unroll") for (int s = 0; s < 2; ++s) dst[rr * 2 + s] = *(const LAS bf16x8*)(img + (off) + ((r0) + rr) * 2048 + fo128[s]); } while (0)
#define SC_SCHED __builtin_amdgcn_sched_barrier(0)
#define SC_EPI(t, ov, zv) do { const LAS float* sq_ = SSQ + ((t) & 1) * 512; GAS unsigned char* mb_ = (GAS unsigned char*)((MODE == 0 ? P.MIX : P.XN) + (size_t)SC_ROW0(t) * D + 2048 + h * 128); \
        _Pragma("unroll") for (int m = 0; m < 4; ++m) _Pragma("unroll") for (int r = 0; r < 4; ++r) { const int i_ = 16 * m + 4 * q4 + r; \
            const f32x4 t0_ = *(const LAS f32x4*)(sq_ + i_ * 8), t1_ = *(const LAS f32x4*)(sq_ + i_ * 8 + 4); const float tot_ = ((t0_.x + t0_.y) + (t0_.z + t0_.w)) + ((t1_.x + t1_.y) + (t1_.z + t1_.w)); \
            const float rstd_ = rsqrtf(tot_ * (1.f / 128.f) + RMS_EPS); \
            *(GAS unsigned short*)(mb_ + (16 * m + r) * (D * 2) + voM) = (unsigned short)f2bf(ov[m][r] * rstd_ * nw * silu1(bf2f(zv[m][r]))); } } while (0)
    { gcp ud0 = SC_UD(0); if (MODE != 1) { SC_DMA(ud0, 0); } SC_PREFETCH(ud0); }
#pragma unroll
    for (int m = 0; m < 4; ++m)
#pragma unroll
        for (int r = 0; r < 4; ++r) zn[m][r] = 0u;
    f32x4 op[4]; unsigned zp[4][4];
#pragma unroll
    for (int m = 0; m < 4; ++m) { op[m] = (f32x4){0.f, 0.f, 0.f, 0.f};
#pragma unroll
        for (int r = 0; r < 4; ++r) zp[m][r] = 0u; }
    for (int step = 0; step < nsteps; ++step) {
        const bool has_out = !(kind == 0 && step == 0), prev_out = step > 0 && !(kind == 0 && step == 1);
        asm volatile("s_waitcnt vmcnt(0) lgkmcnt(0)" ::: "memory"); __builtin_amdgcn_s_barrier(); asm volatile("" ::: "memory");
        float uc[4][4], gl = gln;
#pragma unroll
        for (int m = 0; m < 4; ++m) {
#pragma unroll
            for (int r = 0; r < 4; ++r) { uc[m][r] = un[m][r]; zp[m][r] = zn[m][r]; }
            asm volatile("" : "+v"(uc[m][0]), "+v"(uc[m][1]), "+v"(uc[m][2]), "+v"(uc[m][3]), "+v"(zp[m][0]), "+v"(zp[m][1]), "+v"(zp[m][2]), "+v"(zp[m][3])); }
        asm volatile("" : "+v"(gl));
        SC_SCHED;
        if (has_out && MODE != 1) { gcp zb_ = (gcp)(P.H + (size_t)SC_ROW0(step) * DINP + C_Z + h * 128);
#pragma unroll
            for (int m = 0; m < 4; ++m)
#pragma unroll
                for (int r = 0; r < 4; ++r) zn[m][r] = ldg_u<unsigned short>(zb_ + (16 * m + r) * (DINP * 2), voZ); }
        if (step + 1 < nsteps && MODE != 1) { gcp udn = SC_UD(step + 1); SC_DMA(udn, (step + 1) & 1); SC_PREFETCH(udn); }
        SC_SCHED;
        if (prev_out) SC_EPI(step - 1, op, zp);
        SC_SCHED;
        if (MODE != 2) {
        const LAS unsigned char* img = F.lds + (step & 1) * SC_ABUF;
        bf16x8 X[8], Y[8];
        SC_LD256(X, GU_W - GU_W, 0); SC_LD256(Y, GU_W - GU_W, 2); SC_SCHED;
        bf16x8 Bs[4];
#pragma unroll
        for (int s = 0; s < 4; ++s) { const v4u t = {pkbf(S[2 * s][0], S[2 * s][1]), pkbf(S[2 * s][2], S[2 * s][3]), pkbf(S[2 * s + 1][0], S[2 * s + 1][1]), pkbf(S[2 * s + 1][2], S[2 * s + 1][3])}; Bs[s] = __builtin_bit_cast(bf16x8, t); }
        f32x4 vn[4], o[4];
#pragma unroll
        for (int mm = 0; mm < 2; ++mm) { f32x4 acc = {0.f, 0.f, 0.f, 0.f};
#pragma unroll
            for (int s = 0; s < 4; ++s) acc = __builtin_amdgcn_mfma_f32_16x16x32_bf16(X[mm * 4 + s], Bs[s], acc, 0, 0, 0);
#pragma unroll
            for (int r = 0; r < 4; ++r) vn[mm][r] = uc[mm][r] - acc[r]; }
        SC_SCHED; SC_LD256(X, GU_QD - GU_W, 0); SC_SCHED;
#pragma unroll
        for (int mm = 0; mm < 2; ++mm) { f32x4 acc = {0.f, 0.f, 0.f, 0.f};
#pragma unroll
            for (int s = 0; s < 4; ++s) acc = __builtin_amdgcn_mfma_f32_16x16x32_bf16(Y[mm * 4 + s], Bs[s], acc, 0, 0, 0);
#pragma unroll
            for (int r = 0; r < 4; ++r) vn[2 + mm][r] = uc[2 + mm][r] - acc[r]; }
        SC_SCHED; SC_LD256(Y, GU_QD - GU_W, 2); SC_SCHED;
        bf16x8 Bv[2];
#pragma unroll
        for (int s = 0; s < 2; ++s) { const v4u t = {pkbf(vn[2 * s][0], vn[2 * s][1]), pkbf(vn[2 * s][2], vn[2 * s][3]), pkbf(vn[2 * s + 1][0], vn[2 * s + 1][1]), pkbf(vn[2 * s + 1][2], vn[2 * s + 1][3])}; Bv[s] = __builtin_bit_cast(bf16x8, t); }
#pragma unroll
        for (int mm = 0; mm < 2; ++mm) { f32x4 acc = {0.f, 0.f, 0.f, 0.f};
#pragma unroll
            for (int s = 0; s < 4; ++s) acc = __builtin_amdgcn_mfma_f32_16x16x32_bf16(X[mm * 4 + s], Bs[s], acc, 0, 0, 0);
            o[mm] = acc; }
        SC_SCHED; SC_LD128(X, GU_KDT - GU_W, 0); SC_SCHED;
#pragma unroll
        for (int mm = 0; mm < 2; ++mm) { f32x4 acc = {0.f, 0.f, 0.f, 0.f};
#pragma unroll
            for (int s = 0; s < 4; ++s) acc = __builtin_amdgcn_mfma_f32_16x16x32_bf16(Y[mm * 4 + s], Bs[s], acc, 0, 0, 0);
            o[2 + mm] = acc; }
        SC_SCHED; SC_LD128(Y, GU_KDT - GU_W, 4); SC_SCHED;
#pragma unroll
        for (int rr = 0; rr < 4; ++rr) { f32x4 acc = S[rr] * gl;
#pragma unroll
            for (int s = 0; s < 2; ++s) acc = __builtin_amdgcn_mfma_f32_16x16x32_bf16(X[rr * 2 + s], Bv[s], acc, 0, 0, 0);
            S[rr] = acc; }
        SC_SCHED; SC_LD128(X, GU_QK - GU_W, 0); SC_SCHED;
#pragma unroll
        for (int rr = 0; rr < 4; ++rr) { f32x4 acc = S[4 + rr] * gl;
#pragma unroll
            for (int s = 0; s < 2; ++s) acc = __builtin_amdgcn_mfma_f32_16x16x32_bf16(Y[rr * 2 + s], Bv[s], acc, 0, 0, 0);
            S[4 + rr] = acc; }
        SC_SCHED;
#pragma unroll
        for (int m = 0; m < 4; ++m)
#pragma unroll
            for (int s = 0; s < 2; ++s) o[m] = __builtin_amdgcn_mfma_f32_16x16x32_bf16(X[m * 2 + s], Bv[s], o[m], 0, 0, 0);
        if (has_out) { LAS float* sq = SSQ + (step & 1) * 512;
#pragma unroll
            for (int m = 0; m < 4; ++m)
#pragma unroll
                for (int r = 0; r < 4; ++r) { float p = o[m][r] * o[m][r];
                    p += __builtin_bit_cast(float, __builtin_amdgcn_update_dpp(0, __builtin_bit_cast(int, p), 0xB1, 0xF, 0xF, true));
                    p += __builtin_bit_cast(float, __builtin_amdgcn_update_dpp(0, __builtin_bit_cast(int, p), 0x4E, 0xF, 0xF, true));
                    p += __builtin_bit_cast(float, __builtin_amdgcn_update_dpp(0, __builtin_bit_cast(int, p), 0x141, 0xF, 0xF, true));
                    p += __builtin_bit_cast(float, __builtin_amdgcn_update_dpp(0, __builtin_bit_cast(int, p), 0x140, 0xF, 0xF, true));
                    if (c16 == 0) sq[(16 * m + 4 * q4 + r) * 8 + w] = p; op[m][r] = o[m][r]; } }
            }
    }
    asm volatile("s_waitcnt vmcnt(0) lgkmcnt(0)" ::: "memory"); __builtin_amdgcn_s_barrier(); asm volatile("" ::: "memory");
    { const int t = nsteps - 1;
#pragma unroll
      for (int m = 0; m < 4; ++m) {
#pragma unroll
        for (int r = 0; r < 4; ++r) zp[m][r] = zn[m][r]; }
      if (!(kind == 0 && t == 0)) SC_EPI(t, op, zp); }
#undef SC_PREFETCH
#undef SC_LD256
#undef SC_LD128
#undef SC_SCHED
#undef SC_EPI
#undef SC_UD
#undef SC_ROW0
#undef SC_DMA
    GAS unsigned char* dst = (GAS unsigned char*)((MODE != 0 ? (float*)(P.GDN + (size_t)N_GUNITS * GU_BYTES) : (kind == 0 ? P.out + O_PGDN : P.out + O_SGDN)) + (size_t)(b * NHG + h) * 128 * 128);
#pragma unroll
    for (int db = 0; db < 8; ++db)
#pragma unroll
        for (int r = 0; r < 4; ++r) *(GAS float*)(dst + db * 8192 + (voU + r * 512)) = S[db][r];
    asm volatile("s_waitcnt vmcnt(0) lgkmcnt(0)" ::: "memory"); __syncthreads();
}

#ifndef SPLIT_P1
#define SPLIT_P1 2
#endif
#ifndef SPLIT_P9
#define SPLIT_P9 8
#endif
#ifndef SPLIT_P2
#define SPLIT_P2 3
#endif
#ifndef SPLIT_P7
#define SPLIT_P7 4
#endif
#ifndef SPLIT_P10
#define SPLIT_P10 4
#endif
struct Args { const float* in[N_IN]; float* out; unsigned char* ws; int ph_lo, ph_hi, li, pad; };
static_assert(sizeof(Args) == (N_IN + 2) * 8 + 16, "Args has no padding");
__global__ void __launch_bounds__(NWAVES * 64, 2) fwd_kernel(Args args) {
    extern __shared__ __attribute__((aligned(16))) unsigned char lds[];
    Frame F;
    F.lds = (LAS unsigned char*)lds;
    F.MISC = (volatile LAS unsigned*)(F.lds + MISC_OFF);
    F.tid = threadIdx.x; F.lane = F.tid & 63; F.wave = __builtin_amdgcn_readfirstlane(F.tid >> 6);
    F.G = gridDim.x; { const int bx = blockIdx.x; F.vcu = (F.G % 8 == 0) ? (bx % 8) * (F.G / 8) + bx / 8 : bx; }
    unsigned char* ws = args.ws;
    F.ctl = (gu32*)(ws + WS_CTL);
    Ptrs P;
#pragma unroll
    for (int i = 0; i < N_IN; ++i) P.in[i] = args.in[i];
    P.out = args.out;
    P.Wgu1 = (bf16*)(ws + WS_WGU1); P.Wd1 = (bf16*)(ws + WS_WD1); P.Wgu2 = (bf16*)(ws + WS_WGU2); P.Wd2 = (bf16*)(ws + WS_WD2); P.Win = (bf16*)(ws + WS_WIN); P.Wout = (bf16*)(ws + WS_WOUT);
    P.XN = (bf16*)(ws + WS_XN); P.MIX = (bf16*)(ws + WS_MIX); P.H = (bf16*)(ws + WS_H); P.KB = (bf16*)(ws + WS_KB); P.VB = (bf16*)(ws + WS_VB);
    P.Y = (float*)(ws + WS_Y); P.ROPE = (float*)(ws + WS_ROPE); P.GDN = ws + WS_GDN; P.SLAB = (float*)(ws + WS_SLAB); P.XQ = (signed char*)(ws + WS_XQ); P.SA = (float*)(ws + WS_SA); P.SB1 = (float*)(ws + WS_SB); P.SB2 = (float*)(ws + WS_SB + AL((size_t)NGU * 4)); P.CMAX = (unsigned*)(ws + WS_CTL) + CW_CMAX; P.HQ = (signed char*)(ws + WS_HQ); P.SH = (float*)(ws + WS_SH); P.SBD1 = (float*)(ws + WS_SBD); P.SBD2 = (float*)(ws + WS_SBD + AL((size_t)D * 4)); P.CMAXD = (unsigned*)(ws + WS_CTL) + CW_CMAXD; P.RMAX = (unsigned*)(ws + WS_CTL) + CW_RMAX;
    for (int u = F.tid; u < (LDS_BYTES - LDSCTL_OFF) / 4; u += NWAVES * 64) ((LAS unsigned*)(F.lds + LDSCTL_OFF))[u] = 0u;
    __syncthreads();
    XcdBarrier bar; bar.bar = (unsigned*)(F.ctl + CW_BAR) + args.li * XCD_BAR_WORDS; bar.x = 0; bar.st = nullptr;
    if (N_LAUNCHES == 1) bar = xcd_barrier_post((unsigned*)(F.ctl + CW_BAR) + args.li * XCD_BAR_WORDS, F.MISC + 8);
#define GRID_BAR() do { if (N_LAUNCHES == 1) xcd_barrier(bar); } while (0)
    const int lo = args.ph_lo, hi = args.ph_hi;
#define IN(k) (lo <= (k) && (k) < hi)
#define BOTH(k) (IN(k) && IN((k) + 1))

#ifndef PROBE_REPEAT
#define PROBE_REPEAT 0
#endif
#define REP(k) (((PROBE_REPEAT >> (k)) & 1) ? 2 : 1)
    if (IN(0)) { p0_prologue(F, P); GRID_BAR(); p0_quant_wgu1(F, P); if (BOTH(0)) GRID_BAR(); }
    if (IN(1)) { pg8::Gemm g{(const pg8::bf16_t*)P.XQ, (const pg8::bf16_t*)P.Wgu1, M1, NGU, D / 2}; pg8::StaticOrder S; S.init(M1, NGU, D / 2, F.G, (int)blockIdx.x);
        pg8::EpiSwiGLU<true> E{P.H, FF, P.SLAB, 1, P.SA, P.SB1, nullptr};
        pg8::gemm_phase<pg8::EpiSwiGLU<true>, pg8::StaticOrder, true, true, true>(F.lds + RING_OFF, g, S, E);
        PHASE_DONE(1); q_fill(F, P, 1); q_catch_up(F, P, Q_E1);
        GRID_BAR(); quant_h(F, P.H, P.HQ, P.RMAX, P.SH, M1V);
        if (BOTH(1)) GRID_BAR(); }
    if (IN(2)) { pg8::Gemm g{(const pg8::bf16_t*)P.HQ, (const pg8::bf16_t*)P.Wd1, M1, D, FF / 2}; pg8::SplitOrder S; S.init(M1, D, FF / 2, F.G, (int)blockIdx.x, SPLIT_P2);
        typedef pg8::EpiResF32<0, true, false, true, true> Epi; Epi E{P.Y, D, pg8::RowSrc<0>{P.in[I_XP], P.in[I_XS], P.in[I_META], ROW_S, ROW_M, M1V, D}, P.SLAB, SPLIT_P2, P.SH, P.SBD1};
        pg8::gemm_phase<Epi, pg8::SplitOrder, true, true, true>(F.lds + RING_OFF, g, S, E);
        PHASE_DONE(2); q_fill(F, P, 2); q_catch_up(F, P, Q_E2);
        if (BOTH(2)) GRID_BAR(); }
    if (IN(3)) { pg8::SplitOrder SO; SO.init(M1, D, FF / 2, F.G, 0, SPLIT_P2); ln_phase(F, (const bf16*)P.Y, nullptr, P.XN, P.in[I_LNG], P.in[I_LNB], M1V, SO, P.SLAB, 0.5f, nullptr, nullptr); q_catch_up(F, P, Q_E2); if (BOTH(3)) GRID_BAR(); }
    if (IN(4)) { pg8::Gemm g{P.XN, P.Win, M1, DINP, D}; pg8::StaticOrder S; S.init(M1, DINP, D, F.G, (int)blockIdx.x);
        pg8::EpiStoreBf16 E{P.H, DINP};
        pg8::gemm_phase<pg8::EpiStoreBf16, pg8::StaticOrder, true, true>(F.lds + RING_OFF, g, S, E);
        PHASE_DONE(4); q_fill(F, P, 4);
        if (BOTH(4)) GRID_BAR(); }
#ifndef PROBE_ABL5
#define PROBE_ABL5 0
#endif
    if (IN(5)) { for (int rep = 0; rep < REP(5); ++rep) { const int abl = (args.li == 1) ? PROBE_ABL5 : 0;
        if (!(abl & 8)) kv_prep(F, P);
        gdn_prep_all(F, P, abl);
        q_catch_up(F, P, Q_E3);
        if (BOTH(5)) GRID_BAR(); } }
    if (IN(6)) {
        int it = blockIdx.x, st = (it < 64) ? (1 << 20) : F.G - 64;
        for (; it < 896; it += st) {
            if (it < 320) { const int s = it < 64 ? it : it - 64; gdn_scan_seq<0>(F, P, it < 64 ? 0 : 2, s >> 4, s & 15); }
            else attn_unit(F, P, it - 320);
        }
        if ((int)blockIdx.x >= 64) {
            sub_barrier(F, F.ctl + CW_SUB, (unsigned)(F.G - 64));
            pg8::Gemm g{P.MIX, P.Wout, M2, D, D}; pg8::StaticOrder S; S.init(M2, D, D, F.G - 64, (int)blockIdx.x - 64); S.set_k(0, 32);
            typedef pg8::EpiResF32<1, false, false, false, true> Epi; Epi E{P.Y, D, pg8::RowSrc<1>{(const float*)P.XN, (const float*)P.XN, (const float*)P.XN, M2, M2, M2, D}, P.SLAB, 1, nullptr, nullptr};
            pg8::gemm_phase<Epi, pg8::StaticOrder, true, true>(F.lds + RING_OFF, g, S, E);
        }
        PHASE_DONE(6); q_fill(F, P, 6);
        if (BOTH(6)) GRID_BAR(); }
    if (IN(7)) {
        pg8::Gemm g{P.MIX, P.Wout, M2, D, D}; pg8::SplitOrder S; S.init(M2, D, D, F.G, (int)blockIdx.x, SPLIT_P7); S.set_k(32, 32);
        typedef pg8::EpiResF32<1, false, true, false, true> Epi; Epi E{P.Y, D, pg8::RowSrc<1>{P.Y, P.Y, P.Y, M2, M2, M2, D}, P.SLAB, SPLIT_P7, nullptr, nullptr};
        pg8::gemm_phase<Epi, pg8::SplitOrder, true, true>(F.lds + RING_OFF, g, S, E);
        PHASE_DONE(7); q_fill(F, P, 7);
        if (BOTH(7)) GRID_BAR(); }
    if (IN(8)) { pg8::SplitOrder SO; SO.init(M2, D, D, F.G, 0, SPLIT_P7); ln_phase(F, (const bf16*)P.Y, nullptr, P.XN, P.in[I_LNG] + D, P.in[I_LNB] + D, M2, SO, P.SLAB, 1.0f, P.XQ, P.SA); q_catch_up(F, P, Q_E4); if (BOTH(8)) GRID_BAR(); }
    if (IN(9)) { pg8::Gemm g{(const pg8::bf16_t*)P.XQ, (const pg8::bf16_t*)P.Wgu2, M2, NGU, D / 2}; pg8::StaticOrder S; S.init(M2, NGU, D / 2, F.G, (int)blockIdx.x);
        pg8::EpiSwiGLU<true> E{P.H, FF, P.SLAB, 1, P.SA, P.SB2, nullptr};
        pg8::gemm_phase<pg8::EpiSwiGLU<true>, pg8::StaticOrder, true, true, true>(F.lds + RING_OFF, g, S, E);
        PHASE_DONE(9); q_fill(F, P, 9); q_catch_up(F, P, Q_E5);
        GRID_BAR(); quant_h(F, P.H, P.HQ, P.RMAX + M1, P.SH, M2);
        if (BOTH(9)) GRID_BAR(); }
    if (IN(10)) { pg8::Gemm g{(const pg8::bf16_t*)P.HQ, (const pg8::bf16_t*)P.Wd2, M2, D, FF / 2}; pg8::SplitOrder S; S.init(M2, D, FF / 2, F.G, (int)blockIdx.x, SPLIT_P10);
        typedef pg8::EpiResF32<1, true, false, true, true> Epi; Epi E{P.Y, D, pg8::RowSrc<1>{(const float*)P.XN, (const float*)P.XN, (const float*)P.XN, M2, M2, M2, D}, P.SLAB, SPLIT_P10, P.SH, P.SBD2};
        pg8::gemm_phase<Epi, pg8::SplitOrder, true, true, true>(F.lds + RING_OFF, g, S, E);
        if (BOTH(10)) GRID_BAR(); }
    if (IN(11)) { for (int rep = 0; rep < REP(11); ++rep) { pg8::SplitOrder SO; SO.init(M2, D, FF / 2, F.G, 0, SPLIT_P10); ln_phase(F, (const bf16*)P.Y, P.out + O_YP, nullptr, P.in[I_LNG] + 2 * D, P.in[I_LNB] + 2 * D, M2, SO, P.SLAB, 0.5f, nullptr, nullptr); if (rep + 1 < REP(11)) GRID_BAR(); } }
#undef IN
#undef BOTH
#undef GRID_BAR
}

extern "C" void kernel_launch(void* const* d_in, const int* in_sizes, int n_in, void* d_out, int out_size, void* d_ws, size_t ws_size, hipStream_t stream) {
    static int grid = 0;
    if (grid == 0) {
        if (n_in != N_IN || in_sizes[I_XP] != ROW_S * D || in_sizes[I_WIN] != D * DIN || (size_t)out_size != O_END || ws_size < WS_END) {
            fprintf(stderr, "kernel_launch: shape mismatch: n_in %d in0 %d out %d ws %zu (need %zu); nothing launched\n", n_in, n_in > 0 ? in_sizes[0] : -1, out_size, ws_size, (size_t)WS_END); grid = -1; return; }
        int dev = 0, cus = 0, per_cu = 0;
        if (hipGetDevice(&dev) != hipSuccess || hipDeviceGetAttribute(&cus, hipDeviceAttributeMultiprocessorCount, dev) != hipSuccess) { fprintf(stderr, "kernel_launch: device query failed\n"); grid = -1; return; }
        if (hipFuncSetAttribute((const void*)fwd_kernel, hipFuncAttributeMaxDynamicSharedMemorySize, LDS_BYTES) != hipSuccess) { fprintf(stderr, "kernel_launch: hipFuncSetAttribute failed\n"); grid = -1; return; }
        if (hipOccupancyMaxActiveBlocksPerMultiprocessor(&per_cu, (const void*)fwd_kernel, NWAVES * 64, LDS_BYTES) != hipSuccess || per_cu < 1)
            fprintf(stderr, "kernel_launch: note: occupancy query reports %d workgroups per CU\n", per_cu);
        (void)hipGetLastError();
        if (cus <= 64) { fprintf(stderr, "kernel_launch: %d CUs: this program needs more than 64 workgroups (64 of them run the GDN scans while the others start w_out); nothing launched\n", cus); grid = -1; return; }
        grid = cus;
    }
    if (grid < 0) return;
    if (hipMemsetAsync((char*)d_ws + WS_CTL, 0, CTL_ZERO_BYTES, stream) != hipSuccess) { fprintf(stderr, "kernel_launch: hipMemsetAsync failed\n"); return; }
    Args a{};
    for (int i = 0; i < N_IN; ++i) a.in[i] = (const float*)d_in[i];
    a.out = (float*)d_out; a.ws = (unsigned char*)d_ws;
#ifndef PROBE_PLAN
#define PROBE_PLAN {0, N_PHASES}
#endif
    const int plan[][2] = { PROBE_PLAN }; const int n_plan = (N_LAUNCHES == 1) ? (int)(sizeof(plan) / sizeof(plan[0])) : N_LAUNCHES;
    for (int li = 0; li < n_plan; ++li) {
        a.ph_lo = (N_LAUNCHES == 1) ? plan[li][0] : li; a.ph_hi = (N_LAUNCHES == 1) ? plan[li][1] : li + 1; a.li = (N_LAUNCHES == 1) ? li : 0;
        hipLaunchKernelGGL(fwd_kernel, dim3(grid), dim3(NWAVES * 64), LDS_BYTES, stream, a);
        const hipError_t le = hipPeekAtLastError();
        if (le != hipSuccess) { fprintf(stderr, "kernel_launch: launch %d failed: %s\n", li, hipGetErrorName(le)); break; }
    }
}
```

```cpp
#include <hip/hip_runtime.h>
#include <cstdio>
#include <cstdint>
namespace pg8 {
#define PG8_LAS __attribute__((address_space(3)))
typedef unsigned short bf16_t;
typedef short bf16x8 __attribute__((ext_vector_type(8)));
typedef float f32x4 __attribute__((ext_vector_type(4)));
typedef unsigned u32x4 __attribute__((ext_vector_type(4)));
typedef int i32x4 __attribute__((ext_vector_type(4)));
constexpr int BM = 256, BK = 64, HALF = 128, HTB = HALF * BK * 2  , STAGE_BYTES = 8 * HTB, NXCD = 8, WGM = 8;

__host__ __device__ __forceinline__ int lds_byte(int r, int c) { const int st = (r >> 4) * 2 + (c >> 5), rr = r & 15, cc = c & 31, ob = rr * 64 + cc * 2; return st * 1024 + (ob ^ (((ob >> 9) & 1) << 5)); }
__host__ __device__ __forceinline__ void stage_rc(int b, int& R, int& C) { const int st = b / 1024, sb = b % 1024, swz = sb ^ (((sb >> 9) & 1) << 5); R = (st >> 1) * 16 + swz / 64; C = (st & 1) * 32 + (swz % 64) / 2; }
__host__ __device__ __forceinline__ int perm32(int rho) { const int n = rho >> 4, i = rho & 15; return 8 * (i >> 2) + 4 * n + (i & 3); }

struct Unit { int pm, pn, k0, nt, sl, ri; };
struct Gemm { const bf16_t* A; const bf16_t* Bt; int M, N, K; };

struct StaticOrder {
    int nM, nN, nwg, G, c, ntk, kb;
    __host__ __device__ void init(int M, int N, int K, int G_, int c_) { nM = M / BM; nN = N / BM; nwg = nM * nN; G = G_; c = c_; ntk = K / BK; kb = 0; }
    __host__ __device__ void set_k(int kb_, int ntk_) { kb = kb_; ntk = ntk_; }
    __host__ __device__ void map(int L, Unit& u) const {
        int wgid = L; { const int q = nwg / NXCD, r = nwg % NXCD, xcd = wgid % NXCD, off = wgid / NXCD; wgid = (xcd < r ? xcd * (q + 1) : r * (q + 1) + (xcd - r) * q) + off; }
        const int nig = WGM * nN, gid = wgid / nig, fm = gid * WGM, gsz = (nM - fm) < WGM ? (nM - fm) : WGM;
        u.pm = fm + ((wgid % nig) % gsz); u.pn = (wgid % nig) / gsz; }
    __host__ __device__ int inv(int pm, int pn) const {
        const int nig = WGM * nN, gid = pm / WGM, fm = gid * WGM, gsz = (nM - fm) < WGM ? (nM - fm) : WGM; const int w = gid * nig + pn * gsz + (pm - fm);
        const int q = nwg / NXCD, r = nwg % NXCD; int xcd, off;
        if (w < r * (q + 1)) { xcd = w / (q + 1); off = w - xcd * (q + 1); } else { const int w2 = w - r * (q + 1); const int t = w2 / q; xcd = r + t; off = w2 - t * q; }
        return off * NXCD + xcd; }
    __host__ __device__ bool next(int i, Unit& u) const {
        const long L = (long)i * G + c; if (L >= nwg) return false;
        map((int)L, u); u.k0 = kb; u.nt = ntk; u.sl = 0; u.ri = -1; return true;
    }
    __device__ __forceinline__ void a_ready(const Unit&) const {}
    __device__ __forceinline__ void done(const Unit&) const {}
};
struct SplitOrder : StaticOrder {
    int R, rem, S;
    __host__ __device__ void init(int M, int N, int K, int G_, int c_, int S_) { StaticOrder::init(M, N, K, G_, c_); R = nwg / G; rem = nwg - R * G; S = S_; }
    __host__ __device__ bool next(int i, Unit& u) const {
        if (i < R) { map(i * G + c, u); u.k0 = kb; u.nt = ntk; u.sl = 0; u.ri = -1; return true; }
        const int j = (i - R) * G + c; if (j >= rem * S) return false;
        const int ri = j / S, s = j - ri * S, h = ntk / 2; map(R * G + ri, u);
        const int o0 = 2 * ((h * s) / S); u.k0 = kb + o0; u.nt = 2 * ((h * (s + 1)) / S) - o0; u.sl = s; u.ri = ri; return true;
    }
};

__device__ __forceinline__ unsigned cvt_pk_bf16(float lo, float hi) { unsigned r; asm volatile("v_cvt_pk_bf16_f32 %0, %1, %2" : "=v"(r) : "v"(lo), "v"(hi)); return r; }
typedef float f32x2 __attribute__((ext_vector_type(2)));
__device__ __forceinline__ float silu_f(float g) { return g * __builtin_amdgcn_rcpf(1.0f + __builtin_amdgcn_exp2f(-1.4426950408889634f * g)); }
template <bool I8> struct EpiSwiGLU {
    static constexpr bool PERM = true, AFTER_DRAIN = false;
    bf16_t* O; int ldc; float* slab; int S; const float *sA, *sB; unsigned* rmax;
    __device__ __forceinline__ void operator()(const f32x4 (&acc)[2][2][4][2], const Unit& u, int wr, int wc, int fr, int fq) const {
        if (u.ri >= 0) { float* sb = slab + ((size_t)(u.ri * S + u.sl) << 16) + wc * 32 + 8 * fq;
#pragma unroll
            for (int ai = 0; ai < 2; ++ai)
#pragma unroll
                for (int m = 0; m < 4; ++m) { float* o = sb + (ai * HALF + wr * 64 + m * 16 + fr) * BM;
#pragma unroll
                    for (int bj = 0; bj < 2; ++bj)
#pragma unroll
                        for (int n = 0; n < 2; ++n) *(f32x4*)(o + bj * HALF + 4 * n) = acc[ai][bj][m][n]; }
            return; }
        const int row0 = u.pm * BM + wr * 64 + fr, col0 = u.pn * HALF + wc * 32 + 8 * fq;
        f32x4 sbg0 = {1.f, 1.f, 1.f, 1.f}, sbg1 = sbg0, sbu0 = sbg0, sbu1 = sbg0;
        if constexpr (I8) { const int fr0 = u.pn * BM + wc * 32 + 8 * fq;
            sbg0 = *(const f32x4*)(sB + fr0); sbg1 = *(const f32x4*)(sB + fr0 + 4); sbu0 = *(const f32x4*)(sB + fr0 + HALF); sbu1 = *(const f32x4*)(sB + fr0 + HALF + 4); }
#pragma unroll
        for (int ai = 0; ai < 2; ++ai)
#pragma unroll
            for (int m = 0; m < 4; ++m) { bf16_t* rowp = O + (size_t)(row0 + ai * HALF + m * 16) * ldc + col0;
                f32x4 g0 = acc[ai][0][m][0], g1 = acc[ai][0][m][1], u0 = acc[ai][1][m][0], u1 = acc[ai][1][m][1];
                if constexpr (I8) { const float sa = sA[row0 + ai * HALF + m * 16];
                    g0 = __builtin_convertvector(__builtin_bit_cast(i32x4, g0), f32x4) * (sbg0 * sa); g1 = __builtin_convertvector(__builtin_bit_cast(i32x4, g1), f32x4) * (sbg1 * sa);
                    u0 = __builtin_convertvector(__builtin_bit_cast(i32x4, u0), f32x4) * (sbu0 * sa); u1 = __builtin_convertvector(__builtin_bit_cast(i32x4, u1), f32x4) * (sbu1 * sa); }
                u32x4 w;
                w.x = cvt_pk_bf16(silu_f(g0[0]) * u0[0], silu_f(g0[1]) * u0[1]); w.y = cvt_pk_bf16(silu_f(g0[2]) * u0[2], silu_f(g0[3]) * u0[3]);
                w.z = cvt_pk_bf16(silu_f(g1[0]) * u1[0], silu_f(g1[1]) * u1[1]); w.w = cvt_pk_bf16(silu_f(g1[2]) * u1[2], silu_f(g1[3]) * u1[3]);
                *(u32x4*)rowp = w;
                if (rmax) { unsigned mx = 0u;
                    { const unsigned ww_[4] = {w.x, w.y, w.z, w.w};
#pragma unroll
                      for (int k_ = 0; k_ < 4; ++k_) { const unsigned lo_ = (ww_[k_] << 16) & 0x7fff0000u, hi_ = ww_[k_] & 0x7fff0000u; mx = mx > lo_ ? mx : lo_; mx = mx > hi_ ? mx : hi_; } }
                    { const unsigned o_ = (unsigned)__shfl_xor((int)mx, 16); mx = mx > o_ ? mx : o_; } { const unsigned o_ = (unsigned)__shfl_xor((int)mx, 32); mx = mx > o_ ? mx : o_; }
                    if (fq == 0) (void)__hip_atomic_fetch_max(rmax + row0 + ai * HALF + m * 16, mx, __ATOMIC_RELAXED, __HIP_MEMORY_SCOPE_AGENT); } }
    }
};
struct EpiStoreBf16 {
    static constexpr bool PERM = true, AFTER_DRAIN = false;
    bf16_t* O; int ldc;
    __device__ __forceinline__ void operator()(const f32x4 (&acc)[2][2][4][2], const Unit& u, int wr, int wc, int fr, int fq) const {
        const int row0 = u.pm * BM + wr * 64 + fr, col0 = u.pn * BM + wc * 32 + 8 * fq;
#pragma unroll
        for (int ai = 0; ai < 2; ++ai)
#pragma unroll
            for (int m = 0; m < 4; ++m) { bf16_t* rowp = O + (size_t)(row0 + ai * HALF + m * 16) * ldc + col0;
#pragma unroll
                for (int bj = 0; bj < 2; ++bj) { const f32x4 v0 = acc[ai][bj][m][0], v1 = acc[ai][bj][m][1];
                    u32x4 w; w.x = cvt_pk_bf16(v0[0], v0[1]); w.y = cvt_pk_bf16(v0[2], v0[3]); w.z = cvt_pk_bf16(v1[0], v1[1]); w.w = cvt_pk_bf16(v1[2], v1[3]);
                    *(u32x4*)(rowp + bj * HALF) = w; } }
    }
};
template <int MODE> struct RowSrc {
    const float *p0, *p1, *p2; int n0, n1, n2, ld;
    __device__ __forceinline__ const float* row(int r) const {
        if (MODE == 1) return r < n0 ? p0 + (size_t)r * ld : nullptr;
        if (r < n0) return p0 + (size_t)r * ld;
        if (r < n1) return p1 + (size_t)(r - n0) * ld;
        if (r < n2) return p2 + (size_t)(r - n1) * ld;
        return nullptr; }
};
typedef unsigned u32x2e __attribute__((ext_vector_type(2)));
template <int MODE, bool HALF_, bool ALPHA1 = false, bool I8 = false, bool R16 = false> struct EpiResF32 {
    static constexpr bool PERM = false, AFTER_DRAIN = false;
    float* out; int ldc; RowSrc<MODE> src; float* slab; int S;
    const float *sA, *sB;
    __device__ __forceinline__ void operator()(const f32x4 (&acc)[2][2][4][2], const Unit& u, int wr, int wc, int fr, int fq) const {
        constexpr float alpha = ALPHA1 ? 1.0f : 1.189207115002721f, scale = HALF_ ? 0.5f : 1.0f;
        f32x4 sb_[2][2];
        if constexpr (I8) { const int c0_ = u.pn * BM + wc * 32 + 4 * fq;
#pragma unroll
            for (int bj = 0; bj < 2; ++bj)
#pragma unroll
                for (int n = 0; n < 2; ++n) sb_[bj][n] = *(const f32x4*)(sB + c0_ + bj * HALF + n * 16); }
#define EPI_VAL(ai, bj, m, n, sa_) (I8 ? __builtin_convertvector(__builtin_bit_cast(i32x4, acc[ai][bj][m][n]), f32x4) * (sb_[bj][n] * (sa_)) : acc[ai][bj][m][n])
        if (u.sl > 0) {
            float* sb = slab + ((size_t)(u.ri * (S - 1) + (u.sl - 1)) << 16) + wc * 32 + 4 * fq;
#pragma unroll
            for (int ai = 0; ai < 2; ++ai)
#pragma unroll
                for (int m = 0; m < 4; ++m) { float* o = sb + (ai * HALF + wr * 64 + m * 16 + fr) * BM; float sa_ = 1.f; if constexpr (I8) sa_ = sA[u.pm * BM + ai * HALF + wr * 64 + m * 16 + fr];
#pragma unroll
                    for (int bj = 0; bj < 2; ++bj)
#pragma unroll
                        for (int n = 0; n < 2; ++n) *(f32x4*)(o + bj * HALF + n * 16) = EPI_VAL(ai, bj, m, n, sa_); }
            return; }
        const int col0 = u.pn * BM + wc * 32 + 4 * fq;
#pragma unroll
        for (int ai = 0; ai < 2; ++ai)
#pragma unroll
            for (int m = 0; m < 4; ++m) { const int r = u.pm * BM + ai * HALF + wr * 64 + m * 16 + fr; const float* b = src.row(r);
                if (b) { float* o = out + (size_t)r * ldc; float sa_ = 1.f; if constexpr (I8) sa_ = sA[r];
#pragma unroll
                    for (int bj = 0; bj < 2; ++bj)
#pragma unroll
                        for (int n = 0; n < 2; ++n) { const int c = col0 + bj * HALF + n * 16; f32x4 bs;
                            if constexpr (R16 && MODE == 1) { const u32x2e w_ = *(const u32x2e*)((const bf16_t*)src.p0 + (size_t)r * src.ld + c);
                                bs = (f32x4){__uint_as_float(w_.x << 16), __uint_as_float(w_.x & 0xffff0000u), __uint_as_float(w_.y << 16), __uint_as_float(w_.y & 0xffff0000u)}; }
                            else bs = *(const f32x4*)(b + c);
                            const f32x4 v_ = bs * alpha + EPI_VAL(ai, bj, m, n, sa_) * scale;
                            if constexpr (R16) { u32x2e o_; o_.x = cvt_pk_bf16(v_[0], v_[1]); o_.y = cvt_pk_bf16(v_[2], v_[3]); *(u32x2e*)((bf16_t*)out + (size_t)r * ldc + c) = o_; }
                            else *(f32x4*)(o + c) = v_; } } }
#undef EPI_VAL
    }
};
template <class Epi, class Sched, bool ALIGN_EPI = false, bool SP2 = false, bool I8 = false>
__device__ __forceinline__ void gemm_phase(PG8_LAS unsigned char* lds, const Gemm g, const Sched& S, const Epi& E) {
    const int tid = threadIdx.x, wid = __builtin_amdgcn_readfirstlane(tid >> 6), lane = tid & 63, wr = wid >> 2, wc = wid & 3, fr = lane & 15, fq = lane >> 4;
    const int K = g.K;
    unsigned voffA[2], voffB[2];
#pragma unroll
    for (int i = 0; i < 2; ++i) { int R, C; stage_rc(tid * 16 + i * 8192, R, C); const int Rb = Epi::PERM ? ((R & ~31) + perm32(R & 31)) : R;
        voffA[i] = (unsigned)(R * K + C) * 2u; voffB[i] = (unsigned)(Rb * K + C) * 2u; }
    const size_t kstep = (size_t)(BK * 2);
    const size_t hstep = (size_t)HALF * K * 2;
    const size_t tstep = 2 * hstep;
    const unsigned ldsw = (unsigned)wid * 1024u;
    const int aoff = lds_byte(wr * 64 + fr, fq * 8), boff = lds_byte(wc * 32 + fr, fq * 8);
#define PG8_SA(b, h) (((b) * 2 + (h)) * HTB)
#define PG8_SB(b, h) ((4 + (b) * 2 + (h)) * HTB)
#define PG8_STAGE(bufoff, gbase, voff) do { _Pragma("unroll") for (int _i = 0; _i < 2; ++_i) \
        __builtin_amdgcn_global_load_lds((const unsigned*)((const char*)(gbase) + (voff)[_i]), (PG8_LAS unsigned*)(lds + (bufoff) + ldsw + _i * 8192), 16, 0, 0); } while (0)
#define PG8_LDA(dst, b, h) do { _Pragma("unroll") for (int m = 0; m < 4; ++m) _Pragma("unroll") for (int k = 0; k < 2; ++k) dst[m][k] = *(const PG8_LAS bf16x8*)(lds + PG8_SA(b, h) + aoff + m * 2048 + k * 1024); } while (0)
#define PG8_LDB(dst, b, h) do { _Pragma("unroll") for (int n = 0; n < 2; ++n) _Pragma("unroll") for (int k = 0; k < 2; ++k) dst[n][k] = *(const PG8_LAS bf16x8*)(lds + PG8_SB(b, h) + boff + n * 2048 + k * 1024); } while (0)
#define PG8_MMA(ai, bj, At, Bt) do { __builtin_amdgcn_s_setprio(1); _Pragma("unroll") for (int m = 0; m < 4; ++m) _Pragma("unroll") for (int n = 0; n < 2; ++n) _Pragma("unroll") for (int k = 0; k < 2; ++k) \
        { if constexpr (I8) acc[ai][bj][m][n] = __builtin_bit_cast(f32x4, __builtin_amdgcn_mfma_i32_16x16x64_i8(__builtin_bit_cast(i32x4, Bt[n][k]), __builtin_bit_cast(i32x4, At[m][k]), __builtin_bit_cast(i32x4, acc[ai][bj][m][n]), 0, 0, 0)); \
          else acc[ai][bj][m][n] = __builtin_amdgcn_mfma_f32_16x16x32_bf16(Bt[n][k], At[m][k], acc[ai][bj][m][n], 0, 0, 0); } __builtin_amdgcn_s_setprio(0); } while (0)
#define PG8_WAIT_V(n) asm volatile("s_waitcnt vmcnt(" #n ")" ::: "memory")
#define PG8_WAIT_L(n) asm volatile("s_waitcnt lgkmcnt(" #n ")" ::: "memory")
#define PG8_BAR __builtin_amdgcn_s_barrier()
#define PG8_SCHED __builtin_amdgcn_sched_barrier(0)
    Unit cur, nxt; int ui = 0;
    if (!S.next(0, cur)) return;
    f32x4 acc[2][2][4][2];
#pragma unroll
    for (int a = 0; a < 2; ++a)
#pragma unroll
        for (int b = 0; b < 2; ++b)
#pragma unroll
            for (int m = 0; m < 4; ++m)
#pragma unroll
                for (int n = 0; n < 2; ++n) acc[a][b][m][n] = (f32x4){0.f, 0.f, 0.f, 0.f};
    bf16x8 At[4][2], B0[2][2], B1[2][2];
    const char* cA = (const char*)g.A + (size_t)cur.pm * tstep + (size_t)cur.k0 * kstep; const char* cB = (const char*)g.Bt + (size_t)cur.pn * tstep + (size_t)cur.k0 * kstep; int nt = cur.nt;
    S.a_ready(cur);
    if constexpr (SP2) {
        PG8_STAGE(PG8_SB(0, 0), cB, voffB); PG8_STAGE(PG8_SB(0, 1), cB + hstep, voffB); PG8_STAGE(PG8_SA(0, 0), cA, voffA); PG8_STAGE(PG8_SA(0, 1), cA + hstep, voffA);
        if (wr == 1) PG8_BAR;
        PG8_WAIT_V(2); PG8_BAR;
        PG8_STAGE(PG8_SB(1, 0), cB + kstep, voffB); PG8_STAGE(PG8_SA(1, 0), cA + kstep, voffA); PG8_STAGE(PG8_SB(1, 1), cB + hstep + kstep, voffB);
        PG8_WAIT_V(6); PG8_BAR;
    } else {
        PG8_STAGE(PG8_SB(0, 0), cB, voffB); PG8_STAGE(PG8_SA(0, 0), cA, voffA); PG8_STAGE(PG8_SB(0, 1), cB + hstep, voffB); PG8_STAGE(PG8_SA(0, 1), cA + hstep, voffA);
        if (wr == 1) PG8_BAR;
        PG8_WAIT_V(4); PG8_BAR;
        PG8_STAGE(PG8_SB(1, 0), cB + kstep, voffB); PG8_STAGE(PG8_SA(1, 0), cA + kstep, voffA); PG8_STAGE(PG8_SB(1, 1), cB + hstep + kstep, voffB);
        PG8_WAIT_V(6); PG8_BAR;
    }
    for (;;) {
        const bool has_next = S.next(ui + 1, nxt);
        const char* nA = has_next ? (const char*)g.A + (size_t)nxt.pm * tstep + (size_t)nxt.k0 * kstep : cA; const char* nB = has_next ? (const char*)g.Bt + (size_t)nxt.pn * tstep + (size_t)nxt.k0 * kstep : cB;
        for (int t = 0; t < nt; t += 2) {
            const bool last = (t == nt - 2);
            const char* a1 = cA + (size_t)(t + 1) * kstep;
            const char* a2 = last ? nA : cA + (size_t)(t + 2) * kstep; const char* b2 = last ? nB : cB + (size_t)(t + 2) * kstep;
            const char* a3 = a2 + kstep; const char* b3 = b2 + kstep;
            if (last && has_next) S.a_ready(nxt);
            if constexpr (SP2) {
            PG8_LDB(B0, 0, 0); PG8_LDB(B1, 0, 1); PG8_SCHED; PG8_LDA(At, 0, 0); PG8_STAGE(PG8_SA(1, 1), a1 + hstep, voffA);
            PG8_WAIT_V(8); PG8_WAIT_L(0); PG8_BAR; PG8_MMA(0, 0, At, B0); PG8_MMA(0, 1, At, B1); PG8_BAR; PG8_SCHED;
            PG8_LDA(At, 0, 1); PG8_STAGE(PG8_SB(0, 0), b2, voffB); PG8_STAGE(PG8_SB(0, 1), b2 + hstep, voffB); PG8_STAGE(PG8_SA(0, 0), a2, voffA);
            PG8_WAIT_V(8); PG8_WAIT_L(0); PG8_BAR; PG8_MMA(1, 0, At, B0); PG8_MMA(1, 1, At, B1); PG8_BAR; PG8_SCHED;
            PG8_LDB(B0, 1, 0); PG8_LDB(B1, 1, 1); PG8_SCHED; PG8_LDA(At, 1, 0); PG8_STAGE(PG8_SA(0, 1), a2 + hstep, voffA);
            PG8_WAIT_V(8); PG8_WAIT_L(0); PG8_BAR; PG8_MMA(0, 0, At, B0); PG8_MMA(0, 1, At, B1); PG8_BAR; PG8_SCHED;
            PG8_LDA(At, 1, 1); PG8_STAGE(PG8_SB(1, 0), b3, voffB); PG8_STAGE(PG8_SB(1, 1), b3 + hstep, voffB); PG8_STAGE(PG8_SA(1, 0), a3, voffA);
            PG8_WAIT_V(8); PG8_WAIT_L(0); PG8_BAR; PG8_MMA(1, 0, At, B0); PG8_MMA(1, 1, At, B1); PG8_BAR; PG8_SCHED;
            } else {
            PG8_LDB(B0, 0, 0); PG8_SCHED; PG8_LDA(At, 0, 0); PG8_STAGE(PG8_SA(1, 1), a1 + hstep, voffA);
            PG8_WAIT_L(8); PG8_BAR; PG8_WAIT_L(0); PG8_MMA(0, 0, At, B0); PG8_BAR; PG8_SCHED;
            PG8_LDB(B1, 0, 1); PG8_STAGE(PG8_SB(0, 0), b2, voffB);
            PG8_BAR; PG8_WAIT_L(0); PG8_MMA(0, 1, At, B1); PG8_BAR;
            PG8_LDA(At, 0, 1); PG8_STAGE(PG8_SA(0, 0), a2, voffA);
            PG8_BAR; PG8_WAIT_L(0); PG8_MMA(1, 0, At, B0); PG8_BAR; PG8_SCHED;
            PG8_STAGE(PG8_SB(0, 1), b2 + hstep, voffB);
            PG8_WAIT_V(6); PG8_BAR; PG8_MMA(1, 1, At, B1); PG8_BAR;
            PG8_LDB(B0, 1, 0); PG8_SCHED; PG8_LDA(At, 1, 0); PG8_STAGE(PG8_SA(0, 1), a2 + hstep, voffA);
            PG8_WAIT_L(8); PG8_BAR; PG8_WAIT_L(0); PG8_MMA(0, 0, At, B0); PG8_BAR; PG8_SCHED;
            PG8_LDB(B1, 1, 1); PG8_STAGE(PG8_SB(1, 0), b3, voffB);
            PG8_BAR; PG8_WAIT_L(0); PG8_MMA(0, 1, At, B1); PG8_BAR;
            PG8_LDA(At, 1, 1); PG8_STAGE(PG8_SA(1, 0), a3, voffA);
            PG8_BAR; PG8_WAIT_L(0); PG8_MMA(1, 0, At, B0); PG8_BAR; PG8_SCHED;
            PG8_STAGE(PG8_SB(1, 1), b3 + hstep, voffB);
            PG8_WAIT_V(6); PG8_BAR; PG8_MMA(1, 1, At, B1); PG8_BAR;
            }
        }
        if constexpr (ALIGN_EPI) { if (wr == 0) PG8_BAR; }
        if constexpr (!Epi::AFTER_DRAIN) { E(acc, cur, wr, wc, fr, fq); S.done(cur); }
        if (!has_next) break;
#pragma unroll
        for (int a = 0; a < 2; ++a)
#pragma unroll
            for (int b = 0; b < 2; ++b)
#pragma unroll
                for (int m = 0; m < 4; ++m)
#pragma unroll
                    for (int n = 0; n < 2; ++n) acc[a][b][m][n] = (f32x4){0.f, 0.f, 0.f, 0.f};
        cur = nxt; cA = nA; cB = nB; nt = cur.nt; ++ui;
        if constexpr (ALIGN_EPI) { if (wr == 1) PG8_BAR; }
    }
    PG8_WAIT_V(0);
    if constexpr (!ALIGN_EPI) { if (wr == 0) PG8_BAR; }
    PG8_BAR;
    if constexpr (Epi::AFTER_DRAIN) { E.fused(acc, cur, wr, wc, fr, fq, lds, wid, lane); S.done(cur); }
#undef PG8_SA
#undef PG8_SB
#undef PG8_STAGE
#undef PG8_LDA
#undef PG8_LDB
#undef PG8_MMA
#undef PG8_WAIT_V
#undef PG8_WAIT_L
#undef PG8_BAR
#undef PG8_SCHED
}
}
#define GAS __attribute__((address_space(1)))
#define LAS __attribute__((address_space(3)))
typedef unsigned short bf16;
typedef unsigned v4u __attribute__((ext_vector_type(4)));
typedef float f32x4 __attribute__((ext_vector_type(4)));
typedef short bf16x8 __attribute__((ext_vector_type(8)));
typedef GAS unsigned gu32;
typedef GAS unsigned long long gu64;
#define RLX_AGENT __ATOMIC_RELAXED, __HIP_MEMORY_SCOPE_AGENT
#define LDS_WAIT() asm volatile("s_waitcnt lgkmcnt(0)" ::: "memory")
#define VM_WAIT() asm volatile("s_waitcnt vmcnt(0)" ::: "memory")
__device__ __forceinline__ unsigned long long rt() { return __builtin_amdgcn_s_memrealtime(); }
__device__ __forceinline__ unsigned f2bf(float f) { unsigned u = __builtin_bit_cast(unsigned, f); return (u + 0x7fffu + ((u >> 16) & 1u)) >> 16; }
__device__ __forceinline__ unsigned pk2(float lo, float hi) { return f2bf(lo) | (f2bf(hi) << 16); }

#define XB_TMO      128
#define XB_XCNT(j)  (256  + 64 * (j))
#define XB_XSUB(j)  (1280 + 64 * (j))
#define XB_XGEN(j)  (2304 + 64 * (j))
#define XB_TOP      3328
#define XB_TOPGEN   3392
#define XCD_BAR_WORDS 3456
#define XB_SPIN_CAP (1u << 18)

__device__ __forceinline__ unsigned xb_ld(unsigned* p)              { return __hip_atomic_load(p, __ATOMIC_RELAXED, __HIP_MEMORY_SCOPE_AGENT); }
__device__ __forceinline__ unsigned xb_add(unsigned* p, unsigned v) { return __hip_atomic_fetch_add(p, v, __ATOMIC_RELAXED, __HIP_MEMORY_SCOPE_AGENT); }
__device__ __forceinline__ unsigned xb_xcc_id() { return (unsigned)__builtin_amdgcn_s_getreg((3 << 11) | 20) & 0xFu; }
#define XB_SPIN(cond, bar) do { unsigned _sp = 0; while (cond) { __builtin_amdgcn_s_sleep(1); \
    if ((++_sp & 255u) == 0u) { if (xb_ld(&(bar)[XB_TMO])) break; if (_sp > XB_SPIN_CAP) { atomicAdd(&(bar)[XB_TMO], 1u); break; } } } } while (0)

struct XcdBarrier {
    unsigned* bar; unsigned x;
    volatile LAS unsigned* st;
};

__device__ __forceinline__ XcdBarrier xcd_barrier_post(unsigned* bar, volatile LAS unsigned* st) {
    XcdBarrier b; b.bar = bar; b.x = xb_xcc_id(); b.st = st;
    if (threadIdx.x == 0) (void)xb_add(&bar[XB_XCNT(b.x)], 1u);
    return b;
}
__device__ __forceinline__ void xcd_barrier_complete(unsigned* bar, unsigned x, unsigned& nloc, unsigned& nx) {
    const unsigned G = gridDim.x * gridDim.y * gridDim.z;
    unsigned sum, cnt, mine, sp = 0u;
    for (;;) {
        sum = 0u; cnt = 0u; mine = 0u;
#pragma unroll
        for (unsigned j = 0; j < 16; ++j) { const unsigned c = xb_ld(&bar[XB_XCNT(j)]); sum += c; cnt += (c > 0u) ? 1u : 0u; mine = (j == x) ? c : mine; }
        if (sum == G) break;
        __builtin_amdgcn_s_sleep(1);
        if ((++sp & 255u) == 0u) { if (xb_ld(&bar[XB_TMO])) break; if (sp > XB_SPIN_CAP) { atomicAdd(&bar[XB_TMO], 1u); break; } }
    }
    nloc = mine > 0u ? mine : 1u; nx = cnt > 0u ? cnt : 1u;
}

__device__ __forceinline__ void xcd_barrier(const XcdBarrier& b) {
    asm volatile("s_waitcnt vmcnt(0)" ::: "memory");
    __syncthreads();
    if (threadIdx.x == 0) {
        unsigned* bar = b.bar;
        __builtin_amdgcn_s_waitcnt(0);
        unsigned nloc = b.st[0], nx = b.st[1];
        if (nloc == 0u) { xcd_barrier_complete(bar, b.x, nloc, nx); b.st[0] = nloc; b.st[1] = nx; }
        const unsigned old = xb_add(&bar[XB_XSUB(b.x)], 1u);
        const unsigned gen = old / nloc;
        if (old + 1u == (gen + 1u) * nloc) {
            __builtin_amdgcn_fence(__ATOMIC_RELEASE, "agent");
            asm volatile("s_waitcnt vmcnt(0)" ::: "memory");
            const unsigned og = xb_add(&bar[XB_TOP], 1u);
            const unsigned tg = og / nx;
            if (og + 1u == (tg + 1u) * nx) xb_add(&bar[XB_TOPGEN], 1u);
            else XB_SPIN(xb_ld(&bar[XB_TOPGEN]) == tg, bar);
            __builtin_amdgcn_fence(__ATOMIC_ACQUIRE, "agent");
            xb_add(&bar[XB_XGEN(b.x)], 1u);
            asm volatile("s_waitcnt vmcnt(0)" ::: "memory");
        } else {
            XB_SPIN(xb_ld(&bar[XB_XGEN(b.x)]) == gen, bar);
            __builtin_amdgcn_fence(__ATOMIC_ACQUIRE, "agent");
            asm volatile("s_waitcnt vmcnt(0)" ::: "memory");
        }
    }
    __syncthreads();
}


constexpr int NWAVES = 8;
#ifndef MK_N_LAUNCHES
#define MK_N_LAUNCHES 1
#endif
constexpr int N_PHASES = 12;
constexpr int N_LAUNCHES = MK_N_LAUNCHES;
static_assert(N_LAUNCHES == 1 || N_LAUNCHES == N_PHASES, "MK_N_LAUNCHES is 1 or 12");

constexpr int D = 4096, FF = 11008, NGU = 2 * FF, DIN = 11296, DINP = 11520;
constexpr int NB_P = 4, SEQ_P = 2048, NB_S = 16, SEQ_S = 64, NMETA = 16, PAST = 2048;
constexpr int ROW_S = NB_P * SEQ_P  , ROW_M = ROW_S + NB_S * SEQ_S  , M1V = ROW_M + NMETA  , M1 = 9472  , M2 = ROW_M  ;
constexpr int KVH = 4, HD = 128, KVW = KVH * HD  , NHQ = 16, NHG = 16, WIN = 128;
constexpr int KVR_SMETA = M1, KVR_SWIN = M1 + NB_S * NMETA  , KV_ROWS = KVR_SWIN + NB_S * WIN  ;
constexpr int NPOS = NMETA + PAST + SEQ_S;
constexpr int C_Q = 0, C_K = 2048, C_V = 2560, C_CONV = 3072, C_Z = 9216, C_B = 11264, C_A = 11280, DCONV = 6144;
constexpr float LN_EPS = 1e-5f, RMS_EPS = 1e-6f, ALPHA = 1.189207115002721f;
enum { I_XP = 0, I_XS, I_CMK, I_CMV, I_CWK, I_CWV, I_SCONV, I_SGDN, I_META, I_LNG, I_LNB, I_WG, I_WU, I_WD, I_WIN, I_WOUT, I_SINK, I_CONVW, I_ALOG, I_DTB, I_NORMW, N_IN };
constexpr size_t O_YP = 0, O_YS = O_YP + (size_t)ROW_S * D, O_PMK = O_YS + (size_t)NB_S * SEQ_S * D, O_PMV = O_PMK + (size_t)NB_P * NMETA * KVW, O_PWK = O_PMV + (size_t)NB_P * NMETA * KVW,
                 O_PWV = O_PWK + (size_t)NB_P * WIN * KVW, O_PCONV = O_PWV + (size_t)NB_P * WIN * KVW, O_PGDN = O_PCONV + (size_t)NB_P * 3 * DCONV, O_SWK = O_PGDN + (size_t)NB_P * NHG * 128 * 128,
                 O_SWV = O_SWK + (size_t)NB_S * SEQ_S * KVW, O_SCONV = O_SWV + (size_t)NB_S * SEQ_S * KVW, O_SGDN = O_SCONV + (size_t)NB_S * 3 * DCONV, O_END = O_SGDN + (size_t)NB_S * NHG * 128 * 128;
static_assert(O_END == 44998656, "output map");

constexpr size_t AL(size_t x) { return (x + 4095) / 4096 * 4096; }
constexpr size_t WS_CTL = 0, CTL_ZERO_BYTES = 1u << 20;
constexpr size_t WS_WGU1 = CTL_ZERO_BYTES, SZ_WGU = (size_t)NGU * D * 2, SZ_WD = (size_t)D * FF * 2;
constexpr size_t WS_WD1 = WS_WGU1 + AL(SZ_WGU), WS_WGU2 = WS_WD1 + AL(SZ_WD), WS_WD2 = WS_WGU2 + AL(SZ_WGU), WS_WIN = WS_WD2 + AL(SZ_WD), WS_WOUT = WS_WIN + AL((size_t)DINP * D * 2);
constexpr size_t WS_XN = WS_WOUT + AL((size_t)D * D * 2), WS_MIX = WS_XN + AL((size_t)M1 * D * 2), WS_H = WS_MIX + AL((size_t)M2 * D * 2);
constexpr size_t WS_Y = WS_H + AL((size_t)M1 * DINP * 2), WS_KB = WS_Y + AL((size_t)M1 * D * 4), WS_VB = WS_KB + AL((size_t)KV_ROWS * KVW * 2), WS_ROPE = WS_VB + AL((size_t)KV_ROWS * KVW * 2);
constexpr size_t WS_SLAB = WS_ROPE + AL((size_t)NPOS * 64 * 8), N_SLABS = 224, WS_XQ = WS_SLAB + N_SLABS * 262144, WS_SA = WS_XQ + AL((size_t)M1 * D), WS_SB = WS_SA + AL((size_t)M1 * 4), WS_SH = WS_SB + 2 * AL((size_t)NGU * 4), WS_SBD = WS_SH + AL((size_t)M1 * 4), WS_HQ = WS_SBD + 2 * AL((size_t)D * 4), WS_END = WS_HQ + AL((size_t)M1 * FF);
static_assert((size_t)M1 * FF <= (WS_H - WS_XN), "the int8 copy of h fits over the XN | MIX region");
constexpr int GU_U = 0, GU_W = 32768, GU_QD = GU_W + 16384, GU_KDT = GU_QD + 16384, GU_QK = GU_KDT + 16384, GU_GL = GU_QK + 8192, GU_BYTES = GU_GL + 256;
constexpr int N_GUNITS = NB_P * NHG * 32 + NHG + NB_S * NHG;
constexpr size_t WS_GDN = WS_WGU1;
static_assert((size_t)N_GUNITS * GU_BYTES <= WS_WGU2 - WS_WGU1, "GDN chunk data fits in the FFN1 weight region");
constexpr int CW_TMO = 0, CW_CODE = 1, CW_BAR = 4096, CW_CMAX = 131072, CW_CMAXD = CW_CMAX + 2 * NGU, CW_RMAX = CW_CMAXD + 2 * D;
static_assert((CW_RMAX + 2 * M1) * 4 <= (int)CTL_ZERO_BYTES, "column maxima inside the per-call memset");

constexpr int RING_OFF = 0, RING_BYTES = 139264;
constexpr int LDSCTL_OFF = RING_BYTES, MISC_OFF = LDSCTL_OFF + 320;
constexpr int LDS_BYTES = 147456;
static_assert(MISC_OFF + 128 <= LDS_BYTES, "LDS map");

struct Frame {
    LAS unsigned char* lds;
    volatile LAS unsigned* MISC;
    gu32* ctl;
    int tid, lane, wave;
    int vcu, G;
};
struct Ptrs {
    const float* in[N_IN]; float* out;
    bf16 *Wgu1, *Wd1, *Wgu2, *Wd2, *Win, *Wout, *XN, *MIX, *H, *KB, *VB;
    float* Y; float* ROPE; unsigned char* GDN; float* SLAB;
    signed char* XQ; float *SA, *SB1, *SB2; unsigned* CMAX;
    signed char* HQ; float *SH, *SBD1, *SBD2; unsigned *CMAXD, *RMAX;
};
__host__ __device__ constexpr int kpos32(int kk) { return 8 * ((kk & 15) >> 2) + (kk & 3) + 4 * (kk >> 4); }
__host__ __device__ constexpr int a256_off(int r, int k) { return r * 256 + ((((k >> 5) * 4 + (kpos32(k & 31) >> 3)) ^ (r & 15)) * 16) + (kpos32(k & 31) & 7) * 2; }
__host__ __device__ constexpr int a128_off(int r, int k) { return r * 128 + ((((k >> 5) * 4 + (kpos32(k & 31) >> 3)) ^ ((r >> 1) & 7)) * 16) + (kpos32(k & 31) & 7) * 2; }
typedef short s16x4 __attribute__((ext_vector_type(4)));
__device__ __forceinline__ unsigned pkbf(float lo, float hi) { unsigned r; asm volatile("v_cvt_pk_bf16_f32 %0, %1, %2" : "=v"(r) : "v"(lo), "v"(hi)); return r; }
typedef float f32x2v __attribute__((ext_vector_type(2)));
typedef unsigned u32x2v __attribute__((ext_vector_type(2)));
__device__ __forceinline__ float bf2f(unsigned b) { return __uint_as_float(b << 16); }
__device__ __forceinline__ float wave_sum(float v) {
#pragma unroll
    for (int o = 1; o < 64; o <<= 1) v += __shfl_xor(v, o);
    return v;
}
__device__ __forceinline__ float silu1(float g) { return g * __builtin_amdgcn_rcpf(1.0f + __builtin_amdgcn_exp2f(-1.4426950408889634f * g)); }

template <int NB, int MODE>
__device__ __forceinline__ void p0_transpose_item(const float* W, int K, int N, bf16* WT, LAS float* scr, int item, int lane) {
    constexpr int LPR = NB / 4, RPI = 64 / LPR, NIT = 64 / RPI, ST = NB + 1;
    const int nblk = N / NB, kb = item / nblk, nb = item - kb * nblk, k0 = 64 * kb, n0 = NB * nb;
    const int lr = lane / LPR, lc = 4 * (lane % LPR);
#pragma unroll
    for (int i = 0; i < NIT; ++i) { const int kk = RPI * i + lr; const f32x4 v = __builtin_nontemporal_load((const GAS f32x4*)(W + (size_t)(k0 + kk) * N + n0 + lc));
        LAS float* s = scr + kk * ST + lc; s[0] = v.x; s[1] = v.y; s[2] = v.z; s[3] = v.w; }
    LDS_WAIT(); asm volatile("" ::: "memory");
    const int c = lane & 7;
#pragma unroll
    for (int j = 0; j < NB / 8; ++j) { const int n = (lane >> 3) + 8 * j; const LAS float* s = scr + (8 * c) * ST + n;
        v4u o; o.x = pk2(s[0 * ST], s[1 * ST]); o.y = pk2(s[2 * ST], s[3 * ST]); o.z = pk2(s[4 * ST], s[5 * ST]); o.w = pk2(s[6 * ST], s[7 * ST]);
        const int nn = n0 + n; const int r = (MODE == 0) ? nn : ((nn >> 7) * 256 + (nn & 127) + (MODE == 2 ? 128 : 0));
        *(GAS v4u*)(WT + (size_t)r * K + k0 + 8 * c) = o; }
    LDS_WAIT(); asm volatile("" ::: "memory");
}
__device__ __forceinline__ void cvt_flat(const float* src, bf16* dst, int n8, int gt, int NGT) {
    for (int i = gt; i < n8; i += NGT) { const f32x4 a = *(const GAS f32x4*)(src + (size_t)i * 8), b = *(const GAS f32x4*)(src + (size_t)i * 8 + 4);
        v4u o; o.x = pk2(a.x, a.y); o.y = pk2(a.z, a.w); o.z = pk2(b.x, b.y); o.w = pk2(b.z, b.w); *(GAS v4u*)(dst + (size_t)i * 8) = o; }
}
__device__ __forceinline__ unsigned pack_i8x4(f32x4 v, float inv) {
    const int a = (int)__builtin_rintf(v.x * inv), b = (int)__builtin_rintf(v.y * inv), c = (int)__builtin_rintf(v.z * inv), d = (int)__builtin_rintf(v.w * inv);
    return (unsigned)(a & 255) | ((unsigned)(b & 255) << 8) | ((unsigned)(c & 255) << 16) | ((unsigned)d << 24); }
__device__ __forceinline__ float wave_max(float v) {
#pragma unroll
    for (int o = 1; o < 64; o <<= 1) v = fmaxf(v, __shfl_xor(v, o));
    return v; }
__device__ __forceinline__ void quant_row_i8(const f32x4 (&v)[16], signed char* dst, float* sa, int lane) {
    float m = 0.f;
#pragma unroll
    for (int j = 0; j < 16; ++j) m = fmaxf(fmaxf(m, fmaxf(fabsf(v[j].x), fabsf(v[j].y))), fmaxf(fabsf(v[j].z), fabsf(v[j].w)));
    m = wave_max(m); const float inv = m > 0.f ? 127.f / m : 0.f;
    if (lane == 0) *sa = m * (1.f / 127.f);
#pragma unroll
    for (int j = 0; j < 16; ++j) ((GAS unsigned*)dst)[lane + 64 * j] = pack_i8x4(v[j], inv);
}
__device__ __forceinline__ int gu_row(int mode, int nn) { return mode == 0 ? nn : (nn >> 7) * 256 + (nn & 127) + (mode == 2 ? 128 : 0); }
__device__ __forceinline__ void p0_colmax_item(const float* W, int N, unsigned* cmax, int mode, int item, int lane) {
    const int nblk = N / 64, kb = item / nblk, nb = item - kb * nblk, k0 = 64 * kb, n0 = 64 * nb, lr = lane >> 4, lc = 4 * (lane & 15);
    f32x4 m = {0.f, 0.f, 0.f, 0.f};
#pragma unroll
    for (int i = 0; i < 16; ++i) { const f32x4 v = __builtin_nontemporal_load((const GAS f32x4*)(W + (size_t)(k0 + 4 * i + lr) * N + n0 + lc));
        m.x = fmaxf(m.x, fabsf(v.x)); m.y = fmaxf(m.y, fabsf(v.y)); m.z = fmaxf(m.z, fabsf(v.z)); m.w = fmaxf(m.w, fabsf(v.w)); }
    m.x = fmaxf(m.x, __shfl_xor(m.x, 16)); m.y = fmaxf(m.y, __shfl_xor(m.y, 16)); m.z = fmaxf(m.z, __shfl_xor(m.z, 16)); m.w = fmaxf(m.w, __shfl_xor(m.w, 16));
    m.x = fmaxf(m.x, __shfl_xor(m.x, 32)); m.y = fmaxf(m.y, __shfl_xor(m.y, 32)); m.z = fmaxf(m.z, __shfl_xor(m.z, 32)); m.w = fmaxf(m.w, __shfl_xor(m.w, 32));
    if (lane < 16) { const int r = gu_row(mode, n0 + lc);
        (void)__hip_atomic_fetch_max(cmax + r + 0, __float_as_uint(m.x), RLX_AGENT); (void)__hip_atomic_fetch_max(cmax + r + 1, __float_as_uint(m.y), RLX_AGENT);
        (void)__hip_atomic_fetch_max(cmax + r + 2, __float_as_uint(m.z), RLX_AGENT); (void)__hip_atomic_fetch_max(cmax + r + 3, __float_as_uint(m.w), RLX_AGENT); }
}
__device__ __forceinline__ void p0_quant_item(const float* W, int K, int N, signed char* WT, const unsigned* cmax, float* sB, int mode, LAS float* scr, int item, int lane) {
    const int nblk = N / 64, kb = item / nblk, nb = item - kb * nblk, k0 = 64 * kb, n0 = 64 * nb, lr = lane >> 4, lc = 4 * (lane & 15);
#pragma unroll
    for (int i = 0; i < 16; ++i) { const int kk = 4 * i + lr; const f32x4 v = __builtin_nontemporal_load((const GAS f32x4*)(W + (size_t)(k0 + kk) * N + n0 + lc));
        LAS float* s = scr + kk * 65 + lc; s[0] = v.x; s[1] = v.y; s[2] = v.z; s[3] = v.w; }
    LDS_WAIT(); asm volatile("" ::: "memory");
    const int r = gu_row(mode, n0 + lane); const float am = __uint_as_float(__hip_atomic_load(cmax + r, RLX_AGENT)), inv = am > 0.f ? 127.f / am : 0.f;
    if (kb == 0) sB[r] = am * (1.f / 127.f);
    const LAS float* s = scr + lane;
#pragma unroll
    for (int c = 0; c < 4; ++c) { v4u o;
        o.x = pack_i8x4((f32x4){s[(16 * c + 0) * 65], s[(16 * c + 1) * 65], s[(16 * c + 2) * 65], s[(16 * c + 3) * 65]}, inv); o.y = pack_i8x4((f32x4){s[(16 * c + 4) * 65], s[(16 * c + 5) * 65], s[(16 * c + 6) * 65], s[(16 * c + 7) * 65]}, inv);
        o.z = pack_i8x4((f32x4){s[(16 * c + 8) * 65], s[(16 * c + 9) * 65], s[(16 * c + 10) * 65], s[(16 * c + 11) * 65]}, inv); o.w = pack_i8x4((f32x4){s[(16 * c + 12) * 65], s[(16 * c + 13) * 65], s[(16 * c + 14) * 65], s[(16 * c + 15) * 65]}, inv);
        *(GAS v4u*)(WT + (size_t)r * K + k0 + 16 * c) = o; }
    LDS_WAIT(); asm volatile("" ::: "memory");
}
__device__ __forceinline__ void quant_h(Frame& F, const bf16* H, signed char* HQ, const unsigned* rmax, float* SH, int nrows) {
    const int gw = F.vcu * NWAVES + F.wave, NGW = F.G * NWAVES;
    for (int r = gw; r < nrows; r += NGW) {
        const GAS v4u* src = (const GAS v4u*)(H + (size_t)r * FF); GAS u32x2v* dst = (GAS u32x2v*)(HQ + (size_t)r * FF);
        unsigned mx = 0u;
#pragma unroll 4
        for (int c = F.lane; c < FF / 8; c += 64) { const v4u w = src[c]; const unsigned ww_[4] = {w.x, w.y, w.z, w.w};
#pragma unroll
            for (int k_ = 0; k_ < 4; ++k_) { const unsigned lo_ = (ww_[k_] << 16) & 0x7fff0000u, hi_ = ww_[k_] & 0x7fff0000u; mx = mx > lo_ ? mx : lo_; mx = mx > hi_ ? mx : hi_; } }
#pragma unroll
        for (int o = 1; o < 64; o <<= 1) { const unsigned t_ = (unsigned)__shfl_xor((int)mx, o); mx = mx > t_ ? mx : t_; }
        const float am = __uint_as_float(mx), inv = am > 0.f ? 127.f / am : 0.f;
        if (F.lane == 0) SH[r] = am * (1.f / 127.f);
#pragma unroll 4
        for (int c = F.lane; c < FF / 8; c += 64) { const v4u w = src[c]; u32x2v o;
            o.x = pack_i8x4((f32x4){bf2f(w.x & 0xffffu), bf2f(w.x >> 16), bf2f(w.y & 0xffffu), bf2f(w.y >> 16)}, inv); o.y = pack_i8x4((f32x4){bf2f(w.z & 0xffffu), bf2f(w.z >> 16), bf2f(w.w & 0xffffu), bf2f(w.w >> 16)}, inv);
            dst[c] = o; } }
}
constexpr int IT_GU = (D / 64) * (FF / 64), IT_IN = (D / 64) * (DIN / 32), IT_OUT = (D / 64) * (D / 64);
constexpr int Q_E1 = IT_GU  , Q_E2 = Q_E1 + IT_IN  , Q_E3 = Q_E2 + IT_OUT  , Q_E4 = Q_E3 + 2 * IT_GU  , Q_E5 = Q_E4 + IT_GU  ;
constexpr int QCH = 8;
constexpr int CW_QCTR = 2048, CW_DONE = 2112;
__device__ __forceinline__ void conv_item(const Ptrs& P, LAS float* scr, int q, int lane) {
    const float* wg = P.in[I_WG] + (size_t)D * FF; const float* wu = P.in[I_WU] + (size_t)D * FF; const float* wd = P.in[I_WD];
    if (q < Q_E1) p0_quant_item(wd, FF, D, (signed char*)P.Wd1, P.CMAXD, P.SBD1, 0, scr, q, lane);
    else if (q < Q_E2) p0_transpose_item<32, 0>(P.in[I_WIN], D, DIN, P.Win, scr, q - Q_E1, lane);
    else if (q < Q_E3) p0_transpose_item<64, 0>(P.in[I_WOUT], D, D, P.Wout, scr, q - Q_E2, lane);
    else if (q < Q_E3 + IT_GU) p0_quant_item(wg, D, FF, (signed char*)P.Wgu2, P.CMAX + NGU, P.SB2, 1, scr, q - Q_E3, lane);
    else if (q < Q_E4) p0_quant_item(wu, D, FF, (signed char*)P.Wgu2, P.CMAX + NGU, P.SB2, 2, scr, q - Q_E3 - IT_GU, lane);
    else p0_quant_item(wd + (size_t)D * FF, FF, D, (signed char*)P.Wd2, P.CMAXD + D, P.SBD2, 0, scr, q - Q_E4, lane);
}
__device__ __forceinline__ int q_take(Frame& F) { int i = 0; if (F.lane == 0) i = (int)__hip_atomic_fetch_add(F.ctl + CW_QCTR, (unsigned)QCH, RLX_AGENT); return __builtin_amdgcn_readfirstlane(i); }
__device__ __forceinline__ int q_head(Frame& F) { return (int)__builtin_amdgcn_readfirstlane(__hip_atomic_load(F.ctl + CW_QCTR, RLX_AGENT)); }
__device__ __forceinline__ void q_catch_up(Frame& F, const Ptrs& P, int E) {
    LAS float* scr = (LAS float*)(F.lds + RING_OFF + F.wave * 16640);
    for (;;) { if (q_head(F) >= E) break; const int i = q_take(F);
        for (int k = 0; k < QCH; ++k) if (i + k < Q_E5) conv_item(P, scr, i + k, F.lane); }
}
__device__ __forceinline__ void q_fill(Frame& F, const Ptrs& P, int ph) {
    LAS float* scr = (LAS float*)(F.lds + RING_OFF + F.wave * 16640);
    gu32* done = F.ctl + CW_DONE + 64 * ph;
    for (;;) {
        if ((int)__builtin_amdgcn_readfirstlane(__hip_atomic_load(done, RLX_AGENT)) >= F.G || q_head(F) >= Q_E5) break;
        const int i = q_take(F); if (i >= Q_E5) break;
        for (int k = 0; k < QCH; ++k) if (i + k < Q_E5) conv_item(P, scr, i + k, F.lane); }
}
__device__ __forceinline__ void sub_barrier(Frame& F, gu32* ctr, unsigned n) {
    asm volatile("s_waitcnt vmcnt(0) lgkmcnt(0)" ::: "memory"); __syncthreads();
    if (F.tid == 0) {
        __builtin_amdgcn_fence(__ATOMIC_RELEASE, "agent"); asm volatile("s_waitcnt vmcnt(0)" ::: "memory");
        (void)__hip_atomic_fetch_add(ctr, 1u, RLX_AGENT);
        unsigned sp = 0; while (__hip_atomic_load(ctr, RLX_AGENT) < n) { __builtin_amdgcn_s_sleep(2); if (++sp > (1u << 22)) { __hip_atomic_store(F.ctl + CW_TMO, 1u, RLX_AGENT); break; } }
        __builtin_amdgcn_fence(__ATOMIC_ACQUIRE, "agent"); asm volatile("s_waitcnt vmcnt(0)" ::: "memory");
    }
    __syncthreads();
}
constexpr int CW_SUB = 3072;
#define PHASE_DONE(ph) do { if (F.tid == 0) (void)__hip_atomic_fetch_add(F.ctl + CW_DONE + 64 * (ph), 1u, RLX_AGENT); } while (0)
__device__ __forceinline__ void p0_quant_wgu1(Frame& F, const Ptrs& P) {
    LAS float* scr = (LAS float*)(F.lds + RING_OFF + F.wave * 16640);
    const int gw = F.vcu * NWAVES + F.wave, NGW = F.G * NWAVES;
    for (int it = gw; it < 2 * IT_GU; it += NGW) {
        if (it < IT_GU) p0_quant_item(P.in[I_WG], D, FF, (signed char*)P.Wgu1, P.CMAX, P.SB1, 1, scr, it, F.lane);
        else p0_quant_item(P.in[I_WU], D, FF, (signed char*)P.Wgu1, P.CMAX, P.SB1, 2, scr, it - IT_GU, F.lane);
    }
}
__device__ __forceinline__ void p0_prologue(Frame& F, const Ptrs& P) {
    const int gw = F.vcu * NWAVES + F.wave, NGW = F.G * NWAVES;
    for (int it = gw; it < 4 * IT_GU; it += NGW) { const int mtx = it / IT_GU, r = it - mtx * IT_GU;
        p0_colmax_item((mtx & 1 ? P.in[I_WU] : P.in[I_WG]) + (size_t)(mtx >> 1) * D * FF, FF, P.CMAX + (mtx >> 1) * NGU, 1 + (mtx & 1), r, F.lane); }
    for (int it = gw; it < 2 * IT_GU; it += NGW) { const int mtx = it / IT_GU, r = it - mtx * IT_GU;
        p0_colmax_item(P.in[I_WD] + (size_t)mtx * D * FF, D, P.CMAXD + mtx * D, 0, r, F.lane); }
    for (int m = gw; m < M1V; m += NGW) {
        const float* src = m < ROW_S ? P.in[I_XP] + (size_t)m * D : (m < ROW_M ? P.in[I_XS] + (size_t)(m - ROW_S) * D : P.in[I_META] + (size_t)(m - ROW_M) * D);
        const GAS f32x4* xr = (const GAS f32x4*)src + F.lane; f32x4 v[16];
#pragma unroll
        for (int j = 0; j < 16; ++j) v[j] = xr[64 * j];
        quant_row_i8(v, P.XQ + (size_t)m * D, P.SA + m, F.lane);
    }
    const int gt = gw * 64 + F.lane, NGT = NGW * 64;
    for (int i = gt; i < NPOS * 64; i += NGT) { const int pos = i >> 6, k = i & 63;
        const double inv = exp2(-(double)k * (13.287712379549449 / 64.0)); const float ang = (float)((double)pos * inv);
        float s, c; sincosf(ang, &s, &c); ((GAS f32x2v*)P.ROPE)[i] = (f32x2v){c, s}; }
    cvt_flat(P.in[I_CMK], P.KB + (size_t)KVR_SMETA * KVW, NB_S * NMETA * KVW / 8, gt, NGT);
    cvt_flat(P.in[I_CMV], P.VB + (size_t)KVR_SMETA * KVW, NB_S * NMETA * KVW / 8, gt, NGT);
    cvt_flat(P.in[I_CWK], P.KB + (size_t)KVR_SWIN * KVW, NB_S * WIN * KVW / 8, gt, NGT);
    cvt_flat(P.in[I_CWV], P.VB + (size_t)KVR_SWIN * KVW, NB_S * WIN * KVW / 8, gt, NGT);
}

__device__ __forceinline__ void swiglu_combine(Frame& F, const pg8::SplitOrder& SO, const float* slab, bf16* H, const float* sA, const float* sB) {
    const int tid = F.tid, row = tid >> 4, c8 = (tid & 15) * 8;
    for (int it = blockIdx.x; it < SO.rem * 8; it += F.G) { const int ri = it >> 3, r0 = (it & 7) * 32 + row; pg8::Unit u; SO.map(SO.R * SO.G + ri, u);
        typedef int i32x4 __attribute__((ext_vector_type(4)));
        i32x4 ig0 = {0, 0, 0, 0}, ig1 = ig0, iu0 = ig0, iu1 = ig0;
        for (int s2 = 0; s2 < SO.S; ++s2) { const GAS i32x4* sp = (const GAS i32x4*)(slab + ((size_t)(ri * SO.S + s2) << 16) + r0 * 256 + c8);
            ig0 = ig0 + sp[0]; ig1 = ig1 + sp[1]; iu0 = iu0 + sp[32]; iu1 = iu1 + sp[33]; }
        const float sa = sA[u.pm * 256 + r0]; const float* sbp = sB + u.pn * 256 + c8;
        const f32x4 g0 = __builtin_convertvector(ig0, f32x4) * (*(const GAS f32x4*)(sbp) * sa), g1 = __builtin_convertvector(ig1, f32x4) * (*(const GAS f32x4*)(sbp + 4) * sa);
        const f32x4 u0 = __builtin_convertvector(iu0, f32x4) * (*(const GAS f32x4*)(sbp + 128) * sa), u1 = __builtin_convertvector(iu1, f32x4) * (*(const GAS f32x4*)(sbp + 132) * sa);
        v4u o; o.x = pkbf(silu1(g0.x) * u0.x, silu1(g0.y) * u0.y); o.y = pkbf(silu1(g0.z) * u0.z, silu1(g0.w) * u0.w);
        o.z = pkbf(silu1(g1.x) * u1.x, silu1(g1.y) * u1.y); o.w = pkbf(silu1(g1.z) * u1.z, silu1(g1.w) * u1.w);
        *(GAS v4u*)(H + (size_t)(u.pm * 256 + r0) * FF + u.pn * 128 + c8) = o; }
}
__device__ __forceinline__ void ln_phase(Frame& F, const bf16* Y, float* Xo, bf16* XN, const float* g, const float* b, int nrows, const pg8::SplitOrder& SO, const float* slab, float sscale, signed char* XQ, float* SA) {
    const int gw = F.vcu * NWAVES + F.wave, NGW = F.G * NWAVES;
    f32x4 gg_[16], bb_[16];
#pragma unroll
    for (int j = 0; j < 16; ++j) { gg_[j] = ((const GAS f32x4*)g)[F.lane + 64 * j]; bb_[j] = ((const GAS f32x4*)b)[F.lane + 64 * j]; }
    for (int r = gw; r < nrows; r += NGW) {
        const GAS u32x2v* yr = (const GAS u32x2v*)(Y + (size_t)r * D) + F.lane;
        f32x4 v[16];
#pragma unroll
        for (int j = 0; j < 16; ++j) { const u32x2v w_ = yr[64 * j]; v[j] = (f32x4){bf2f(w_.x & 0xffffu), bf2f(w_.x >> 16), bf2f(w_.y & 0xffffu), bf2f(w_.y >> 16)}; }
        if (SO.rem > 0 && SO.S > 1) { const int pm = r >> 8, rr = r & 255;
#pragma unroll
            for (int j = 0; j < 16; ++j) { const int ri = SO.inv(pm, j) - SO.R * SO.G;
                if (ri >= 0) { const GAS f32x4* sp = (const GAS f32x4*)(slab + ((size_t)(ri * (SO.S - 1)) << 16) + rr * 256) + F.lane; f32x4 a = sp[0];
                    for (int s2 = 1; s2 < SO.S - 1; ++s2) a = a + sp[(size_t)s2 << 14];
                    v[j] = v[j] + a * sscale; } } }
        float s = 0.f;
#pragma unroll
        for (int j = 0; j < 16; ++j) s += (v[j].x + v[j].y) + (v[j].z + v[j].w);
        const float mean = wave_sum(s) * (1.f / D); float s2 = 0.f;
#pragma unroll
        for (int j = 0; j < 16; ++j) { v[j] = v[j] - mean; s2 += (v[j].x * v[j].x + v[j].y * v[j].y) + (v[j].z * v[j].z + v[j].w * v[j].w); }
        const float rstd = 1.f / sqrtf(wave_sum(s2) * (1.f / D) + LN_EPS);
#pragma unroll
        for (int j = 0; j < 16; ++j) { const f32x4 gg = gg_[j], bb = bb_[j];
            const f32x4 o = v[j] * rstd * gg + bb; v[j] = o;
            if (Xo) ((GAS f32x4*)(Xo + (size_t)r * D))[F.lane + 64 * j] = o;
            if (XN) { u32x2v w; w.x = pk2(o.x, o.y); w.y = pk2(o.z, o.w); ((GAS u32x2v*)(XN + (size_t)r * D))[F.lane + 64 * j] = w; } }
        if (XQ) quant_row_i8(v, XQ + (size_t)r * D, SA + r, F.lane);
    }
}

__device__ __forceinline__ void kv_prep(Frame& F, const Ptrs& P) {
    const int gw = F.vcu * NWAVES + F.wave, NGW = F.G * NWAVES, lane = F.lane;
    const bf16* HIN = P.H;
    for (int r = gw; r < M1V; r += NGW) {
        int pos; float* kdst = nullptr; float* vdst = nullptr; int ncp = 1;
        if (r < ROW_S) { const int t = r & (SEQ_P - 1), b = r >> 11; pos = NMETA + t;
            if (t >= SEQ_P - WIN) { kdst = P.out + O_PWK + (size_t)(b * WIN + t - (SEQ_P - WIN)) * KVW; vdst = P.out + O_PWV + (size_t)(b * WIN + t - (SEQ_P - WIN)) * KVW; } }
        else if (r < ROW_M) { pos = NMETA + PAST + ((r - ROW_S) & (SEQ_S - 1)); kdst = P.out + O_SWK + (size_t)(r - ROW_S) * KVW; vdst = P.out + O_SWV + (size_t)(r - ROW_S) * KVW; }
        else { pos = r - ROW_M; kdst = P.out + O_PMK + (size_t)pos * KVW; vdst = P.out + O_PMV + (size_t)pos * KVW; ncp = NB_P; }
        const bf16* hrow = HIN + (size_t)r * DINP;
        const f32x2v cs = ((const GAS f32x2v*)P.ROPE)[pos * 64 + lane];
#pragma unroll
        for (int kh = 0; kh < KVH; ++kh) { const float x1 = bf2f(hrow[C_K + kh * HD + lane]), x2 = bf2f(hrow[C_K + kh * HD + 64 + lane]);
            const float o1 = x1 * cs.x - x2 * cs.y, o2 = x2 * cs.x + x1 * cs.y;
            P.KB[(size_t)r * KVW + kh * HD + lane] = (bf16)f2bf(o1); P.KB[(size_t)r * KVW + kh * HD + 64 + lane] = (bf16)f2bf(o2);
            if (kdst) for (int cp = 0; cp < ncp; ++cp) { kdst[(size_t)cp * NMETA * KVW + kh * HD + lane] = o1; kdst[(size_t)cp * NMETA * KVW + kh * HD + 64 + lane] = o2; } }
        const v4u vv = *(const GAS v4u*)(hrow + C_V + 8 * lane);
        *(GAS v4u*)(P.VB + (size_t)r * KVW + 8 * lane) = vv;
        if (vdst) { const f32x4 a = {bf2f(vv.x & 0xffffu), bf2f(vv.x >> 16), bf2f(vv.y & 0xffffu), bf2f(vv.y >> 16)}, c = {bf2f(vv.z & 0xffffu), bf2f(vv.z >> 16), bf2f(vv.w & 0xffffu), bf2f(vv.w >> 16)};
            for (int cp = 0; cp < ncp; ++cp) { *(GAS f32x4*)(vdst + (size_t)cp * NMETA * KVW + 8 * lane) = a; *(GAS f32x4*)(vdst + (size_t)cp * NMETA * KVW + 8 * lane + 4) = c; } }
    }
    for (int it = gw; it < (NB_P + NB_S) * 3 * (DCONV / 512); it += NGW) {
        const int part = it % (DCONV / 512), rj = it / (DCONV / 512), j = rj % 3, sb = rj / 3;
        const int srow = sb < NB_P ? sb * SEQ_P + SEQ_P - 3 + j : ROW_S + (sb - NB_P) * SEQ_S + SEQ_S - 3 + j;
        float* dst = (sb < NB_P ? P.out + O_PCONV + (size_t)(sb * 3 + j) * DCONV : P.out + O_SCONV + (size_t)((sb - NB_P) * 3 + j) * DCONV) + part * 512 + 8 * lane;
        const v4u vv = *(const GAS v4u*)(HIN + (size_t)srow * DINP + C_CONV + part * 512 + 8 * lane);
        *(GAS f32x4*)dst = (f32x4){bf2f(vv.x & 0xffffu), bf2f(vv.x >> 16), bf2f(vv.y & 0xffffu), bf2f(vv.y >> 16)};
        *(GAS f32x4*)(dst + 4) = (f32x4){bf2f(vv.z & 0xffffu), bf2f(vv.z >> 16), bf2f(vv.w & 0xffffu), bf2f(vv.w >> 16)};
    }
}

constexpr int PB_ST = 136;
constexpr int L_AT = 0, L_TAB = L_AT + 64 * 68 * 4, L_QKR = L_TAB + 12 * 256, L_QB = L_QKR + 64 * 68 * 4, L_KB = L_QB + 64 * PB_ST * 2, L_VB = L_KB + 64 * PB_ST * 2, L_XR = L_VB + 64 * PB_ST * 2, L_PREP_END = L_XR + 64 * 768;
static_assert(L_PREP_END <= RING_BYTES && (L_XR % 1024) == 0, "GDN prep LDS");
enum { T_BETA = 0, T_GC, T_EG, T_EK, T_RK2, T_RQ2, T_SU, T_SW, T_SKD, T_SQD, T_N };
struct PrepUnit { int kind, b, h, n, row0; };
__device__ __forceinline__ PrepUnit prep_decode(int uidx) {
    PrepUnit u; u.b = 0; u.n = 0;
    if (uidx < 2048) { u.kind = 0; u.b = uidx >> 9; u.h = (uidx >> 5) & 15; u.n = uidx & 31; u.row0 = u.b * SEQ_P + 64 * u.n; }
    else if (uidx < 2064) { u.kind = 1; u.h = uidx - 2048; u.row0 = ROW_M - 48; }
    else { u.kind = 2; u.b = (uidx - 2064) >> 4; u.h = (uidx - 2064) & 15; u.row0 = ROW_S + u.b * SEQ_S; }
    return u;
}
__device__ __forceinline__ float dpp_sum16(float p) {
    p += __builtin_bit_cast(float, __builtin_amdgcn_update_dpp(0, __builtin_bit_cast(int, p), 0xB1, 0xF, 0xF, true));
    p += __builtin_bit_cast(float, __builtin_amdgcn_update_dpp(0, __builtin_bit_cast(int, p), 0x4E, 0xF, 0xF, true));
    p += __builtin_bit_cast(float, __builtin_amdgcn_update_dpp(0, __builtin_bit_cast(int, p), 0x141, 0xF, 0xF, true));
    p += __builtin_bit_cast(float, __builtin_amdgcn_update_dpp(0, __builtin_bit_cast(int, p), 0x140, 0xF, 0xF, true));
    return p;
}
template <bool ISU> __device__ __forceinline__ void prep_solve(LAS float* AT, LAS float* TAB, LAS unsigned char* VB, LAS unsigned char* KB, LAS unsigned char* OUTW, unsigned char* ud, int tid) {
    const int cc = tid & 127; const LAS unsigned char* src = (ISU ? VB : KB) + cc * 2; const LAS float* sc = TAB + (ISU ? T_SU : T_SW) * 64;
    float* U = (float*)(ud + GU_U);
    const int cslot = (cc >> 5) * 4 + (kpos32(cc & 31) >> 3), cpos2 = (kpos32(cc & 31) & 7) * 2;
    float r[64];
#pragma unroll
    for (int i = 0; i < 64; ++i) r[i] = bf2f(*(const LAS unsigned short*)(src + i * (PB_ST * 2))) * sc[i];
    const LAS float* atp = AT;
#pragma unroll
    for (int j = 0; j < 64; ++j) { float sol = r[j]; asm volatile("" : "+v"(atp), "+v"(sol));
        if (ISU) U[j * 128 + cc] = sol; else *(LAS unsigned short*)(OUTW + j * 256 + ((cslot ^ (j & 15)) << 4) + cpos2) = (unsigned short)f2bf(sol);
#pragma unroll
        for (int q = (j + 1) / 4; q < 16; ++q) { const f32x4 a = *(const LAS f32x4*)(atp + j * 68 + 4 * q);
            if (4 * q + 0 > j) r[4 * q + 0] -= a.x * sol; if (4 * q + 1 > j) r[4 * q + 1] -= a.y * sol;
            if (4 * q + 2 > j) r[4 * q + 2] -= a.z * sol; if (4 * q + 3 > j) r[4 * q + 3] -= a.w * sol; }
        __builtin_amdgcn_sched_barrier(0); }
}
struct Solve2State { float r0[32], r1[32]; f32x4 a[2][8]; const LAS float* atp; float* U; LAS unsigned char* ow; int pi, cslot; };
template <bool ISU, int J> __device__ __forceinline__ void prep_solve2_step(Solve2State& st) {
    if constexpr (J < 64) {
        constexpr int pj = (J >> 2) & 1, kj = 4 * (J >> 3) + (J & 3);
        asm volatile("" : "+v"(st.atp), "+v"(st.r0[kj]));
        if constexpr (J + 1 < 64) {
#pragma unroll
            for (int kk = (J + 1) >> 3; kk < 8; ++kk) st.a[(J + 1) & 1][kk] = *(const LAS f32x4*)(st.atp + (J + 1) * 68 + 8 * kk); }
        const float m0 = st.r0[kj], m1 = st.r1[kj];
        const float o0 = __builtin_bit_cast(float, __builtin_amdgcn_update_dpp(0, __builtin_bit_cast(int, m0), 0xB1, 0xF, 0xF, true)), o1 = __builtin_bit_cast(float, __builtin_amdgcn_update_dpp(0, __builtin_bit_cast(int, m1), 0xB1, 0xF, 0xF, true));
        const float s0 = (st.pi == pj) ? m0 : o0, s1 = (st.pi == pj) ? m1 : o1;
        if (ISU) *(GAS f32x2v*)(st.U + J * 128) = (f32x2v){s0, s1}; else *(LAS unsigned*)(st.ow + J * 256 + ((st.cslot ^ (J & 15)) << 4)) = pkbf(s0, s1);
#pragma unroll
        for (int kk = J >> 3; kk < 8; ++kk) { const f32x4 av = st.a[J & 1][kk];
            st.r0[4 * kk + 0] -= av.x * s0; st.r0[4 * kk + 1] -= av.y * s0; st.r0[4 * kk + 2] -= av.z * s0; st.r0[4 * kk + 3] -= av.w * s0;
            st.r1[4 * kk + 0] -= av.x * s1; st.r1[4 * kk + 1] -= av.y * s1; st.r1[4 * kk + 2] -= av.z * s1; st.r1[4 * kk + 3] -= av.w * s1; }
        __builtin_amdgcn_sched_barrier(0);
        prep_solve2_step<ISU, J + 1>(st);
    }
}
template <bool ISU> __device__ __forceinline__ void prep_solve2(LAS float* AT, LAS float* TAB, LAS unsigned char* VB, LAS unsigned char* KB, LAS unsigned char* OUTW, unsigned char* ud, int tid) {
    Solve2State st; st.pi = tid & 1; const int c0 = (tid & 127) & ~1;
    const LAS unsigned char* src = (ISU ? VB : KB) + c0 * 2 + st.pi * (4 * PB_ST * 2); const LAS float* sc = TAB + (ISU ? T_SU : T_SW) * 64 + 4 * st.pi;
    st.U = (float*)(ud + GU_U) + c0; st.ow = OUTW + (kpos32(c0 & 31) & 7) * 2; st.cslot = (c0 >> 5) * 4 + (kpos32(c0 & 31) >> 3);
#pragma unroll
    for (int k = 0; k < 32; ++k) { const int rw = 8 * (k >> 2) + (k & 3); const unsigned w_ = *(const LAS unsigned*)(src + rw * (PB_ST * 2)); const float s_ = sc[rw]; st.r0[k] = bf2f(w_ & 0xffffu) * s_; st.r1[k] = bf2f(w_ >> 16) * s_; }
    st.atp = AT + 4 * st.pi;
#pragma unroll
    for (int kk = 0; kk < 8; ++kk) st.a[0][kk] = *(const LAS f32x4*)(st.atp + 8 * kk);
    prep_solve2_step<ISU, 0>(st);
}
#define PB_BAR() do { asm volatile("s_waitcnt lgkmcnt(0)" ::: "memory"); __builtin_amdgcn_s_barrier(); asm volatile("" ::: "memory"); } while (0)
__device__ __forceinline__ void gdn_prep_all(Frame& F, const Ptrs& P, int abl  ) {
    int tid_ = F.tid; asm volatile("" : "+v"(tid_));
    const int tid = tid_, wv = F.wave;
    LAS unsigned char* L = F.lds;
    LAS float* AT = (LAS float*)(L + L_AT); LAS float* TAB = (LAS float*)(L + L_TAB); LAS float* QKR = (LAS float*)(L + L_QKR);
    LAS unsigned char* QB = L + L_QB; LAS unsigned char* KB = L + L_KB; LAS unsigned char* VB = L + L_VB; LAS unsigned char* XR = L + L_XR; LAS unsigned char* OUTW = L + L_QKR;
    const bf16* HIN = P.H;
    const int part = wv >> 1, half = wv & 1;
    f32x2v cwn[4], hxn[3]; float bln = 0.f, aln = 0.f;
#define PB_PREFETCH(U) do { const PrepUnit& u_ = (U); int lane = tid; asm volatile("" : "+v"(lane)); lane &= 63; \
          \
        _Pragma("unroll") for (int k_ = 0; k_ < 6; ++k_) { const int p_ = (6 * wv + k_) * 64 + lane, t_ = p_ >> 4, r_ = (t_ * 171) >> 9, pt_ = t_ - 3 * r_; \
            const int rr_ = (u_.kind == 1 && r_ < 48) ? 48 : r_; \
            __builtin_amdgcn_global_load_lds((const GAS unsigned*)(HIN + (size_t)(u_.row0 + rr_) * DINP + C_CONV + pt_ * 2048 + u_.h * 128 + (p_ & 15) * 8), (LAS unsigned*)(XR + (6 * wv + k_) * 1024), 16, 0, 0); } \
        if (wv < 6) { const int ch_ = part * 2048 + u_.h * 128 + 2 * lane; const float* cw_ = P.in[I_CONVW] + ch_; \
            _Pragma("unroll") for (int j_ = 0; j_ < 4; ++j_) cwn[j_] = *(const GAS f32x2v*)(cw_ + j_ * DCONV); \
            _Pragma("unroll") for (int j_ = 0; j_ < 3; ++j_) hxn[j_] = (f32x2v){0.f, 0.f}; \
            if (half == 0) { \
                if (u_.kind == 0) { const int hr_ = (u_.n == 0) ? ROW_M + 13 : u_.row0 - 3; \
                    _Pragma("unroll") for (int j_ = 0; j_ < 3; ++j_) { const unsigned w_ = *(const GAS unsigned*)(HIN + (size_t)(hr_ + j_) * DINP + C_CONV + ch_); hxn[j_] = (f32x2v){bf2f(w_ & 0xffffu), bf2f(w_ >> 16)}; } } \
                else if (u_.kind == 2) { const float* sc_ = P.in[I_SCONV] + (size_t)u_.b * 3 * DCONV + ch_; \
                    _Pragma("unroll") for (int j_ = 0; j_ < 3; ++j_) hxn[j_] = *(const GAS f32x2v*)(sc_ + j_ * DCONV); } } } \
        else if (wv == 6) { const bf16* hr_ = HIN + (size_t)(u_.row0 + ((u_.kind == 1 && lane < 48) ? 48 : lane)) * DINP; bln = bf2f(hr_[C_B + u_.h]); aln = bf2f(hr_[C_A + u_.h]); } } while (0)
    int uidx = blockIdx.x;
    if (uidx >= N_GUNITS) return;
    PrepUnit un_ = prep_decode(uidx);
    PB_PREFETCH(un_);
    for (; uidx < N_GUNITS; uidx += F.G) {
        const PrepUnit u = prep_decode(uidx);
        unsigned char* ud = P.GDN + (size_t)uidx * GU_BYTES;
        asm volatile("s_waitcnt vmcnt(0) lgkmcnt(0)" ::: "memory"); __builtin_amdgcn_s_barrier(); asm volatile("" ::: "memory");
        f32x2v cw[4], hx[3]; float bl = bln, al = aln;
#pragma unroll
        for (int j = 0; j < 4; ++j) cw[j] = cwn[j];
#pragma unroll
        for (int j = 0; j < 3; ++j) hx[j] = hxn[j];
        asm volatile("" : "+v"(cw[0]), "+v"(cw[1]), "+v"(cw[2]), "+v"(cw[3]), "+v"(hx[0]), "+v"(hx[1]), "+v"(hx[2]), "+v"(bl), "+v"(al));
        { int tl_ = tid; asm volatile("" : "+v"(tl_)); const int lane = tl_ & 63;
        if (wv < 6) {
            const LAS unsigned char* xr = XR + part * 256 + lane * 4; LAS unsigned char* dst = (part == 0 ? QB : (part == 1 ? KB : VB)) + lane * 4;
            const int i0 = 32 * half;
            f32x2v xm3 = hx[0], xm2 = hx[1], xm1 = hx[2];
            if (half == 1) { const unsigned a_ = *(const LAS unsigned*)(xr + 29 * 768), b_ = *(const LAS unsigned*)(xr + 30 * 768), c_ = *(const LAS unsigned*)(xr + 31 * 768);
                xm3 = (f32x2v){bf2f(a_ & 0xffffu), bf2f(a_ >> 16)}; xm2 = (f32x2v){bf2f(b_ & 0xffffu), bf2f(b_ >> 16)}; xm1 = (f32x2v){bf2f(c_ & 0xffffu), bf2f(c_ >> 16)};
                if (u.kind == 1) { xm3 = (f32x2v){0.f, 0.f}; xm2 = xm3; xm1 = xm3; } }
#pragma unroll 8
            for (int ii = 0; ii < 32; ++ii) { const int i = i0 + ii; const unsigned w_ = *(const LAS unsigned*)(xr + i * 768);
                f32x2v x = (f32x2v){bf2f(w_ & 0xffffu), bf2f(w_ >> 16)};
                if (u.kind == 1 && i < 48) x = (f32x2v){0.f, 0.f};
                const f32x2v y = cw[0] * xm3 + cw[1] * xm2 + cw[2] * xm1 + cw[3] * x;
                *(LAS unsigned*)(dst + i * (PB_ST * 2)) = pkbf(silu1(y.x), silu1(y.y)); xm3 = xm2; xm2 = xm1; xm1 = x; }
        } else if (wv == 6) {
            float be = 0.f, g = 0.f;
            if (!(u.kind == 1 && lane < 48)) { be = 1.f / (1.f + expf(-bl)); const float x = al + P.in[I_DTB][u.h]; const float sp = fmaxf(x, 0.f) + log1pf(expf(-fabsf(x))); g = -expf(P.in[I_ALOG][u.h]) * sp; }
            float v = g;
#pragma unroll
            for (int o = 1; o < 64; o <<= 1) { const float t = __shfl_up(v, o); if (lane >= o) v += t; }
            const float last = __shfl(v, 63);
            TAB[T_BETA * 64 + lane] = be; TAB[T_GC * 64 + lane] = v; TAB[T_EG * 64 + lane] = expf(v); TAB[T_EK * 64 + lane] = expf(last - v);
        } }
        PB_BAR();
        if (uidx + F.G < N_GUNITS) { un_ = prep_decode(uidx + F.G); PB_PREFETCH(un_); }
        __builtin_amdgcn_sched_barrier(0);
        if (!(abl & 4)) { int tl_ = tid; asm volatile("" : "+v"(tl_)); const int lane = tl_ & 63, c16 = lane & 15, q4 = lane >> 4;
#pragma unroll
        for (int tk = 0; tk < 3; ++tk) { const int task = wv + 8 * tk;
            int rb, cb; const LAS unsigned char *Ap, *Bp;
            if (task < 20) { const int t10 = task < 10 ? task : task - 10; int a = 0, b = t10;
                if (b >= 1) { a = 1; b -= 1; if (b >= 2) { a = 2; b -= 2; if (b >= 3) { a = 3; b -= 3; } } }
                if (task < 10) { rb = a; cb = b; Ap = KB; Bp = KB; } else { rb = b; cb = a; Ap = KB; Bp = QB; } }
            else { rb = task - 20; cb = rb; Ap = QB; Bp = QB; }
            f32x4 acc = {0.f, 0.f, 0.f, 0.f};
#pragma unroll
            for (int s = 0; s < 4; ++s) { const bf16x8 A = *(const LAS bf16x8*)(Ap + (16 * rb + c16) * (PB_ST * 2) + 64 * s + 16 * q4), B = *(const LAS bf16x8*)(Bp + (16 * cb + c16) * (PB_ST * 2) + 64 * s + 16 * q4);
                acc = __builtin_amdgcn_mfma_f32_16x16x32_bf16(A, B, acc, 0, 0, 0); }
            if (task < 10) { *(LAS f32x4*)(AT + (16 * cb + c16) * 68 + 16 * rb + 4 * q4) = acc;
                if (rb == cb) {
#pragma unroll
                    for (int r = 0; r < 4; ++r) if (c16 == 4 * q4 + r) TAB[T_RK2 * 64 + 16 * rb + c16] = acc[r]; } }
            else if (task < 20) { *(LAS f32x4*)(QKR + (16 * cb + c16) * 68 + 16 * rb + 4 * q4) = acc; }
            else {
#pragma unroll
                for (int r = 0; r < 4; ++r) if (c16 == 4 * q4 + r) TAB[T_RQ2 * 64 + 16 * rb + c16] = acc[r]; }
        } }
        PB_BAR();
        if (!(abl & 4)) { int tid = tid_; asm volatile("" : "+v"(tid));
        { const int j = tid >> 3, i8 = (tid & 7) * 8;
            const float rkj = rsqrtf(TAB[T_RK2 * 64 + j] + RMS_EPS), gcj = TAB[T_GC * 64 + j];
#pragma unroll
            for (int e = 0; e < 8; ++e) { const int i = i8 + e; const float v = AT[j * 68 + i];
                const float sc = TAB[T_BETA * 64 + i] * rsqrtf(TAB[T_RK2 * 64 + i] + RMS_EPS) * rkj * expf(fminf(TAB[T_GC * 64 + i] - gcj, 0.f));
                AT[j * 68 + i] = (i > j) ? v * sc : 0.f; } }
        { const int i = tid >> 3, sl = tid & 7, g = sl >> 2, qq = sl & 3;
            const float rqi = rsqrtf(TAB[T_RQ2 * 64 + i] + RMS_EPS) * 0.08838834764831845f, gci = TAB[T_GC * 64 + i];
            float v[8];
#pragma unroll
            for (int e = 0; e < 8; ++e) { const int j = 32 * g + 4 * qq + (e & 3) + 16 * (e >> 2); const float raw = QKR[i * 68 + j];
                v[e] = (i >= j) ? raw * rqi * rsqrtf(TAB[T_RK2 * 64 + j] + RMS_EPS) * expf(fminf(gci - TAB[T_GC * 64 + j], 0.f)) : 0.f; }
            v4u o; o.x = pkbf(v[0], v[1]); o.y = pkbf(v[2], v[3]); o.z = pkbf(v[4], v[5]); o.w = pkbf(v[6], v[7]);
            *(GAS v4u*)(ud + GU_QK + i * 128 + ((sl ^ ((i >> 1) & 7)) * 16)) = o; }
        if (tid < 64) { const int i = tid; const float rk = rsqrtf(TAB[T_RK2 * 64 + i] + RMS_EPS), rq = rsqrtf(TAB[T_RQ2 * 64 + i] + RMS_EPS) * 0.08838834764831845f, be = TAB[T_BETA * 64 + i], eg = TAB[T_EG * 64 + i];
            TAB[T_SU * 64 + i] = be; TAB[T_SW * 64 + i] = be * eg * rk; TAB[T_SKD * 64 + i] = TAB[T_EK * 64 + i] * rk; TAB[T_SQD * 64 + i] = eg * rq;
            if (i == 63) *(GAS float*)(ud + GU_GL) = eg; } }
        PB_BAR();
        { int tid = tid_; asm volatile("" : "+v"(tid)); const int lane = tid & 63, c16 = lane & 15, q4 = lane >> 4;
        if (tid < 128) { if (!(abl & 1)) prep_solve2<true>(AT, TAB, VB, KB, OUTW, ud, tid); }
        else if (tid < 256) { if (!(abl & 1)) prep_solve2<false>(AT, TAB, VB, KB, OUTW, ud, tid); }
        else if (!(abl & 2)) {
            const int t = tid - 256;
#pragma unroll
            for (int k = 0; k < 4; ++k) { const int id = t + 256 * k, i = id >> 4, sl = id & 15, g = sl >> 2, qq = sl & 3; const float sc = TAB[T_SQD * 64 + i];
                const u32x2v lo = *(const LAS u32x2v*)(QB + i * (PB_ST * 2) + (32 * g + 4 * qq) * 2), hi = *(const LAS u32x2v*)(QB + i * (PB_ST * 2) + (32 * g + 16 + 4 * qq) * 2);
                v4u o; o.x = pkbf(bf2f(lo.x & 0xffffu) * sc, bf2f(lo.x >> 16) * sc); o.y = pkbf(bf2f(lo.y & 0xffffu) * sc, bf2f(lo.y >> 16) * sc);
                o.z = pkbf(bf2f(hi.x & 0xffffu) * sc, bf2f(hi.x >> 16) * sc); o.w = pkbf(bf2f(hi.y & 0xffffu) * sc, bf2f(hi.y >> 16) * sc);
                *(GAS v4u*)(ud + GU_QD + i * 256 + ((sl ^ (i & 15)) * 16)) = o; }
            const int w4 = wv - 4;
#pragma unroll
            for (int k = 0; k < 4; ++k) { const int task = w4 * 4 + k, db = task >> 1, g = task & 1;
                const int addr = (int)(size_t)KB + (32 * g + 4 * q4 + ((lane & 15) >> 2)) * (PB_ST * 2) + (16 * db + 4 * (lane & 3)) * 2;
                const f32x4 s0 = *(const LAS f32x4*)(TAB + T_SKD * 64 + 32 * g + 4 * q4), s1 = *(const LAS f32x4*)(TAB + T_SKD * 64 + 32 * g + 16 + 4 * q4);
                s16x4 lo, hi;
                asm volatile("ds_read_b64_tr_b16 %0, %2\n\tds_read_b64_tr_b16 %1, %2 offset:4352\n\ts_waitcnt lgkmcnt(0)" : "=&v"(lo), "=&v"(hi) : "v"(addr) : "memory");
                v4u o; o.x = pkbf(bf2f((unsigned short)lo[0]) * s0.x, bf2f((unsigned short)lo[1]) * s0.y); o.y = pkbf(bf2f((unsigned short)lo[2]) * s0.z, bf2f((unsigned short)lo[3]) * s0.w);
                o.z = pkbf(bf2f((unsigned short)hi[0]) * s1.x, bf2f((unsigned short)hi[1]) * s1.y); o.w = pkbf(bf2f((unsigned short)hi[2]) * s1.z, bf2f((unsigned short)hi[3]) * s1.w);
                const int d = 16 * db + c16;
                *(GAS v4u*)(ud + GU_KDT + d * 128 + (((4 * g + q4) ^ ((d >> 1) & 7)) * 16)) = o; }
        } }
        PB_BAR();
        if (!(abl & 1)) { int tid = tid_; asm volatile("" : "+v"(tid));
#pragma unroll
        for (int k = 0; k < 2; ++k) { const int o16 = (tid + 512 * k) * 16; *(GAS v4u*)(ud + GU_W + o16) = *(const LAS v4u*)(OUTW + o16); } }
    }
    asm volatile("s_waitcnt vmcnt(0) lgkmcnt(0)" ::: "memory"); __syncthreads();
#undef PB_PREFETCH
}
#undef PB_BAR

typedef float f32x16 __attribute__((ext_vector_type(16)));
#define KSWZ(row, colB) ((row) * 256 + ((colB) ^ (((row) & 7) << 4)))
#define SBAR() __builtin_amdgcn_sched_barrier(0)
__device__ __forceinline__ int crow(int r, int hi) { return (r & 3) + 8 * (r >> 2) + 4 * hi; }
__device__ __forceinline__ unsigned cvtpk(float lo, float hi) { unsigned r; asm volatile("v_cvt_pk_bf16_f32 %0, %1, %2" : "=v"(r) : "v"(lo), "v"(hi)); return r; }
__device__ __forceinline__ void qkt(f32x16& p0, f32x16& p1, const LAS unsigned char* Ks, const bf16x8* qr, int r32, int hi) {
    p0 = f32x16{}; p1 = f32x16{};
#pragma unroll
    for (int d0 = 0; d0 < 8; ++d0) { const int cb = (d0 * 16 + hi * 8) * 2;
        const bf16x8 b0 = *(const LAS bf16x8*)(Ks + KSWZ(r32, cb)), b1 = *(const LAS bf16x8*)(Ks + KSWZ(32 + r32, cb));
        p0 = __builtin_amdgcn_mfma_f32_32x32x16_bf16(b0, qr[d0], p0, 0, 0, 0);
        p1 = __builtin_amdgcn_mfma_f32_32x32x16_bf16(b1, qr[d0], p1, 0, 0, 0); }
}
__device__ __forceinline__ int v_st(int k, int c) { const int kk = (k & ~0xC) | ((k & 4) << 1) | ((k & 8) >> 1); return ((kk >> 3) * 4 + (c >> 5)) * 512 + ((kk & 7) * 32 + (c & 31)) * 2; }
__device__ __forceinline__ int v_rd_base(int lane) { return ((lane & 3) << 3) | (((lane >> 2) & 3) << 6) | (((lane >> 4) & 1) << 5) | (((lane >> 5) & 1) << 8); }
constexpr int v_rd_off(int d0, int ks, int half) { return d0 * 512 + ks * 4096 + half * 2048; }
template <int OFF> __device__ __forceinline__ s16x4 tr_read(int vb) { s16x4 r; asm volatile("ds_read_b64_tr_b16 %0, %1 offset:%2" : "=&v"(r) : "v"(vb), "i"(OFF) : "memory"); return r; }
template <int D0> __device__ __forceinline__ void pv_one(f32x16& od, int vb, bf16x8 pa0, bf16x8 pa1, bf16x8 pa2, bf16x8 pa3) {
    const s16x4 l0 = tr_read<v_rd_off(D0, 0, 0)>(vb), h0 = tr_read<v_rd_off(D0, 0, 1)>(vb), l1 = tr_read<v_rd_off(D0, 1, 0)>(vb), h1 = tr_read<v_rd_off(D0, 1, 1)>(vb);
    const s16x4 l2 = tr_read<v_rd_off(D0, 2, 0)>(vb), h2 = tr_read<v_rd_off(D0, 2, 1)>(vb), l3 = tr_read<v_rd_off(D0, 3, 0)>(vb), h3 = tr_read<v_rd_off(D0, 3, 1)>(vb);
    asm volatile("s_waitcnt lgkmcnt(0)" ::: "memory"); SBAR();
#define PK(L, H) (bf16x8){L[0], L[1], L[2], L[3], H[0], H[1], H[2], H[3]}
    od = __builtin_amdgcn_mfma_f32_32x32x16_bf16(pa0, PK(l0, h0), od, 0, 0, 0);
    od = __builtin_amdgcn_mfma_f32_32x32x16_bf16(pa1, PK(l1, h1), od, 0, 0, 0);
    od = __builtin_amdgcn_mfma_f32_32x32x16_bf16(pa2, PK(l2, h2), od, 0, 0, 0);
    od = __builtin_amdgcn_mfma_f32_32x32x16_bf16(pa3, PK(l3, h3), od, 0, 0, 0);
#undef PK
}
constexpr int ATT_V = 0, ATT_K = 16384, ATT_WS = 32768;
__device__ __forceinline__ void attn_unit(Frame& F, const Ptrs& P, int a) {
    constexpr float SCALE = 0.088388347648318440f, C = SCALE * 1.4426950408889634f;
    int tid_ = F.tid; asm volatile("" : "+v"(tid_));
    const int tid = tid_, wid = F.wave, lane = tid & 63, r32 = lane & 31, hi = lane >> 5;
    const bool isp = a < 512; const int kvh = a & 3, ab = isp ? (a >> 7) : ((a - 512) >> 2), ac = isp ? ((a >> 2) & 31) : 0;
    const int qrow0 = isp ? ab * SEQ_P + 64 * ac : ROW_S + ab * SEQ_S, pos0 = isp ? NMETA + 64 * ac : NMETA + PAST;
    LAS unsigned char* V_lds = F.lds + ATT_V; LAS unsigned char* K_lds = F.lds + ATT_K;
    LAS float* ws = (LAS float*)(F.lds + ATT_WS) + wid * 64; LAS float* li_l = ws; LAS float* al_l = ws + 32;
    const int g = wid >> 1, qoff = 32 * (wid & 1), hq = kvh * 4 + g;
    bf16x8 qr[8];
    { const bf16* qp = P.H + (size_t)(qrow0 + qoff + r32) * DINP + C_Q + hq * HD + hi * 8; const GAS f32x2v* cs = (const GAS f32x2v*)P.ROPE + (size_t)(pos0 + qoff + r32) * 64 + hi * 8;
#pragma unroll
        for (int d0 = 0; d0 < 4; ++d0) { const v4u lo = *(const GAS v4u*)(qp + d0 * 16), hh = *(const GAS v4u*)(qp + 64 + d0 * 16);
            const unsigned lw[4] = {lo.x, lo.y, lo.z, lo.w}, hw[4] = {hh.x, hh.y, hh.z, hh.w}; unsigned o1[4], o2[4];
#pragma unroll
            for (int j = 0; j < 4; ++j) { const f32x2v c0 = cs[d0 * 16 + 2 * j], c1 = cs[d0 * 16 + 2 * j + 1];
                const float a0 = bf2f(lw[j] & 0xffffu), a1 = bf2f(lw[j] >> 16), b0 = bf2f(hw[j] & 0xffffu), b1 = bf2f(hw[j] >> 16);
                o1[j] = cvtpk(a0 * c0.x - b0 * c0.y, a1 * c1.x - b1 * c1.y); o2[j] = cvtpk(b0 * c0.x + a0 * c0.y, b1 * c1.x + a1 * c1.y); }
            const v4u w1 = {o1[0], o1[1], o1[2], o1[3]}, w2 = {o2[0], o2[1], o2[2], o2[3]};
            qr[d0] = __builtin_bit_cast(bf16x8, w1); qr[d0 + 4] = __builtin_bit_cast(bf16x8, w2); } }
    float m_reg = -1e30f, l_reg = 0.f; f32x16 o[4] = {};
    const int sr = tid >> 4, sc = (tid & 15) * 8, vst0 = v_st(sr, sc), vst1 = v_st(32 + sr, sc);
    const int vb0 = (int)(size_t)V_lds + v_rd_base(lane);
    const int tmin = isp ? (ac >= 2 ? 1 : 3 - ac) : 1;
#define ATT_KROW(t) ((t) == 0 ? (isp ? ROW_M : KVR_SMETA + ab * NMETA) : (isp ? ab * SEQ_P + 64 * (ac - 3 + (t)) : ((t) == 3 ? ROW_S + ab * SEQ_S : KVR_SWIN + ab * WIN + 64 * ((t) - 1))))
#define ATT_LOAD(t) do { const int ra_ = ((t) == 0) ? (sr & 15) : sr, rb_ = ((t) == 0) ? (sr & 15) : 32 + sr;     \
        const bf16* kp_ = P.KB + (size_t)ATT_KROW(t) * KVW + kvh * HD + sc; const bf16* vp_ = P.VB + (size_t)ATT_KROW(t) * KVW + kvh * HD + sc; \
        nk0 = *(const GAS v4u*)(kp_ + (size_t)ra_ * KVW); nk1 = *(const GAS v4u*)(kp_ + (size_t)rb_ * KVW); nv0 = *(const GAS v4u*)(vp_ + (size_t)ra_ * KVW); nv1 = *(const GAS v4u*)(vp_ + (size_t)rb_ * KVW); } while (0)
    v4u nk0, nk1, nv0, nv1; ATT_LOAD(0);
#pragma unroll
    for (int t = 0; t < 4; ++t) {
        const bool kval_t = (t == 0) || (t >= tmin);
        if (kval_t) {
        const v4u k0 = nk0, k1 = nk1, v0 = nv0, v1 = nv1;
        __syncthreads();
        *(LAS v4u*)(V_lds + vst0) = v0; *(LAS v4u*)(V_lds + vst1) = v1; *(LAS v4u*)(K_lds + KSWZ(sr, sc * 2)) = k0; *(LAS v4u*)(K_lds + KSWZ(32 + sr, sc * 2)) = k1;
        __syncthreads();
        { const int nt_ = (t == 0) ? tmin : t + 1; if (nt_ <= 3) { if (nt_ == 1) ATT_LOAD(1); else if (nt_ == 2) ATT_LOAD(2); else ATT_LOAD(3); } }
        f32x16 p0, p1; qkt(p0, p1, K_lds, qr, r32, hi);
        if (t == 0) {
#pragma unroll
            for (int r = 8; r < 16; ++r) p0[r] = -INFINITY;
#pragma unroll
            for (int r = 0; r < 16; ++r) p1[r] = -INFINITY; }
        float pmax = p0[0];
#pragma unroll
        for (int r = 1; r < 16; ++r) pmax = fmaxf(pmax, p0[r]);
#pragma unroll
        for (int r = 0; r < 16; ++r) pmax = fmaxf(pmax, p1[r]);
        { auto rr = __builtin_amdgcn_permlane32_swap(__float_as_uint(pmax), __float_as_uint(pmax), false, false); pmax = fmaxf(__uint_as_float(rr[0]), __uint_as_float(rr[1])); }
        const float mn = fmaxf(m_reg, pmax), alpha = __builtin_amdgcn_exp2f((m_reg - mn) * C), mnC = -mn * C; m_reg = mn;
        float ps = 0.f;
#pragma unroll
        for (int r = 0; r < 16; ++r) { p0[r] = __builtin_amdgcn_exp2f(fmaf(p0[r], C, mnC)); p1[r] = __builtin_amdgcn_exp2f(fmaf(p1[r], C, mnC)); ps += p0[r] + p1[r]; }
        { auto rr = __builtin_amdgcn_permlane32_swap(__float_as_uint(ps), __float_as_uint(ps), false, false); ps = __uint_as_float(rr[0]) + __uint_as_float(rr[1]); }
        l_reg = l_reg * alpha + ps;
        if (hi == 0) al_l[r32] = alpha;
        asm volatile("s_waitcnt lgkmcnt(0)" ::: "memory");
#pragma unroll
        for (int d = 0; d < 4; ++d)
#pragma unroll
            for (int r = 0; r < 16; ++r) o[d][r] *= al_l[crow(r, hi)];
        bf16x8 pa0, pa1, pa2, pa3;
#define PK4(Pv, BASE, OUT) do { unsigned a0 = cvtpk(Pv[BASE + 0], Pv[BASE + 1]), a1 = cvtpk(Pv[BASE + 2], Pv[BASE + 3]);   \
    unsigned b0 = cvtpk(Pv[BASE + 4], Pv[BASE + 5]), b1 = cvtpk(Pv[BASE + 6], Pv[BASE + 7]);                              \
    auto r0 = __builtin_amdgcn_permlane32_swap(a0, b0, false, false); auto r1 = __builtin_amdgcn_permlane32_swap(a1, b1, false, false); \
    v4u w = {r0[0], r1[0], r0[1], r1[1]}; OUT = __builtin_bit_cast(bf16x8, w); } while (0)
        PK4(p0, 0, pa0); PK4(p0, 8, pa1); PK4(p1, 0, pa2); PK4(p1, 8, pa3);
#undef PK4
        SBAR();
        pv_one<0>(o[0], vb0, pa0, pa1, pa2, pa3); pv_one<1>(o[1], vb0, pa0, pa1, pa2, pa3); pv_one<2>(o[2], vb0, pa0, pa1, pa2, pa3); pv_one<3>(o[3], vb0, pa0, pa1, pa2, pa3);
        }
    }
#undef ATT_KROW
#undef ATT_LOAD
    l_reg += __builtin_amdgcn_exp2f(P.in[I_SINK][hq] * 1.4426950408889634f - m_reg * C);
    if (hi == 0) li_l[r32] = l_reg;
    asm volatile("s_waitcnt lgkmcnt(0)" ::: "memory");
    bf16* Ow = P.MIX + (size_t)(qrow0 + qoff) * D + hq * HD;
#pragma unroll
    for (int r = 0; r < 16; ++r) { const int orow = crow(r, hi); const float rl = __builtin_amdgcn_rcpf(li_l[orow]);
#pragma unroll
        for (int d0 = 0; d0 < 4; ++d0) Ow[(size_t)orow * D + d0 * 32 + r32] = (bf16)f2bf(o[d0][r] * rl); }
    __syncthreads();
}

typedef const GAS unsigned char* gcp;
template <class T> __device__ __forceinline__ T ldg_u(gcp ubase, unsigned voff) { return *(const GAS T*)(ubase + voff); }
constexpr int SC_ABUF = 57344, SC_SSQ_OFF = 2 * SC_ABUF;
template <int MODE  > __device__ __forceinline__ void gdn_scan_seq(Frame& F, const Ptrs& P, int kind  , int b, int h) {
    int lane_ = F.lane; asm volatile("" : "+v"(lane_));
    const int w = F.wave, lane = lane_, c16 = lane & 15, q4 = lane >> 4;
    LAS float* SSQ = (LAS float*)(F.lds + SC_SSQ_OFF);
    const unsigned ecol = (unsigned)(16 * w + c16);
    const unsigned voU = (unsigned)(q4 * 2048) + ecol * 4u;
    const unsigned voZ = (unsigned)(q4 * 4 * DINP * 2) + ecol * 2u;
    const unsigned voM = (unsigned)(q4 * 4 * D * 2) + ecol * 2u;
    unsigned fo256[4], fo128[2];
#pragma unroll
    for (int s = 0; s < 4; ++s) fo256[s] = (unsigned)(c16 * 256 + (((4 * s + q4) ^ c16) * 16));
#pragma unroll
    for (int s = 0; s < 2; ++s) fo128[s] = (unsigned)(c16 * 128 + (((4 * s + q4) ^ ((c16 >> 1) & 7)) * 16));
    const unsigned dma_lane = (unsigned)(w * 7168 + lane * 16);
    f32x4 S[8];
    if (kind == 2) { gcp s0 = (gcp)(P.in[I_SGDN] + (size_t)(b * NHG + h) * 128 * 128);
#pragma unroll
        for (int db = 0; db < 8; ++db)
#pragma unroll
            for (int r = 0; r < 4; ++r) S[db][r] = ldg_u<float>(s0 + db * 8192, voU + r * 512); }
    else {
#pragma unroll
        for (int db = 0; db < 8; ++db) S[db] = (f32x4){0.f, 0.f, 0.f, 0.f}; }
    const int nsteps = kind == 0 ? 33 : 1;
    const float nw = P.in[I_NORMW][ecol];
    const int seq = b * NHG + h;
#define SC_UD(t) ((gcp)(P.GDN + (size_t)(kind == 2 ? 2064 + seq : ((t) == 0 ? 2048 + h : seq * 32 + (t) - 1)) * GU_BYTES))
#define SC_ROW0(t) (kind == 0 ? b * SEQ_P + 64 * ((t) - 1) : ROW_S + b * SEQ_S)
#define SC_DMA(ud, buf) do { _Pragma("unroll") for (int _i = 0; _i < 7; ++_i) \
        __builtin_amdgcn_global_load_lds((const GAS unsigned*)((ud) + GU_W + dma_lane + _i * 1024), (LAS unsigned*)(F.lds + (buf) * SC_ABUF + w * 7168 + _i * 1024), 16, 0, 0); } while (0)
    float un[4][4], gln; unsigned zn[4][4];
#define SC_PREFETCH(udp) do { gln = *(const GAS float*)((udp) + GU_GL); \
        _Pragma("unroll") for (int m = 0; m < 4; ++m) _Pragma("unroll") for (int r = 0; r < 4; ++r) un[m][r] = ldg_u<float>((udp) + GU_U + m * 8192, voU + r * 512); } while (0)
#define SC_LD256(dst, off, m0) do { _Pragma("unroll") for (int mm = 0; mm < 2; ++mm) _Pragma("unroll") for (int s = 0; s < 4; ++s) dst[mm * 4 + s] = *(const LAS bf16x8*)(img + (off) + ((m0) + mm) * 4096 + fo256[s]); } while (0)
#define SC_LD128(dst, off, r0) do { _Pragma("unroll") for (int rr = 0; rr < 4; ++rr) _Pragma("unroll") for (int s = 0; s < 2; ++s) dst[rr * 2 + s] = *(const LAS bf16x8*)(img + (off) + ((r0) + rr) * 2048 + fo128[s]); } while (0)
#define SC_SCHED __builtin_amdgcn_sched_barrier(0)
#define SC_EPI(t, ov, zv) do { const LAS float* sq_ = SSQ + ((t) & 1) * 512; GAS unsigned char* mb_ = (GAS unsigned char*)((MODE == 0 ? P.MIX : P.XN) + (size_t)SC_ROW0(t) * D + 2048 + h * 128); \
        _Pragma("unroll") for (int m = 0; m < 4; ++m) _Pragma("unroll") for (int r = 0; r < 4; ++r) { const int i_ = 16 * m + 4 * q4 + r; \
            const f32x4 t0_ = *(const LAS f32x4*)(sq_ + i_ * 8), t1_ = *(const LAS f32x4*)(sq_ + i_ * 8 + 4); const float tot_ = ((t0_.x + t0_.y) + (t0_.z + t0_.w)) + ((t1_.x + t1_.y) + (t1_.z + t1_.w)); \
            const float rstd_ = rsqrtf(tot_ * (1.f / 128.f) + RMS_EPS); \
            *(GAS unsigned short*)(mb_ + (16 * m + r) * (D * 2) + voM) = (unsigned short)f2bf(ov[m][r] * rstd_ * nw * silu1(bf2f(zv[m][r]))); } } while (0)
    { gcp ud0 = SC_UD(0); if (MODE != 1) { SC_DMA(ud0, 0); } SC_PREFETCH(ud0); }
#pragma unroll
    for (int m = 0; m < 4; ++m)
#pragma unroll
        for (int r = 0; r < 4; ++r) zn[m][r] = 0u;
    f32x4 op[4]; unsigned zp[4][4];
#pragma unroll
    for (int m = 0; m < 4; ++m) { op[m] = (f32x4){0.f, 0.f, 0.f, 0.f};
#pragma unroll
        for (int r = 0; r < 4; ++r) zp[m][r] = 0u; }
    for (int step = 0; step < nsteps; ++step) {
        const bool has_out = !(kind == 0 && step == 0), prev_out = step > 0 && !(kind == 0 && step == 1);
        asm volatile("s_waitcnt vmcnt(0) lgkmcnt(0)" ::: "memory"); __builtin_amdgcn_s_barrier(); asm volatile("" ::: "memory");
        float uc[4][4], gl = gln;
#pragma unroll
        for (int m = 0; m < 4; ++m) {
#pragma unroll
            for (int r = 0; r < 4; ++r) { uc[m][r] = un[m][r]; zp[m][r] = zn[m][r]; }
            asm volatile("" : "+v"(uc[m][0]), "+v"(uc[m][1]), "+v"(uc[m][2]), "+v"(uc[m][3]), "+v"(zp[m][0]), "+v"(zp[m][1]), "+v"(zp[m][2]), "+v"(zp[m][3])); }
        asm volatile("" : "+v"(gl));
        SC_SCHED;
        if (has_out && MODE != 1) { gcp zb_ = (gcp)(P.H + (size_t)SC_ROW0(step) * DINP + C_Z + h * 128);
#pragma unroll
            for (int m = 0; m < 4; ++m)
#pragma unroll
                for (int r = 0; r < 4; ++r) zn[m][r] = ldg_u<unsigned short>(zb_ + (16 * m + r) * (DINP * 2), voZ); }
        if (step + 1 < nsteps && MODE != 1) { gcp udn = SC_UD(step + 1); SC_DMA(udn, (step + 1) & 1); SC_PREFETCH(udn); }
        SC_SCHED;
        if (prev_out) SC_EPI(step - 1, op, zp);
        SC_SCHED;
        if (MODE != 2) {
        const LAS unsigned char* img = F.lds + (step & 1) * SC_ABUF;
        bf16x8 X[8], Y[8];
        SC_LD256(X, GU_W - GU_W, 0); SC_LD256(Y, GU_W - GU_W, 2); SC_SCHED;
        bf16x8 Bs[4];
#pragma unroll
        for (int s = 0; s < 4; ++s) { const v4u t = {pkbf(S[2 * s][0], S[2 * s][1]), pkbf(S[2 * s][2], S[2 * s][3]), pkbf(S[2 * s + 1][0], S[2 * s + 1][1]), pkbf(S[2 * s + 1][2], S[2 * s + 1][3])}; Bs[s] = __builtin_bit_cast(bf16x8, t); }
        f32x4 vn[4], o[4];
#pragma unroll
        for (int mm = 0; mm < 2; ++mm) { f32x4 acc = {0.f, 0.f, 0.f, 0.f};
#pragma unroll
            for (int s = 0; s < 4; ++s) acc = __builtin_amdgcn_mfma_f32_16x16x32_bf16(X[mm * 4 + s], Bs[s], acc, 0, 0, 0);
#pragma unroll
            for (int r = 0; r < 4; ++r) vn[mm][r] = uc[mm][r] - acc[r]; }
        SC_SCHED; SC_LD256(X, GU_QD - GU_W, 0); SC_SCHED;
#pragma unroll
        for (int mm = 0; mm < 2; ++mm) { f32x4 acc = {0.f, 0.f, 0.f, 0.f};
#pragma unroll
            for (int s = 0; s < 4; ++s) acc = __builtin_amdgcn_mfma_f32_16x16x32_bf16(Y[mm * 4 + s], Bs[s], acc, 0, 0, 0);
#pragma unroll
            for (int r = 0; r < 4; ++r) vn[2 + mm][r] = uc[2 + mm][r] - acc[r]; }
        SC_SCHED; SC_LD256(Y, GU_QD - GU_W, 2); SC_SCHED;
        bf16x8 Bv[2];
#pragma unroll
        for (int s = 0; s < 2; ++s) { const v4u t = {pkbf(vn[2 * s][0], vn[2 * s][1]), pkbf(vn[2 * s][2], vn[2 * s][3]), pkbf(vn[2 * s + 1][0], vn[2 * s + 1][1]), pkbf(vn[2 * s + 1][2], vn[2 * s + 1][3])}; Bv[s] = __builtin_bit_cast(bf16x8, t); }
#pragma unroll
        for (int mm = 0; mm < 2; ++mm) { f32x4 acc = {0.f, 0.f, 0.f, 0.f};
#pragma unroll
            for (int s = 0; s < 4; ++s) acc = __builtin_amdgcn_mfma_f32_16x16x32_bf16(X[mm * 4 + s], Bs[s], acc, 0, 0, 0);
            o[mm] = acc; }
        SC_SCHED; SC_LD128(X, GU_KDT - GU_W, 0); SC_SCHED;
#pragma unroll
        for (int mm = 0; mm < 2; ++mm) { f32x4 acc = {0.f, 0.f, 0.f, 0.f};
#pragma unroll
            for (int s = 0; s < 4; ++s) acc = __builtin_amdgcn_mfma_f32_16x16x32_bf16(Y[mm * 4 + s], Bs[s], acc, 0, 0, 0);
            o[2 + mm] = acc; }
        SC_SCHED; SC_LD128(Y, GU_KDT - GU_W, 4); SC_SCHED;
#pragma unroll
        for (int rr = 0; rr < 4; ++rr) { f32x4 acc = S[rr] * gl;
#pragma unroll
            for (int s = 0; s < 2; ++s) acc = __builtin_amdgcn_mfma_f32_16x16x32_bf16(X[rr * 2 + s], Bv[s], acc, 0, 0, 0);
            S[rr] = acc; }
        SC_SCHED; SC_LD128(X, GU_QK - GU_W, 0); SC_SCHED;
#pragma unroll
        for (int rr = 0; rr < 4; ++rr) { f32x4 acc = S[4 + rr] * gl;
#pragma unroll
            for (int s = 0; s < 2; ++s) acc = __builtin_amdgcn_mfma_f32_16x16x32_bf16(Y[rr * 2 + s], Bv[s], acc, 0, 0, 0);
            S[4 + rr] = acc; }
        SC_SCHED;
#pragma unroll
        for (int m = 0; m < 4; ++m)
#pragma unroll
            for (int s = 0; s < 2; ++s) o[m] = __builtin_amdgcn_mfma_f32_16x16x32_bf16(X[m * 2 + s], Bv[s], o[m], 0, 0, 0);
        if (has_out) { LAS float* sq = SSQ + (step & 1) * 512;
#pragma unroll
            for (int m = 0; m < 4; ++m)
#pragma unroll
                for (int r = 0; r < 4; ++r) { float p = o[m][r] * o[m][r];
                    p += __builtin_bit_cast(float, __builtin_amdgcn_update_dpp(0, __builtin_bit_cast(int, p), 0xB1, 0xF, 0xF, true));
                    p += __builtin_bit_cast(float, __builtin_amdgcn_update_dpp(0, __builtin_bit_cast(int, p), 0x4E, 0xF, 0xF, true));
                    p += __builtin_bit_cast(float, __builtin_amdgcn_update_dpp(0, __builtin_bit_cast(int, p), 0x141, 0xF, 0xF, true));
                    p += __builtin_bit_cast(float, __builtin_amdgcn_update_dpp(0, __builtin_bit_cast(int, p), 0x140, 0xF, 0xF, true));
                    if (c16 == 0) sq[(16 * m + 4 * q4 + r) * 8 + w] = p; op[m][r] = o[m][r]; } }
            }
    }
    asm volatile("s_waitcnt vmcnt(0) lgkmcnt(0)" ::: "memory"); __builtin_amdgcn_s_barrier(); asm volatile("" ::: "memory");
    { const int t = nsteps - 1;
#pragma unroll
      for (int m = 0; m < 4; ++m) {
#pragma unroll
        for (int r = 0; r < 4; ++r) zp[m][r] = zn[m][r]; }
      if (!(kind == 0 && t == 0)) SC_EPI(t, op, zp); }
#undef SC_PREFETCH
#undef SC_LD256
#undef SC_LD128
#undef SC_SCHED
#undef SC_EPI
#undef SC_UD
#undef SC_ROW0
#undef SC_DMA
    GAS unsigned char* dst = (GAS unsigned char*)((MODE != 0 ? (float*)(P.GDN + (size_t)N_GUNITS * GU_BYTES) : (kind == 0 ? P.out + O_PGDN : P.out + O_SGDN)) + (size_t)(b * NHG + h) * 128 * 128);
#pragma unroll
    for (int db = 0; db < 8; ++db)
#pragma unroll
        for (int r = 0; r < 4; ++r) *(GAS float*)(dst + db * 8192 + (voU + r * 512)) = S[db][r];
    asm volatile("s_waitcnt vmcnt(0) lgkmcnt(0)" ::: "memory"); __syncthreads();
}

#ifndef SPLIT_P1
#define SPLIT_P1 2
#endif
#ifndef SPLIT_P9
#define SPLIT_P9 8
#endif
#ifndef SPLIT_P2
#define SPLIT_P2 3
#endif
#ifndef SPLIT_P7
#define SPLIT_P7 4
#endif
#ifndef SPLIT_P10
#define SPLIT_P10 4
#endif
struct Args { const float* in[N_IN]; float* out; unsigned char* ws; int ph_lo, ph_hi, li, pad; };
static_assert(sizeof(Args) == (N_IN + 2) * 8 + 16, "Args has no padding");
__global__ void __launch_bounds__(NWAVES * 64, 2) fwd_kernel(Args args) {
    extern __shared__ __attribute__((aligned(16))) unsigned char lds[];
    Frame F;
    F.lds = (LAS unsigned char*)lds;
    F.MISC = (volatile LAS unsigned*)(F.lds + MISC_OFF);
    F.tid = threadIdx.x; F.lane = F.tid & 63; F.wave = __builtin_amdgcn_readfirstlane(F.tid >> 6);
    F.G = gridDim.x; { const int bx = blockIdx.x; F.vcu = (F.G % 8 == 0) ? (bx % 8) * (F.G / 8) + bx / 8 : bx; }
    unsigned char* ws = args.ws;
    F.ctl = (gu32*)(ws + WS_CTL);
    Ptrs P;
#pragma unroll
    for (int i = 0; i < N_IN; ++i) P.in[i] = args.in[i];
    P.out = args.out;
    P.Wgu1 = (bf16*)(ws + WS_WGU1); P.Wd1 = (bf16*)(ws + WS_WD1); P.Wgu2 = (bf16*)(ws + WS_WGU2); P.Wd2 = (bf16*)(ws + WS_WD2); P.Win = (bf16*)(ws + WS_WIN); P.Wout = (bf16*)(ws + WS_WOUT);
    P.XN = (bf16*)(ws + WS_XN); P.MIX = (bf16*)(ws + WS_MIX); P.H = (bf16*)(ws + WS_H); P.KB = (bf16*)(ws + WS_KB); P.VB = (bf16*)(ws + WS_VB);
    P.Y = (float*)(ws + WS_Y); P.ROPE = (float*)(ws + WS_ROPE); P.GDN = ws + WS_GDN; P.SLAB = (float*)(ws + WS_SLAB); P.XQ = (signed char*)(ws + WS_XQ); P.SA = (float*)(ws + WS_SA); P.SB1 = (float*)(ws + WS_SB); P.SB2 = (float*)(ws + WS_SB + AL((size_t)NGU * 4)); P.CMAX = (unsigned*)(ws + WS_CTL) + CW_CMAX; P.HQ = (signed char*)(ws + WS_HQ); P.SH = (float*)(ws + WS_SH); P.SBD1 = (float*)(ws + WS_SBD); P.SBD2 = (float*)(ws + WS_SBD + AL((size_t)D * 4)); P.CMAXD = (unsigned*)(ws + WS_CTL) + CW_CMAXD; P.RMAX = (unsigned*)(ws + WS_CTL) + CW_RMAX;
    for (int u = F.tid; u < (LDS_BYTES - LDSCTL_OFF) / 4; u += NWAVES * 64) ((LAS unsigned*)(F.lds + LDSCTL_OFF))[u] = 0u;
    __syncthreads();
    XcdBarrier bar; bar.bar = (unsigned*)(F.ctl + CW_BAR) + args.li * XCD_BAR_WORDS; bar.x = 0; bar.st = nullptr;
    if (N_LAUNCHES == 1) bar = xcd_barrier_post((unsigned*)(F.ctl + CW_BAR) + args.li * XCD_BAR_WORDS, F.MISC + 8);
#define GRID_BAR() do { if (N_LAUNCHES == 1) xcd_barrier(bar); } while (0)
    const int lo = args.ph_lo, hi = args.ph_hi;
#define IN(k) (lo <= (k) && (k) < hi)
#define BOTH(k) (IN(k) && IN((k) + 1))

#ifndef PROBE_REPEAT
#define PROBE_REPEAT 0
#endif
#define REP(k) (((PROBE_REPEAT >> (k)) & 1) ? 2 : 1)
    if (IN(0)) { p0_prologue(F, P); GRID_BAR(); p0_quant_wgu1(F, P); if (BOTH(0)) GRID_BAR(); }
    if (IN(1)) { pg8::Gemm g{(const pg8::bf16_t*)P.XQ, (const pg8::bf16_t*)P.Wgu1, M1, NGU, D / 2}; pg8::StaticOrder S; S.init(M1, NGU, D / 2, F.G, (int)blockIdx.x);
        pg8::EpiSwiGLU<true> E{P.H, FF, P.SLAB, 1, P.SA, P.SB1, nullptr};
        pg8::gemm_phase<pg8::EpiSwiGLU<true>, pg8::StaticOrder, true, true, true>(F.lds + RING_OFF, g, S, E);
        PHASE_DONE(1); q_fill(F, P, 1); q_catch_up(F, P, Q_E1);
        GRID_BAR(); quant_h(F, P.H, P.HQ, P.RMAX, P.SH, M1V);
        if (BOTH(1)) GRID_BAR(); }
    if (IN(2)) { pg8::Gemm g{(const pg8::bf16_t*)P.HQ, (const pg8::bf16_t*)P.Wd1, M1, D, FF / 2}; pg8::SplitOrder S; S.init(M1, D, FF / 2, F.G, (int)blockIdx.x, SPLIT_P2);
        typedef pg8::EpiResF32<0, true, false, true, true> Epi; Epi E{P.Y, D, pg8::RowSrc<0>{P.in[I_XP], P.in[I_XS], P.in[I_META], ROW_S, ROW_M, M1V, D}, P.SLAB, SPLIT_P2, P.SH, P.SBD1};
        pg8::gemm_phase<Epi, pg8::SplitOrder, true, true, true>(F.lds + RING_OFF, g, S, E);
        PHASE_DONE(2); q_fill(F, P, 2); q_catch_up(F, P, Q_E2);
        if (BOTH(2)) GRID_BAR(); }
    if (IN(3)) { pg8::SplitOrder SO; SO.init(M1, D, FF / 2, F.G, 0, SPLIT_P2); ln_phase(F, (const bf16*)P.Y, nullptr, P.XN, P.in[I_LNG], P.in[I_LNB], M1V, SO, P.SLAB, 0.5f, nullptr, nullptr); q_catch_up(F, P, Q_E2); if (BOTH(3)) GRID_BAR(); }
    if (IN(4)) { pg8::Gemm g{P.XN, P.Win, M1, DINP, D}; pg8::StaticOrder S; S.init(M1, DINP, D, F.G, (int)blockIdx.x);
        pg8::EpiStoreBf16 E{P.H, DINP};
        pg8::gemm_phase<pg8::EpiStoreBf16, pg8::StaticOrder, true, true>(F.lds + RING_OFF, g, S, E);
        PHASE_DONE(4); q_fill(F, P, 4);
        if (BOTH(4)) GRID_BAR(); }
#ifndef PROBE_ABL5
#define PROBE_ABL5 0
#endif
    if (IN(5)) { for (int rep = 0; rep < REP(5); ++rep) { const int abl = (args.li == 1) ? PROBE_ABL5 : 0;
        if (!(abl & 8)) kv_prep(F, P);
        gdn_prep_all(F, P, abl);
        q_catch_up(F, P, Q_E3);
        if (BOTH(5)) GRID_BAR(); } }
    if (IN(6)) {
        int it = blockIdx.x, st = (it < 64) ? (1 << 20) : F.G - 64;
        for (; it < 896; it += st) {
            if (it < 320) { const int s = it < 64 ? it : it - 64; gdn_scan_seq<0>(F, P, it < 64 ? 0 : 2, s >> 4, s & 15); }
            else attn_unit(F, P, it - 320);
        }
        if ((int)blockIdx.x >= 64) {
            sub_barrier(F, F.ctl + CW_SUB, (unsigned)(F.G - 64));
            pg8::Gemm g{P.MIX, P.Wout, M2, D, D}; pg8::StaticOrder S; S.init(M2, D, D, F.G - 64, (int)blockIdx.x - 64); S.set_k(0, 32);
            typedef pg8::EpiResF32<1, false, false, false, true> Epi; Epi E{P.Y, D, pg8::RowSrc<1>{(const float*)P.XN, (const float*)P.XN, (const float*)P.XN, M2, M2, M2, D}, P.SLAB, 1, nullptr, nullptr};
            pg8::gemm_phase<Epi, pg8::StaticOrder, true, true>(F.lds + RING_OFF, g, S, E);
        }
        PHASE_DONE(6); q_fill(F, P, 6);
        if (BOTH(6)) GRID_BAR(); }
    if (IN(7)) {
        pg8::Gemm g{P.MIX, P.Wout, M2, D, D}; pg8::SplitOrder S; S.init(M2, D, D, F.G, (int)blockIdx.x, SPLIT_P7); S.set_k(32, 32);
        typedef pg8::EpiResF32<1, false, true, false, true> Epi; Epi E{P.Y, D, pg8::RowSrc<1>{P.Y, P.Y, P.Y, M2, M2, M2, D}, P.SLAB, SPLIT_P7, nullptr, nullptr};
        pg8::gemm_phase<Epi, pg8::SplitOrder, true, true>(F.lds + RING_OFF, g, S, E);
        PHASE_DONE(7); q_fill(F, P, 7);
        if (BOTH(7)) GRID_BAR(); }
    if (IN(8)) { pg8::SplitOrder SO; SO.init(M2, D, D, F.G, 0, SPLIT_P7); ln_phase(F, (const bf16*)P.Y, nullptr, P.XN, P.in[I_LNG] + D, P.in[I_LNB] + D, M2, SO, P.SLAB, 1.0f, P.XQ, P.SA); q_catch_up(F, P, Q_E4); if (BOTH(8)) GRID_BAR(); }
    if (IN(9)) { pg8::Gemm g{(const pg8::bf16_t*)P.XQ, (const pg8::bf16_t*)P.Wgu2, M2, NGU, D / 2}; pg8::StaticOrder S; S.init(M2, NGU, D / 2, F.G, (int)blockIdx.x);
        pg8::EpiSwiGLU<true> E{P.H, FF, P.SLAB, 1, P.SA, P.SB2, nullptr};
        pg8::gemm_phase<pg8::EpiSwiGLU<true>, pg8::StaticOrder, true, true, true>(F.lds + RING_OFF, g, S, E);
        PHASE_DONE(9); q_fill(F, P, 9); q_catch_up(F, P, Q_E5);
        GRID_BAR(); quant_h(F, P.H, P.HQ, P.RMAX + M1, P.SH, M2);
        if (BOTH(9)) GRID_BAR(); }
    if (IN(10)) { pg8::Gemm g{(const pg8::bf16_t*)P.HQ, (const pg8::bf16_t*)P.Wd2, M2, D, FF / 2}; pg8::SplitOrder S; S.init(M2, D, FF / 2, F.G, (int)blockIdx.x, SPLIT_P10);
        typedef pg8::EpiResF32<1, true, false, true, true> Epi; Epi E{P.Y, D, pg8::RowSrc<1>{(const float*)P.XN, (const float*)P.XN, (const float*)P.XN, M2, M2, M2, D}, P.SLAB, SPLIT_P10, P.SH, P.SBD2};
        pg8::gemm_phase<Epi, pg8::SplitOrder, true, true, true>(F.lds + RING_OFF, g, S, E);
        if (BOTH(10)) GRID_BAR(); }
    if (IN(11)) { for (int rep = 0; rep < REP(11); ++rep) { pg8::SplitOrder SO; SO.init(M2, D, FF / 2, F.G, 0, SPLIT_P10); ln_phase(F, (const bf16*)P.Y, P.out + O_YP, nullptr, P.in[I_LNG] + 2 * D, P.in[I_LNB] + 2 * D, M2, SO, P.SLAB, 0.5f, nullptr, nullptr); if (rep + 1 < REP(11)) GRID_BAR(); } }
#undef IN
#undef BOTH
#undef GRID_BAR
}

extern "C" void kernel_launch(void* const* d_in, const int* in_sizes, int n_in, void* d_out, int out_size, void* d_ws, size_t ws_size, hipStream_t stream) {
    static int grid = 0;
    if (grid == 0) {
        if (n_in != N_IN || in_sizes[I_XP] != ROW_S * D || in_sizes[I_WIN] != D * DIN || (size_t)out_size != O_END || ws_size < WS_END) {
            fprintf(stderr, "kernel_launch: shape mismatch: n_in %d in0 %d out %d ws %zu (need %zu); nothing launched\n", n_in, n_in > 0 ? in_sizes[0] : -1, out_size, ws_size, (size_t)WS_END); grid = -1; return; }
        int dev = 0, cus = 0, per_cu = 0;
        if (hipGetDevice(&dev) != hipSuccess || hipDeviceGetAttribute(&cus, hipDeviceAttributeMultiprocessorCount, dev) != hipSuccess) { fprintf(stderr, "kernel_launch: device query failed\n"); grid = -1; return; }
        if (hipFuncSetAttribute((const void*)fwd_kernel, hipFuncAttributeMaxDynamicSharedMemorySize, LDS_BYTES) != hipSuccess) { fprintf(stderr, "kernel_launch: hipFuncSetAttribute failed\n"); grid = -1; return; }
        if (hipOccupancyMaxActiveBlocksPerMultiprocessor(&per_cu, (const void*)fwd_kernel, NWAVES * 64, LDS_BYTES) != hipSuccess || per_cu < 1)
            fprintf(stderr, "kernel_launch: note: occupancy query reports %d workgroups per CU\n", per_cu);
        (void)hipGetLastError();
        if (cus <= 64) { fprintf(stderr, "kernel_launch: %d CUs: this program needs more than 64 workgroups (64 of them run the GDN scans while the others start w_out); nothing launched\n", cus); grid = -1; return; }
        grid = cus;
    }
    if (grid < 0) return;
    if (hipMemsetAsync((char*)d_ws + WS_CTL, 0, CTL_ZERO_BYTES, stream) != hipSuccess) { fprintf(stderr, "kernel_launch: hipMemsetAsync failed\n"); return; }
    Args a{};
    for (int i = 0; i < N_IN; ++i) a.in[i] = (const float*)d_in[i];
    a.out = (float*)d_out; a.ws = (unsigned char*)d_ws;
#ifndef PROBE_PLAN
#define PROBE_PLAN {0, N_PHASES}
#endif
    const int plan[][2] = { PROBE_PLAN }; const int n_plan = (N_LAUNCHES == 1) ? (int)(sizeof(plan) / sizeof(plan[0])) : N_LAUNCHES;
    for (int li = 0; li < n_plan; ++li) {
        a.ph_lo = (N_LAUNCHES == 1) ? plan[li][0] : li; a.ph_hi = (N_LAUNCHES == 1) ? plan[li][1] : li + 1; a.li = (N_LAUNCHES == 1) ? li : 0;
        hipLaunchKernelGGL(fwd_kernel, dim3(grid), dim3(NWAVES * 64), LDS_BYTES, stream, a);
        const hipError_t le = hipPeekAtLastError();
        if (le != hipSuccess) { fprintf(stderr, "kernel_launch: launch %d failed: %s\n", li, hipGetErrorName(le)); break; }
    }
}
```

```cpp
#include <hip/hip_runtime.h>
#include <cstdio>
#include <cstdint>
namespace pg8 {
#define PG8_LAS __attribute__((address_space(3)))
typedef unsigned short bf16_t;
typedef short bf16x8 __attribute__((ext_vector_type(8)));
typedef float f32x4 __attribute__((ext_vector_type(4)));
typedef unsigned u32x4 __attribute__((ext_vector_type(4)));
typedef int i32x4 __attribute__((ext_vector_type(4)));
constexpr int BM = 256, BK = 64, HALF = 128, HTB = HALF * BK * 2  , STAGE_BYTES = 8 * HTB, NXCD = 8, WGM = 8;

__host__ __device__ __forceinline__ int lds_byte(int r, int c) { const int st = (r >> 4) * 2 + (c >> 5), rr = r & 15, cc = c & 31, ob = rr * 64 + cc * 2; return st * 1024 + (ob ^ (((ob >> 9) & 1) << 5)); }
__host__ __device__ __forceinline__ void stage_rc(int b, int& R, int& C) { const int st = b / 1024, sb = b % 1024, swz = sb ^ (((sb >> 9) & 1) << 5); R = (st >> 1) * 16 + swz / 64; C = (st & 1) * 32 + (swz % 64) / 2; }
__host__ __device__ __forceinline__ int perm32(int rho) { const int n = rho >> 4, i = rho & 15; return 8 * (i >> 2) + 4 * n + (i & 3); }

struct Unit { int pm, pn, k0, nt, sl, ri; };
struct Gemm { const bf16_t* A; const bf16_t* Bt; int M, N, K; };

struct StaticOrder {
    int nM, nN, nwg, G, c, ntk, kb;
    __host__ __device__ void init(int M, int N, int K, int G_, int c_) { nM = M / BM; nN = N / BM; nwg = nM * nN; G = G_; c = c_; ntk = K / BK; kb = 0; }
    __host__ __device__ void set_k(int kb_, int ntk_) { kb = kb_; ntk = ntk_; }
    __host__ __device__ void map(int L, Unit& u) const {
        int wgid = L; { const int q = nwg / NXCD, r = nwg % NXCD, xcd = wgid % NXCD, off = wgid / NXCD; wgid = (xcd < r ? xcd * (q + 1) : r * (q + 1) + (xcd - r) * q) + off; }
        const int nig = WGM * nN, gid = wgid / nig, fm = gid * WGM, gsz = (nM - fm) < WGM ? (nM - fm) : WGM;
        u.pm = fm + ((wgid % nig) % gsz); u.pn = (wgid % nig) / gsz; }
    __host__ __device__ int inv(int pm, int pn) const {
        const int nig = WGM * nN, gid = pm / WGM, fm = gid * WGM, gsz = (nM - fm) < WGM ? (nM - fm) : WGM; const int w = gid * nig + pn * gsz + (pm - fm);
        const int q = nwg / NXCD, r = nwg % NXCD; int xcd, off;
        if (w < r * (q + 1)) { xcd = w / (q + 1); off = w - xcd * (q + 1); } else { const int w2 = w - r * (q + 1); const int t = w2 / q; xcd = r + t; off = w2 - t * q; }
        return off * NXCD + xcd; }
    __host__ __device__ bool next(int i, Unit& u) const {
        const long L = (long)i * G + c; if (L >= nwg) return false;
        map((int)L, u); u.k0 = kb; u.nt = ntk; u.sl = 0; u.ri = -1; return true;
    }
    __device__ __forceinline__ void a_ready(const Unit&) const {}
    __device__ __forceinline__ void done(const Unit&) const {}
};
struct SplitOrder : StaticOrder {
    int R, rem, S;
    __host__ __device__ void init(int M, int N, int K, int G_, int c_, int S_) { StaticOrder::init(M, N, K, G_, c_); R = nwg / G; rem = nwg - R * G; S = S_; }
    __host__ __device__ bool next(int i, Unit& u) const {
        if (i < R) { map(i * G + c, u); u.k0 = kb; u.nt = ntk; u.sl = 0; u.ri = -1; return true; }
        const int j = (i - R) * G + c; if (j >= rem * S) return false;
        const int ri = j / S, s = j - ri * S, h = ntk / 2; map(R * G + ri, u);
        const int o0 = 2 * ((h * s) / S); u.k0 = kb + o0; u.nt = 2 * ((h * (s + 1)) / S) - o0; u.sl = s; u.ri = ri; return true;
    }
};

__device__ __forceinline__ unsigned cvt_pk_bf16(float lo, float hi) { unsigned r; asm volatile("v_cvt_pk_bf16_f32 %0, %1, %2" : "=v"(r) : "v"(lo), "v"(hi)); return r; }
typedef float f32x2 __attribute__((ext_vector_type(2)));
__device__ __forceinline__ float silu_f(float g) { return g * __builtin_amdgcn_rcpf(1.0f + __builtin_amdgcn_exp2f(-1.4426950408889634f * g)); }
template <bool I8> struct EpiSwiGLU {
    static constexpr bool PERM = true, AFTER_DRAIN = false;
    bf16_t* O; int ldc; float* slab; int S; const float *sA, *sB; unsigned* rmax;
    __device__ __forceinline__ void operator()(const f32x4 (&acc)[2][2][4][2], const Unit& u, int wr, int wc, int fr, int fq) const {
        if (u.ri >= 0) { float* sb = slab + ((size_t)(u.ri * S + u.sl) << 16) + wc * 32 + 8 * fq;
#pragma unroll
            for (int ai = 0; ai < 2; ++ai)
#pragma unroll
                for (int m = 0; m < 4; ++m) { float* o = sb + (ai * HALF + wr * 64 + m * 16 + fr) * BM;
#pragma unroll
                    for (int bj = 0; bj < 2; ++bj)
#pragma unroll
                        for (int n = 0; n < 2; ++n) *(f32x4*)(o + bj * HALF + 4 * n) = acc[ai][bj][m][n]; }
            return; }
        const int row0 = u.pm * BM + wr * 64 + fr, col0 = u.pn * HALF + wc * 32 + 8 * fq;
        f32x4 sbg0 = {1.f, 1.f, 1.f, 1.f}, sbg1 = sbg0, sbu0 = sbg0, sbu1 = sbg0;
        if constexpr (I8) { const int fr0 = u.pn * BM + wc * 32 + 8 * fq;
            sbg0 = *(const f32x4*)(sB + fr0); sbg1 = *(const f32x4*)(sB + fr0 + 4); sbu0 = *(const f32x4*)(sB + fr0 + HALF); sbu1 = *(const f32x4*)(sB + fr0 + HALF + 4); }
#pragma unroll
        for (int ai = 0; ai < 2; ++ai)
#pragma unroll
            for (int m = 0; m < 4; ++m) { bf16_t* rowp = O + (size_t)(row0 + ai * HALF + m * 16) * ldc + col0;
                f32x4 g0 = acc[ai][0][m][0], g1 = acc[ai][0][m][1], u0 = acc[ai][1][m][0], u1 = acc[ai][1][m][1];
                if constexpr (I8) { const float sa = sA[row0 + ai * HALF + m * 16];
                    g0 = __builtin_convertvector(__builtin_bit_cast(i32x4, g0), f32x4) * (sbg0 * sa); g1 = __builtin_convertvector(__builtin_bit_cast(i32x4, g1), f32x4) * (sbg1 * sa);
                    u0 = __builtin_convertvector(__builtin_bit_cast(i32x4, u0), f32x4) * (sbu0 * sa); u1 = __builtin_convertvector(__builtin_bit_cast(i32x4, u1), f32x4) * (sbu1 * sa); }
                u32x4 w;
                w.x = cvt_pk_bf16(silu_f(g0[0]) * u0[0], silu_f(g0[1]) * u0[1]); w.y = cvt_pk_bf16(silu_f(g0[2]) * u0[2], silu_f(g0[3]) * u0[3]);
                w.z = cvt_pk_bf16(silu_f(g1[0]) * u1[0], silu_f(g1[1]) * u1[1]); w.w = cvt_pk_bf16(silu_f(g1[2]) * u1[2], silu_f(g1[3]) * u1[3]);
                *(u32x4*)rowp = w;
                if (rmax) { unsigned mx = 0u;
                    { const unsigned ww_[4] = {w.x, w.y, w.z, w.w};
#pragma unroll
                      for (int k_ = 0; k_ < 4; ++k_) { const unsigned lo_ = (ww_[k_] << 16) & 0x7fff0000u, hi_ = ww_[k_] & 0x7fff0000u; mx = mx > lo_ ? mx : lo_; mx = mx > hi_ ? mx : hi_; } }
                    { const unsigned o_ = (unsigned)__shfl_xor((int)mx, 16); mx = mx > o_ ? mx : o_; } { const unsigned o_ = (unsigned)__shfl_xor((int)mx, 32); mx = mx > o_ ? mx : o_; }
                    if (fq == 0) (void)__hip_atomic_fetch_max(rmax + row0 + ai * HALF + m * 16, mx, __ATOMIC_RELAXED, __HIP_MEMORY_SCOPE_AGENT); } }
    }
};
struct EpiStoreBf16 {
    static constexpr bool PERM = true, AFTER_DRAIN = false;
    bf16_t* O; int ldc;
    __device__ __forceinline__ void operator()(const f32x4 (&acc)[2][2][4][2], const Unit& u, int wr, int wc, int fr, int fq) const {
        const int row0 = u.pm * BM + wr * 64 + fr, col0 = u.pn * BM + wc * 32 + 8 * fq;
#pragma unroll
        for (int ai = 0; ai < 2; ++ai)
#pragma unroll
            for (int m = 0; m < 4; ++m) { bf16_t* rowp = O + (size_t)(row0 + ai * HALF + m * 16) * ldc + col0;
#pragma unroll
                for (int bj = 0; bj < 2; ++bj) { const f32x4 v0 = acc[ai][bj][m][0], v1 = acc[ai][bj][m][1];
                    u32x4 w; w.x = cvt_pk_bf16(v0[0], v0[1]); w.y = cvt_pk_bf16(v0[2], v0[3]); w.z = cvt_pk_bf16(v1[0], v1[1]); w.w = cvt_pk_bf16(v1[2], v1[3]);
                    *(u32x4*)(rowp + bj * HALF) = w; } }
    }
};
template <int MODE> struct RowSrc {
    const float *p0, *p1, *p2; int n0, n1, n2, ld;
    __device__ __forceinline__ const float* row(int r) const {
        if (MODE == 1) return r < n0 ? p0 + (size_t)r * ld : nullptr;
        if (r < n0) return p0 + (size_t)r * ld;
        if (r < n1) return p1 + (size_t)(r - n0) * ld;
        if (r < n2) return p2 + (size_t)(r - n1) * ld;
        return nullptr; }
};
typedef unsigned u32x2e __attribute__((ext_vector_type(2)));
template <int MODE, bool HALF_, bool ALPHA1 = false, bool I8 = false, bool R16 = false> struct EpiResF32 {
    static constexpr bool PERM = false, AFTER_DRAIN = false;
    float* out; int ldc; RowSrc<MODE> src; float* slab; int S;
    const float *sA, *sB;
    __device__ __forceinline__ void operator()(const f32x4 (&acc)[2][2][4][2], const Unit& u, int wr, int wc, int fr, int fq) const {
        constexpr float alpha = ALPHA1 ? 1.0f : 1.189207115002721f, scale = HALF_ ? 0.5f : 1.0f;
        f32x4 sb_[2][2];
        if constexpr (I8) { const int c0_ = u.pn * BM + wc * 32 + 4 * fq;
#pragma unroll
            for (int bj = 0; bj < 2; ++bj)
#pragma unroll
                for (int n = 0; n < 2; ++n) sb_[bj][n] = *(const f32x4*)(sB + c0_ + bj * HALF + n * 16); }
#define EPI_VAL(ai, bj, m, n, sa_) (I8 ? __builtin_convertvector(__builtin_bit_cast(i32x4, acc[ai][bj][m][n]), f32x4) * (sb_[bj][n] * (sa_)) : acc[ai][bj][m][n])
        if (u.sl > 0) {
            float* sb = slab + ((size_t)(u.ri * (S - 1) + (u.sl - 1)) << 16) + wc * 32 + 4 * fq;
#pragma unroll
            for (int ai = 0; ai < 2; ++ai)
#pragma unroll
                for (int m = 0; m < 4; ++m) { float* o = sb + (ai * HALF + wr * 64 + m * 16 + fr) * BM; float sa_ = 1.f; if constexpr (I8) sa_ = sA[u.pm * BM + ai * HALF + wr * 64 + m * 16 + fr];
#pragma unroll
                    for (int bj = 0; bj < 2; ++bj)
#pragma unroll
                        for (int n = 0; n < 2; ++n) *(f32x4*)(o + bj * HALF + n * 16) = EPI_VAL(ai, bj, m, n, sa_); }
            return; }
        const int col0 = u.pn * BM + wc * 32 + 4 * fq;
#pragma unroll
        for (int ai = 0; ai < 2; ++ai)
#pragma unroll
            for (int m = 0; m < 4; ++m) { const int r = u.pm * BM + ai * HALF + wr * 64 + m * 16 + fr; const float* b = src.row(r);
                if (b) { float* o = out + (size_t)r * ldc; float sa_ = 1.f; if constexpr (I8) sa_ = sA[r];
#pragma unroll
                    for (int bj = 0; bj < 2; ++bj)
#pragma unroll
                        for (int n = 0; n < 2; ++n) { const int c = col0 + bj * HALF + n * 16; f32x4 bs;
                            if constexpr (R16 && MODE == 1) { const u32x2e w_ = *(const u32x2e*)((const bf16_t*)src.p0 + (size_t)r * src.ld + c);
                                bs = (f32x4){__uint_as_float(w_.x << 16), __uint_as_float(w_.x & 0xffff0000u), __uint_as_float(w_.y << 16), __uint_as_float(w_.y & 0xffff0000u)}; }
                            else bs = *(const f32x4*)(b + c);
                            const f32x4 v_ = bs * alpha + EPI_VAL(ai, bj, m, n, sa_) * scale;
                            if constexpr (R16) { u32x2e o_; o_.x = cvt_pk_bf16(v_[0], v_[1]); o_.y = cvt_pk_bf16(v_[2], v_[3]); *(u32x2e*)((bf16_t*)out + (size_t)r * ldc + c) = o_; }
                            else *(f32x4*)(o + c) = v_; } } }
#undef EPI_VAL
    }
};
template <class Epi, class Sched, bool ALIGN_EPI = false, bool SP2 = false, bool I8 = false>
__device__ __forceinline__ void gemm_phase(PG8_LAS unsigned char* lds, const Gemm g, const Sched& S, const Epi& E) {
    const int tid = threadIdx.x, wid = __builtin_amdgcn_readfirstlane(tid >> 6), lane = tid & 63, wr = wid >> 2, wc = wid & 3, fr = lane & 15, fq = lane >> 4;
    const int K = g.K;
    unsigned voffA[2], voffB[2];
#pragma unroll
    for (int i = 0; i < 2; ++i) { int R, C; stage_rc(tid * 16 + i * 8192, R, C); const int Rb = Epi::PERM ? ((R & ~31) + perm32(R & 31)) : R;
        voffA[i] = (unsigned)(R * K + C) * 2u; voffB[i] = (unsigned)(Rb * K + C) * 2u; }
    const size_t kstep = (size_t)(BK * 2);
    const size_t hstep = (size_t)HALF * K * 2;
    const size_t tstep = 2 * hstep;
    const unsigned ldsw = (unsigned)wid * 1024u;
    const int aoff = lds_byte(wr * 64 + fr, fq * 8), boff = lds_byte(wc * 32 + fr, fq * 8);
#define PG8_SA(b, h) (((b) * 2 + (h)) * HTB)
#define PG8_SB(b, h) ((4 + (b) * 2 + (h)) * HTB)
#define PG8_STAGE(bufoff, gbase, voff) do { _Pragma("unroll") for (int _i = 0; _i < 2; ++_i) \
        __builtin_amdgcn_global_load_lds((const unsigned*)((const char*)(gbase) + (voff)[_i]), (PG8_LAS unsigned*)(lds + (bufoff) + ldsw + _i * 8192), 16, 0, 0); } while (0)
#define PG8_LDA(dst, b, h) do { _Pragma("unroll") for (int m = 0; m < 4; ++m) _Pragma("unroll") for (int k = 0; k < 2; ++k) dst[m][k] = *(const PG8_LAS bf16x8*)(lds + PG8_SA(b, h) + aoff + m * 2048 + k * 1024); } while (0)
#define PG8_LDB(dst, b, h) do { _Pragma("unroll") for (int n = 0; n < 2; ++n) _Pragma("unroll") for (int k = 0; k < 2; ++k) dst[n][k] = *(const PG8_LAS bf16x8*)(lds + PG8_SB(b, h) + boff + n * 2048 + k * 1024); } while (0)
#define PG8_MMA(ai, bj, At, Bt) do { __builtin_amdgcn_s_setprio(1); _Pragma("unroll") for (int m = 0; m < 4; ++m) _Pragma("unroll") for (int n = 0; n < 2; ++n) _Pragma("unroll") for (int k = 0; k < 2; ++k) \
        { if constexpr (I8) acc[ai][bj][m][n] = __builtin_bit_cast(f32x4, __builtin_amdgcn_mfma_i32_16x16x64_i8(__builtin_bit_cast(i32x4, Bt[n][k]), __builtin_bit_cast(i32x4, At[m][k]), __builtin_bit_cast(i32x4, acc[ai][bj][m][n]), 0, 0, 0)); \
          else acc[ai][bj][m][n] = __builtin_amdgcn_mfma_f32_16x16x32_bf16(Bt[n][k], At[m][k], acc[ai][bj][m][n], 0, 0, 0); } __builtin_amdgcn_s_setprio(0); } while (0)
#define PG8_WAIT_V(n) asm volatile("s_waitcnt vmcnt(" #n ")" ::: "memory")
#define PG8_WAIT_L(n) asm volatile("s_waitcnt lgkmcnt(" #n ")" ::: "memory")
#define PG8_BAR __builtin_amdgcn_s_barrier()
#define PG8_SCHED __builtin_amdgcn_sched_barrier(0)
    Unit cur, nxt; int ui = 0;
    if (!S.next(0, cur)) return;
    f32x4 acc[2][2][4][2];
#pragma unroll
    for (int a = 0; a < 2; ++a)
#pragma unroll
        for (int b = 0; b < 2; ++b)
#pragma unroll
            for (int m = 0; m < 4; ++m)
#pragma unroll
                for (int n = 0; n < 2; ++n) acc[a][b][m][n] = (f32x4){0.f, 0.f, 0.f, 0.f};
    bf16x8 At[4][2], B0[2][2], B1[2][2];
    const char* cA = (const char*)g.A + (size_t)cur.pm * tstep + (size_t)cur.k0 * kstep; const char* cB = (const char*)g.Bt + (size_t)cur.pn * tstep + (size_t)cur.k0 * kstep; int nt = cur.nt;
    S.a_ready(cur);
    if constexpr (SP2) {
        PG8_STAGE(PG8_SB(0, 0), cB, voffB); PG8_STAGE(PG8_SB(0, 1), cB + hstep, voffB); PG8_STAGE(PG8_SA(0, 0), cA, voffA); PG8_STAGE(PG8_SA(0, 1), cA + hstep, voffA);
        if (wr == 1) PG8_BAR;
        PG8_WAIT_V(2); PG8_BAR;
        PG8_STAGE(PG8_SB(1, 0), cB + kstep, voffB); PG8_STAGE(PG8_SA(1, 0), cA + kstep, voffA); PG8_STAGE(PG8_SB(1, 1), cB + hstep + kstep, voffB);
        PG8_WAIT_V(6); PG8_BAR;
    } else {
        PG8_STAGE(PG8_SB(0, 0), cB, voffB); PG8_STAGE(PG8_SA(0, 0), cA, voffA); PG8_STAGE(PG8_SB(0, 1), cB + hstep, voffB); PG8_STAGE(PG8_SA(0, 1), cA + hstep, voffA);
        if (wr == 1) PG8_BAR;
        PG8_WAIT_V(4); PG8_BAR;
        PG8_STAGE(PG8_SB(1, 0), cB + kstep, voffB); PG8_STAGE(PG8_SA(1, 0), cA + kstep, voffA); PG8_STAGE(PG8_SB(1, 1), cB + hstep + kstep, voffB);
        PG8_WAIT_V(6); PG8_BAR;
    }
    for (;;) {
        const bool has_next = S.next(ui + 1, nxt);
        const char* nA = has_next ? (const char*)g.A + (size_t)nxt.pm * tstep + (size_t)nxt.k0 * kstep : cA; const char* nB = has_next ? (const char*)g.Bt + (size_t)nxt.pn * tstep + (size_t)nxt.k0 * kstep : cB;
        for (int t = 0; t < nt; t += 2) {
            const bool last = (t == nt - 2);
            const char* a1 = cA + (size_t)(t + 1) * kstep;
            const char* a2 = last ? nA : cA + (size_t)(t + 2) * kstep; const char* b2 = last ? nB : cB + (size_t)(t + 2) * kstep;
            const char* a3 = a2 + kstep; const char* b3 = b2 + kstep;
            if (last && has_next) S.a_ready(nxt);
            if constexpr (SP2) {
            PG8_LDB(B0, 0, 0); PG8_LDB(B1, 0, 1); PG8_SCHED; PG8_LDA(At, 0, 0); PG8_STAGE(PG8_SA(1, 1), a1 + hstep, voffA);
            PG8_WAIT_V(8); PG8_WAIT_L(0); PG8_BAR; PG8_MMA(0, 0, At, B0); PG8_MMA(0, 1, At, B1); PG8_BAR; PG8_SCHED;
            PG8_LDA(At, 0, 1); PG8_STAGE(PG8_SB(0, 0), b2, voffB); PG8_STAGE(PG8_SB(0, 1), b2 + hstep, voffB); PG8_STAGE(PG8_SA(0, 0), a2, voffA);
            PG8_WAIT_V(8); PG8_WAIT_L(0); PG8_BAR; PG8_MMA(1, 0, At, B0); PG8_MMA(1, 1, At, B1); PG8_BAR; PG8_SCHED;
            PG8_LDB(B0, 1, 0); PG8_LDB(B1, 1, 1); PG8_SCHED; PG8_LDA(At, 1, 0); PG8_STAGE(PG8_SA(0, 1), a2 + hstep, voffA);
            PG8_WAIT_V(8); PG8_WAIT_L(0); PG8_BAR; PG8_MMA(0, 0, At, B0); PG8_MMA(0, 1, At, B1); PG8_BAR; PG8_SCHED;
            PG8_LDA(At, 1, 1); PG8_STAGE(PG8_SB(1, 0), b3, voffB); PG8_STAGE(PG8_SB(1, 1), b3 + hstep, voffB); PG8_STAGE(PG8_SA(1, 0), a3, voffA);
            PG8_WAIT_V(8); PG8_WAIT_L(0); PG8_BAR; PG8_MMA(1, 0, At, B0); PG8_MMA(1, 1, At, B1); PG8_BAR; PG8_SCHED;
            } else {
            PG8_LDB(B0, 0, 0); PG8_SCHED; PG8_LDA(At, 0, 0); PG8_STAGE(PG8_SA(1, 1), a1 + hstep, voffA);
            PG8_WAIT_L(8); PG8_BAR; PG8_WAIT_L(0); PG8_MMA(0, 0, At, B0); PG8_BAR; PG8_SCHED;
            PG8_LDB(B1, 0, 1); PG8_STAGE(PG8_SB(0, 0), b2, voffB);
            PG8_BAR; PG8_WAIT_L(0); PG8_MMA(0, 1, At, B1); PG8_BAR;
            PG8_LDA(At, 0, 1); PG8_STAGE(PG8_SA(0, 0), a2, voffA);
            PG8_BAR; PG8_WAIT_L(0); PG8_MMA(1, 0, At, B0); PG8_BAR; PG8_SCHED;
            PG8_STAGE(PG8_SB(0, 1), b2 + hstep, voffB);
            PG8_WAIT_V(6); PG8_BAR; PG8_MMA(1, 1, At, B1); PG8_BAR;
            PG8_LDB(B0, 1, 0); PG8_SCHED; PG8_LDA(At, 1, 0); PG8_STAGE(PG8_SA(0, 1), a2 + hstep, voffA);
            PG8_WAIT_L(8); PG8_BAR; PG8_WAIT_L(0); PG8_MMA(0, 0, At, B0); PG8_BAR; PG8_SCHED;
            PG8_LDB(B1, 1, 1); PG8_STAGE(PG8_SB(1, 0), b3, voffB);
            PG8_BAR; PG8_WAIT_L(0); PG8_MMA(0, 1, At, B1); PG8_BAR;
            PG8_LDA(At, 1, 1); PG8_STAGE(PG8_SA(1, 0), a3, voffA);
            PG8_BAR; PG8_WAIT_L(0); PG8_MMA(1, 0, At, B0); PG8_BAR; PG8_SCHED;
            PG8_STAGE(PG8_SB(1, 1), b3 + hstep, voffB);
            PG8_WAIT_V(6); PG8_BAR; PG8_MMA(1, 1, At, B1); PG8_BAR;
            }
        }
        if constexpr (ALIGN_EPI) { if (wr == 0) PG8_BAR; }
        if constexpr (!Epi::AFTER_DRAIN) { E(acc, cur, wr, wc, fr, fq); S.done(cur); }
        if (!has_next) break;
#pragma unroll
        for (int a = 0; a < 2; ++a)
#pragma unroll
            for (int b = 0; b < 2; ++b)
#pragma unroll
                for (int m = 0; m < 4; ++m)
#pragma unroll
                    for (int n = 0; n < 2; ++n) acc[a][b][m][n] = (f32x4){0.f, 0.f, 0.f, 0.f};
        cur = nxt; cA = nA; cB = nB; nt = cur.nt; ++ui;
        if constexpr (ALIGN_EPI) { if (wr == 1) PG8_BAR; }
    }
    PG8_WAIT_V(0);
    if constexpr (!ALIGN_EPI) { if (wr == 0) PG8_BAR; }
    PG8_BAR;
    if constexpr (Epi::AFTER_DRAIN) { E.fused(acc, cur, wr, wc, fr, fq, lds, wid, lane); S.done(cur); }
#undef PG8_SA
#undef PG8_SB
#undef PG8_STAGE
#undef PG8_LDA
#undef PG8_LDB
#undef PG8_MMA
#undef PG8_WAIT_V
#undef PG8_WAIT_L
#undef PG8_BAR
#undef PG8_SCHED
}
}
#define GAS __attribute__((address_space(1)))
#define LAS __attribute__((address_space(3)))
typedef unsigned short bf16;
typedef unsigned v4u __attribute__((ext_vector_type(4)));
typedef float f32x4 __attribute__((ext_vector_type(4)));
typedef short bf16x8 __attribute__((ext_vector_type(8)));
typedef GAS unsigned gu32;
typedef GAS unsigned long long gu64;
#define RLX_AGENT __ATOMIC_RELAXED, __HIP_MEMORY_SCOPE_AGENT
#define LDS_WAIT() asm volatile("s_waitcnt lgkmcnt(0)" ::: "memory")
#define VM_WAIT() asm volatile("s_waitcnt vmcnt(0)" ::: "memory")
__device__ __forceinline__ unsigned long long rt() { return __builtin_amdgcn_s_memrealtime(); }
__device__ __forceinline__ unsigned f2bf(float f) { unsigned u = __builtin_bit_cast(unsigned, f); return (u + 0x7fffu + ((u >> 16) & 1u)) >> 16; }
__device__ __forceinline__ unsigned pk2(float lo, float hi) { return f2bf(lo) | (f2bf(hi) << 16); }

#define XB_TMO      128
#define XB_XCNT(j)  (256  + 64 * (j))
#define XB_XSUB(j)  (1280 + 64 * (j))
#define XB_XGEN(j)  (2304 + 64 * (j))
#define XB_TOP      3328
#define XB_TOPGEN   3392
#define XCD_BAR_WORDS 3456
#define XB_SPIN_CAP (1u << 18)

__device__ __forceinline__ unsigned xb_ld(unsigned* p)              { return __hip_atomic_load(p, __ATOMIC_RELAXED, __HIP_MEMORY_SCOPE_AGENT); }
__device__ __forceinline__ unsigned xb_add(unsigned* p, unsigned v) { return __hip_atomic_fetch_add(p, v, __ATOMIC_RELAXED, __HIP_MEMORY_SCOPE_AGENT); }
__device__ __forceinline__ unsigned xb_xcc_id() { return (unsigned)__builtin_amdgcn_s_getreg((3 << 11) | 20) & 0xFu; }
#define XB_SPIN(cond, bar) do { unsigned _sp = 0; while (cond) { __builtin_amdgcn_s_sleep(1); \
    if ((++_sp & 255u) == 0u) { if (xb_ld(&(bar)[XB_TMO])) break; if (_sp > XB_SPIN_CAP) { atomicAdd(&(bar)[XB_TMO], 1u); break; } } } } while (0)

struct XcdBarrier {
    unsigned* bar; unsigned x;
    volatile LAS unsigned* st;
};

__device__ __forceinline__ XcdBarrier xcd_barrier_post(unsigned* bar, volatile LAS unsigned* st) {
    XcdBarrier b; b.bar = bar; b.x = xb_xcc_id(); b.st = st;
    if (threadIdx.x == 0) (void)xb_add(&bar[XB_XCNT(b.x)], 1u);
    return b;
}
__device__ __forceinline__ void xcd_barrier_complete(unsigned* bar, unsigned x, unsigned& nloc, unsigned& nx) {
    const unsigned G = gridDim.x * gridDim.y * gridDim.z;
    unsigned sum, cnt, mine, sp = 0u;
    for (;;) {
        sum = 0u; cnt = 0u; mine = 0u;
#pragma unroll
        for (unsigned j = 0; j < 16; ++j) { const unsigned c = xb_ld(&bar[XB_XCNT(j)]); sum += c; cnt += (c > 0u) ? 1u : 0u; mine = (j == x) ? c : mine; }
        if (sum == G) break;
        __builtin_amdgcn_s_sleep(1);
        if ((++sp & 255u) == 0u) { if (xb_ld(&bar[XB_TMO])) break; if (sp > XB_SPIN_CAP) { atomicAdd(&bar[XB_TMO], 1u); break; } }
    }
    nloc = mine > 0u ? mine : 1u; nx = cnt > 0u ? cnt : 1u;
}

__device__ __forceinline__ void xcd_barrier(const XcdBarrier& b) {
    asm volatile("s_waitcnt vmcnt(0)" ::: "memory");
    __syncthreads();
    if (threadIdx.x == 0) {
        unsigned* bar = b.bar;
        __builtin_amdgcn_s_waitcnt(0);
        unsigned nloc = b.st[0], nx = b.st[1];
        if (nloc == 0u) { xcd_barrier_complete(bar, b.x, nloc, nx); b.st[0] = nloc; b.st[1] = nx; }
        const unsigned old = xb_add(&bar[XB_XSUB(b.x)], 1u);
        const unsigned gen = old / nloc;
        if (old + 1u == (gen + 1u) * nloc) {
            __builtin_amdgcn_fence(__ATOMIC_RELEASE, "agent");
            asm volatile("s_waitcnt vmcnt(0)" ::: "memory");
            const unsigned og = xb_add(&bar[XB_TOP], 1u);
            const unsigned tg = og / nx;
            if (og + 1u == (tg + 1u) * nx) xb_add(&bar[XB_TOPGEN], 1u);
            else XB_SPIN(xb_ld(&bar[XB_TOPGEN]) == tg, bar);
            __builtin_amdgcn_fence(__ATOMIC_ACQUIRE, "agent");
            xb_add(&bar[XB_XGEN(b.x)], 1u);
            asm volatile("s_waitcnt vmcnt(0)" ::: "memory");
        } else {
            XB_SPIN(xb_ld(&bar[XB_XGEN(b.x)]) == gen, bar);
            __builtin_amdgcn_fence(__ATOMIC_ACQUIRE, "agent");
            asm volatile("s_waitcnt vmcnt(0)" ::: "memory");
        }
    }
    __syncthreads();
}


constexpr int NWAVES = 8;
#ifndef MK_N_LAUNCHES
#define MK_N_LAUNCHES 1
#endif
constexpr int N_PHASES = 12;
constexpr int N_LAUNCHES = MK_N_LAUNCHES;
static_assert(N_LAUNCHES == 1 || N_LAUNCHES == N_PHASES, "MK_N_LAUNCHES is 1 or 12");

constexpr int D = 4096, FF = 11008, NGU = 2 * FF, DIN = 11296, DINP = 11520;
constexpr int NB_P = 4, SEQ_P = 2048, NB_S = 16, SEQ_S = 64, NMETA = 16, PAST = 2048;
constexpr int ROW_S = NB_P * SEQ_P  , ROW_M = ROW_S + NB_S * SEQ_S  , M1V = ROW_M + NMETA  , M1 = 9472  , M2 = ROW_M  ;
constexpr int KVH = 4, HD = 128, KVW = KVH * HD  , NHQ = 16, NHG = 16, WIN = 128;
constexpr int KVR_SMETA = M1, KVR_SWIN = M1 + NB_S * NMETA  , KV_ROWS = KVR_SWIN + NB_S * WIN  ;
constexpr int NPOS = NMETA + PAST + SEQ_S;
constexpr int C_Q = 0, C_K = 2048, C_V = 2560, C_CONV = 3072, C_Z = 9216, C_B = 11264, C_A = 11280, DCONV = 6144;
constexpr float LN_EPS = 1e-5f, RMS_EPS = 1e-6f, ALPHA = 1.189207115002721f;
enum { I_XP = 0, I_XS, I_CMK, I_CMV, I_CWK, I_CWV, I_SCONV, I_SGDN, I_META, I_LNG, I_LNB, I_WG, I_WU, I_WD, I_WIN, I_WOUT, I_SINK, I_CONVW, I_ALOG, I_DTB, I_NORMW, N_IN };
constexpr size_t O_YP = 0, O_YS = O_YP + (size_t)ROW_S * D, O_PMK = O_YS + (size_t)NB_S * SEQ_S * D, O_PMV = O_PMK + (size_t)NB_P * NMETA * KVW, O_PWK = O_PMV + (size_t)NB_P * NMETA * KVW,
                 O_PWV = O_PWK + (size_t)NB_P * WIN * KVW, O_PCONV = O_PWV + (size_t)NB_P * WIN * KVW, O_PGDN = O_PCONV + (size_t)NB_P * 3 * DCONV, O_SWK = O_PGDN + (size_t)NB_P * NHG * 128 * 128,
                 O_SWV = O_SWK + (size_t)NB_S * SEQ_S * KVW, O_SCONV = O_SWV + (size_t)NB_S * SEQ_S * KVW, O_SGDN = O_SCONV + (size_t)NB_S * 3 * DCONV, O_END = O_SGDN + (size_t)NB_S * NHG * 128 * 128;
static_assert(O_END == 44998656, "output map");

constexpr size_t AL(size_t x) { return (x + 4095) / 4096 * 4096; }
constexpr size_t WS_CTL = 0, CTL_ZERO_BYTES = 1u << 20;
constexpr size_t WS_WGU1 = CTL_ZERO_BYTES, SZ_WGU = (size_t)NGU * D * 2, SZ_WD = (size_t)D * FF * 2;
constexpr size_t WS_WD1 = WS_WGU1 + AL(SZ_WGU), WS_WGU2 = WS_WD1 + AL(SZ_WD), WS_WD2 = WS_WGU2 + AL(SZ_WGU), WS_WIN = WS_WD2 + AL(SZ_WD), WS_WOUT = WS_WIN + AL((size_t)DINP * D * 2);
constexpr size_t WS_XN = WS_WOUT + AL((size_t)D * D * 2), WS_MIX = WS_XN + AL((size_t)M1 * D * 2), WS_H = WS_MIX + AL((size_t)M2 * D * 2);
constexpr size_t WS_Y = WS_H + AL((size_t)M1 * DINP * 2), WS_KB = WS_Y + AL((size_t)M1 * D * 4), WS_VB = WS_KB + AL((size_t)KV_ROWS * KVW * 2), WS_ROPE = WS_VB + AL((size_t)KV_ROWS * KVW * 2);
constexpr size_t WS_SLAB = WS_ROPE + AL((size_t)NPOS * 64 * 8), N_SLABS = 224, WS_XQ = WS_SLAB + N_SLABS * 262144, WS_SA = WS_XQ + AL((size_t)M1 * D), WS_SB = WS_SA + AL((size_t)M1 * 4), WS_SH = WS_SB + 2 * AL((size_t)NGU * 4), WS_SBD = WS_SH + AL((size_t)M1 * 4), WS_HQ = WS_SBD + 2 * AL((size_t)D * 4), WS_END = WS_HQ + AL((size_t)M1 * FF);
static_assert((size_t)M1 * FF <= (WS_H - WS_XN), "the int8 copy of h fits over the XN | MIX region");
constexpr int GU_U = 0, GU_W = 32768, GU_QD = GU_W + 16384, GU_KDT = GU_QD + 16384, GU_QK = GU_KDT + 16384, GU_GL = GU_QK + 8192, GU_BYTES = GU_GL + 256;
constexpr int N_GUNITS = NB_P * NHG * 32 + NHG + NB_S * NHG;
constexpr size_t WS_GDN = WS_WGU1;
static_assert((size_t)N_GUNITS * GU_BYTES <= WS_WGU2 - WS_WGU1, "GDN chunk data fits in the FFN1 weight region");
constexpr int CW_TMO = 0, CW_CODE = 1, CW_BAR = 4096, CW_CMAX = 131072, CW_CMAXD = CW_CMAX + 2 * NGU, CW_RMAX = CW_CMAXD + 2 * D;
static_assert((CW_RMAX + 2 * M1) * 4 <= (int)CTL_ZERO_BYTES, "column maxima inside the per-call memset");

constexpr int RING_OFF = 0, RING_BYTES = 139264;
constexpr int LDSCTL_OFF = RING_BYTES, MISC_OFF = LDSCTL_OFF + 320;
constexpr int LDS_BYTES = 147456;
static_assert(MISC_OFF + 128 <= LDS_BYTES, "LDS map");

struct Frame {
    LAS unsigned char* lds;
    volatile LAS unsigned* MISC;
    gu32* ctl;
    int tid, lane, wave;
    int vcu, G;
};
struct Ptrs {
    const float* in[N_IN]; float* out;
    bf16 *Wgu1, *Wd1, *Wgu2, *Wd2, *Win, *Wout, *XN, *MIX, *H, *KB, *VB;
    float* Y; float* ROPE; unsigned char* GDN; float* SLAB;
    signed char* XQ; float *SA, *SB1, *SB2; unsigned* CMAX;
    signed char* HQ; float *SH, *SBD1, *SBD2; unsigned *CMAXD, *RMAX;
};
__host__ __device__ constexpr int kpos32(int kk) { return 8 * ((kk & 15) >> 2) + (kk & 3) + 4 * (kk >> 4); }
__host__ __device__ constexpr int a256_off(int r, int k) { return r * 256 + ((((k >> 5) * 4 + (kpos32(k & 31) >> 3)) ^ (r & 15)) * 16) + (kpos32(k & 31) & 7) * 2; }
__host__ __device__ constexpr int a128_off(int r, int k) { return r * 128 + ((((k >> 5) * 4 + (kpos32(k & 31) >> 3)) ^ ((r >> 1) & 7)) * 16) + (kpos32(k & 31) & 7) * 2; }
typedef short s16x4 __attribute__((ext_vector_type(4)));
__device__ __forceinline__ unsigned pkbf(float lo, float hi) { unsigned r; asm volatile("v_cvt_pk_bf16_f32 %0, %1, %2" : "=v"(r) : "v"(lo), "v"(hi)); return r; }
typedef float f32x2v __attribute__((ext_vector_type(2)));
typedef unsigned u32x2v __attribute__((ext_vector_type(2)));
__device__ __forceinline__ float bf2f(unsigned b) { return __uint_as_float(b << 16); }
__device__ __forceinline__ float wave_sum(float v) {
#pragma unroll
    for (int o = 1; o < 64; o <<= 1) v += __shfl_xor(v, o);
    return v;
}
__device__ __forceinline__ float silu1(float g) { return g * __builtin_amdgcn_rcpf(1.0f + __builtin_amdgcn_exp2f(-1.4426950408889634f * g)); }

template <int NB, int MODE>
__device__ __forceinline__ void p0_transpose_item(const float* W, int K, int N, bf16* WT, LAS float* scr, int item, int lane) {
    constexpr int LPR = NB / 4, RPI = 64 / LPR, NIT = 64 / RPI, ST = NB + 1;
    const int nblk = N / NB, kb = item / nblk, nb = item - kb * nblk, k0 = 64 * kb, n0 = NB * nb;
    const int lr = lane / LPR, lc = 4 * (lane % LPR);
#pragma unroll
    for (int i = 0; i < NIT; ++i) { const int kk = RPI * i + lr; const f32x4 v = __builtin_nontemporal_load((const GAS f32x4*)(W + (size_t)(k0 + kk) * N + n0 + lc));
        LAS float* s = scr + kk * ST + lc; s[0] = v.x; s[1] = v.y; s[2] = v.z; s[3] = v.w; }
    LDS_WAIT(); asm volatile("" ::: "memory");
    const int c = lane & 7;
#pragma unroll
    for (int j = 0; j < NB / 8; ++j) { const int n = (lane >> 3) + 8 * j; const LAS float* s = scr + (8 * c) * ST + n;
        v4u o; o.x = pk2(s[0 * ST], s[1 * ST]); o.y = pk2(s[2 * ST], s[3 * ST]); o.z = pk2(s[4 * ST], s[5 * ST]); o.w = pk2(s[6 * ST], s[7 * ST]);
        const int nn = n0 + n; const int r = (MODE == 0) ? nn : ((nn >> 7) * 256 + (nn & 127) + (MODE == 2 ? 128 : 0));
        *(GAS v4u*)(WT + (size_t)r * K + k0 + 8 * c) = o; }
    LDS_WAIT(); asm volatile("" ::: "memory");
}
__device__ __forceinline__ void cvt_flat(const float* src, bf16* dst, int n8, int gt, int NGT) {
    for (int i = gt; i < n8; i += NGT) { const f32x4 a = *(const GAS f32x4*)(src + (size_t)i * 8), b = *(const GAS f32x4*)(src + (size_t)i * 8 + 4);
        v4u o; o.x = pk2(a.x, a.y); o.y = pk2(a.z, a.w); o.z = pk2(b.x, b.y); o.w = pk2(b.z, b.w); *(GAS v4u*)(dst + (size_t)i * 8) = o; }
}
__device__ __forceinline__ unsigned pack_i8x4(f32x4 v, float inv) {
    const int a = (int)__builtin_rintf(v.x * inv), b = (int)__builtin_rintf(v.y * inv), c = (int)__builtin_rintf(v.z * inv), d = (int)__builtin_rintf(v.w * inv);
    return (unsigned)(a & 255) | ((unsigned)(b & 255) << 8) | ((unsigned)(c & 255) << 16) | ((unsigned)d << 24); }
__device__ __forceinline__ float wave_max(float v) {
#pragma unroll
    for (int o = 1; o < 64; o <<= 1) v = fmaxf(v, __shfl_xor(v, o));
    return v; }
__device__ __forceinline__ void quant_row_i8(const f32x4 (&v)[16], signed char* dst, float* sa, int lane) {
    float m = 0.f;
#pragma unroll
    for (int j = 0; j < 16; ++j) m = fmaxf(fmaxf(m, fmaxf(fabsf(v[j].x), fabsf(v[j].y))), fmaxf(fabsf(v[j].z), fabsf(v[j].w)));
    m = wave_max(m); const float inv = m > 0.f ? 127.f / m : 0.f;
    if (lane == 0) *sa = m * (1.f / 127.f);
#pragma unroll
    for (int j = 0; j < 16; ++j) ((GAS unsigned*)dst)[lane + 64 * j] = pack_i8x4(v[j], inv);
}
__device__ __forceinline__ int gu_row(int mode, int nn) { return mode == 0 ? nn : (nn >> 7) * 256 + (nn & 127) + (mode == 2 ? 128 : 0); }
__device__ __forceinline__ void p0_colmax_item(const float* W, int N, unsigned* cmax, int mode, int item, int lane) {
    const int nblk = N / 64, kb = item / nblk, nb = item - kb * nblk, k0 = 64 * kb, n0 = 64 * nb, lr = lane >> 4, lc = 4 * (lane & 15);
    f32x4 m = {0.f, 0.f, 0.f, 0.f};
#pragma unroll
    for (int i = 0; i < 16; ++i) { const f32x4 v = __builtin_nontemporal_load((const GAS f32x4*)(W + (size_t)(k0 + 4 * i + lr) * N + n0 + lc));
        m.x = fmaxf(m.x, fabsf(v.x)); m.y = fmaxf(m.y, fabsf(v.y)); m.z = fmaxf(m.z, fabsf(v.z)); m.w = fmaxf(m.w, fabsf(v.w)); }
    m.x = fmaxf(m.x, __shfl_xor(m.x, 16)); m.y = fmaxf(m.y, __shfl_xor(m.y, 16)); m.z = fmaxf(m.z, __shfl_xor(m.z, 16)); m.w = fmaxf(m.w, __shfl_xor(m.w, 16));
    m.x = fmaxf(m.x, __shfl_xor(m.x, 32)); m.y = fmaxf(m.y, __shfl_xor(m.y, 32)); m.z = fmaxf(m.z, __shfl_xor(m.z, 32)); m.w = fmaxf(m.w, __shfl_xor(m.w, 32));
    if (lane < 16) { const int r = gu_row(mode, n0 + lc);
        (void)__hip_atomic_fetch_max(cmax + r + 0, __float_as_uint(m.x), RLX_AGENT); (void)__hip_atomic_fetch_max(cmax + r + 1, __float_as_uint(m.y), RLX_AGENT);
        (void)__hip_atomic_fetch_max(cmax + r + 2, __float_as_uint(m.z), RLX_AGENT); (void)__hip_atomic_fetch_max(cmax + r + 3, __float_as_uint(m.w), RLX_AGENT); }
}
__device__ __forceinline__ void p0_quant_item(const float* W, int K, int N, signed char* WT, const unsigned* cmax, float* sB, int mode, LAS float* scr, int item, int lane) {
    const int nblk = N / 64, kb = item / nblk, nb = item - kb * nblk, k0 = 64 * kb, n0 = 64 * nb, lr = lane >> 4, lc = 4 * (lane & 15);
#pragma unroll
    for (int i = 0; i < 16; ++i) { const int kk = 4 * i + lr; const f32x4 v = __builtin_nontemporal_load((const GAS f32x4*)(W + (size_t)(k0 + kk) * N + n0 + lc));
        LAS float* s = scr + kk * 65 + lc; s[0] = v.x; s[1] = v.y; s[2] = v.z; s[3] = v.w; }
    LDS_WAIT(); asm volatile("" ::: "memory");
    const int r = gu_row(mode, n0 + lane); const float am = __uint_as_float(__hip_atomic_load(cmax + r, RLX_AGENT)), inv = am > 0.f ? 127.f / am : 0.f;
    if (kb == 0) sB[r] = am * (1.f / 127.f);
    const LAS float* s = scr + lane;
#pragma unroll
    for (int c = 0; c < 4; ++c) { v4u o;
        o.x = pack_i8x4((f32x4){s[(16 * c + 0) * 65], s[(16 * c + 1) * 65], s[(16 * c + 2) * 65], s[(16 * c + 3) * 65]}, inv); o.y = pack_i8x4((f32x4){s[(16 * c + 4) * 65], s[(16 * c + 5) * 65], s[(16 * c + 6) * 65], s[(16 * c + 7) * 65]}, inv);
        o.z = pack_i8x4((f32x4){s[(16 * c + 8) * 65], s[(16 * c + 9) * 65], s[(16 * c + 10) * 65], s[(16 * c + 11) * 65]}, inv); o.w = pack_i8x4((f32x4){s[(16 * c + 12) * 65], s[(16 * c + 13) * 65], s[(16 * c + 14) * 65], s[(16 * c + 15) * 65]}, inv);
        *(GAS v4u*)(WT + (size_t)r * K + k0 + 16 * c) = o; }
    LDS_WAIT(); asm volatile("" ::: "memory");
}
__device__ __forceinline__ void quant_h(Frame& F, const bf16* H, signed char* HQ, const unsigned* rmax, float* SH, int nrows) {
    const int gw = F.vcu * NWAVES + F.wave, NGW = F.G * NWAVES;
    constexpr int NCH = FF / 8, NIT = (NCH + 63) / 64;
    for (int r = gw; r < nrows; r += NGW) {
        const GAS v4u* src = (const GAS v4u*)(H + (size_t)r * FF); GAS u32x2v* dst = (GAS u32x2v*)(HQ + (size_t)r * FF);
        v4u w[NIT];
#pragma unroll
        for (int i = 0; i < NIT; ++i) { const int c = F.lane + 64 * i; w[i] = (v4u){0u, 0u, 0u, 0u}; if (c < NCH) w[i] = src[c]; }
        unsigned mx = 0u;
#pragma unroll
        for (int i = 0; i < NIT; ++i) { const unsigned ww_[4] = {w[i].x, w[i].y, w[i].z, w[i].w};
#pragma unroll
            for (int k_ = 0; k_ < 4; ++k_) { const unsigned lo_ = (ww_[k_] << 16) & 0x7fff0000u, hi_ = ww_[k_] & 0x7fff0000u; mx = mx > lo_ ? mx : lo_; mx = mx > hi_ ? mx : hi_; } }
#pragma unroll
        for (int o = 1; o < 64; o <<= 1) { const unsigned t_ = (unsigned)__shfl_xor((int)mx, o); mx = mx > t_ ? mx : t_; }
        const float am = __uint_as_float(mx), inv = am > 0.f ? 127.f / am : 0.f;
        if (F.lane == 0) SH[r] = am * (1.f / 127.f);
#pragma unroll
        for (int i = 0; i < NIT; ++i) { const int c = F.lane + 64 * i; u32x2v o;
            o.x = pack_i8x4((f32x4){bf2f(w[i].x & 0xffffu), bf2f(w[i].x >> 16), bf2f(w[i].y & 0xffffu), bf2f(w[i].y >> 16)}, inv); o.y = pack_i8x4((f32x4){bf2f(w[i].z & 0xffffu), bf2f(w[i].z >> 16), bf2f(w[i].w & 0xffffu), bf2f(w[i].w >> 16)}, inv);
            if (c < NCH) dst[c] = o; } }
}
constexpr int IT_GU = (D / 64) * (FF / 64), IT_IN = (D / 64) * (DIN / 32), IT_OUT = (D / 64) * (D / 64);
constexpr int Q_E1 = IT_GU  , Q_E2 = Q_E1 + IT_IN  , Q_E3 = Q_E2 + IT_OUT  , Q_E4 = Q_E3 + 2 * IT_GU  , Q_E5 = Q_E4 + IT_GU  ;
constexpr int QCH = 8;
constexpr int CW_QCTR = 2048, CW_DONE = 2112;
__device__ __forceinline__ void conv_item(const Ptrs& P, LAS float* scr, int q, int lane) {
    const float* wg = P.in[I_WG] + (size_t)D * FF; const float* wu = P.in[I_WU] + (size_t)D * FF; const float* wd = P.in[I_WD];
    if (q < Q_E1) p0_quant_item(wd, FF, D, (signed char*)P.Wd1, P.CMAXD, P.SBD1, 0, scr, q, lane);
    else if (q < Q_E2) p0_transpose_item<32, 0>(P.in[I_WIN], D, DIN, P.Win, scr, q - Q_E1, lane);
    else if (q < Q_E3) p0_transpose_item<64, 0>(P.in[I_WOUT], D, D, P.Wout, scr, q - Q_E2, lane);
    else if (q < Q_E3 + IT_GU) p0_quant_item(wg, D, FF, (signed char*)P.Wgu2, P.CMAX + NGU, P.SB2, 1, scr, q - Q_E3, lane);
    else if (q < Q_E4) p0_quant_item(wu, D, FF, (signed char*)P.Wgu2, P.CMAX + NGU, P.SB2, 2, scr, q - Q_E3 - IT_GU, lane);
    else p0_quant_item(wd + (size_t)D * FF, FF, D, (signed char*)P.Wd2, P.CMAXD + D, P.SBD2, 0, scr, q - Q_E4, lane);
}
__device__ __forceinline__ int q_take(Frame& F) { int i = 0; if (F.lane == 0) i = (int)__hip_atomic_fetch_add(F.ctl + CW_QCTR, (unsigned)QCH, RLX_AGENT); return __builtin_amdgcn_readfirstlane(i); }
__device__ __forceinline__ int q_head(Frame& F) { return (int)__builtin_amdgcn_readfirstlane(__hip_atomic_load(F.ctl + CW_QCTR, RLX_AGENT)); }
__device__ __forceinline__ void q_catch_up(Frame& F, const Ptrs& P, int E) {
    LAS float* scr = (LAS float*)(F.lds + RING_OFF + F.wave * 16640);
    for (;;) { if (q_head(F) >= E) break; const int i = q_take(F);
        for (int k = 0; k < QCH; ++k) if (i + k < Q_E5) conv_item(P, scr, i + k, F.lane); }
}
__device__ __forceinline__ void q_fill(Frame& F, const Ptrs& P, int ph) {
    LAS float* scr = (LAS float*)(F.lds + RING_OFF + F.wave * 16640);
    gu32* done = F.ctl + CW_DONE + 64 * ph;
    for (;;) {
        if ((int)__builtin_amdgcn_readfirstlane(__hip_atomic_load(done, RLX_AGENT)) >= F.G || q_head(F) >= Q_E5) break;
        const int i = q_take(F); if (i >= Q_E5) break;
        for (int k = 0; k < QCH; ++k) if (i + k < Q_E5) conv_item(P, scr, i + k, F.lane); }
}
__device__ __forceinline__ void sub_barrier(Frame& F, gu32* ctr, unsigned n) {
    asm volatile("s_waitcnt vmcnt(0) lgkmcnt(0)" ::: "memory"); __syncthreads();
    if (F.tid == 0) {
        __builtin_amdgcn_fence(__ATOMIC_RELEASE, "agent"); asm volatile("s_waitcnt vmcnt(0)" ::: "memory");
        (void)__hip_atomic_fetch_add(ctr, 1u, RLX_AGENT);
        unsigned sp = 0; while (__hip_atomic_load(ctr, RLX_AGENT) < n) { __builtin_amdgcn_s_sleep(2); if (++sp > (1u << 22)) { __hip_atomic_store(F.ctl + CW_TMO, 1u, RLX_AGENT); break; } }
        __builtin_amdgcn_fence(__ATOMIC_ACQUIRE, "agent"); asm volatile("s_waitcnt vmcnt(0)" ::: "memory");
    }
    __syncthreads();
}
constexpr int CW_SUB = 3072;
#define PHASE_DONE(ph) do { if (F.tid == 0) (void)__hip_atomic_fetch_add(F.ctl + CW_DONE + 64 * (ph), 1u, RLX_AGENT); } while (0)
__device__ __forceinline__ void p0_quant_wgu1(Frame& F, const Ptrs& P) {
    LAS float* scr = (LAS float*)(F.lds + RING_OFF + F.wave * 16640);
    const int gw = F.vcu * NWAVES + F.wave, NGW = F.G * NWAVES;
    for (int it = gw; it < 2 * IT_GU; it += NGW) {
        if (it < IT_GU) p0_quant_item(P.in[I_WG], D, FF, (signed char*)P.Wgu1, P.CMAX, P.SB1, 1, scr, it, F.lane);
        else p0_quant_item(P.in[I_WU], D, FF, (signed char*)P.Wgu1, P.CMAX, P.SB1, 2, scr, it - IT_GU, F.lane);
    }
}
__device__ __forceinline__ void p0_prologue(Frame& F, const Ptrs& P) {
    const int gw = F.vcu * NWAVES + F.wave, NGW = F.G * NWAVES;
    for (int it = gw; it < 4 * IT_GU; it += NGW) { const int mtx = it / IT_GU, r = it - mtx * IT_GU;
        p0_colmax_item((mtx & 1 ? P.in[I_WU] : P.in[I_WG]) + (size_t)(mtx >> 1) * D * FF, FF, P.CMAX + (mtx >> 1) * NGU, 1 + (mtx & 1), r, F.lane); }
    for (int it = gw; it < 2 * IT_GU; it += NGW) { const int mtx = it / IT_GU, r = it - mtx * IT_GU;
        p0_colmax_item(P.in[I_WD] + (size_t)mtx * D * FF, D, P.CMAXD + mtx * D, 0, r, F.lane); }
    for (int m = gw; m < M1V; m += NGW) {
        const float* src = m < ROW_S ? P.in[I_XP] + (size_t)m * D : (m < ROW_M ? P.in[I_XS] + (size_t)(m - ROW_S) * D : P.in[I_META] + (size_t)(m - ROW_M) * D);
        const GAS f32x4* xr = (const GAS f32x4*)src + F.lane; f32x4 v[16];
#pragma unroll
        for (int j = 0; j < 16; ++j) v[j] = xr[64 * j];
        quant_row_i8(v, P.XQ + (size_t)m * D, P.SA + m, F.lane);
    }
    const int gt = gw * 64 + F.lane, NGT = NGW * 64;
    for (int i = gt; i < NPOS * 64; i += NGT) { const int pos = i >> 6, k = i & 63;
        const double inv = exp2(-(double)k * (13.287712379549449 / 64.0)); const float ang = (float)((double)pos * inv);
        float s, c; sincosf(ang, &s, &c); ((GAS f32x2v*)P.ROPE)[i] = (f32x2v){c, s}; }
    cvt_flat(P.in[I_CMK], P.KB + (size_t)KVR_SMETA * KVW, NB_S * NMETA * KVW / 8, gt, NGT);
    cvt_flat(P.in[I_CMV], P.VB + (size_t)KVR_SMETA * KVW, NB_S * NMETA * KVW / 8, gt, NGT);
    cvt_flat(P.in[I_CWK], P.KB + (size_t)KVR_SWIN * KVW, NB_S * WIN * KVW / 8, gt, NGT);
    cvt_flat(P.in[I_CWV], P.VB + (size_t)KVR_SWIN * KVW, NB_S * WIN * KVW / 8, gt, NGT);
}

__device__ __forceinline__ void swiglu_combine(Frame& F, const pg8::SplitOrder& SO, const float* slab, bf16* H, const float* sA, const float* sB) {
    const int tid = F.tid, row = tid >> 4, c8 = (tid & 15) * 8;
    for (int it = blockIdx.x; it < SO.rem * 8; it += F.G) { const int ri = it >> 3, r0 = (it & 7) * 32 + row; pg8::Unit u; SO.map(SO.R * SO.G + ri, u);
        typedef int i32x4 __attribute__((ext_vector_type(4)));
        i32x4 ig0 = {0, 0, 0, 0}, ig1 = ig0, iu0 = ig0, iu1 = ig0;
        for (int s2 = 0; s2 < SO.S; ++s2) { const GAS i32x4* sp = (const GAS i32x4*)(slab + ((size_t)(ri * SO.S + s2) << 16) + r0 * 256 + c8);
            ig0 = ig0 + sp[0]; ig1 = ig1 + sp[1]; iu0 = iu0 + sp[32]; iu1 = iu1 + sp[33]; }
        const float sa = sA[u.pm * 256 + r0]; const float* sbp = sB + u.pn * 256 + c8;
        const f32x4 g0 = __builtin_convertvector(ig0, f32x4) * (*(const GAS f32x4*)(sbp) * sa), g1 = __builtin_convertvector(ig1, f32x4) * (*(const GAS f32x4*)(sbp + 4) * sa);
        const f32x4 u0 = __builtin_convertvector(iu0, f32x4) * (*(const GAS f32x4*)(sbp + 128) * sa), u1 = __builtin_convertvector(iu1, f32x4) * (*(const GAS f32x4*)(sbp + 132) * sa);
        v4u o; o.x = pkbf(silu1(g0.x) * u0.x, silu1(g0.y) * u0.y); o.y = pkbf(silu1(g0.z) * u0.z, silu1(g0.w) * u0.w);
        o.z = pkbf(silu1(g1.x) * u1.x, silu1(g1.y) * u1.y); o.w = pkbf(silu1(g1.z) * u1.z, silu1(g1.w) * u1.w);
        *(GAS v4u*)(H + (size_t)(u.pm * 256 + r0) * FF + u.pn * 128 + c8) = o; }
}
__device__ __forceinline__ void ln_phase(Frame& F, const bf16* Y, float* Xo, bf16* XN, const float* g, const float* b, int nrows, const pg8::SplitOrder& SO, const float* slab, float sscale, signed char* XQ, float* SA) {
    const int gw = F.vcu * NWAVES + F.wave, NGW = F.G * NWAVES;
    f32x4 gg_[16], bb_[16];
#pragma unroll
    for (int j = 0; j < 16; ++j) { gg_[j] = ((const GAS f32x4*)g)[F.lane + 64 * j]; bb_[j] = ((const GAS f32x4*)b)[F.lane + 64 * j]; }
    for (int r = gw; r < nrows; r += NGW) {
        const GAS u32x2v* yr = (const GAS u32x2v*)(Y + (size_t)r * D) + F.lane;
        f32x4 v[16];
#pragma unroll
        for (int j = 0; j < 16; ++j) { const u32x2v w_ = yr[64 * j]; v[j] = (f32x4){bf2f(w_.x & 0xffffu), bf2f(w_.x >> 16), bf2f(w_.y & 0xffffu), bf2f(w_.y >> 16)}; }
        if (SO.rem > 0 && SO.S > 1) { const int pm = r >> 8, rr = r & 255;
#pragma unroll
            for (int j = 0; j < 16; ++j) { const int ri = SO.inv(pm, j) - SO.R * SO.G;
                if (ri >= 0) { const GAS f32x4* sp = (const GAS f32x4*)(slab + ((size_t)(ri * (SO.S - 1)) << 16) + rr * 256) + F.lane; f32x4 a = sp[0];
                    for (int s2 = 1; s2 < SO.S - 1; ++s2) a = a + sp[(size_t)s2 << 14];
                    v[j] = v[j] + a * sscale; } } }
        float s = 0.f;
#pragma unroll
        for (int j = 0; j < 16; ++j) s += (v[j].x + v[j].y) + (v[j].z + v[j].w);
        const float mean = wave_sum(s) * (1.f / D); float s2 = 0.f;
#pragma unroll
        for (int j = 0; j < 16; ++j) { v[j] = v[j] - mean; s2 += (v[j].x * v[j].x + v[j].y * v[j].y) + (v[j].z * v[j].z + v[j].w * v[j].w); }
        const float rstd = 1.f / sqrtf(wave_sum(s2) * (1.f / D) + LN_EPS);
#pragma unroll
        for (int j = 0; j < 16; ++j) { const f32x4 gg = gg_[j], bb = bb_[j];
            const f32x4 o = v[j] * rstd * gg + bb; v[j] = o;
            if (Xo) ((GAS f32x4*)(Xo + (size_t)r * D))[F.lane + 64 * j] = o;
            if (XN) { u32x2v w; w.x = pk2(o.x, o.y); w.y = pk2(o.z, o.w); ((GAS u32x2v*)(XN + (size_t)r * D))[F.lane + 64 * j] = w; } }
        if (XQ) quant_row_i8(v, XQ + (size_t)r * D, SA + r, F.lane);
    }
}

__device__ __forceinline__ void kv_prep(Frame& F, const Ptrs& P) {
    const int gw = F.vcu * NWAVES + F.wave, NGW = F.G * NWAVES, lane = F.lane;
    const bf16* HIN = P.H;
    for (int r = gw; r < M1V; r += NGW) {
        int pos; float* kdst = nullptr; float* vdst = nullptr; int ncp = 1;
        if (r < ROW_S) { const int t = r & (SEQ_P - 1), b = r >> 11; pos = NMETA + t;
            if (t >= SEQ_P - WIN) { kdst = P.out + O_PWK + (size_t)(b * WIN + t - (SEQ_P - WIN)) * KVW; vdst = P.out + O_PWV + (size_t)(b * WIN + t - (SEQ_P - WIN)) * KVW; } }
        else if (r < ROW_M) { pos = NMETA + PAST + ((r - ROW_S) & (SEQ_S - 1)); kdst = P.out + O_SWK + (size_t)(r - ROW_S) * KVW; vdst = P.out + O_SWV + (size_t)(r - ROW_S) * KVW; }
        else { pos = r - ROW_M; kdst = P.out + O_PMK + (size_t)pos * KVW; vdst = P.out + O_PMV + (size_t)pos * KVW; ncp = NB_P; }
        const bf16* hrow = HIN + (size_t)r * DINP;
        const f32x2v cs = ((const GAS f32x2v*)P.ROPE)[pos * 64 + lane];
#pragma unroll
        for (int kh = 0; kh < KVH; ++kh) { const float x1 = bf2f(hrow[C_K + kh * HD + lane]), x2 = bf2f(hrow[C_K + kh * HD + 64 + lane]);
            const float o1 = x1 * cs.x - x2 * cs.y, o2 = x2 * cs.x + x1 * cs.y;
            P.KB[(size_t)r * KVW + kh * HD + lane] = (bf16)f2bf(o1); P.KB[(size_t)r * KVW + kh * HD + 64 + lane] = (bf16)f2bf(o2);
            if (kdst) for (int cp = 0; cp < ncp; ++cp) { kdst[(size_t)cp * NMETA * KVW + kh * HD + lane] = o1; kdst[(size_t)cp * NMETA * KVW + kh * HD + 64 + lane] = o2; } }
        const v4u vv = *(const GAS v4u*)(hrow + C_V + 8 * lane);
        *(GAS v4u*)(P.VB + (size_t)r * KVW + 8 * lane) = vv;
        if (vdst) { const f32x4 a = {bf2f(vv.x & 0xffffu), bf2f(vv.x >> 16), bf2f(vv.y & 0xffffu), bf2f(vv.y >> 16)}, c = {bf2f(vv.z & 0xffffu), bf2f(vv.z >> 16), bf2f(vv.w & 0xffffu), bf2f(vv.w >> 16)};
            for (int cp = 0; cp < ncp; ++cp) { *(GAS f32x4*)(vdst + (size_t)cp * NMETA * KVW + 8 * lane) = a; *(GAS f32x4*)(vdst + (size_t)cp * NMETA * KVW + 8 * lane + 4) = c; } }
    }
    for (int it = gw; it < (NB_P + NB_S) * 3 * (DCONV / 512); it += NGW) {
        const int part = it % (DCONV / 512), rj = it / (DCONV / 512), j = rj % 3, sb = rj / 3;
        const int srow = sb < NB_P ? sb * SEQ_P + SEQ_P - 3 + j : ROW_S + (sb - NB_P) * SEQ_S + SEQ_S - 3 + j;
        float* dst = (sb < NB_P ? P.out + O_PCONV + (size_t)(sb * 3 + j) * DCONV : P.out + O_SCONV + (size_t)((sb - NB_P) * 3 + j) * DCONV) + part * 512 + 8 * lane;
        const v4u vv = *(const GAS v4u*)(HIN + (size_t)srow * DINP + C_CONV + part * 512 + 8 * lane);
        *(GAS f32x4*)dst = (f32x4){bf2f(vv.x & 0xffffu), bf2f(vv.x >> 16), bf2f(vv.y & 0xffffu), bf2f(vv.y >> 16)};
        *(GAS f32x4*)(dst + 4) = (f32x4){bf2f(vv.z & 0xffffu), bf2f(vv.z >> 16), bf2f(vv.w & 0xffffu), bf2f(vv.w >> 16)};
    }
}

constexpr int PB_ST = 136;
constexpr int L_AT = 0, L_TAB = L_AT + 64 * 68 * 4, L_QKR = L_TAB + 12 * 256, L_QB = L_QKR + 64 * 68 * 4, L_KB = L_QB + 64 * PB_ST * 2, L_VB = L_KB + 64 * PB_ST * 2, L_XR = L_VB + 64 * PB_ST * 2, L_PREP_END = L_XR + 64 * 768;
static_assert(L_PREP_END <= RING_BYTES && (L_XR % 1024) == 0, "GDN prep LDS");
enum { T_BETA = 0, T_GC, T_EG, T_EK, T_RK2, T_RQ2, T_SU, T_SW, T_SKD, T_SQD, T_N };
struct PrepUnit { int kind, b, h, n, row0; };
__device__ __forceinline__ PrepUnit prep_decode(int uidx) {
    PrepUnit u; u.b = 0; u.n = 0;
    if (uidx < 2048) { u.kind = 0; u.b = uidx >> 9; u.h = (uidx >> 5) & 15; u.n = uidx & 31; u.row0 = u.b * SEQ_P + 64 * u.n; }
    else if (uidx < 2064) { u.kind = 1; u.h = uidx - 2048; u.row0 = ROW_M - 48; }
    else { u.kind = 2; u.b = (uidx - 2064) >> 4; u.h = (uidx - 2064) & 15; u.row0 = ROW_S + u.b * SEQ_S; }
    return u;
}
__device__ __forceinline__ float dpp_sum16(float p) {
    p += __builtin_bit_cast(float, __builtin_amdgcn_update_dpp(0, __builtin_bit_cast(int, p), 0xB1, 0xF, 0xF, true));
    p += __builtin_bit_cast(float, __builtin_amdgcn_update_dpp(0, __builtin_bit_cast(int, p), 0x4E, 0xF, 0xF, true));
    p += __builtin_bit_cast(float, __builtin_amdgcn_update_dpp(0, __builtin_bit_cast(int, p), 0x141, 0xF, 0xF, true));
    p += __builtin_bit_cast(float, __builtin_amdgcn_update_dpp(0, __builtin_bit_cast(int, p), 0x140, 0xF, 0xF, true));
    return p;
}
template <bool ISU> __device__ __forceinline__ void prep_solve(LAS float* AT, LAS float* TAB, LAS unsigned char* VB, LAS unsigned char* KB, LAS unsigned char* OUTW, unsigned char* ud, int tid) {
    const int cc = tid & 127; const LAS unsigned char* src = (ISU ? VB : KB) + cc * 2; const LAS float* sc = TAB + (ISU ? T_SU : T_SW) * 64;
    float* U = (float*)(ud + GU_U);
    const int cslot = (cc >> 5) * 4 + (kpos32(cc & 31) >> 3), cpos2 = (kpos32(cc & 31) & 7) * 2;
    float r[64];
#pragma unroll
    for (int i = 0; i < 64; ++i) r[i] = bf2f(*(const LAS unsigned short*)(src + i * (PB_ST * 2))) * sc[i];
    const LAS float* atp = AT;
#pragma unroll
    for (int j = 0; j < 64; ++j) { float sol = r[j]; asm volatile("" : "+v"(atp), "+v"(sol));
        if (ISU) U[j * 128 + cc] = sol; else *(LAS unsigned short*)(OUTW + j * 256 + ((cslot ^ (j & 15)) << 4) + cpos2) = (unsigned short)f2bf(sol);
#pragma unroll
        for (int q = (j + 1) / 4; q < 16; ++q) { const f32x4 a = *(const LAS f32x4*)(atp + j * 68 + 4 * q);
            if (4 * q + 0 > j) r[4 * q + 0] -= a.x * sol; if (4 * q + 1 > j) r[4 * q + 1] -= a.y * sol;
            if (4 * q + 2 > j) r[4 * q + 2] -= a.z * sol; if (4 * q + 3 > j) r[4 * q + 3] -= a.w * sol; }
        __builtin_amdgcn_sched_barrier(0); }
}
struct Solve2State { float r0[32], r1[32]; f32x4 a[2][8]; const LAS float* atp; float* U; LAS unsigned char* ow; int pi, cslot; };
template <bool ISU, int J> __device__ __forceinline__ void prep_solve2_step(Solve2State& st) {
    if constexpr (J < 64) {
        constexpr int pj = (J >> 2) & 1, kj = 4 * (J >> 3) + (J & 3);
        asm volatile("" : "+v"(st.atp), "+v"(st.r0[kj]));
        if constexpr (J + 1 < 64) {
#pragma unroll
            for (int kk = (J + 1) >> 3; kk < 8; ++kk) st.a[(J + 1) & 1][kk] = *(const LAS f32x4*)(st.atp + (J + 1) * 68 + 8 * kk); }
        const float m0 = st.r0[kj], m1 = st.r1[kj];
        const float o0 = __builtin_bit_cast(float, __builtin_amdgcn_update_dpp(0, __builtin_bit_cast(int, m0), 0xB1, 0xF, 0xF, true)), o1 = __builtin_bit_cast(float, __builtin_amdgcn_update_dpp(0, __builtin_bit_cast(int, m1), 0xB1, 0xF, 0xF, true));
        const float s0 = (st.pi == pj) ? m0 : o0, s1 = (st.pi == pj) ? m1 : o1;
        if (ISU) *(GAS f32x2v*)(st.U + J * 128) = (f32x2v){s0, s1}; else *(LAS unsigned*)(st.ow + J * 256 + ((st.cslot ^ (J & 15)) << 4)) = pkbf(s0, s1);
#pragma unroll
        for (int kk = J >> 3; kk < 8; ++kk) { const f32x4 av = st.a[J & 1][kk];
            st.r0[4 * kk + 0] -= av.x * s0; st.r0[4 * kk + 1] -= av.y * s0; st.r0[4 * kk + 2] -= av.z * s0; st.r0[4 * kk + 3] -= av.w * s0;
            st.r1[4 * kk + 0] -= av.x * s1; st.r1[4 * kk + 1] -= av.y * s1; st.r1[4 * kk + 2] -= av.z * s1; st.r1[4 * kk + 3] -= av.w * s1; }
        __builtin_amdgcn_sched_barrier(0);
        prep_solve2_step<ISU, J + 1>(st);
    }
}
template <bool ISU> __device__ __forceinline__ void prep_solve2(LAS float* AT, LAS float* TAB, LAS unsigned char* VB, LAS unsigned char* KB, LAS unsigned char* OUTW, unsigned char* ud, int tid) {
    Solve2State st; st.pi = tid & 1; const int c0 = (tid & 127) & ~1;
    const LAS unsigned char* src = (ISU ? VB : KB) + c0 * 2 + st.pi * (4 * PB_ST * 2); const LAS float* sc = TAB + (ISU ? T_SU : T_SW) * 64 + 4 * st.pi;
    st.U = (float*)(ud + GU_U) + c0; st.ow = OUTW + (kpos32(c0 & 31) & 7) * 2; st.cslot = (c0 >> 5) * 4 + (kpos32(c0 & 31) >> 3);
#pragma unroll
    for (int k = 0; k < 32; ++k) { const int rw = 8 * (k >> 2) + (k & 3); const unsigned w_ = *(const LAS unsigned*)(src + rw * (PB_ST * 2)); const float s_ = sc[rw]; st.r0[k] = bf2f(w_ & 0xffffu) * s_; st.r1[k] = bf2f(w_ >> 16) * s_; }
    st.atp = AT + 4 * st.pi;
#pragma unroll
    for (int kk = 0; kk < 8; ++kk) st.a[0][kk] = *(const LAS f32x4*)(st.atp + 8 * kk);
    prep_solve2_step<ISU, 0>(st);
}
#define PB_BAR() do { asm volatile("s_waitcnt lgkmcnt(0)" ::: "memory"); __builtin_amdgcn_s_barrier(); asm volatile("" ::: "memory"); } while (0)
__device__ __forceinline__ void gdn_prep_all(Frame& F, const Ptrs& P, int abl  ) {
    int tid_ = F.tid; asm volatile("" : "+v"(tid_));
    const int tid = tid_, wv = F.wave;
    LAS unsigned char* L = F.lds;
    LAS float* AT = (LAS float*)(L + L_AT); LAS float* TAB = (LAS float*)(L + L_TAB); LAS float* QKR = (LAS float*)(L + L_QKR);
    LAS unsigned char* QB = L + L_QB; LAS unsigned char* KB = L + L_KB; LAS unsigned char* VB = L + L_VB; LAS unsigned char* XR = L + L_XR; LAS unsigned char* OUTW = L + L_QKR;
    const bf16* HIN = P.H;
    const int part = wv >> 1, half = wv & 1;
    f32x2v cwn[4], hxn[3]; float bln = 0.f, aln = 0.f;
#define PB_PREFETCH(U) do { const PrepUnit& u_ = (U); int lane = tid; asm volatile("" : "+v"(lane)); lane &= 63; \
          \
        _Pragma("unroll") for (int k_ = 0; k_ < 6; ++k_) { const int p_ = (6 * wv + k_) * 64 + lane, t_ = p_ >> 4, r_ = (t_ * 171) >> 9, pt_ = t_ - 3 * r_; \
            const int rr_ = (u_.kind == 1 && r_ < 48) ? 48 : r_; \
            __builtin_amdgcn_global_load_lds((const GAS unsigned*)(HIN + (size_t)(u_.row0 + rr_) * DINP + C_CONV + pt_ * 2048 + u_.h * 128 + (p_ & 15) * 8), (LAS unsigned*)(XR + (6 * wv + k_) * 1024), 16, 0, 0); } \
        if (wv < 6) { const int ch_ = part * 2048 + u_.h * 128 + 2 * lane; const float* cw_ = P.in[I_CONVW] + ch_; \
            _Pragma("unroll") for (int j_ = 0; j_ < 4; ++j_) cwn[j_] = *(const GAS f32x2v*)(cw_ + j_ * DCONV); \
            _Pragma("unroll") for (int j_ = 0; j_ < 3; ++j_) hxn[j_] = (f32x2v){0.f, 0.f}; \
            if (half == 0) { \
                if (u_.kind == 0) { const int hr_ = (u_.n == 0) ? ROW_M + 13 : u_.row0 - 3; \
                    _Pragma("unroll") for (int j_ = 0; j_ < 3; ++j_) { const unsigned w_ = *(const GAS unsigned*)(HIN + (size_t)(hr_ + j_) * DINP + C_CONV + ch_); hxn[j_] = (f32x2v){bf2f(w_ & 0xffffu), bf2f(w_ >> 16)}; } } \
                else if (u_.kind == 2) { const float* sc_ = P.in[I_SCONV] + (size_t)u_.b * 3 * DCONV + ch_; \
                    _Pragma("unroll") for (int j_ = 0; j_ < 3; ++j_) hxn[j_] = *(const GAS f32x2v*)(sc_ + j_ * DCONV); } } } \
        else if (wv == 6) { const bf16* hr_ = HIN + (size_t)(u_.row0 + ((u_.kind == 1 && lane < 48) ? 48 : lane)) * DINP; bln = bf2f(hr_[C_B + u_.h]); aln = bf2f(hr_[C_A + u_.h]); } } while (0)
    int uidx = blockIdx.x;
    if (uidx >= N_GUNITS) return;
    PrepUnit un_ = prep_decode(uidx);
    PB_PREFETCH(un_);
    for (; uidx < N_GUNITS; uidx += F.G) {
        const PrepUnit u = prep_decode(uidx);
        unsigned char* ud = P.GDN + (size_t)uidx * GU_BYTES;
        asm volatile("s_waitcnt vmcnt(0) lgkmcnt(0)" ::: "memory"); __builtin_amdgcn_s_barrier(); asm volatile("" ::: "memory");
        f32x2v cw[4], hx[3]; float bl = bln, al = aln;
#pragma unroll
        for (int j = 0; j < 4; ++j) cw[j] = cwn[j];
#pragma unroll
        for (int j = 0; j < 3; ++j) hx[j] = hxn[j];
        asm volatile("" : "+v"(cw[0]), "+v"(cw[1]), "+v"(cw[2]), "+v"(cw[3]), "+v"(hx[0]), "+v"(hx[1]), "+v"(hx[2]), "+v"(bl), "+v"(al));
        { int tl_ = tid; asm volatile("" : "+v"(tl_)); const int lane = tl_ & 63;
        if (wv < 6) {
            const LAS unsigned char* xr = XR + part * 256 + lane * 4; LAS unsigned char* dst = (part == 0 ? QB : (part == 1 ? KB : VB)) + lane * 4;
            const int i0 = 32 * half;
            f32x2v xm3 = hx[0], xm2 = hx[1], xm1 = hx[2];
            if (half == 1) { const unsigned a_ = *(const LAS unsigned*)(xr + 29 * 768), b_ = *(const LAS unsigned*)(xr + 30 * 768), c_ = *(const LAS unsigned*)(xr + 31 * 768);
                xm3 = (f32x2v){bf2f(a_ & 0xffffu), bf2f(a_ >> 16)}; xm2 = (f32x2v){bf2f(b_ & 0xffffu), bf2f(b_ >> 16)}; xm1 = (f32x2v){bf2f(c_ & 0xffffu), bf2f(c_ >> 16)};
                if (u.kind == 1) { xm3 = (f32x2v){0.f, 0.f}; xm2 = xm3; xm1 = xm3; } }
#pragma unroll 8
            for (int ii = 0; ii < 32; ++ii) { const int i = i0 + ii; const unsigned w_ = *(const LAS unsigned*)(xr + i * 768);
                f32x2v x = (f32x2v){bf2f(w_ & 0xffffu), bf2f(w_ >> 16)};
                if (u.kind == 1 && i < 48) x = (f32x2v){0.f, 0.f};
                const f32x2v y = cw[0] * xm3 + cw[1] * xm2 + cw[2] * xm1 + cw[3] * x;
                *(LAS unsigned*)(dst + i * (PB_ST * 2)) = pkbf(silu1(y.x), silu1(y.y)); xm3 = xm2; xm2 = xm1; xm1 = x; }
        } else if (wv == 6) {
            float be = 0.f, g = 0.f;
            if (!(u.kind == 1 && lane < 48)) { be = 1.f / (1.f + expf(-bl)); const float x = al + P.in[I_DTB][u.h]; const float sp = fmaxf(x, 0.f) + log1pf(expf(-fabsf(x))); g = -expf(P.in[I_ALOG][u.h]) * sp; }
            float v = g;
#pragma unroll
            for (int o = 1; o < 64; o <<= 1) { const float t = __shfl_up(v, o); if (lane >= o) v += t; }
            const float last = __shfl(v, 63);
            TAB[T_BETA * 64 + lane] = be; TAB[T_GC * 64 + lane] = v; TAB[T_EG * 64 + lane] = expf(v); TAB[T_EK * 64 + lane] = expf(last - v);
        } }
        PB_BAR();
        if (uidx + F.G < N_GUNITS) { un_ = prep_decode(uidx + F.G); PB_PREFETCH(un_); }
        __builtin_amdgcn_sched_barrier(0);
        if (!(abl & 4)) { int tl_ = tid; asm volatile("" : "+v"(tl_)); const int lane = tl_ & 63, c16 = lane & 15, q4 = lane >> 4;
#pragma unroll
        for (int tk = 0; tk < 3; ++tk) { const int task = wv + 8 * tk;
            int rb, cb; const LAS unsigned char *Ap, *Bp;
            if (task < 20) { const int t10 = task < 10 ? task : task - 10; int a = 0, b = t10;
                if (b >= 1) { a = 1; b -= 1; if (b >= 2) { a = 2; b -= 2; if (b >= 3) { a = 3; b -= 3; } } }
                if (task < 10) { rb = a; cb = b; Ap = KB; Bp = KB; } else { rb = b; cb = a; Ap = KB; Bp = QB; } }
            else { rb = task - 20; cb = rb; Ap = QB; Bp = QB; }
            f32x4 acc = {0.f, 0.f, 0.f, 0.f};
#pragma unroll
            for (int s = 0; s < 4; ++s) { const bf16x8 A = *(const LAS bf16x8*)(Ap + (16 * rb + c16) * (PB_ST * 2) + 64 * s + 16 * q4), B = *(const LAS bf16x8*)(Bp + (16 * cb + c16) * (PB_ST * 2) + 64 * s + 16 * q4);
                acc = __builtin_amdgcn_mfma_f32_16x16x32_bf16(A, B, acc, 0, 0, 0); }
            if (task < 10) { *(LAS f32x4*)(AT + (16 * cb + c16) * 68 + 16 * rb + 4 * q4) = acc;
                if (rb == cb) {
#pragma unroll
                    for (int r = 0; r < 4; ++r) if (c16 == 4 * q4 + r) TAB[T_RK2 * 64 + 16 * rb + c16] = acc[r]; } }
            else if (task < 20) { *(LAS f32x4*)(QKR + (16 * cb + c16) * 68 + 16 * rb + 4 * q4) = acc; }
            else {
#pragma unroll
                for (int r = 0; r < 4; ++r) if (c16 == 4 * q4 + r) TAB[T_RQ2 * 64 + 16 * rb + c16] = acc[r]; }
        } }
        PB_BAR();
        if (!(abl & 4)) { int tid = tid_; asm volatile("" : "+v"(tid));
        { const int j = tid >> 3, i8 = (tid & 7) * 8;
            const float rkj = rsqrtf(TAB[T_RK2 * 64 + j] + RMS_EPS), gcj = TAB[T_GC * 64 + j];
#pragma unroll
            for (int e = 0; e < 8; ++e) { const int i = i8 + e; const float v = AT[j * 68 + i];
                const float sc = TAB[T_BETA * 64 + i] * rsqrtf(TAB[T_RK2 * 64 + i] + RMS_EPS) * rkj * expf(fminf(TAB[T_GC * 64 + i] - gcj, 0.f));
                AT[j * 68 + i] = (i > j) ? v * sc : 0.f; } }
        { const int i = tid >> 3, sl = tid & 7, g = sl >> 2, qq = sl & 3;
            const float rqi = rsqrtf(TAB[T_RQ2 * 64 + i] + RMS_EPS) * 0.08838834764831845f, gci = TAB[T_GC * 64 + i];
            float v[8];
#pragma unroll
            for (int e = 0; e < 8; ++e) { const int j = 32 * g + 4 * qq + (e & 3) + 16 * (e >> 2); const float raw = QKR[i * 68 + j];
                v[e] = (i >= j) ? raw * rqi * rsqrtf(TAB[T_RK2 * 64 + j] + RMS_EPS) * expf(fminf(gci - TAB[T_GC * 64 + j], 0.f)) : 0.f; }
            v4u o; o.x = pkbf(v[0], v[1]); o.y = pkbf(v[2], v[3]); o.z = pkbf(v[4], v[5]); o.w = pkbf(v[6], v[7]);
            *(GAS v4u*)(ud + GU_QK + i * 128 + ((sl ^ ((i >> 1) & 7)) * 16)) = o; }
        if (tid < 64) { const int i = tid; const float rk = rsqrtf(TAB[T_RK2 * 64 + i] + RMS_EPS), rq = rsqrtf(TAB[T_RQ2 * 64 + i] + RMS_EPS) * 0.08838834764831845f, be = TAB[T_BETA * 64 + i], eg = TAB[T_EG * 64 + i];
            TAB[T_SU * 64 + i] = be; TAB[T_SW * 64 + i] = be * eg * rk; TAB[T_SKD * 64 + i] = TAB[T_EK * 64 + i] * rk; TAB[T_SQD * 64 + i] = eg * rq;
            if (i == 63) *(GAS float*)(ud + GU_GL) = eg; } }
        PB_BAR();
        { int tid = tid_; asm volatile("" : "+v"(tid)); const int lane = tid & 63, c16 = lane & 15, q4 = lane >> 4;
        if (tid < 128) { if (!(abl & 1)) prep_solve2<true>(AT, TAB, VB, KB, OUTW, ud, tid); }
        else if (tid < 256) { if (!(abl & 1)) prep_solve2<false>(AT, TAB, VB, KB, OUTW, ud, tid); }
        else if (!(abl & 2)) {
            const int t = tid - 256;
#pragma unroll
            for (int k = 0; k < 4; ++k) { const int id = t + 256 * k, i = id >> 4, sl = id & 15, g = sl >> 2, qq = sl & 3; const float sc = TAB[T_SQD * 64 + i];
                const u32x2v lo = *(const LAS u32x2v*)(QB + i * (PB_ST * 2) + (32 * g + 4 * qq) * 2), hi = *(const LAS u32x2v*)(QB + i * (PB_ST * 2) + (32 * g + 16 + 4 * qq) * 2);
                v4u o; o.x = pkbf(bf2f(lo.x & 0xffffu) * sc, bf2f(lo.x >> 16) * sc); o.y = pkbf(bf2f(lo.y & 0xffffu) * sc, bf2f(lo.y >> 16) * sc);
                o.z = pkbf(bf2f(hi.x & 0xffffu) * sc, bf2f(hi.x >> 16) * sc); o.w = pkbf(bf2f(hi.y & 0xffffu) * sc, bf2f(hi.y >> 16) * sc);
                *(GAS v4u*)(ud + GU_QD + i * 256 + ((sl ^ (i & 15)) * 16)) = o; }
            const int w4 = wv - 4;
#pragma unroll
            for (int k = 0; k < 4; ++k) { const int task = w4 * 4 + k, db = task >> 1, g = task & 1;
                const int addr = (int)(size_t)KB + (32 * g + 4 * q4 + ((lane & 15) >> 2)) * (PB_ST * 2) + (16 * db + 4 * (lane & 3)) * 2;
                const f32x4 s0 = *(const LAS f32x4*)(TAB + T_SKD * 64 + 32 * g + 4 * q4), s1 = *(const LAS f32x4*)(TAB + T_SKD * 64 + 32 * g + 16 + 4 * q4);
                s16x4 lo, hi;
                asm volatile("ds_read_b64_tr_b16 %0, %2\n\tds_read_b64_tr_b16 %1, %2 offset:4352\n\ts_waitcnt lgkmcnt(0)" : "=&v"(lo), "=&v"(hi) : "v"(addr) : "memory");
                v4u o; o.x = pkbf(bf2f((unsigned short)lo[0]) * s0.x, bf2f((unsigned short)lo[1]) * s0.y); o.y = pkbf(bf2f((unsigned short)lo[2]) * s0.z, bf2f((unsigned short)lo[3]) * s0.w);
                o.z = pkbf(bf2f((unsigned short)hi[0]) * s1.x, bf2f((unsigned short)hi[1]) * s1.y); o.w = pkbf(bf2f((unsigned short)hi[2]) * s1.z, bf2f((unsigned short)hi[3]) * s1.w);
                const int d = 16 * db + c16;
                *(GAS v4u*)(ud + GU_KDT + d * 128 + (((4 * g + q4) ^ ((d >> 1) & 7)) * 16)) = o; }
        } }
        PB_BAR();
        if (!(abl & 1)) { int tid = tid_; asm volatile("" : "+v"(tid));
#pragma unroll
        for (int k = 0; k < 2; ++k) { const int o16 = (tid + 512 * k) * 16; *(GAS v4u*)(ud + GU_W + o16) = *(const LAS v4u*)(OUTW + o16); } }
    }
    asm volatile("s_waitcnt vmcnt(0) lgkmcnt(0)" ::: "memory"); __syncthreads();
#undef PB_PREFETCH
}
#undef PB_BAR

typedef float f32x16 __attribute__((ext_vector_type(16)));
#define KSWZ(row, colB) ((row) * 256 + ((colB) ^ (((row) & 7) << 4)))
#define SBAR() __builtin_amdgcn_sched_barrier(0)
__device__ __forceinline__ int crow(int r, int hi) { return (r & 3) + 8 * (r >> 2) + 4 * hi; }
__device__ __forceinline__ unsigned cvtpk(float lo, float hi) { unsigned r; asm volatile("v_cvt_pk_bf16_f32 %0, %1, %2" : "=v"(r) : "v"(lo), "v"(hi)); return r; }
__device__ __forceinline__ void qkt(f32x16& p0, f32x16& p1, const LAS unsigned char* Ks, const bf16x8* qr, int r32, int hi) {
    p0 = f32x16{}; p1 = f32x16{};
#pragma unroll
    for (int d0 = 0; d0 < 8; ++d0) { const int cb = (d0 * 16 + hi * 8) * 2;
        const bf16x8 b0 = *(const LAS bf16x8*)(Ks + KSWZ(r32, cb)), b1 = *(const LAS bf16x8*)(Ks + KSWZ(32 + r32, cb));
        p0 = __builtin_amdgcn_mfma_f32_32x32x16_bf16(b0, qr[d0], p0, 0, 0, 0);
        p1 = __builtin_amdgcn_mfma_f32_32x32x16_bf16(b1, qr[d0], p1, 0, 0, 0); }
}
__device__ __forceinline__ int v_st(int k, int c) { const int kk = (k & ~0xC) | ((k & 4) << 1) | ((k & 8) >> 1); return ((kk >> 3) * 4 + (c >> 5)) * 512 + ((kk & 7) * 32 + (c & 31)) * 2; }
__device__ __forceinline__ int v_rd_base(int lane) { return ((lane & 3) << 3) | (((lane >> 2) & 3) << 6) | (((lane >> 4) & 1) << 5) | (((lane >> 5) & 1) << 8); }
constexpr int v_rd_off(int d0, int ks, int half) { return d0 * 512 + ks * 4096 + half * 2048; }
template <int OFF> __device__ __forceinline__ s16x4 tr_read(int vb) { s16x4 r; asm volatile("ds_read_b64_tr_b16 %0, %1 offset:%2" : "=&v"(r) : "v"(vb), "i"(OFF) : "memory"); return r; }
template <int D0> __device__ __forceinline__ void pv_one(f32x16& od, int vb, bf16x8 pa0, bf16x8 pa1, bf16x8 pa2, bf16x8 pa3) {
    const s16x4 l0 = tr_read<v_rd_off(D0, 0, 0)>(vb), h0 = tr_read<v_rd_off(D0, 0, 1)>(vb), l1 = tr_read<v_rd_off(D0, 1, 0)>(vb), h1 = tr_read<v_rd_off(D0, 1, 1)>(vb);
    const s16x4 l2 = tr_read<v_rd_off(D0, 2, 0)>(vb), h2 = tr_read<v_rd_off(D0, 2, 1)>(vb), l3 = tr_read<v_rd_off(D0, 3, 0)>(vb), h3 = tr_read<v_rd_off(D0, 3, 1)>(vb);
    asm volatile("s_waitcnt lgkmcnt(0)" ::: "memory"); SBAR();
#define PK(L, H) (bf16x8){L[0], L[1], L[2], L[3], H[0], H[1], H[2], H[3]}
    od = __builtin_amdgcn_mfma_f32_32x32x16_bf16(pa0, PK(l0, h0), od, 0, 0, 0);
    od = __builtin_amdgcn_mfma_f32_32x32x16_bf16(pa1, PK(l1, h1), od, 0, 0, 0);
    od = __builtin_amdgcn_mfma_f32_32x32x16_bf16(pa2, PK(l2, h2), od, 0, 0, 0);
    od = __builtin_amdgcn_mfma_f32_32x32x16_bf16(pa3, PK(l3, h3), od, 0, 0, 0);
#undef PK
}
constexpr int ATT_V = 0, ATT_K = 16384, ATT_WS = 32768;
__device__ __forceinline__ void attn_unit(Frame& F, const Ptrs& P, int a) {
    constexpr float SCALE = 0.088388347648318440f, C = SCALE * 1.4426950408889634f;
    int tid_ = F.tid; asm volatile("" : "+v"(tid_));
    const int tid = tid_, wid = F.wave, lane = tid & 63, r32 = lane & 31, hi = lane >> 5;
    const bool isp = a < 512; const int kvh = a & 3, ab = isp ? (a >> 7) : ((a - 512) >> 2), ac = isp ? ((a >> 2) & 31) : 0;
    const int qrow0 = isp ? ab * SEQ_P + 64 * ac : ROW_S + ab * SEQ_S, pos0 = isp ? NMETA + 64 * ac : NMETA + PAST;
    LAS unsigned char* V_lds = F.lds + ATT_V; LAS unsigned char* K_lds = F.lds + ATT_K;
    LAS float* ws = (LAS float*)(F.lds + ATT_WS) + wid * 64; LAS float* li_l = ws; LAS float* al_l = ws + 32;
    const int g = wid >> 1, qoff = 32 * (wid & 1), hq = kvh * 4 + g;
    bf16x8 qr[8];
    { const bf16* qp = P.H + (size_t)(qrow0 + qoff + r32) * DINP + C_Q + hq * HD + hi * 8; const GAS f32x2v* cs = (const GAS f32x2v*)P.ROPE + (size_t)(pos0 + qoff + r32) * 64 + hi * 8;
#pragma unroll
        for (int d0 = 0; d0 < 4; ++d0) { const v4u lo = *(const GAS v4u*)(qp + d0 * 16), hh = *(const GAS v4u*)(qp + 64 + d0 * 16);
            const unsigned lw[4] = {lo.x, lo.y, lo.z, lo.w}, hw[4] = {hh.x, hh.y, hh.z, hh.w}; unsigned o1[4], o2[4];
#pragma unroll
            for (int j = 0; j < 4; ++j) { const f32x2v c0 = cs[d0 * 16 + 2 * j], c1 = cs[d0 * 16 + 2 * j + 1];
                const float a0 = bf2f(lw[j] & 0xffffu), a1 = bf2f(lw[j] >> 16), b0 = bf2f(hw[j] & 0xffffu), b1 = bf2f(hw[j] >> 16);
                o1[j] = cvtpk(a0 * c0.x - b0 * c0.y, a1 * c1.x - b1 * c1.y); o2[j] = cvtpk(b0 * c0.x + a0 * c0.y, b1 * c1.x + a1 * c1.y); }
            const v4u w1 = {o1[0], o1[1], o1[2], o1[3]}, w2 = {o2[0], o2[1], o2[2], o2[3]};
            qr[d0] = __builtin_bit_cast(bf16x8, w1); qr[d0 + 4] = __builtin_bit_cast(bf16x8, w2); } }
    float m_reg = -1e30f, l_reg = 0.f; f32x16 o[4] = {};
    const int sr = tid >> 4, sc = (tid & 15) * 8, vst0 = v_st(sr, sc), vst1 = v_st(32 + sr, sc);
    const int vb0 = (int)(size_t)V_lds + v_rd_base(lane);
    const int tmin = isp ? (ac >= 2 ? 1 : 3 - ac) : 1;
#define ATT_KROW(t) ((t) == 0 ? (isp ? ROW_M : KVR_SMETA + ab * NMETA) : (isp ? ab * SEQ_P + 64 * (ac - 3 + (t)) : ((t) == 3 ? ROW_S + ab * SEQ_S : KVR_SWIN + ab * WIN + 64 * ((t) - 1))))
#define ATT_LOAD(t) do { const int ra_ = ((t) == 0) ? (sr & 15) : sr, rb_ = ((t) == 0) ? (sr & 15) : 32 + sr;     \
        const bf16* kp_ = P.KB + (size_t)ATT_KROW(t) * KVW + kvh * HD + sc; const bf16* vp_ = P.VB + (size_t)ATT_KROW(t) * KVW + kvh * HD + sc; \
        nk0 = *(const GAS v4u*)(kp_ + (size_t)ra_ * KVW); nk1 = *(const GAS v4u*)(kp_ + (size_t)rb_ * KVW); nv0 = *(const GAS v4u*)(vp_ + (size_t)ra_ * KVW); nv1 = *(const GAS v4u*)(vp_ + (size_t)rb_ * KVW); } while (0)
    v4u nk0, nk1, nv0, nv1; ATT_LOAD(0);
#pragma unroll
    for (int t = 0; t < 4; ++t) {
        const bool kval_t = (t == 0) || (t >= tmin);
        if (kval_t) {
        const v4u k0 = nk0, k1 = nk1, v0 = nv0, v1 = nv1;
        __syncthreads();
        *(LAS v4u*)(V_lds + vst0) = v0; *(LAS v4u*)(V_lds + vst1) = v1; *(LAS v4u*)(K_lds + KSWZ(sr, sc * 2)) = k0; *(LAS v4u*)(K_lds + KSWZ(32 + sr, sc * 2)) = k1;
        __syncthreads();
        { const int nt_ = (t == 0) ? tmin : t + 1; if (nt_ <= 3) { if (nt_ == 1) ATT_LOAD(1); else if (nt_ == 2) ATT_LOAD(2); else ATT_LOAD(3); } }
        f32x16 p0, p1; qkt(p0, p1, K_lds, qr, r32, hi);
        if (t == 0) {
#pragma unroll
            for (int r = 8; r < 16; ++r) p0[r] = -INFINITY;
#pragma unroll
            for (int r = 0; r < 16; ++r) p1[r] = -INFINITY; }
        float pmax = p0[0];
#pragma unroll
        for (int r = 1; r < 16; ++r) pmax = fmaxf(pmax, p0[r]);
#pragma unroll
        for (int r = 0; r < 16; ++r) pmax = fmaxf(pmax, p1[r]);
        { auto rr = __builtin_amdgcn_permlane32_swap(__float_as_uint(pmax), __float_as_uint(pmax), false, false); pmax = fmaxf(__uint_as_float(rr[0]), __uint_as_float(rr[1])); }
        const float mn = fmaxf(m_reg, pmax), alpha = __builtin_amdgcn_exp2f((m_reg - mn) * C), mnC = -mn * C; m_reg = mn;
        float ps = 0.f;
#pragma unroll
        for (int r = 0; r < 16; ++r) { p0[r] = __builtin_amdgcn_exp2f(fmaf(p0[r], C, mnC)); p1[r] = __builtin_amdgcn_exp2f(fmaf(p1[r], C, mnC)); ps += p0[r] + p1[r]; }
        { auto rr = __builtin_amdgcn_permlane32_swap(__float_as_uint(ps), __float_as_uint(ps), false, false); ps = __uint_as_float(rr[0]) + __uint_as_float(rr[1]); }
        l_reg = l_reg * alpha + ps;
        if (hi == 0) al_l[r32] = alpha;
        asm volatile("s_waitcnt lgkmcnt(0)" ::: "memory");
#pragma unroll
        for (int d = 0; d < 4; ++d)
#pragma unroll
            for (int r = 0; r < 16; ++r) o[d][r] *= al_l[crow(r, hi)];
        bf16x8 pa0, pa1, pa2, pa3;
#define PK4(Pv, BASE, OUT) do { unsigned a0 = cvtpk(Pv[BASE + 0], Pv[BASE + 1]), a1 = cvtpk(Pv[BASE + 2], Pv[BASE + 3]);   \
    unsigned b0 = cvtpk(Pv[BASE + 4], Pv[BASE + 5]), b1 = cvtpk(Pv[BASE + 6], Pv[BASE + 7]);                              \
    auto r0 = __builtin_amdgcn_permlane32_swap(a0, b0, false, false); auto r1 = __builtin_amdgcn_permlane32_swap(a1, b1, false, false); \
    v4u w = {r0[0], r1[0], r0[1], r1[1]}; OUT = __builtin_bit_cast(bf16x8, w); } while (0)
        PK4(p0, 0, pa0); PK4(p0, 8, pa1); PK4(p1, 0, pa2); PK4(p1, 8, pa3);
#undef PK4
        SBAR();
        pv_one<0>(o[0], vb0, pa0, pa1, pa2, pa3); pv_one<1>(o[1], vb0, pa0, pa1, pa2, pa3); pv_one<2>(o[2], vb0, pa0, pa1, pa2, pa3); pv_one<3>(o[3], vb0, pa0, pa1, pa2, pa3);
        }
    }
#undef ATT_KROW
#undef ATT_LOAD
    l_reg += __builtin_amdgcn_exp2f(P.in[I_SINK][hq] * 1.4426950408889634f - m_reg * C);
    if (hi == 0) li_l[r32] = l_reg;
    asm volatile("s_waitcnt lgkmcnt(0)" ::: "memory");
    bf16* Ow = P.MIX + (size_t)(qrow0 + qoff) * D + hq * HD;
#pragma unroll
    for (int r = 0; r < 16; ++r) { const int orow = crow(r, hi); const float rl = __builtin_amdgcn_rcpf(li_l[orow]);
#pragma unroll
        for (int d0 = 0; d0 < 4; ++d0) Ow[(size_t)orow * D + d0 * 32 + r32] = (bf16)f2bf(o[d0][r] * rl); }
    __syncthreads();
}

typedef const GAS unsigned char* gcp;
template <class T> __device__ __forceinline__ T ldg_u(gcp ubase, unsigned voff) { return *(const GAS T*)(ubase + voff); }
constexpr int SC_ABUF = 57344, SC_SSQ_OFF = 2 * SC_ABUF;
template <int MODE  > __device__ __forceinline__ void gdn_scan_seq(Frame& F, const Ptrs& P, int kind  , int b, int h) {
    int lane_ = F.lane; asm volatile("" : "+v"(lane_));
    const int w = F.wave, lane = lane_, c16 = lane & 15, q4 = lane >> 4;
    LAS float* SSQ = (LAS float*)(F.lds + SC_SSQ_OFF);
    const unsigned ecol = (unsigned)(16 * w + c16);
    const unsigned voU = (unsigned)(q4 * 2048) + ecol * 4u;
    const unsigned voZ = (unsigned)(q4 * 4 * DINP * 2) + ecol * 2u;
    const unsigned voM = (unsigned)(q4 * 4 * D * 2) + ecol * 2u;
    unsigned fo256[4], fo128[2];
#pragma unroll
    for (int s = 0; s < 4; ++s) fo256[s] = (unsigned)(c16 * 256 + (((4 * s + q4) ^ c16) * 16));
#pragma unroll
    for (int s = 0; s < 2; ++s) fo128[s] = (unsigned)(c16 * 128 + (((4 * s + q4) ^ ((c16 >> 1) & 7)) * 16));
    const unsigned dma_lane = (unsigned)(w * 7168 + lane * 16);
    f32x4 S[8];
    if (kind == 2) { gcp s0 = (gcp)(P.in[I_SGDN] + (size_t)(b * NHG + h) * 128 * 128);
#pragma unroll
        for (int db = 0; db < 8; ++db)
#pragma unroll
            for (int r = 0; r < 4; ++r) S[db][r] = ldg_u<float>(s0 + db * 8192, voU + r * 512); }
    else {
#pragma unroll
        for (int db = 0; db < 8; ++db) S[db] = (f32x4){0.f, 0.f, 0.f, 0.f}; }
    const int nsteps = kind == 0 ? 33 : 1;
    const float nw = P.in[I_NORMW][ecol];
    const int seq = b * NHG + h;
#define SC_UD(t) ((gcp)(P.GDN + (size_t)(kind == 2 ? 2064 + seq : ((t) == 0 ? 2048 + h : seq * 32 + (t) - 1)) * GU_BYTES))
#define SC_ROW0(t) (kind == 0 ? b * SEQ_P + 64 * ((t) - 1) : ROW_S + b * SEQ_S)
#define SC_DMA(ud, buf) do { _Pragma("unroll") for (int _i = 0; _i < 7; ++_i) \
        __builtin_amdgcn_global_load_lds((const GAS unsigned*)((ud) + GU_W + dma_lane + _i * 1024), (LAS unsigned*)(F.lds + (buf) * SC_ABUF + w * 7168 + _i * 1024), 16, 0, 0); } while (0)
    float un[4][4], gln; unsigned zn[4][4];
#define SC_PREFETCH(udp) do { gln = *(const GAS float*)((udp) + GU_GL); \
        _Pragma("unroll") for (int m = 0; m < 4; ++m) _Pragma("unroll") for (int r = 0; r < 4; ++r) un[m][r] = ldg_u<float>((udp) + GU_U + m * 8192, voU + r * 512); } while (0)
#define SC_LD256(dst, off, m0) do { _Pragma("unroll") for (int mm = 0; mm < 2; ++mm) _Pragma("unroll") for (int s = 0; s < 4; ++s) dst[mm * 4 + s] = *(const LAS bf16x8*)(img + (off) + ((m0) + mm) * 4096 + fo256[s]); } while (0)
#define SC_LD128(dst, off, r0) do { _Pragma("unroll") for (int rr = 0; rr < 4; ++rr) _Pragma("unroll") for (int s = 0; s < 2; ++s) dst[rr * 2 + s] = *(const LAS bf16x8*)(img + (off) + ((r0) + rr) * 2048 + fo128[s]); } while (0)
#define SC_SCHED __builtin_amdgcn_sched_barrier(0)
#define SC_EPI(t, ov, zv) do { const LAS float* sq_ = SSQ + ((t) & 1) * 512; GAS unsigned char* mb_ = (GAS unsigned char*)((MODE == 0 ? P.MIX : P.XN) + (size_t)SC_ROW0(t) * D + 2048 + h * 128); \
        _Pragma("unroll") for (int m = 0; m < 4; ++m) _Pragma("unroll") for (int r = 0; r < 4; ++r) { const int i_ = 16 * m + 4 * q4 + r; \
            const f32x4 t0_ = *(const LAS f32x4*)(sq_ + i_ * 8), t1_ = *(const LAS f32x4*)(sq_ + i_ * 8 + 4); const float tot_ = ((t0_.x + t0_.y) + (t0_.z + t0_.w)) + ((t1_.x + t1_.y) + (t1_.z + t1_.w)); \
            const float rstd_ = rsqrtf(tot_ * (1.f / 128.f) + RMS_EPS); \
            *(GAS unsigned short*)(mb_ + (16 * m + r) * (D * 2) + voM) = (unsigned short)f2bf(ov[m][r] * rstd_ * nw * silu1(bf2f(zv[m][r]))); } } while (0)
    { gcp ud0 = SC_UD(0); if (MODE != 1) { SC_DMA(ud0, 0); } SC_PREFETCH(ud0); }
#pragma unroll
    for (int m = 0; m < 4; ++m)
#pragma unroll
        for (int r = 0; r < 4; ++r) zn[m][r] = 0u;
    f32x4 op[4]; unsigned zp[4][4];
#pragma unroll
    for (int m = 0; m < 4; ++m) { op[m] = (f32x4){0.f, 0.f, 0.f, 0.f};
#pragma unroll
        for (int r = 0; r < 4; ++r) zp[m][r] = 0u; }
    for (int step = 0; step < nsteps; ++step) {
        const bool has_out = !(kind == 0 && step == 0), prev_out = step > 0 && !(kind == 0 && step == 1);
        asm volatile("s_waitcnt vmcnt(0) lgkmcnt(0)" ::: "memory"); __builtin_amdgcn_s_barrier(); asm volatile("" ::: "memory");
        float uc[4][4], gl = gln;
#pragma unroll
        for (int m = 0; m < 4; ++m) {
#pragma unroll
            for (int r = 0; r < 4; ++r) { uc[m][r] = un[m][r]; zp[m][r] = zn[m][r]; }
            asm volatile("" : "+v"(uc[m][0]), "+v"(uc[m][1]), "+v"(uc[m][2]), "+v"(uc[m][3]), "+v"(zp[m][0]), "+v"(zp[m][1]), "+v"(zp[m][2]), "+v"(zp[m][3])); }
        asm volatile("" : "+v"(gl));
        SC_SCHED;
        if (has_out && MODE != 1) { gcp zb_ = (gcp)(P.H + (size_t)SC_ROW0(step) * DINP + C_Z + h * 128);
#pragma unroll
            for (int m = 0; m < 4; ++m)
#pragma unroll
                for (int r = 0; r < 4; ++r) zn[m][r] = ldg_u<unsigned short>(zb_ + (16 * m + r) * (DINP * 2), voZ); }
        if (step + 1 < nsteps && MODE != 1) { gcp udn = SC_UD(step + 1); SC_DMA(udn, (step + 1) & 1); SC_PREFETCH(udn); }
        SC_SCHED;
        if (prev_out) SC_EPI(step - 1, op, zp);
        SC_SCHED;
        if (MODE != 2) {
        const LAS unsigned char* img = F.lds + (step & 1) * SC_ABUF;
        bf16x8 X[8], Y[8];
        SC_LD256(X, GU_W - GU_W, 0); SC_LD256(Y, GU_W - GU_W, 2); SC_SCHED;
        bf16x8 Bs[4];
#pragma unroll
        for (int s = 0; s < 4; ++s) { const v4u t = {pkbf(S[2 * s][0], S[2 * s][1]), pkbf(S[2 * s][2], S[2 * s][3]), pkbf(S[2 * s + 1][0], S[2 * s + 1][1]), pkbf(S[2 * s + 1][2], S[2 * s + 1][3])}; Bs[s] = __builtin_bit_cast(bf16x8, t); }
        f32x4 vn[4], o[4];
#pragma unroll
        for (int mm = 0; mm < 2; ++mm) { f32x4 acc = {0.f, 0.f, 0.f, 0.f};
#pragma unroll
            for (int s = 0; s < 4; ++s) acc = __builtin_amdgcn_mfma_f32_16x16x32_bf16(X[mm * 4 + s], Bs[s], acc, 0, 0, 0);
#pragma unroll
            for (int r = 0; r < 4; ++r) vn[mm][r] = uc[mm][r] - acc[r]; }
        SC_SCHED; SC_LD256(X, GU_QD - GU_W, 0); SC_SCHED;
#pragma unroll
        for (int mm = 0; mm < 2; ++mm) { f32x4 acc = {0.f, 0.f, 0.f, 0.f};
#pragma unroll
            for (int s = 0; s < 4; ++s) acc = __builtin_amdgcn_mfma_f32_16x16x32_bf16(Y[mm * 4 + s], Bs[s], acc, 0, 0, 0);
#pragma unroll
            for (int r = 0; r < 4; ++r) vn[2 + mm][r] = uc[2 + mm][r] - acc[r]; }
        SC_SCHED; SC_LD256(Y, GU_QD - GU_W, 2); SC_SCHED;
        bf16x8 Bv[2];
#pragma unroll
        for (int s = 0; s < 2; ++s) { const v4u t = {pkbf(vn[2 * s][0], vn[2 * s][1]), pkbf(vn[2 * s][2], vn[2 * s][3]), pkbf(vn[2 * s + 1][0], vn[2 * s + 1][1]), pkbf(vn[2 * s + 1][2], vn[2 * s + 1][3])}; Bv[s] = __builtin_bit_cast(bf16x8, t); }
#pragma unroll
        for (int mm = 0; mm < 2; ++mm) { f32x4 acc = {0.f, 0.f, 0.f, 0.f};
#pragma unroll
            for (int s = 0; s < 4; ++s) acc = __builtin_amdgcn_mfma_f32_16x16x32_bf16(X[mm * 4 + s], Bs[s], acc, 0, 0, 0);
            o[mm] = acc; }
        SC_SCHED; SC_LD128(X, GU_KDT - GU_W, 0); SC_SCHED;
#pragma unroll
        for (int mm = 0; mm < 2; ++mm) { f32x4 acc = {0.f, 0.f, 0.f, 0.f};
#pragma unroll
            for (int s = 0; s < 4; ++s) acc = __builtin_amdgcn_mfma_f32_16x16x32_bf16(Y[mm * 4 + s], Bs[s], acc, 0, 0, 0);
            o[2 + mm] = acc; }
        SC_SCHED; SC_LD128(Y, GU_KDT - GU_W, 4); SC_SCHED;
#pragma unroll
        for (int rr = 0; rr < 4; ++rr) { f32x4 acc = S[rr] * gl;
#pragma unroll
            for (int s = 0; s < 2; ++s) acc = __builtin_amdgcn_mfma_f32_16x16x32_bf16(X[rr * 2 + s], Bv[s], acc, 0, 0, 0);
            S[rr] = acc; }
        SC_SCHED; SC_LD128(X, GU_QK - GU_W, 0); SC_SCHED;
#pragma unroll
        for (int rr = 0; rr < 4; ++rr) { f32x4 acc = S[4 + rr] * gl;
#pragma unroll
            for (int s = 0; s < 2; ++s) acc = __builtin_amdgcn_mfma_f32_16x16x32_bf16(Y[rr * 2 + s], Bv[s], acc, 0, 0, 0);
            S[4 + rr] = acc; }
        SC_SCHED;
#pragma unroll
        for (int m = 0; m < 4; ++m)
#pragma unroll
            for (int s = 0; s < 2; ++s) o[m] = __builtin_amdgcn_mfma_f32_16x16x32_bf16(X[m * 2 + s], Bv[s], o[m], 0, 0, 0);
        if (has_out) { LAS float* sq = SSQ + (step & 1) * 512;
#pragma unroll
            for (int m = 0; m < 4; ++m)
#pragma unroll
                for (int r = 0; r < 4; ++r) { float p = o[m][r] * o[m][r];
                    p += __builtin_bit_cast(float, __builtin_amdgcn_update_dpp(0, __builtin_bit_cast(int, p), 0xB1, 0xF, 0xF, true));
                    p += __builtin_bit_cast(float, __builtin_amdgcn_update_dpp(0, __builtin_bit_cast(int, p), 0x4E, 0xF, 0xF, true));
                    p += __builtin_bit_cast(float, __builtin_amdgcn_update_dpp(0, __builtin_bit_cast(int, p), 0x141, 0xF, 0xF, true));
                    p += __builtin_bit_cast(float, __builtin_amdgcn_update_dpp(0, __builtin_bit_cast(int, p), 0x140, 0xF, 0xF, true));
                    if (c16 == 0) sq[(16 * m + 4 * q4 + r) * 8 + w] = p; op[m][r] = o[m][r]; } }
            }
    }
    asm volatile("s_waitcnt vmcnt(0) lgkmcnt(0)" ::: "memory"); __builtin_amdgcn_s_barrier(); asm volatile("" ::: "memory");
    { const int t = nsteps - 1;
#pragma unroll
      for (int m = 0; m < 4; ++m) {
#pragma unroll
        for (int r = 0; r < 4; ++r) zp[m][r] = zn[m][r]; }
      if (!(kind == 0 && t == 0)) SC_EPI(t, op, zp); }
#undef SC_PREFETCH
#undef SC_LD256
#undef SC_LD128
#undef SC_SCHED
#undef SC_EPI
#undef SC_UD
#undef SC_ROW0
#undef SC_DMA
    GAS unsigned char* dst = (GAS unsigned char*)((MODE != 0 ? (float*)(P.GDN + (size_t)N_GUNITS * GU_BYTES) : (kind == 0 ? P.out + O_PGDN : P.out + O_SGDN)) + (size_t)(b * NHG + h) * 128 * 128);
#pragma unroll
    for (int db = 0; db < 8; ++db)
#pragma unroll
        for (int r = 0; r < 4; ++r) *(GAS float*)(dst + db * 8192 + (voU + r * 512)) = S[db][r];
    asm volatile("s_waitcnt vmcnt(0) lgkmcnt(0)" ::: "memory"); __syncthreads();
}

#ifndef SPLIT_P1
#define SPLIT_P1 2
#endif
#ifndef SPLIT_P9
#define SPLIT_P9 8
#endif
#ifndef SPLIT_P2
#define SPLIT_P2 3
#endif
#ifndef SPLIT_P7
#define SPLIT_P7 4
#endif
#ifndef SPLIT_P10
#define SPLIT_P10 4
#endif
struct Args { const float* in[N_IN]; float* out; unsigned char* ws; int ph_lo, ph_hi, li, pad; };
static_assert(sizeof(Args) == (N_IN + 2) * 8 + 16, "Args has no padding");
__global__ void __launch_bounds__(NWAVES * 64, 2) fwd_kernel(Args args) {
    extern __shared__ __attribute__((aligned(16))) unsigned char lds[];
    Frame F;
    F.lds = (LAS unsigned char*)lds;
    F.MISC = (volatile LAS unsigned*)(F.lds + MISC_OFF);
    F.tid = threadIdx.x; F.lane = F.tid & 63; F.wave = __builtin_amdgcn_readfirstlane(F.tid >> 6);
    F.G = gridDim.x; { const int bx = blockIdx.x; F.vcu = (F.G % 8 == 0) ? (bx % 8) * (F.G / 8) + bx / 8 : bx; }
    unsigned char* ws = args.ws;
    F.ctl = (gu32*)(ws + WS_CTL);
    Ptrs P;
#pragma unroll
    for (int i = 0; i < N_IN; ++i) P.in[i] = args.in[i];
    P.out = args.out;
    P.Wgu1 = (bf16*)(ws + WS_WGU1); P.Wd1 = (bf16*)(ws + WS_WD1); P.Wgu2 = (bf16*)(ws + WS_WGU2); P.Wd2 = (bf16*)(ws + WS_WD2); P.Win = (bf16*)(ws + WS_WIN); P.Wout = (bf16*)(ws + WS_WOUT);
    P.XN = (bf16*)(ws + WS_XN); P.MIX = (bf16*)(ws + WS_MIX); P.H = (bf16*)(ws + WS_H); P.KB = (bf16*)(ws + WS_KB); P.VB = (bf16*)(ws + WS_VB);
    P.Y = (float*)(ws + WS_Y); P.ROPE = (float*)(ws + WS_ROPE); P.GDN = ws + WS_GDN; P.SLAB = (float*)(ws + WS_SLAB); P.XQ = (signed char*)(ws + WS_XQ); P.SA = (float*)(ws + WS_SA); P.SB1 = (float*)(ws + WS_SB); P.SB2 = (float*)(ws + WS_SB + AL((size_t)NGU * 4)); P.CMAX = (unsigned*)(ws + WS_CTL) + CW_CMAX; P.HQ = (signed char*)(ws + WS_HQ); P.SH = (float*)(ws + WS_SH); P.SBD1 = (float*)(ws + WS_SBD); P.SBD2 = (float*)(ws + WS_SBD + AL((size_t)D * 4)); P.CMAXD = (unsigned*)(ws + WS_CTL) + CW_CMAXD; P.RMAX = (unsigned*)(ws + WS_CTL) + CW_RMAX;
    for (int u = F.tid; u < (LDS_BYTES - LDSCTL_OFF) / 4; u += NWAVES * 64) ((LAS unsigned*)(F.lds + LDSCTL_OFF))[u] = 0u;
    __syncthreads();
    XcdBarrier bar; bar.bar = (unsigned*)(F.ctl + CW_BAR) + args.li * XCD_BAR_WORDS; bar.x = 0; bar.st = nullptr;
    if (N_LAUNCHES == 1) bar = xcd_barrier_post((unsigned*)(F.ctl + CW_BAR) + args.li * XCD_BAR_WORDS, F.MISC + 8);
#define GRID_BAR() do { if (N_LAUNCHES == 1) xcd_barrier(bar); } while (0)
    const int lo = args.ph_lo, hi = args.ph_hi;
#define IN(k) (lo <= (k) && (k) < hi)
#define BOTH(k) (IN(k) && IN((k) + 1))

#ifndef PROBE_REPEAT
#define PROBE_REPEAT 0
#endif
#define REP(k) (((PROBE_REPEAT >> (k)) & 1) ? 2 : 1)
    if (IN(0)) { p0_prologue(F, P); GRID_BAR(); p0_quant_wgu1(F, P); if (BOTH(0)) GRID_BAR(); }
    if (IN(1)) { pg8::Gemm g{(const pg8::bf16_t*)P.XQ, (const pg8::bf16_t*)P.Wgu1, M1, NGU, D / 2}; pg8::StaticOrder S; S.init(M1, NGU, D / 2, F.G, (int)blockIdx.x);
        pg8::EpiSwiGLU<true> E{P.H, FF, P.SLAB, 1, P.SA, P.SB1, nullptr};
        pg8::gemm_phase<pg8::EpiSwiGLU<true>, pg8::StaticOrder, true, true, true>(F.lds + RING_OFF, g, S, E);
        PHASE_DONE(1); q_fill(F, P, 1); q_catch_up(F, P, Q_E1);
        GRID_BAR(); quant_h(F, P.H, P.HQ, P.RMAX, P.SH, M1V);
        if (BOTH(1)) GRID_BAR(); }
    if (IN(2)) { pg8::Gemm g{(const pg8::bf16_t*)P.HQ, (const pg8::bf16_t*)P.Wd1, M1, D, FF / 2}; pg8::SplitOrder S; S.init(M1, D, FF / 2, F.G, (int)blockIdx.x, SPLIT_P2);
        typedef pg8::EpiResF32<0, true, false, true, true> Epi; Epi E{P.Y, D, pg8::RowSrc<0>{P.in[I_XP], P.in[I_XS], P.in[I_META], ROW_S, ROW_M, M1V, D}, P.SLAB, SPLIT_P2, P.SH, P.SBD1};
        pg8::gemm_phase<Epi, pg8::SplitOrder, true, true, true>(F.lds + RING_OFF, g, S, E);
        PHASE_DONE(2); q_fill(F, P, 2); q_catch_up(F, P, Q_E2);
        if (BOTH(2)) GRID_BAR(); }
    if (IN(3)) { pg8::SplitOrder SO; SO.init(M1, D, FF / 2, F.G, 0, SPLIT_P2); ln_phase(F, (const bf16*)P.Y, nullptr, P.XN, P.in[I_LNG], P.in[I_LNB], M1V, SO, P.SLAB, 0.5f, nullptr, nullptr); q_catch_up(F, P, Q_E2); if (BOTH(3)) GRID_BAR(); }
    if (IN(4)) { pg8::Gemm g{P.XN, P.Win, M1, DINP, D}; pg8::StaticOrder S; S.init(M1, DINP, D, F.G, (int)blockIdx.x);
        pg8::EpiStoreBf16 E{P.H, DINP};
        pg8::gemm_phase<pg8::EpiStoreBf16, pg8::StaticOrder, true, true>(F.lds + RING_OFF, g, S, E);
        PHASE_DONE(4); q_fill(F, P, 4);
        if (BOTH(4)) GRID_BAR(); }
#ifndef PROBE_ABL5
#define PROBE_ABL5 0
#endif
    if (IN(5)) { for (int rep = 0; rep < REP(5); ++rep) { const int abl = (args.li == 1) ? PROBE_ABL5 : 0;
        if (!(abl & 8)) kv_prep(F, P);
        gdn_prep_all(F, P, abl);
        q_catch_up(F, P, Q_E3);
        if (BOTH(5)) GRID_BAR(); } }
    if (IN(6)) {
        int it = blockIdx.x, st = (it < 64) ? (1 << 20) : F.G - 64;
        for (; it < 896; it += st) {
            if (it < 320) { const int s = it < 64 ? it : it - 64; gdn_scan_seq<0>(F, P, it < 64 ? 0 : 2, s >> 4, s & 15); }
            else attn_unit(F, P, it - 320);
        }
        if ((int)blockIdx.x >= 64) {
            sub_barrier(F, F.ctl + CW_SUB, (unsigned)(F.G - 64));
            pg8::Gemm g{P.MIX, P.Wout, M2, D, D}; pg8::StaticOrder S; S.init(M2, D, D, F.G - 64, (int)blockIdx.x - 64); S.set_k(0, 32);
            typedef pg8::EpiResF32<1, false, false, false, true> Epi; Epi E{P.Y, D, pg8::RowSrc<1>{(const float*)P.XN, (const float*)P.XN, (const float*)P.XN, M2, M2, M2, D}, P.SLAB, 1, nullptr, nullptr};
            pg8::gemm_phase<Epi, pg8::StaticOrder, true, true>(F.lds + RING_OFF, g, S, E);
        }
        PHASE_DONE(6); q_fill(F, P, 6);
        if (BOTH(6)) GRID_BAR(); }
    if (IN(7)) {
        pg8::Gemm g{P.MIX, P.Wout, M2, D, D}; pg8::SplitOrder S; S.init(M2, D, D, F.G, (int)blockIdx.x, SPLIT_P7); S.set_k(32, 32);
        typedef pg8::EpiResF32<1, false, true, false, true> Epi; Epi E{P.Y, D, pg8::RowSrc<1>{P.Y, P.Y, P.Y, M2, M2, M2, D}, P.SLAB, SPLIT_P7, nullptr, nullptr};
        pg8::gemm_phase<Epi, pg8::SplitOrder, true, true>(F.lds + RING_OFF, g, S, E);
        PHASE_DONE(7); q_fill(F, P, 7);
        if (BOTH(7)) GRID_BAR(); }
    if (IN(8)) { pg8::SplitOrder SO; SO.init(M2, D, D, F.G, 0, SPLIT_P7); ln_phase(F, (const bf16*)P.Y, nullptr, P.XN, P.in[I_LNG] + D, P.in[I_LNB] + D, M2, SO, P.SLAB, 1.0f, P.XQ, P.SA); q_catch_up(F, P, Q_E4); if (BOTH(8)) GRID_BAR(); }
    if (IN(9)) { pg8::Gemm g{(const pg8::bf16_t*)P.XQ, (const pg8::bf16_t*)P.Wgu2, M2, NGU, D / 2}; pg8::StaticOrder S; S.init(M2, NGU, D / 2, F.G, (int)blockIdx.x);
        pg8::EpiSwiGLU<true> E{P.H, FF, P.SLAB, 1, P.SA, P.SB2, nullptr};
        pg8::gemm_phase<pg8::EpiSwiGLU<true>, pg8::StaticOrder, true, true, true>(F.lds + RING_OFF, g, S, E);
        PHASE_DONE(9); q_fill(F, P, 9); q_catch_up(F, P, Q_E5);
        GRID_BAR(); quant_h(F, P.H, P.HQ, P.RMAX + M1, P.SH, M2);
        if (BOTH(9)) GRID_BAR(); }
    if (IN(10)) { pg8::Gemm g{(const pg8::bf16_t*)P.HQ, (const pg8::bf16_t*)P.Wd2, M2, D, FF / 2}; pg8::SplitOrder S; S.init(M2, D, FF / 2, F.G, (int)blockIdx.x, SPLIT_P10);
        typedef pg8::EpiResF32<1, true, false, true, true> Epi; Epi E{P.Y, D, pg8::RowSrc<1>{(const float*)P.XN, (const float*)P.XN, (const float*)P.XN, M2, M2, M2, D}, P.SLAB, SPLIT_P10, P.SH, P.SBD2};
        pg8::gemm_phase<Epi, pg8::SplitOrder, true, true, true>(F.lds + RING_OFF, g, S, E);
        if (BOTH(10)) GRID_BAR(); }
    if (IN(11)) { for (int rep = 0; rep < REP(11); ++rep) { pg8::SplitOrder SO; SO.init(M2, D, FF / 2, F.G, 0, SPLIT_P10); ln_phase(F, (const bf16*)P.Y, P.out + O_YP, nullptr, P.in[I_LNG] + 2 * D, P.in[I_LNB] + 2 * D, M2, SO, P.SLAB, 0.5f, nullptr, nullptr); if (rep + 1 < REP(11)) GRID_BAR(); } }
#undef IN
#undef BOTH
#undef GRID_BAR
}

extern "C" void kernel_launch(void* const* d_in, const int* in_sizes, int n_in, void* d_out, int out_size, void* d_ws, size_t ws_size, hipStream_t stream) {
    static int grid = 0;
    if (grid == 0) {
        if (n_in != N_IN || in_sizes[I_XP] != ROW_S * D || in_sizes[I_WIN] != D * DIN || (size_t)out_size != O_END || ws_size < WS_END) {
            fprintf(stderr, "kernel_launch: shape mismatch: n_in %d in0 %d out %d ws %zu (need %zu); nothing launched\n", n_in, n_in > 0 ? in_sizes[0] : -1, out_size, ws_size, (size_t)WS_END); grid = -1; return; }
        int dev = 0, cus = 0, per_cu = 0;
        if (hipGetDevice(&dev) != hipSuccess || hipDeviceGetAttribute(&cus, hipDeviceAttributeMultiprocessorCount, dev) != hipSuccess) { fprintf(stderr, "kernel_launch: device query failed\n"); grid = -1; return; }
        if (hipFuncSetAttribute((const void*)fwd_kernel, hipFuncAttributeMaxDynamicSharedMemorySize, LDS_BYTES) != hipSuccess) { fprintf(stderr, "kernel_launch: hipFuncSetAttribute failed\n"); grid = -1; return; }
        if (hipOccupancyMaxActiveBlocksPerMultiprocessor(&per_cu, (const void*)fwd_kernel, NWAVES * 64, LDS_BYTES) != hipSuccess || per_cu < 1)
            fprintf(stderr, "kernel_launch: note: occupancy query reports %d workgroups per CU\n", per_cu);
        (void)hipGetLastError();
        if (cus <= 64) { fprintf(stderr, "kernel_launch: %d CUs: this program needs more than 64 workgroups (64 of them run the GDN scans while the others start w_out); nothing launched\n", cus); grid = -1; return; }
        grid = cus;
    }
    if (grid < 0) return;
    if (hipMemsetAsync((char*)d_ws + WS_CTL, 0, CTL_ZERO_BYTES, stream) != hipSuccess) { fprintf(stderr, "kernel_launch: hipMemsetAsync failed\n"); return; }
    Args a{};
    for (int i = 0; i < N_IN; ++i) a.in[i] = (const float*)d_in[i];
    a.out = (float*)d_out; a.ws = (unsigned char*)d_ws;
#ifndef PROBE_PLAN
#define PROBE_PLAN {0, N_PHASES}
#endif
    const int plan[][2] = { PROBE_PLAN }; const int n_plan = (N_LAUNCHES == 1) ? (int)(sizeof(plan) / sizeof(plan[0])) : N_LAUNCHES;
    for (int li = 0; li < n_plan; ++li) {
        a.ph_lo = (N_LAUNCHES == 1) ? plan[li][0] : li; a.ph_hi = (N_LAUNCHES == 1) ? plan[li][1] : li + 1; a.li = (N_LAUNCHES == 1) ? li : 0;
        hipLaunchKernelGGL(fwd_kernel, dim3(grid), dim3(NWAVES * 64), LDS_BYTES, stream, a);
        const hipError_t le = hipPeekAtLastError();
        if (le != hipSuccess) { fprintf(stderr, "kernel_launch: launch %d failed: %s\n", li, hipGetErrorName(le)); break; }
    }
}
```

```cpp
#include <hip/hip_runtime.h>
#include <cstdio>
#include <cstdint>
namespace pg8 {
#define PG8_LAS __attribute__((address_space(3)))
typedef unsigned short bf16_t;
typedef short bf16x8 __attribute__((ext_vector_type(8)));
typedef float f32x4 __attribute__((ext_vector_type(4)));
typedef unsigned u32x4 __attribute__((ext_vector_type(4)));
typedef int i32x4 __attribute__((ext_vector_type(4)));
constexpr int BM = 256, BK = 64, HALF = 128, HTB = HALF * BK * 2  , STAGE_BYTES = 8 * HTB, NXCD = 8, WGM = 8;

__host__ __device__ __forceinline__ int lds_byte(int r, int c) { const int st = (r >> 4) * 2 + (c >> 5), rr = r & 15, cc = c & 31, ob = rr * 64 + cc * 2; return st * 1024 + (ob ^ (((ob >> 9) & 1) << 5)); }
__host__ __device__ __forceinline__ void stage_rc(int b, int& R, int& C) { const int st = b / 1024, sb = b % 1024, swz = sb ^ (((sb >> 9) & 1) << 5); R = (st >> 1) * 16 + swz / 64; C = (st & 1) * 32 + (swz % 64) / 2; }
__host__ __device__ __forceinline__ int perm32(int rho) { const int n = rho >> 4, i = rho & 15; return 8 * (i >> 2) + 4 * n + (i & 3); }

struct Unit { int pm, pn, k0, nt, sl, ri; };
struct Gemm { const bf16_t* A; const bf16_t* Bt; int M, N, K; };

struct StaticOrder {
    int nM, nN, nwg, G, c, ntk, kb;
    __host__ __device__ void init(int M, int N, int K, int G_, int c_) { nM = M / BM; nN = N / BM; nwg = nM * nN; G = G_; c = c_; ntk = K / BK; kb = 0; }
    __host__ __device__ void set_k(int kb_, int ntk_) { kb = kb_; ntk = ntk_; }
    __host__ __device__ void map(int L, Unit& u) const {
        int wgid = L; { const int q = nwg / NXCD, r = nwg % NXCD, xcd = wgid % NXCD, off = wgid / NXCD; wgid = (xcd < r ? xcd * (q + 1) : r * (q + 1) + (xcd - r) * q) + off; }
        const int nig = WGM * nN, gid = wgid / nig, fm = gid * WGM, gsz = (nM - fm) < WGM ? (nM - fm) : WGM;
        u.pm = fm + ((wgid % nig) % gsz); u.pn = (wgid % nig) / gsz; }
    __host__ __device__ int inv(int pm, int pn) const {
        const int nig = WGM * nN, gid = pm / WGM, fm = gid * WGM, gsz = (nM - fm) < WGM ? (nM - fm) : WGM; const int w = gid * nig + pn * gsz + (pm - fm);
        const int q = nwg / NXCD, r = nwg % NXCD; int xcd, off;
        if (w < r * (q + 1)) { xcd = w / (q + 1); off = w - xcd * (q + 1); } else { const int w2 = w - r * (q + 1); const int t = w2 / q; xcd = r + t; off = w2 - t * q; }
        return off * NXCD + xcd; }
    __host__ __device__ bool next(int i, Unit& u) const {
        const long L = (long)i * G + c; if (L >= nwg) return false;
        map((int)L, u); u.k0 = kb; u.nt = ntk; u.sl = 0; u.ri = -1; return true;
    }
    __device__ __forceinline__ void a_ready(const Unit&) const {}
    __device__ __forceinline__ void done(const Unit&) const {}
};
struct SplitOrder : StaticOrder {
    int R, rem, S;
    __host__ __device__ void init(int M, int N, int K, int G_, int c_, int S_) { StaticOrder::init(M, N, K, G_, c_); R = nwg / G; rem = nwg - R * G; S = S_; }
    __host__ __device__ bool next(int i, Unit& u) const {
        if (i < R) { map(i * G + c, u); u.k0 = kb; u.nt = ntk; u.sl = 0; u.ri = -1; return true; }
        const int j = (i - R) * G + c; if (j >= rem * S) return false;
        const int ri = j / S, s = j - ri * S, h = ntk / 2; map(R * G + ri, u);
        const int o0 = 2 * ((h * s) / S); u.k0 = kb + o0; u.nt = 2 * ((h * (s + 1)) / S) - o0; u.sl = s; u.ri = ri; return true;
    }
};

__device__ __forceinline__ unsigned cvt_pk_bf16(float lo, float hi) { unsigned r; asm volatile("v_cvt_pk_bf16_f32 %0, %1, %2" : "=v"(r) : "v"(lo), "v"(hi)); return r; }
typedef float f32x2 __attribute__((ext_vector_type(2)));
__device__ __forceinline__ float silu_f(float g) { return g * __builtin_amdgcn_rcpf(1.0f + __builtin_amdgcn_exp2f(-1.4426950408889634f * g)); }
template <bool I8> struct EpiSwiGLU {
    static constexpr bool PERM = true, AFTER_DRAIN = false;
    bf16_t* O; int ldc; float* slab; int S; const float *sA, *sB; unsigned* rmax;
    __device__ __forceinline__ void operator()(const f32x4 (&acc)[2][2][4][2], const Unit& u, int wr, int wc, int fr, int fq) const {
        if (u.ri >= 0) { float* sb = slab + ((size_t)(u.ri * S + u.sl) << 16) + wc * 32 + 8 * fq;
#pragma unroll
            for (int ai = 0; ai < 2; ++ai)
#pragma unroll
                for (int m = 0; m < 4; ++m) { float* o = sb + (ai * HALF + wr * 64 + m * 16 + fr) * BM;
#pragma unroll
                    for (int bj = 0; bj < 2; ++bj)
#pragma unroll
                        for (int n = 0; n < 2; ++n) *(f32x4*)(o + bj * HALF + 4 * n) = acc[ai][bj][m][n]; }
            return; }
        const int row0 = u.pm * BM + wr * 64 + fr, col0 = u.pn * HALF + wc * 32 + 8 * fq;
        f32x4 sbg0 = {1.f, 1.f, 1.f, 1.f}, sbg1 = sbg0, sbu0 = sbg0, sbu1 = sbg0;
        if constexpr (I8) { const int fr0 = u.pn * BM + wc * 32 + 8 * fq;
            sbg0 = *(const f32x4*)(sB + fr0); sbg1 = *(const f32x4*)(sB + fr0 + 4); sbu0 = *(const f32x4*)(sB + fr0 + HALF); sbu1 = *(const f32x4*)(sB + fr0 + HALF + 4); }
#pragma unroll
        for (int ai = 0; ai < 2; ++ai)
#pragma unroll
            for (int m = 0; m < 4; ++m) { bf16_t* rowp = O + (size_t)(row0 + ai * HALF + m * 16) * ldc + col0;
                f32x4 g0 = acc[ai][0][m][0], g1 = acc[ai][0][m][1], u0 = acc[ai][1][m][0], u1 = acc[ai][1][m][1];
                if constexpr (I8) { const float sa = sA[row0 + ai * HALF + m * 16];
                    g0 = __builtin_convertvector(__builtin_bit_cast(i32x4, g0), f32x4) * (sbg0 * sa); g1 = __builtin_convertvector(__builtin_bit_cast(i32x4, g1), f32x4) * (sbg1 * sa);
                    u0 = __builtin_convertvector(__builtin_bit_cast(i32x4, u0), f32x4) * (sbu0 * sa); u1 = __builtin_convertvector(__builtin_bit_cast(i32x4, u1), f32x4) * (sbu1 * sa); }
                u32x4 w;
                w.x = cvt_pk_bf16(silu_f(g0[0]) * u0[0], silu_f(g0[1]) * u0[1]); w.y = cvt_pk_bf16(silu_f(g0[2]) * u0[2], silu_f(g0[3]) * u0[3]);
                w.z = cvt_pk_bf16(silu_f(g1[0]) * u1[0], silu_f(g1[1]) * u1[1]); w.w = cvt_pk_bf16(silu_f(g1[2]) * u1[2], silu_f(g1[3]) * u1[3]);
                *(u32x4*)rowp = w;
                if (rmax) { unsigned mx = 0u;
                    { const unsigned ww_[4] = {w.x, w.y, w.z, w.w};
#pragma unroll
                      for (int k_ = 0; k_ < 4; ++k_) { const unsigned lo_ = (ww_[k_] << 16) & 0x7fff0000u, hi_ = ww_[k_] & 0x7fff0000u; mx = mx > lo_ ? mx : lo_; mx = mx > hi_ ? mx : hi_; } }
                    { const unsigned o_ = (unsigned)__shfl_xor((int)mx, 16); mx = mx > o_ ? mx : o_; } { const unsigned o_ = (unsigned)__shfl_xor((int)mx, 32); mx = mx > o_ ? mx : o_; }
                    if (fq == 0) (void)__hip_atomic_fetch_max(rmax + row0 + ai * HALF + m * 16, mx, __ATOMIC_RELAXED, __HIP_MEMORY_SCOPE_AGENT); } }
    }
};
struct EpiStoreBf16 {
    static constexpr bool PERM = true, AFTER_DRAIN = false;
    bf16_t* O; int ldc;
    __device__ __forceinline__ void operator()(const f32x4 (&acc)[2][2][4][2], const Unit& u, int wr, int wc, int fr, int fq) const {
        const int row0 = u.pm * BM + wr * 64 + fr, col0 = u.pn * BM + wc * 32 + 8 * fq;
#pragma unroll
        for (int ai = 0; ai < 2; ++ai)
#pragma unroll
            for (int m = 0; m < 4; ++m) { bf16_t* rowp = O + (size_t)(row0 + ai * HALF + m * 16) * ldc + col0;
#pragma unroll
                for (int bj = 0; bj < 2; ++bj) { const f32x4 v0 = acc[ai][bj][m][0], v1 = acc[ai][bj][m][1];
                    u32x4 w; w.x = cvt_pk_bf16(v0[0], v0[1]); w.y = cvt_pk_bf16(v0[2], v0[3]); w.z = cvt_pk_bf16(v1[0], v1[1]); w.w = cvt_pk_bf16(v1[2], v1[3]);
                    *(u32x4*)(rowp + bj * HALF) = w; } }
    }
};
template <int MODE> struct RowSrc {
    const float *p0, *p1, *p2; int n0, n1, n2, ld;
    __device__ __forceinline__ const float* row(int r) const {
        if (MODE == 1) return r < n0 ? p0 + (size_t)r * ld : nullptr;
        if (r < n0) return p0 + (size_t)r * ld;
        if (r < n1) return p1 + (size_t)(r - n0) * ld;
        if (r < n2) return p2 + (size_t)(r - n1) * ld;
        return nullptr; }
};
typedef unsigned u32x2e __attribute__((ext_vector_type(2)));
template <int MODE, bool HALF_, bool ALPHA1 = false, bool I8 = false, bool R16 = false> struct EpiResF32 {
    static constexpr bool PERM = false, AFTER_DRAIN = false;
    float* out; int ldc; RowSrc<MODE> src; float* slab; int S;
    const float *sA, *sB;
    __device__ __forceinline__ void operator()(const f32x4 (&acc)[2][2][4][2], const Unit& u, int wr, int wc, int fr, int fq) const {
        constexpr float alpha = ALPHA1 ? 1.0f : 1.189207115002721f, scale = HALF_ ? 0.5f : 1.0f;
        f32x4 sb_[2][2];
        if constexpr (I8) { const int c0_ = u.pn * BM + wc * 32 + 4 * fq;
#pragma unroll
            for (int bj = 0; bj < 2; ++bj)
#pragma unroll
                for (int n = 0; n < 2; ++n) sb_[bj][n] = *(const f32x4*)(sB + c0_ + bj * HALF + n * 16); }
#define EPI_VAL(ai, bj, m, n, sa_) (I8 ? __builtin_convertvector(__builtin_bit_cast(i32x4, acc[ai][bj][m][n]), f32x4) * (sb_[bj][n] * (sa_)) : acc[ai][bj][m][n])
        if (u.sl > 0) {
            float* sb = slab + ((size_t)(u.ri * (S - 1) + (u.sl - 1)) << 16) + wc * 32 + 4 * fq;
            float sa8_[2][4];
#pragma unroll
            for (int ai = 0; ai < 2; ++ai)
#pragma unroll
                for (int m = 0; m < 4; ++m) { sa8_[ai][m] = 1.f; if constexpr (I8) sa8_[ai][m] = sA[u.pm * BM + ai * HALF + wr * 64 + m * 16 + fr]; }
#pragma unroll
            for (int ai = 0; ai < 2; ++ai)
#pragma unroll
                for (int m = 0; m < 4; ++m) { float* o = sb + (ai * HALF + wr * 64 + m * 16 + fr) * BM; const float sa_ = sa8_[ai][m];
#pragma unroll
                    for (int bj = 0; bj < 2; ++bj)
#pragma unroll
                        for (int n = 0; n < 2; ++n) *(f32x4*)(o + bj * HALF + n * 16) = EPI_VAL(ai, bj, m, n, sa_); }
            return; }
        const int col0 = u.pn * BM + wc * 32 + 4 * fq;
#pragma unroll
        for (int ai = 0; ai < 2; ++ai) {
            bool ok_[4]; float sa4_[4]; u32x2e bw_[4][2][2]; f32x4 bf_[4][2][2];
#pragma unroll
            for (int m = 0; m < 4; ++m) { const int r = u.pm * BM + ai * HALF + wr * 64 + m * 16 + fr; const float* b = src.row(r); ok_[m] = (b != nullptr); const int rs = ok_[m] ? r : 0;
                sa4_[m] = 1.f; if constexpr (I8) sa4_[m] = sA[rs];
                if constexpr (R16 && MODE == 1) { const bf16_t* bp = (const bf16_t*)src.p0 + (size_t)rs * src.ld + col0;
#pragma unroll
                    for (int bj = 0; bj < 2; ++bj)
#pragma unroll
                        for (int n = 0; n < 2; ++n) bw_[m][bj][n] = *(const u32x2e*)(bp + bj * HALF + n * 16); }
                else { const float* bp = (ok_[m] ? b : src.p0) + col0;
#pragma unroll
                    for (int bj = 0; bj < 2; ++bj)
#pragma unroll
                        for (int n = 0; n < 2; ++n) bf_[m][bj][n] = *(const f32x4*)(bp + bj * HALF + n * 16); } }
#pragma unroll
            for (int m = 0; m < 4; ++m) { const int r = u.pm * BM + ai * HALF + wr * 64 + m * 16 + fr;
                if (ok_[m]) { float* o = out + (size_t)r * ldc; const float sa_ = sa4_[m];
#pragma unroll
                    for (int bj = 0; bj < 2; ++bj)
#pragma unroll
                        for (int n = 0; n < 2; ++n) { const int c = col0 + bj * HALF + n * 16; f32x4 bs;
                            if constexpr (R16 && MODE == 1) { const u32x2e w_ = bw_[m][bj][n];
                                bs = (f32x4){__uint_as_float(w_.x << 16), __uint_as_float(w_.x & 0xffff0000u), __uint_as_float(w_.y << 16), __uint_as_float(w_.y & 0xffff0000u)}; }
                            else bs = bf_[m][bj][n];
                            const f32x4 v_ = bs * alpha + EPI_VAL(ai, bj, m, n, sa_) * scale;
                            if constexpr (R16) { u32x2e o_; o_.x = cvt_pk_bf16(v_[0], v_[1]); o_.y = cvt_pk_bf16(v_[2], v_[3]); *(u32x2e*)((bf16_t*)out + (size_t)r * ldc + c) = o_; }
                            else *(f32x4*)(o + c) = v_; } } } }
#undef EPI_VAL
    }
};
template <class Epi, class Sched, bool ALIGN_EPI = false, bool SP2 = false, bool I8 = false>
__device__ __forceinline__ void gemm_phase(PG8_LAS unsigned char* lds, const Gemm g, const Sched& S, const Epi& E) {
    const int tid = threadIdx.x, wid = __builtin_amdgcn_readfirstlane(tid >> 6), lane = tid & 63, wr = wid >> 2, wc = wid & 3, fr = lane & 15, fq = lane >> 4;
    const int K = g.K;
    unsigned voffA[2], voffB[2];
#pragma unroll
    for (int i = 0; i < 2; ++i) { int R, C; stage_rc(tid * 16 + i * 8192, R, C); const int Rb = Epi::PERM ? ((R & ~31) + perm32(R & 31)) : R;
        voffA[i] = (unsigned)(R * K + C) * 2u; voffB[i] = (unsigned)(Rb * K + C) * 2u; }
    const size_t kstep = (size_t)(BK * 2);
    const size_t hstep = (size_t)HALF * K * 2;
    const size_t tstep = 2 * hstep;
    const unsigned ldsw = (unsigned)wid * 1024u;
    const int aoff = lds_byte(wr * 64 + fr, fq * 8), boff = lds_byte(wc * 32 + fr, fq * 8);
#define PG8_SA(b, h) (((b) * 2 + (h)) * HTB)
#define PG8_SB(b, h) ((4 + (b) * 2 + (h)) * HTB)
#define PG8_STAGE(bufoff, gbase, voff) do { _Pragma("unroll") for (int _i = 0; _i < 2; ++_i) \
        __builtin_amdgcn_global_load_lds((const unsigned*)((const char*)(gbase) + (voff)[_i]), (PG8_LAS unsigned*)(lds + (bufoff) + ldsw + _i * 8192), 16, 0, 0); } while (0)
#define PG8_LDA(dst, b, h) do { _Pragma("unroll") for (int m = 0; m < 4; ++m) _Pragma("unroll") for (int k = 0; k < 2; ++k) dst[m][k] = *(const PG8_LAS bf16x8*)(lds + PG8_SA(b, h) + aoff + m * 2048 + k * 1024); } while (0)
#define PG8_LDB(dst, b, h) do { _Pragma("unroll") for (int n = 0; n < 2; ++n) _Pragma("unroll") for (int k = 0; k < 2; ++k) dst[n][k] = *(const PG8_LAS bf16x8*)(lds + PG8_SB(b, h) + boff + n * 2048 + k * 1024); } while (0)
#define PG8_MMA(ai, bj, At, Bt) do { __builtin_amdgcn_s_setprio(1); _Pragma("unroll") for (int m = 0; m < 4; ++m) _Pragma("unroll") for (int n = 0; n < 2; ++n) _Pragma("unroll") for (int k = 0; k < 2; ++k) \
        { if constexpr (I8) acc[ai][bj][m][n] = __builtin_bit_cast(f32x4, __builtin_amdgcn_mfma_i32_16x16x64_i8(__builtin_bit_cast(i32x4, Bt[n][k]), __builtin_bit_cast(i32x4, At[m][k]), __builtin_bit_cast(i32x4, acc[ai][bj][m][n]), 0, 0, 0)); \
          else acc[ai][bj][m][n] = __builtin_amdgcn_mfma_f32_16x16x32_bf16(Bt[n][k], At[m][k], acc[ai][bj][m][n], 0, 0, 0); } __builtin_amdgcn_s_setprio(0); } while (0)
#define PG8_WAIT_V(n) asm volatile("s_waitcnt vmcnt(" #n ")" ::: "memory")
#define PG8_WAIT_L(n) asm volatile("s_waitcnt lgkmcnt(" #n ")" ::: "memory")
#define PG8_BAR __builtin_amdgcn_s_barrier()
#define PG8_SCHED __builtin_amdgcn_sched_barrier(0)
    Unit cur, nxt; int ui = 0;
    if (!S.next(0, cur)) return;
    f32x4 acc[2][2][4][2];
#pragma unroll
    for (int a = 0; a < 2; ++a)
#pragma unroll
        for (int b = 0; b < 2; ++b)
#pragma unroll
            for (int m = 0; m < 4; ++m)
#pragma unroll
                for (int n = 0; n < 2; ++n) acc[a][b][m][n] = (f32x4){0.f, 0.f, 0.f, 0.f};
    bf16x8 At[4][2], B0[2][2], B1[2][2];
    const char* cA = (const char*)g.A + (size_t)cur.pm * tstep + (size_t)cur.k0 * kstep; const char* cB = (const char*)g.Bt + (size_t)cur.pn * tstep + (size_t)cur.k0 * kstep; int nt = cur.nt;
    S.a_ready(cur);
    if constexpr (SP2) {
        PG8_STAGE(PG8_SB(0, 0), cB, voffB); PG8_STAGE(PG8_SB(0, 1), cB + hstep, voffB); PG8_STAGE(PG8_SA(0, 0), cA, voffA); PG8_STAGE(PG8_SA(0, 1), cA + hstep, voffA);
        if (wr == 1) PG8_BAR;
        PG8_WAIT_V(2); PG8_BAR;
        PG8_STAGE(PG8_SB(1, 0), cB + kstep, voffB); PG8_STAGE(PG8_SA(1, 0), cA + kstep, voffA); PG8_STAGE(PG8_SB(1, 1), cB + hstep + kstep, voffB);
        PG8_WAIT_V(6); PG8_BAR;
    } else {
        PG8_STAGE(PG8_SB(0, 0), cB, voffB); PG8_STAGE(PG8_SA(0, 0), cA, voffA); PG8_STAGE(PG8_SB(0, 1), cB + hstep, voffB); PG8_STAGE(PG8_SA(0, 1), cA + hstep, voffA);
        if (wr == 1) PG8_BAR;
        PG8_WAIT_V(4); PG8_BAR;
        PG8_STAGE(PG8_SB(1, 0), cB + kstep, voffB); PG8_STAGE(PG8_SA(1, 0), cA + kstep, voffA); PG8_STAGE(PG8_SB(1, 1), cB + hstep + kstep, voffB);
        PG8_WAIT_V(6); PG8_BAR;
    }
    for (;;) {
        const bool has_next = S.next(ui + 1, nxt);
        const char* nA = has_next ? (const char*)g.A + (size_t)nxt.pm * tstep + (size_t)nxt.k0 * kstep : cA; const char* nB = has_next ? (const char*)g.Bt + (size_t)nxt.pn * tstep + (size_t)nxt.k0 * kstep : cB;
        for (int t = 0; t < nt; t += 2) {
            const bool last = (t == nt - 2);
            const char* a1 = cA + (size_t)(t + 1) * kstep;
            const char* a2 = last ? nA : cA + (size_t)(t + 2) * kstep; const char* b2 = last ? nB : cB + (size_t)(t + 2) * kstep;
            const char* a3 = a2 + kstep; const char* b3 = b2 + kstep;
            if (last && has_next) S.a_ready(nxt);
            if constexpr (SP2) {
            PG8_LDB(B0, 0, 0); PG8_LDB(B1, 0, 1); PG8_SCHED; PG8_LDA(At, 0, 0); PG8_STAGE(PG8_SA(1, 1), a1 + hstep, voffA);
            PG8_WAIT_V(8); PG8_WAIT_L(0); PG8_BAR; PG8_MMA(0, 0, At, B0); PG8_MMA(0, 1, At, B1); PG8_BAR; PG8_SCHED;
            PG8_LDA(At, 0, 1); PG8_STAGE(PG8_SB(0, 0), b2, voffB); PG8_STAGE(PG8_SB(0, 1), b2 + hstep, voffB); PG8_STAGE(PG8_SA(0, 0), a2, voffA);
            PG8_WAIT_V(8); PG8_WAIT_L(0); PG8_BAR; PG8_MMA(1, 0, At, B0); PG8_MMA(1, 1, At, B1); PG8_BAR; PG8_SCHED;
            PG8_LDB(B0, 1, 0); PG8_LDB(B1, 1, 1); PG8_SCHED; PG8_LDA(At, 1, 0); PG8_STAGE(PG8_SA(0, 1), a2 + hstep, voffA);
            PG8_WAIT_V(8); PG8_WAIT_L(0); PG8_BAR; PG8_MMA(0, 0, At, B0); PG8_MMA(0, 1, At, B1); PG8_BAR; PG8_SCHED;
            PG8_LDA(At, 1, 1); PG8_STAGE(PG8_SB(1, 0), b3, voffB); PG8_STAGE(PG8_SB(1, 1), b3 + hstep, voffB); PG8_STAGE(PG8_SA(1, 0), a3, voffA);
            PG8_WAIT_V(8); PG8_WAIT_L(0); PG8_BAR; PG8_MMA(1, 0, At, B0); PG8_MMA(1, 1, At, B1); PG8_BAR; PG8_SCHED;
            } else {
            PG8_LDB(B0, 0, 0); PG8_SCHED; PG8_LDA(At, 0, 0); PG8_STAGE(PG8_SA(1, 1), a1 + hstep, voffA);
            PG8_WAIT_L(8); PG8_BAR; PG8_WAIT_L(0); PG8_MMA(0, 0, At, B0); PG8_BAR; PG8_SCHED;
            PG8_LDB(B1, 0, 1); PG8_STAGE(PG8_SB(0, 0), b2, voffB);
            PG8_BAR; PG8_WAIT_L(0); PG8_MMA(0, 1, At, B1); PG8_BAR;
            PG8_LDA(At, 0, 1); PG8_STAGE(PG8_SA(0, 0), a2, voffA);
            PG8_BAR; PG8_WAIT_L(0); PG8_MMA(1, 0, At, B0); PG8_BAR; PG8_SCHED;
            PG8_STAGE(PG8_SB(0, 1), b2 + hstep, voffB);
            PG8_WAIT_V(6); PG8_BAR; PG8_MMA(1, 1, At, B1); PG8_BAR;
            PG8_LDB(B0, 1, 0); PG8_SCHED; PG8_LDA(At, 1, 0); PG8_STAGE(PG8_SA(0, 1), a2 + hstep, voffA);
            PG8_WAIT_L(8); PG8_BAR; PG8_WAIT_L(0); PG8_MMA(0, 0, At, B0); PG8_BAR; PG8_SCHED;
            PG8_LDB(B1, 1, 1); PG8_STAGE(PG8_SB(1, 0), b3, voffB);
            PG8_BAR; PG8_WAIT_L(0); PG8_MMA(0, 1, At, B1); PG8_BAR;
            PG8_LDA(At, 1, 1); PG8_STAGE(PG8_SA(1, 0), a3, voffA);
            PG8_BAR; PG8_WAIT_L(0); PG8_MMA(1, 0, At, B0); PG8_BAR; PG8_SCHED;
            PG8_STAGE(PG8_SB(1, 1), b3 + hstep, voffB);
            PG8_WAIT_V(6); PG8_BAR; PG8_MMA(1, 1, At, B1); PG8_BAR;
            }
        }
        if constexpr (ALIGN_EPI) { if (wr == 0) PG8_BAR; }
        if constexpr (!Epi::AFTER_DRAIN) { E(acc, cur, wr, wc, fr, fq); S.done(cur); }
        if (!has_next) break;
#pragma unroll
        for (int a = 0; a < 2; ++a)
#pragma unroll
            for (int b = 0; b < 2; ++b)
#pragma unroll
                for (int m = 0; m < 4; ++m)
#pragma unroll
                    for (int n = 0; n < 2; ++n) acc[a][b][m][n] = (f32x4){0.f, 0.f, 0.f, 0.f};
        cur = nxt; cA = nA; cB = nB; nt = cur.nt; ++ui;
        if constexpr (ALIGN_EPI) { if (wr == 1) PG8_BAR; }
    }
    PG8_WAIT_V(0);
    if constexpr (!ALIGN_EPI) { if (wr == 0) PG8_BAR; }
    PG8_BAR;
    if constexpr (Epi::AFTER_DRAIN) { E.fused(acc, cur, wr, wc, fr, fq, lds, wid, lane); S.done(cur); }
#undef PG8_SA
#undef PG8_SB
#undef PG8_STAGE
#undef PG8_LDA
#undef PG8_LDB
#undef PG8_MMA
#undef PG8_WAIT_V
#undef PG8_WAIT_L
#undef PG8_BAR
#undef PG8_SCHED
}
}
#define GAS __attribute__((address_space(1)))
#define LAS __attribute__((address_space(3)))
typedef unsigned short bf16;
typedef unsigned v4u __attribute__((ext_vector_type(4)));
typedef float f32x4 __attribute__((ext_vector_type(4)));
typedef short bf16x8 __attribute__((ext_vector_type(8)));
typedef GAS unsigned gu32;
typedef GAS unsigned long long gu64;
#define RLX_AGENT __ATOMIC_RELAXED, __HIP_MEMORY_SCOPE_AGENT
#define LDS_WAIT() asm volatile("s_waitcnt lgkmcnt(0)" ::: "memory")
#define VM_WAIT() asm volatile("s_waitcnt vmcnt(0)" ::: "memory")
__device__ __forceinline__ unsigned long long rt() { return __builtin_amdgcn_s_memrealtime(); }
__device__ __forceinline__ unsigned f2bf(float f) { unsigned u = __builtin_bit_cast(unsigned, f); return (u + 0x7fffu + ((u >> 16) & 1u)) >> 16; }
__device__ __forceinline__ unsigned pk2(float lo, float hi) { return f2bf(lo) | (f2bf(hi) << 16); }

#define XB_TMO      128
#define XB_XCNT(j)  (256  + 64 * (j))
#define XB_XSUB(j)  (1280 + 64 * (j))
#define XB_XGEN(j)  (2304 + 64 * (j))
#define XB_TOP      3328
#define XB_TOPGEN   3392
#define XCD_BAR_WORDS 3456
#define XB_SPIN_CAP (1u << 18)

__device__ __forceinline__ unsigned xb_ld(unsigned* p)              { return __hip_atomic_load(p, __ATOMIC_RELAXED, __HIP_MEMORY_SCOPE_AGENT); }
__device__ __forceinline__ unsigned xb_add(unsigned* p, unsigned v) { return __hip_atomic_fetch_add(p, v, __ATOMIC_RELAXED, __HIP_MEMORY_SCOPE_AGENT); }
__device__ __forceinline__ unsigned xb_xcc_id() { return (unsigned)__builtin_amdgcn_s_getreg((3 << 11) | 20) & 0xFu; }
#define XB_SPIN(cond, bar) do { unsigned _sp = 0; while (cond) { __builtin_amdgcn_s_sleep(1); \
    if ((++_sp & 255u) == 0u) { if (xb_ld(&(bar)[XB_TMO])) break; if (_sp > XB_SPIN_CAP) { atomicAdd(&(bar)[XB_TMO], 1u); break; } } } } while (0)

struct XcdBarrier {
    unsigned* bar; unsigned x;
    volatile LAS unsigned* st;
};

__device__ __forceinline__ XcdBarrier xcd_barrier_post(unsigned* bar, volatile LAS unsigned* st) {
    XcdBarrier b; b.bar = bar; b.x = xb_xcc_id(); b.st = st;
    if (threadIdx.x == 0) (void)xb_add(&bar[XB_XCNT(b.x)], 1u);
    return b;
}
__device__ __forceinline__ void xcd_barrier_complete(unsigned* bar, unsigned x, unsigned& nloc, unsigned& nx) {
    const unsigned G = gridDim.x * gridDim.y * gridDim.z;
    unsigned sum, cnt, mine, sp = 0u;
    for (;;) {
        sum = 0u; cnt = 0u; mine = 0u;
#pragma unroll
        for (unsigned j = 0; j < 16; ++j) { const unsigned c = xb_ld(&bar[XB_XCNT(j)]); sum += c; cnt += (c > 0u) ? 1u : 0u; mine = (j == x) ? c : mine; }
        if (sum == G) break;
        __builtin_amdgcn_s_sleep(1);
        if ((++sp & 255u) == 0u) { if (xb_ld(&bar[XB_TMO])) break; if (sp > XB_SPIN_CAP) { atomicAdd(&bar[XB_TMO], 1u); break; } }
    }
    nloc = mine > 0u ? mine : 1u; nx = cnt > 0u ? cnt : 1u;
}

__device__ __forceinline__ void xcd_barrier(const XcdBarrier& b) {
    asm volatile("s_waitcnt vmcnt(0)" ::: "memory");
    __syncthreads();
    if (threadIdx.x == 0) {
        unsigned* bar = b.bar;
        __builtin_amdgcn_s_waitcnt(0);
        unsigned nloc = b.st[0], nx = b.st[1];
        if (nloc == 0u) { xcd_barrier_complete(bar, b.x, nloc, nx); b.st[0] = nloc; b.st[1] = nx; }
        const unsigned old = xb_add(&bar[XB_XSUB(b.x)], 1u);
        const unsigned gen = old / nloc;
        if (old + 1u == (gen + 1u) * nloc) {
            __builtin_amdgcn_fence(__ATOMIC_RELEASE, "agent");
            asm volatile("s_waitcnt vmcnt(0)" ::: "memory");
            const unsigned og = xb_add(&bar[XB_TOP], 1u);
            const unsigned tg = og / nx;
            if (og + 1u == (tg + 1u) * nx) xb_add(&bar[XB_TOPGEN], 1u);
            else XB_SPIN(xb_ld(&bar[XB_TOPGEN]) == tg, bar);
            __builtin_amdgcn_fence(__ATOMIC_ACQUIRE, "agent");
            xb_add(&bar[XB_XGEN(b.x)], 1u);
            asm volatile("s_waitcnt vmcnt(0)" ::: "memory");
        } else {
            XB_SPIN(xb_ld(&bar[XB_XGEN(b.x)]) == gen, bar);
            __builtin_amdgcn_fence(__ATOMIC_ACQUIRE, "agent");
            asm volatile("s_waitcnt vmcnt(0)" ::: "memory");
        }
    }
    __syncthreads();
}


constexpr int NWAVES = 8;
#ifndef MK_N_LAUNCHES
#define MK_N_LAUNCHES 1
#endif
constexpr int N_PHASES = 12;
constexpr int N_LAUNCHES = MK_N_LAUNCHES;
static_assert(N_LAUNCHES == 1 || N_LAUNCHES == N_PHASES, "MK_N_LAUNCHES is 1 or 12");

constexpr int D = 4096, FF = 11008, NGU = 2 * FF, DIN = 11296, DINP = 11520;
constexpr int NB_P = 4, SEQ_P = 2048, NB_S = 16, SEQ_S = 64, NMETA = 16, PAST = 2048;
constexpr int ROW_S = NB_P * SEQ_P  , ROW_M = ROW_S + NB_S * SEQ_S  , M1V = ROW_M + NMETA  , M1 = 9472  , M2 = ROW_M  ;
constexpr int KVH = 4, HD = 128, KVW = KVH * HD  , NHQ = 16, NHG = 16, WIN = 128;
constexpr int KVR_SMETA = M1, KVR_SWIN = M1 + NB_S * NMETA  , KV_ROWS = KVR_SWIN + NB_S * WIN  ;
constexpr int NPOS = NMETA + PAST + SEQ_S;
constexpr int C_Q = 0, C_K = 2048, C_V = 2560, C_CONV = 3072, C_Z = 9216, C_B = 11264, C_A = 11280, DCONV = 6144;
constexpr float LN_EPS = 1e-5f, RMS_EPS = 1e-6f, ALPHA = 1.189207115002721f;
enum { I_XP = 0, I_XS, I_CMK, I_CMV, I_CWK, I_CWV, I_SCONV, I_SGDN, I_META, I_LNG, I_LNB, I_WG, I_WU, I_WD, I_WIN, I_WOUT, I_SINK, I_CONVW, I_ALOG, I_DTB, I_NORMW, N_IN };
constexpr size_t O_YP = 0, O_YS = O_YP + (size_t)ROW_S * D, O_PMK = O_YS + (size_t)NB_S * SEQ_S * D, O_PMV = O_PMK + (size_t)NB_P * NMETA * KVW, O_PWK = O_PMV + (size_t)NB_P * NMETA * KVW,
                 O_PWV = O_PWK + (size_t)NB_P * WIN * KVW, O_PCONV = O_PWV + (size_t)NB_P * WIN * KVW, O_PGDN = O_PCONV + (size_t)NB_P * 3 * DCONV, O_SWK = O_PGDN + (size_t)NB_P * NHG * 128 * 128,
                 O_SWV = O_SWK + (size_t)NB_S * SEQ_S * KVW, O_SCONV = O_SWV + (size_t)NB_S * SEQ_S * KVW, O_SGDN = O_SCONV + (size_t)NB_S * 3 * DCONV, O_END = O_SGDN + (size_t)NB_S * NHG * 128 * 128;
static_assert(O_END == 44998656, "output map");

constexpr size_t AL(size_t x) { return (x + 4095) / 4096 * 4096; }
constexpr size_t WS_CTL = 0, CTL_ZERO_BYTES = 1u << 20;
constexpr size_t WS_WGU1 = CTL_ZERO_BYTES, SZ_WGU = (size_t)NGU * D * 2, SZ_WD = (size_t)D * FF * 2;
constexpr size_t WS_WD1 = WS_WGU1 + AL(SZ_WGU), WS_WGU2 = WS_WD1 + AL(SZ_WD), WS_WD2 = WS_WGU2 + AL(SZ_WGU), WS_WIN = WS_WD2 + AL(SZ_WD), WS_WOUT = WS_WIN + AL((size_t)DINP * D * 2);
constexpr size_t WS_XN = WS_WOUT + AL((size_t)D * D * 2), WS_MIX = WS_XN + AL((size_t)M1 * D * 2), WS_H = WS_MIX + AL((size_t)M2 * D * 2);
constexpr size_t WS_Y = WS_H + AL((size_t)M1 * DINP * 2), WS_KB = WS_Y + AL((size_t)M1 * D * 4), WS_VB = WS_KB + AL((size_t)KV_ROWS * KVW * 2), WS_ROPE = WS_VB + AL((size_t)KV_ROWS * KVW * 2);
constexpr size_t WS_SLAB = WS_ROPE + AL((size_t)NPOS * 64 * 8), N_SLABS = 224, WS_XQ = WS_SLAB + N_SLABS * 262144, WS_SA = WS_XQ + AL((size_t)M1 * D), WS_SB = WS_SA + AL((size_t)M1 * 4), WS_SH = WS_SB + 2 * AL((size_t)NGU * 4), WS_SBD = WS_SH + AL((size_t)M1 * 4), WS_HQ = WS_SBD + 2 * AL((size_t)D * 4), WS_END = WS_HQ + AL((size_t)M1 * FF);
static_assert((size_t)M1 * FF <= (WS_H - WS_XN), "the int8 copy of h fits over the XN | MIX region");
constexpr int GU_U = 0, GU_W = 32768, GU_QD = GU_W + 16384, GU_KDT = GU_QD + 16384, GU_QK = GU_KDT + 16384, GU_GL = GU_QK + 8192, GU_BYTES = GU_GL + 256;
constexpr int N_GUNITS = NB_P * NHG * 32 + NHG + NB_S * NHG;
constexpr size_t WS_GDN = WS_WGU1;
static_assert((size_t)N_GUNITS * GU_BYTES <= WS_WGU2 - WS_WGU1, "GDN chunk data fits in the FFN1 weight region");
constexpr int CW_TMO = 0, CW_CODE = 1, CW_BAR = 4096, CW_CMAX = 131072, CW_CMAXD = CW_CMAX + 2 * NGU, CW_RMAX = CW_CMAXD + 2 * D;
static_assert((CW_RMAX + 2 * M1) * 4 <= (int)CTL_ZERO_BYTES, "column maxima inside the per-call memset");

constexpr int RING_OFF = 0, RING_BYTES = 139264;
constexpr int LDSCTL_OFF = RING_BYTES, MISC_OFF = LDSCTL_OFF + 320;
constexpr int LDS_BYTES = 147456;
static_assert(MISC_OFF + 128 <= LDS_BYTES, "LDS map");

struct Frame {
    LAS unsigned char* lds;
    volatile LAS unsigned* MISC;
    gu32* ctl;
    int tid, lane, wave;
    int vcu, G;
};
struct Ptrs {
    const float* in[N_IN]; float* out;
    bf16 *Wgu1, *Wd1, *Wgu2, *Wd2, *Win, *Wout, *XN, *MIX, *H, *KB, *VB;
    float* Y; float* ROPE; unsigned char* GDN; float* SLAB;
    signed char* XQ; float *SA, *SB1, *SB2; unsigned* CMAX;
    signed char* HQ; float *SH, *SBD1, *SBD2; unsigned *CMAXD, *RMAX;
};
__host__ __device__ constexpr int kpos32(int kk) { return 8 * ((kk & 15) >> 2) + (kk & 3) + 4 * (kk >> 4); }
__host__ __device__ constexpr int a256_off(int r, int k) { return r * 256 + ((((k >> 5) * 4 + (kpos32(k & 31) >> 3)) ^ (r & 15)) * 16) + (kpos32(k & 31) & 7) * 2; }
__host__ __device__ constexpr int a128_off(int r, int k) { return r * 128 + ((((k >> 5) * 4 + (kpos32(k & 31) >> 3)) ^ ((r >> 1) & 7)) * 16) + (kpos32(k & 31) & 7) * 2; }
typedef short s16x4 __attribute__((ext_vector_type(4)));
__device__ __forceinline__ unsigned pkbf(float lo, float hi) { unsigned r; asm volatile("v_cvt_pk_bf16_f32 %0, %1, %2" : "=v"(r) : "v"(lo), "v"(hi)); return r; }
typedef float f32x2v __attribute__((ext_vector_type(2)));
typedef unsigned u32x2v __attribute__((ext_vector_type(2)));
__device__ __forceinline__ float bf2f(unsigned b) { return __uint_as_float(b << 16); }
__device__ __forceinline__ float wave_sum(float v) {
#pragma unroll
    for (int o = 1; o < 64; o <<= 1) v += __shfl_xor(v, o);
    return v;
}
__device__ __forceinline__ float silu1(float g) { return g * __builtin_amdgcn_rcpf(1.0f + __builtin_amdgcn_exp2f(-1.4426950408889634f * g)); }

template <int NB, int MODE>
__device__ __forceinline__ void p0_transpose_item(const float* W, int K, int N, bf16* WT, LAS float* scr, int item, int lane) {
    constexpr int LPR = NB / 4, RPI = 64 / LPR, NIT = 64 / RPI, ST = NB + 1;
    const int nblk = N / NB, kb = item / nblk, nb = item - kb * nblk, k0 = 64 * kb, n0 = NB * nb;
    const int lr = lane / LPR, lc = 4 * (lane % LPR);
#pragma unroll
    for (int i = 0; i < NIT; ++i) { const int kk = RPI * i + lr; const f32x4 v = __builtin_nontemporal_load((const GAS f32x4*)(W + (size_t)(k0 + kk) * N + n0 + lc));
        LAS float* s = scr + kk * ST + lc; s[0] = v.x; s[1] = v.y; s[2] = v.z; s[3] = v.w; }
    LDS_WAIT(); asm volatile("" ::: "memory");
    const int c = lane & 7;
#pragma unroll
    for (int j = 0; j < NB / 8; ++j) { const int n = (lane >> 3) + 8 * j; const LAS float* s = scr + (8 * c) * ST + n;
        v4u o; o.x = pk2(s[0 * ST], s[1 * ST]); o.y = pk2(s[2 * ST], s[3 * ST]); o.z = pk2(s[4 * ST], s[5 * ST]); o.w = pk2(s[6 * ST], s[7 * ST]);
        const int nn = n0 + n; const int r = (MODE == 0) ? nn : ((nn >> 7) * 256 + (nn & 127) + (MODE == 2 ? 128 : 0));
        *(GAS v4u*)(WT + (size_t)r * K + k0 + 8 * c) = o; }
    LDS_WAIT(); asm volatile("" ::: "memory");
}
__device__ __forceinline__ void cvt_flat(const float* src, bf16* dst, int n8, int gt, int NGT) {
    for (int i = gt; i < n8; i += NGT) { const f32x4 a = *(const GAS f32x4*)(src + (size_t)i * 8), b = *(const GAS f32x4*)(src + (size_t)i * 8 + 4);
        v4u o; o.x = pk2(a.x, a.y); o.y = pk2(a.z, a.w); o.z = pk2(b.x, b.y); o.w = pk2(b.z, b.w); *(GAS v4u*)(dst + (size_t)i * 8) = o; }
}
__device__ __forceinline__ unsigned pack_i8x4(f32x4 v, float inv) {
    const int a = (int)__builtin_rintf(v.x * inv), b = (int)__builtin_rintf(v.y * inv), c = (int)__builtin_rintf(v.z * inv), d = (int)__builtin_rintf(v.w * inv);
    return (unsigned)(a & 255) | ((unsigned)(b & 255) << 8) | ((unsigned)(c & 255) << 16) | ((unsigned)d << 24); }
__device__ __forceinline__ float wave_max(float v) {
#pragma unroll
    for (int o = 1; o < 64; o <<= 1) v = fmaxf(v, __shfl_xor(v, o));
    return v; }
__device__ __forceinline__ void quant_row_i8(const f32x4 (&v)[16], signed char* dst, float* sa, int lane) {
    float m = 0.f;
#pragma unroll
    for (int j = 0; j < 16; ++j) m = fmaxf(fmaxf(m, fmaxf(fabsf(v[j].x), fabsf(v[j].y))), fmaxf(fabsf(v[j].z), fabsf(v[j].w)));
    m = wave_max(m); const float inv = m > 0.f ? 127.f / m : 0.f;
    if (lane == 0) *sa = m * (1.f / 127.f);
#pragma unroll
    for (int j = 0; j < 16; ++j) ((GAS unsigned*)dst)[lane + 64 * j] = pack_i8x4(v[j], inv);
}
__device__ __forceinline__ int gu_row(int mode, int nn) { return mode == 0 ? nn : (nn >> 7) * 256 + (nn & 127) + (mode == 2 ? 128 : 0); }
__device__ __forceinline__ void p0_colmax_item(const float* W, int N, unsigned* cmax, int mode, int item, int lane) {
    const int nblk = N / 64, kb = item / nblk, nb = item - kb * nblk, k0 = 64 * kb, n0 = 64 * nb, lr = lane >> 4, lc = 4 * (lane & 15);
    f32x4 m = {0.f, 0.f, 0.f, 0.f};
#pragma unroll
    for (int i = 0; i < 16; ++i) { const f32x4 v = __builtin_nontemporal_load((const GAS f32x4*)(W + (size_t)(k0 + 4 * i + lr) * N + n0 + lc));
        m.x = fmaxf(m.x, fabsf(v.x)); m.y = fmaxf(m.y, fabsf(v.y)); m.z = fmaxf(m.z, fabsf(v.z)); m.w = fmaxf(m.w, fabsf(v.w)); }
    m.x = fmaxf(m.x, __shfl_xor(m.x, 16)); m.y = fmaxf(m.y, __shfl_xor(m.y, 16)); m.z = fmaxf(m.z, __shfl_xor(m.z, 16)); m.w = fmaxf(m.w, __shfl_xor(m.w, 16));
    m.x = fmaxf(m.x, __shfl_xor(m.x, 32)); m.y = fmaxf(m.y, __shfl_xor(m.y, 32)); m.z = fmaxf(m.z, __shfl_xor(m.z, 32)); m.w = fmaxf(m.w, __shfl_xor(m.w, 32));
    if (lane < 16) { const int r = gu_row(mode, n0 + lc);
        (void)__hip_atomic_fetch_max(cmax + r + 0, __float_as_uint(m.x), RLX_AGENT); (void)__hip_atomic_fetch_max(cmax + r + 1, __float_as_uint(m.y), RLX_AGENT);
        (void)__hip_atomic_fetch_max(cmax + r + 2, __float_as_uint(m.z), RLX_AGENT); (void)__hip_atomic_fetch_max(cmax + r + 3, __float_as_uint(m.w), RLX_AGENT); }
}
__device__ __forceinline__ void p0_quant_item(const float* W, int K, int N, signed char* WT, const unsigned* cmax, float* sB, int mode, LAS float* scr, int item, int lane) {
    const int nblk = N / 64, kb = item / nblk, nb = item - kb * nblk, k0 = 64 * kb, n0 = 64 * nb, lr = lane >> 4, lc = 4 * (lane & 15);
#pragma unroll
    for (int i = 0; i < 16; ++i) { const int kk = 4 * i + lr; const f32x4 v = __builtin_nontemporal_load((const GAS f32x4*)(W + (size_t)(k0 + kk) * N + n0 + lc));
        LAS float* s = scr + kk * 65 + lc; s[0] = v.x; s[1] = v.y; s[2] = v.z; s[3] = v.w; }
    LDS_WAIT(); asm volatile("" ::: "memory");
    const int r = gu_row(mode, n0 + lane); const float am = __uint_as_float(__hip_atomic_load(cmax + r, RLX_AGENT)), inv = am > 0.f ? 127.f / am : 0.f;
    if (kb == 0) sB[r] = am * (1.f / 127.f);
    const LAS float* s = scr + lane;
#pragma unroll
    for (int c = 0; c < 4; ++c) { v4u o;
        o.x = pack_i8x4((f32x4){s[(16 * c + 0) * 65], s[(16 * c + 1) * 65], s[(16 * c + 2) * 65], s[(16 * c + 3) * 65]}, inv); o.y = pack_i8x4((f32x4){s[(16 * c + 4) * 65], s[(16 * c + 5) * 65], s[(16 * c + 6) * 65], s[(16 * c + 7) * 65]}, inv);
        o.z = pack_i8x4((f32x4){s[(16 * c + 8) * 65], s[(16 * c + 9) * 65], s[(16 * c + 10) * 65], s[(16 * c + 11) * 65]}, inv); o.w = pack_i8x4((f32x4){s[(16 * c + 12) * 65], s[(16 * c + 13) * 65], s[(16 * c + 14) * 65], s[(16 * c + 15) * 65]}, inv);
        *(GAS v4u*)(WT + (size_t)r * K + k0 + 16 * c) = o; }
    LDS_WAIT(); asm volatile("" ::: "memory");
}
__device__ __forceinline__ void quant_h(Frame& F, const bf16* H, signed char* HQ, const unsigned* rmax, float* SH, int nrows) {
    const int gw = F.vcu * NWAVES + F.wave, NGW = F.G * NWAVES;
    constexpr int NCH = FF / 8, NIT = (NCH + 63) / 64;
    for (int r = gw; r < nrows; r += NGW) {
        const GAS v4u* src = (const GAS v4u*)(H + (size_t)r * FF); GAS u32x2v* dst = (GAS u32x2v*)(HQ + (size_t)r * FF);
        v4u w[NIT];
#pragma unroll
        for (int i = 0; i < NIT; ++i) { const int c = F.lane + 64 * i; w[i] = (v4u){0u, 0u, 0u, 0u}; if (c < NCH) w[i] = src[c]; }
        unsigned mx = 0u;
#pragma unroll
        for (int i = 0; i < NIT; ++i) { const unsigned ww_[4] = {w[i].x, w[i].y, w[i].z, w[i].w};
#pragma unroll
            for (int k_ = 0; k_ < 4; ++k_) { const unsigned lo_ = (ww_[k_] << 16) & 0x7fff0000u, hi_ = ww_[k_] & 0x7fff0000u; mx = mx > lo_ ? mx : lo_; mx = mx > hi_ ? mx : hi_; } }
#pragma unroll
        for (int o = 1; o < 64; o <<= 1) { const unsigned t_ = (unsigned)__shfl_xor((int)mx, o); mx = mx > t_ ? mx : t_; }
        const float am = __uint_as_float(mx), inv = am > 0.f ? 127.f / am : 0.f;
        if (F.lane == 0) SH[r] = am * (1.f / 127.f);
#pragma unroll
        for (int i = 0; i < NIT; ++i) { const int c = F.lane + 64 * i; u32x2v o;
            o.x = pack_i8x4((f32x4){bf2f(w[i].x & 0xffffu), bf2f(w[i].x >> 16), bf2f(w[i].y & 0xffffu), bf2f(w[i].y >> 16)}, inv); o.y = pack_i8x4((f32x4){bf2f(w[i].z & 0xffffu), bf2f(w[i].z >> 16), bf2f(w[i].w & 0xffffu), bf2f(w[i].w >> 16)}, inv);
            if (c < NCH) dst[c] = o; } }
}
constexpr int IT_GU = (D / 64) * (FF / 64), IT_IN = (D / 64) * (DIN / 32), IT_OUT = (D / 64) * (D / 64);
constexpr int Q_E1 = IT_GU  , Q_E2 = Q_E1 + IT_IN  , Q_E3 = Q_E2 + IT_OUT  , Q_E4 = Q_E3 + 2 * IT_GU  , Q_E5 = Q_E4 + IT_GU  ;
constexpr int QCH = 8;
constexpr int CW_QCTR = 2048, CW_DONE = 2112;
__device__ __forceinline__ void conv_item(const Ptrs& P, LAS float* scr, int q, int lane) {
    const float* wg = P.in[I_WG] + (size_t)D * FF; const float* wu = P.in[I_WU] + (size_t)D * FF; const float* wd = P.in[I_WD];
    if (q < Q_E1) p0_quant_item(wd, FF, D, (signed char*)P.Wd1, P.CMAXD, P.SBD1, 0, scr, q, lane);
    else if (q < Q_E2) p0_transpose_item<32, 0>(P.in[I_WIN], D, DIN, P.Win, scr, q - Q_E1, lane);
    else if (q < Q_E3) p0_transpose_item<64, 0>(P.in[I_WOUT], D, D, P.Wout, scr, q - Q_E2, lane);
    else if (q < Q_E3 + IT_GU) p0_quant_item(wg, D, FF, (signed char*)P.Wgu2, P.CMAX + NGU, P.SB2, 1, scr, q - Q_E3, lane);
    else if (q < Q_E4) p0_quant_item(wu, D, FF, (signed char*)P.Wgu2, P.CMAX + NGU, P.SB2, 2, scr, q - Q_E3 - IT_GU, lane);
    else p0_quant_item(wd + (size_t)D * FF, FF, D, (signed char*)P.Wd2, P.CMAXD + D, P.SBD2, 0, scr, q - Q_E4, lane);
}
__device__ __forceinline__ int q_take(Frame& F) { int i = 0; if (F.lane == 0) i = (int)__hip_atomic_fetch_add(F.ctl + CW_QCTR, (unsigned)QCH, RLX_AGENT); return __builtin_amdgcn_readfirstlane(i); }
__device__ __forceinline__ int q_head(Frame& F) { return (int)__builtin_amdgcn_readfirstlane(__hip_atomic_load(F.ctl + CW_QCTR, RLX_AGENT)); }
__device__ __forceinline__ void q_catch_up(Frame& F, const Ptrs& P, int E) {
    LAS float* scr = (LAS float*)(F.lds + RING_OFF + F.wave * 16640);
    for (;;) { if (q_head(F) >= E) break; const int i = q_take(F);
        for (int k = 0; k < QCH; ++k) if (i + k < Q_E5) conv_item(P, scr, i + k, F.lane); }
}
__device__ __forceinline__ void q_fill(Frame& F, const Ptrs& P, int ph) {
    LAS float* scr = (LAS float*)(F.lds + RING_OFF + F.wave * 16640);
    gu32* done = F.ctl + CW_DONE + 64 * ph;
    for (;;) {
        if ((int)__builtin_amdgcn_readfirstlane(__hip_atomic_load(done, RLX_AGENT)) >= F.G || q_head(F) >= Q_E5) break;
        const int i = q_take(F); if (i >= Q_E5) break;
        for (int k = 0; k < QCH; ++k) if (i + k < Q_E5) conv_item(P, scr, i + k, F.lane); }
}
__device__ __forceinline__ void sub_barrier(Frame& F, gu32* ctr, unsigned n) {
    asm volatile("s_waitcnt vmcnt(0) lgkmcnt(0)" ::: "memory"); __syncthreads();
    if (F.tid == 0) {
        __builtin_amdgcn_fence(__ATOMIC_RELEASE, "agent"); asm volatile("s_waitcnt vmcnt(0)" ::: "memory");
        (void)__hip_atomic_fetch_add(ctr, 1u, RLX_AGENT);
        unsigned sp = 0; while (__hip_atomic_load(ctr, RLX_AGENT) < n) { __builtin_amdgcn_s_sleep(2); if (++sp > (1u << 22)) { __hip_atomic_store(F.ctl + CW_TMO, 1u, RLX_AGENT); break; } }
        __builtin_amdgcn_fence(__ATOMIC_ACQUIRE, "agent"); asm volatile("s_waitcnt vmcnt(0)" ::: "memory");
    }
    __syncthreads();
}
constexpr int CW_SUB = 3072;
#define PHASE_DONE(ph) do { if (F.tid == 0) (void)__hip_atomic_fetch_add(F.ctl + CW_DONE + 64 * (ph), 1u, RLX_AGENT); } while (0)
__device__ __forceinline__ void p0_quant_wgu1(Frame& F, const Ptrs& P) {
    LAS float* scr = (LAS float*)(F.lds + RING_OFF + F.wave * 16640);
    const int gw = F.vcu * NWAVES + F.wave, NGW = F.G * NWAVES;
    for (int it = gw; it < 2 * IT_GU; it += NGW) {
        if (it < IT_GU) p0_quant_item(P.in[I_WG], D, FF, (signed char*)P.Wgu1, P.CMAX, P.SB1, 1, scr, it, F.lane);
        else p0_quant_item(P.in[I_WU], D, FF, (signed char*)P.Wgu1, P.CMAX, P.SB1, 2, scr, it - IT_GU, F.lane);
    }
}
__device__ __forceinline__ void p0_prologue(Frame& F, const Ptrs& P) {
    const int gw = F.vcu * NWAVES + F.wave, NGW = F.G * NWAVES;
    for (int it = gw; it < 4 * IT_GU; it += NGW) { const int mtx = it / IT_GU, r = it - mtx * IT_GU;
        p0_colmax_item((mtx & 1 ? P.in[I_WU] : P.in[I_WG]) + (size_t)(mtx >> 1) * D * FF, FF, P.CMAX + (mtx >> 1) * NGU, 1 + (mtx & 1), r, F.lane); }
    for (int it = gw; it < 2 * IT_GU; it += NGW) { const int mtx = it / IT_GU, r = it - mtx * IT_GU;
        p0_colmax_item(P.in[I_WD] + (size_t)mtx * D * FF, D, P.CMAXD + mtx * D, 0, r, F.lane); }
    for (int m = gw; m < M1V; m += NGW) {
        const float* src = m < ROW_S ? P.in[I_XP] + (size_t)m * D : (m < ROW_M ? P.in[I_XS] + (size_t)(m - ROW_S) * D : P.in[I_META] + (size_t)(m - ROW_M) * D);
        const GAS f32x4* xr = (const GAS f32x4*)src + F.lane; f32x4 v[16];
#pragma unroll
        for (int j = 0; j < 16; ++j) v[j] = xr[64 * j];
        quant_row_i8(v, P.XQ + (size_t)m * D, P.SA + m, F.lane);
    }
    const int gt = gw * 64 + F.lane, NGT = NGW * 64;
    for (int i = gt; i < NPOS * 64; i += NGT) { const int pos = i >> 6, k = i & 63;
        const double inv = exp2(-(double)k * (13.287712379549449 / 64.0)); const float ang = (float)((double)pos * inv);
        float s, c; sincosf(ang, &s, &c); ((GAS f32x2v*)P.ROPE)[i] = (f32x2v){c, s}; }
    cvt_flat(P.in[I_CMK], P.KB + (size_t)KVR_SMETA * KVW, NB_S * NMETA * KVW / 8, gt, NGT);
    cvt_flat(P.in[I_CMV], P.VB + (size_t)KVR_SMETA * KVW, NB_S * NMETA * KVW / 8, gt, NGT);
    cvt_flat(P.in[I_CWK], P.KB + (size_t)KVR_SWIN * KVW, NB_S * WIN * KVW / 8, gt, NGT);
    cvt_flat(P.in[I_CWV], P.VB + (size_t)KVR_SWIN * KVW, NB_S * WIN * KVW / 8, gt, NGT);
}

__device__ __forceinline__ void swiglu_combine(Frame& F, const pg8::SplitOrder& SO, const float* slab, bf16* H, const float* sA, const float* sB) {
    const int tid = F.tid, row = tid >> 4, c8 = (tid & 15) * 8;
    for (int it = blockIdx.x; it < SO.rem * 8; it += F.G) { const int ri = it >> 3, r0 = (it & 7) * 32 + row; pg8::Unit u; SO.map(SO.R * SO.G + ri, u);
        typedef int i32x4 __attribute__((ext_vector_type(4)));
        i32x4 ig0 = {0, 0, 0, 0}, ig1 = ig0, iu0 = ig0, iu1 = ig0;
        for (int s2 = 0; s2 < SO.S; ++s2) { const GAS i32x4* sp = (const GAS i32x4*)(slab + ((size_t)(ri * SO.S + s2) << 16) + r0 * 256 + c8);
            ig0 = ig0 + sp[0]; ig1 = ig1 + sp[1]; iu0 = iu0 + sp[32]; iu1 = iu1 + sp[33]; }
        const float sa = sA[u.pm * 256 + r0]; const float* sbp = sB + u.pn * 256 + c8;
        const f32x4 g0 = __builtin_convertvector(ig0, f32x4) * (*(const GAS f32x4*)(sbp) * sa), g1 = __builtin_convertvector(ig1, f32x4) * (*(const GAS f32x4*)(sbp + 4) * sa);
        const f32x4 u0 = __builtin_convertvector(iu0, f32x4) * (*(const GAS f32x4*)(sbp + 128) * sa), u1 = __builtin_convertvector(iu1, f32x4) * (*(const GAS f32x4*)(sbp + 132) * sa);
        v4u o; o.x = pkbf(silu1(g0.x) * u0.x, silu1(g0.y) * u0.y); o.y = pkbf(silu1(g0.z) * u0.z, silu1(g0.w) * u0.w);
        o.z = pkbf(silu1(g1.x) * u1.x, silu1(g1.y) * u1.y); o.w = pkbf(silu1(g1.z) * u1.z, silu1(g1.w) * u1.w);
        *(GAS v4u*)(H + (size_t)(u.pm * 256 + r0) * FF + u.pn * 128 + c8) = o; }
}
__device__ __forceinline__ void ln_phase(Frame& F, const bf16* Y, float* Xo, bf16* XN, const float* g, const float* b, int nrows, const pg8::SplitOrder& SO, const float* slab, float sscale, signed char* XQ, float* SA) {
    const int gw = F.vcu * NWAVES + F.wave, NGW = F.G * NWAVES;
    f32x4 gg_[16], bb_[16];
#pragma unroll
    for (int j = 0; j < 16; ++j) { gg_[j] = ((const GAS f32x4*)g)[F.lane + 64 * j]; bb_[j] = ((const GAS f32x4*)b)[F.lane + 64 * j]; }
    for (int r = gw; r < nrows; r += NGW) {
        const GAS u32x2v* yr = (const GAS u32x2v*)(Y + (size_t)r * D) + F.lane;
        f32x4 v[16];
#pragma unroll
        for (int j = 0; j < 16; ++j) { const u32x2v w_ = yr[64 * j]; v[j] = (f32x4){bf2f(w_.x & 0xffffu), bf2f(w_.x >> 16), bf2f(w_.y & 0xffffu), bf2f(w_.y >> 16)}; }
        if (SO.rem > 0 && SO.S > 1) { const int pm = r >> 8, rr = r & 255;
#pragma unroll
            for (int j = 0; j < 16; ++j) { const int ri = SO.inv(pm, j) - SO.R * SO.G;
                if (ri >= 0) { const GAS f32x4* sp = (const GAS f32x4*)(slab + ((size_t)(ri * (SO.S - 1)) << 16) + rr * 256) + F.lane; f32x4 a = sp[0];
                    for (int s2 = 1; s2 < SO.S - 1; ++s2) a = a + sp[(size_t)s2 << 14];
                    v[j] = v[j] + a * sscale; } } }
        float s = 0.f;
#pragma unroll
        for (int j = 0; j < 16; ++j) s += (v[j].x + v[j].y) + (v[j].z + v[j].w);
        const float mean = wave_sum(s) * (1.f / D); float s2 = 0.f;
#pragma unroll
        for (int j = 0; j < 16; ++j) { v[j] = v[j] - mean; s2 += (v[j].x * v[j].x + v[j].y * v[j].y) + (v[j].z * v[j].z + v[j].w * v[j].w); }
        const float rstd = 1.f / sqrtf(wave_sum(s2) * (1.f / D) + LN_EPS);
#pragma unroll
        for (int j = 0; j < 16; ++j) { const f32x4 gg = gg_[j], bb = bb_[j];
            const f32x4 o = v[j] * rstd * gg + bb; v[j] = o;
            if (Xo) ((GAS f32x4*)(Xo + (size_t)r * D))[F.lane + 64 * j] = o;
            if (XN) { u32x2v w; w.x = pk2(o.x, o.y); w.y = pk2(o.z, o.w); ((GAS u32x2v*)(XN + (size_t)r * D))[F.lane + 64 * j] = w; } }
        if (XQ) quant_row_i8(v, XQ + (size_t)r * D, SA + r, F.lane);
    }
}

__device__ __forceinline__ void kv_prep(Frame& F, const Ptrs& P) {
    const int gw = F.vcu * NWAVES + F.wave, NGW = F.G * NWAVES, lane = F.lane;
    const bf16* HIN = P.H;
    for (int r = gw; r < M1V; r += NGW) {
        int pos; float* kdst = nullptr; float* vdst = nullptr; int ncp = 1;
        if (r < ROW_S) { const int t = r & (SEQ_P - 1), b = r >> 11; pos = NMETA + t;
            if (t >= SEQ_P - WIN) { kdst = P.out + O_PWK + (size_t)(b * WIN + t - (SEQ_P - WIN)) * KVW; vdst = P.out + O_PWV + (size_t)(b * WIN + t - (SEQ_P - WIN)) * KVW; } }
        else if (r < ROW_M) { pos = NMETA + PAST + ((r - ROW_S) & (SEQ_S - 1)); kdst = P.out + O_SWK + (size_t)(r - ROW_S) * KVW; vdst = P.out + O_SWV + (size_t)(r - ROW_S) * KVW; }
        else { pos = r - ROW_M; kdst = P.out + O_PMK + (size_t)pos * KVW; vdst = P.out + O_PMV + (size_t)pos * KVW; ncp = NB_P; }
        const bf16* hrow = HIN + (size_t)r * DINP;
        const f32x2v cs = ((const GAS f32x2v*)P.ROPE)[pos * 64 + lane];
#pragma unroll
        for (int kh = 0; kh < KVH; ++kh) { const float x1 = bf2f(hrow[C_K + kh * HD + lane]), x2 = bf2f(hrow[C_K + kh * HD + 64 + lane]);
            const float o1 = x1 * cs.x - x2 * cs.y, o2 = x2 * cs.x + x1 * cs.y;
            P.KB[(size_t)r * KVW + kh * HD + lane] = (bf16)f2bf(o1); P.KB[(size_t)r * KVW + kh * HD + 64 + lane] = (bf16)f2bf(o2);
            if (kdst) for (int cp = 0; cp < ncp; ++cp) { kdst[(size_t)cp * NMETA * KVW + kh * HD + lane] = o1; kdst[(size_t)cp * NMETA * KVW + kh * HD + 64 + lane] = o2; } }
        const v4u vv = *(const GAS v4u*)(hrow + C_V + 8 * lane);
        *(GAS v4u*)(P.VB + (size_t)r * KVW + 8 * lane) = vv;
        if (vdst) { const f32x4 a = {bf2f(vv.x & 0xffffu), bf2f(vv.x >> 16), bf2f(vv.y & 0xffffu), bf2f(vv.y >> 16)}, c = {bf2f(vv.z & 0xffffu), bf2f(vv.z >> 16), bf2f(vv.w & 0xffffu), bf2f(vv.w >> 16)};
            for (int cp = 0; cp < ncp; ++cp) { *(GAS f32x4*)(vdst + (size_t)cp * NMETA * KVW + 8 * lane) = a; *(GAS f32x4*)(vdst + (size_t)cp * NMETA * KVW + 8 * lane + 4) = c; } }
    }
    for (int it = gw; it < (NB_P + NB_S) * 3 * (DCONV / 512); it += NGW) {
        const int part = it % (DCONV / 512), rj = it / (DCONV / 512), j = rj % 3, sb = rj / 3;
        const int srow = sb < NB_P ? sb * SEQ_P + SEQ_P - 3 + j : ROW_S + (sb - NB_P) * SEQ_S + SEQ_S - 3 + j;
        float* dst = (sb < NB_P ? P.out + O_PCONV + (size_t)(sb * 3 + j) * DCONV : P.out + O_SCONV + (size_t)((sb - NB_P) * 3 + j) * DCONV) + part * 512 + 8 * lane;
        const v4u vv = *(const GAS v4u*)(HIN + (size_t)srow * DINP + C_CONV + part * 512 + 8 * lane);
        *(GAS f32x4*)dst = (f32x4){bf2f(vv.x & 0xffffu), bf2f(vv.x >> 16), bf2f(vv.y & 0xffffu), bf2f(vv.y >> 16)};
        *(GAS f32x4*)(dst + 4) = (f32x4){bf2f(vv.z & 0xffffu), bf2f(vv.z >> 16), bf2f(vv.w & 0xffffu), bf2f(vv.w >> 16)};
    }
}

constexpr int PB_ST = 136;
constexpr int L_AT = 0, L_TAB = L_AT + 64 * 68 * 4, L_QKR = L_TAB + 12 * 256, L_QB = L_QKR + 64 * 68 * 4, L_KB = L_QB + 64 * PB_ST * 2, L_VB = L_KB + 64 * PB_ST * 2, L_XR = L_VB + 64 * PB_ST * 2, L_PREP_END = L_XR + 64 * 768;
static_assert(L_PREP_END <= RING_BYTES && (L_XR % 1024) == 0, "GDN prep LDS");
enum { T_BETA = 0, T_GC, T_EG, T_EK, T_RK2, T_RQ2, T_SU, T_SW, T_SKD, T_SQD, T_N };
struct PrepUnit { int kind, b, h, n, row0; };
__device__ __forceinline__ PrepUnit prep_decode(int uidx) {
    PrepUnit u; u.b = 0; u.n = 0;
    if (uidx < 2048) { u.kind = 0; u.b = uidx >> 9; u.h = (uidx >> 5) & 15; u.n = uidx & 31; u.row0 = u.b * SEQ_P + 64 * u.n; }
    else if (uidx < 2064) { u.kind = 1; u.h = uidx - 2048; u.row0 = ROW_M - 48; }
    else { u.kind = 2; u.b = (uidx - 2064) >> 4; u.h = (uidx - 2064) & 15; u.row0 = ROW_S + u.b * SEQ_S; }
    return u;
}
__device__ __forceinline__ float dpp_sum16(float p) {
    p += __builtin_bit_cast(float, __builtin_amdgcn_update_dpp(0, __builtin_bit_cast(int, p), 0xB1, 0xF, 0xF, true));
    p += __builtin_bit_cast(float, __builtin_amdgcn_update_dpp(0, __builtin_bit_cast(int, p), 0x4E, 0xF, 0xF, true));
    p += __builtin_bit_cast(float, __builtin_amdgcn_update_dpp(0, __builtin_bit_cast(int, p), 0x141, 0xF, 0xF, true));
    p += __builtin_bit_cast(float, __builtin_amdgcn_update_dpp(0, __builtin_bit_cast(int, p), 0x140, 0xF, 0xF, true));
    return p;
}
template <bool ISU> __device__ __forceinline__ void prep_solve(LAS float* AT, LAS float* TAB, LAS unsigned char* VB, LAS unsigned char* KB, LAS unsigned char* OUTW, unsigned char* ud, int tid) {
    const int cc = tid & 127; const LAS unsigned char* src = (ISU ? VB : KB) + cc * 2; const LAS float* sc = TAB + (ISU ? T_SU : T_SW) * 64;
    float* U = (float*)(ud + GU_U);
    const int cslot = (cc >> 5) * 4 + (kpos32(cc & 31) >> 3), cpos2 = (kpos32(cc & 31) & 7) * 2;
    float r[64];
#pragma unroll
    for (int i = 0; i < 64; ++i) r[i] = bf2f(*(const LAS unsigned short*)(src + i * (PB_ST * 2))) * sc[i];
    const LAS float* atp = AT;
#pragma unroll
    for (int j = 0; j < 64; ++j) { float sol = r[j]; asm volatile("" : "+v"(atp), "+v"(sol));
        if (ISU) U[j * 128 + cc] = sol; else *(LAS unsigned short*)(OUTW + j * 256 + ((cslot ^ (j & 15)) << 4) + cpos2) = (unsigned short)f2bf(sol);
#pragma unroll
        for (int q = (j + 1) / 4; q < 16; ++q) { const f32x4 a = *(const LAS f32x4*)(atp + j * 68 + 4 * q);
            if (4 * q + 0 > j) r[4 * q + 0] -= a.x * sol; if (4 * q + 1 > j) r[4 * q + 1] -= a.y * sol;
            if (4 * q + 2 > j) r[4 * q + 2] -= a.z * sol; if (4 * q + 3 > j) r[4 * q + 3] -= a.w * sol; }
        __builtin_amdgcn_sched_barrier(0); }
}
struct Solve2State { float r0[32], r1[32]; f32x4 a[2][8]; const LAS float* atp; float* U; LAS unsigned char* ow; int pi, cslot; };
template <bool ISU, int J> __device__ __forceinline__ void prep_solve2_step(Solve2State& st) {
    if constexpr (J < 64) {
        constexpr int pj = (J >> 2) & 1, kj = 4 * (J >> 3) + (J & 3);
        asm volatile("" : "+v"(st.atp), "+v"(st.r0[kj]));
        if constexpr (J + 1 < 64) {
#pragma unroll
            for (int kk = (J + 1) >> 3; kk < 8; ++kk) st.a[(J + 1) & 1][kk] = *(const LAS f32x4*)(st.atp + (J + 1) * 68 + 8 * kk); }
        const float m0 = st.r0[kj], m1 = st.r1[kj];
        const float o0 = __builtin_bit_cast(float, __builtin_amdgcn_update_dpp(0, __builtin_bit_cast(int, m0), 0xB1, 0xF, 0xF, true)), o1 = __builtin_bit_cast(float, __builtin_amdgcn_update_dpp(0, __builtin_bit_cast(int, m1), 0xB1, 0xF, 0xF, true));
        const float s0 = (st.pi == pj) ? m0 : o0, s1 = (st.pi == pj) ? m1 : o1;
        if (ISU) *(GAS f32x2v*)(st.U + J * 128) = (f32x2v){s0, s1}; else *(LAS unsigned*)(st.ow + J * 256 + ((st.cslot ^ (J & 15)) << 4)) = pkbf(s0, s1);
#pragma unroll
        for (int kk = J >> 3; kk < 8; ++kk) { const f32x4 av = st.a[J & 1][kk];
            st.r0[4 * kk + 0] -= av.x * s0; st.r0[4 * kk + 1] -= av.y * s0; st.r0[4 * kk + 2] -= av.z * s0; st.r0[4 * kk + 3] -= av.w * s0;
            st.r1[4 * kk + 0] -= av.x * s1; st.r1[4 * kk + 1] -= av.y * s1; st.r1[4 * kk + 2] -= av.z * s1; st.r1[4 * kk + 3] -= av.w * s1; }
        __builtin_amdgcn_sched_barrier(0);
        prep_solve2_step<ISU, J + 1>(st);
    }
}
template <bool ISU> __device__ __forceinline__ void prep_solve2(LAS float* AT, LAS float* TAB, LAS unsigned char* VB, LAS unsigned char* KB, LAS unsigned char* OUTW, unsigned char* ud, int tid) {
    Solve2State st; st.pi = tid & 1; const int c0 = (tid & 127) & ~1;
    const LAS unsigned char* src = (ISU ? VB : KB) + c0 * 2 + st.pi * (4 * PB_ST * 2); const LAS float* sc = TAB + (ISU ? T_SU : T_SW) * 64 + 4 * st.pi;
    st.U = (float*)(ud + GU_U) + c0; st.ow = OUTW + (kpos32(c0 & 31) & 7) * 2; st.cslot = (c0 >> 5) * 4 + (kpos32(c0 & 31) >> 3);
#pragma unroll
    for (int k = 0; k < 32; ++k) { const int rw = 8 * (k >> 2) + (k & 3); const unsigned w_ = *(const LAS unsigned*)(src + rw * (PB_ST * 2)); const float s_ = sc[rw]; st.r0[k] = bf2f(w_ & 0xffffu) * s_; st.r1[k] = bf2f(w_ >> 16) * s_; }
    st.atp = AT + 4 * st.pi;
#pragma unroll
    for (int kk = 0; kk < 8; ++kk) st.a[0][kk] = *(const LAS f32x4*)(st.atp + 8 * kk);
    prep_solve2_step<ISU, 0>(st);
}
#define PB_BAR() do { asm volatile("s_waitcnt lgkmcnt(0)" ::: "memory"); __builtin_amdgcn_s_barrier(); asm volatile("" ::: "memory"); } while (0)
__device__ __forceinline__ void gdn_prep_all(Frame& F, const Ptrs& P, int abl  ) {
    int tid_ = F.tid; asm volatile("" : "+v"(tid_));
    const int tid = tid_, wv = F.wave;
    LAS unsigned char* L = F.lds;
    LAS float* AT = (LAS float*)(L + L_AT); LAS float* TAB = (LAS float*)(L + L_TAB); LAS float* QKR = (LAS float*)(L + L_QKR);
    LAS unsigned char* QB = L + L_QB; LAS unsigned char* KB = L + L_KB; LAS unsigned char* VB = L + L_VB; LAS unsigned char* XR = L + L_XR; LAS unsigned char* OUTW = L + L_QKR;
    const bf16* HIN = P.H;
    const int part = wv >> 1, half = wv & 1;
    f32x2v cwn[4], hxn[3]; float bln = 0.f, aln = 0.f;
#define PB_PREFETCH(U) do { const PrepUnit& u_ = (U); int lane = tid; asm volatile("" : "+v"(lane)); lane &= 63; \
          \
        _Pragma("unroll") for (int k_ = 0; k_ < 6; ++k_) { const int p_ = (6 * wv + k_) * 64 + lane, t_ = p_ >> 4, r_ = (t_ * 171) >> 9, pt_ = t_ - 3 * r_; \
            const int rr_ = (u_.kind == 1 && r_ < 48) ? 48 : r_; \
            __builtin_amdgcn_global_load_lds((const GAS unsigned*)(HIN + (size_t)(u_.row0 + rr_) * DINP + C_CONV + pt_ * 2048 + u_.h * 128 + (p_ & 15) * 8), (LAS unsigned*)(XR + (6 * wv + k_) * 1024), 16, 0, 0); } \
        if (wv < 6) { const int ch_ = part * 2048 + u_.h * 128 + 2 * lane; const float* cw_ = P.in[I_CONVW] + ch_; \
            _Pragma("unroll") for (int j_ = 0; j_ < 4; ++j_) cwn[j_] = *(const GAS f32x2v*)(cw_ + j_ * DCONV); \
            _Pragma("unroll") for (int j_ = 0; j_ < 3; ++j_) hxn[j_] = (f32x2v){0.f, 0.f}; \
            if (half == 0) { \
                if (u_.kind == 0) { const int hr_ = (u_.n == 0) ? ROW_M + 13 : u_.row0 - 3; \
                    _Pragma("unroll") for (int j_ = 0; j_ < 3; ++j_) { const unsigned w_ = *(const GAS unsigned*)(HIN + (size_t)(hr_ + j_) * DINP + C_CONV + ch_); hxn[j_] = (f32x2v){bf2f(w_ & 0xffffu), bf2f(w_ >> 16)}; } } \
                else if (u_.kind == 2) { const float* sc_ = P.in[I_SCONV] + (size_t)u_.b * 3 * DCONV + ch_; \
                    _Pragma("unroll") for (int j_ = 0; j_ < 3; ++j_) hxn[j_] = *(const GAS f32x2v*)(sc_ + j_ * DCONV); } } } \
        else if (wv == 6) { const bf16* hr_ = HIN + (size_t)(u_.row0 + ((u_.kind == 1 && lane < 48) ? 48 : lane)) * DINP; bln = bf2f(hr_[C_B + u_.h]); aln = bf2f(hr_[C_A + u_.h]); } } while (0)
    int uidx = blockIdx.x;
    if (uidx >= N_GUNITS) return;
    PrepUnit un_ = prep_decode(uidx);
    PB_PREFETCH(un_);
    for (; uidx < N_GUNITS; uidx += F.G) {
        const PrepUnit u = prep_decode(uidx);
        unsigned char* ud = P.GDN + (size_t)uidx * GU_BYTES;
        asm volatile("s_waitcnt vmcnt(0) lgkmcnt(0)" ::: "memory"); __builtin_amdgcn_s_barrier(); asm volatile("" ::: "memory");
        f32x2v cw[4], hx[3]; float bl = bln, al = aln;
#pragma unroll
        for (int j = 0; j < 4; ++j) cw[j] = cwn[j];
#pragma unroll
        for (int j = 0; j < 3; ++j) hx[j] = hxn[j];
        asm volatile("" : "+v"(cw[0]), "+v"(cw[1]), "+v"(cw[2]), "+v"(cw[3]), "+v"(hx[0]), "+v"(hx[1]), "+v"(hx[2]), "+v"(bl), "+v"(al));
        { int tl_ = tid; asm volatile("" : "+v"(tl_)); const int lane = tl_ & 63;
        if (wv < 6) {
            const LAS unsigned char* xr = XR + part * 256 + lane * 4; LAS unsigned char* dst = (part == 0 ? QB : (part == 1 ? KB : VB)) + lane * 4;
            const int i0 = 32 * half;
            f32x2v xm3 = hx[0], xm2 = hx[1], xm1 = hx[2];
            if (half == 1) { const unsigned a_ = *(const LAS unsigned*)(xr + 29 * 768), b_ = *(const LAS unsigned*)(xr + 30 * 768), c_ = *(const LAS unsigned*)(xr + 31 * 768);
                xm3 = (f32x2v){bf2f(a_ & 0xffffu), bf2f(a_ >> 16)}; xm2 = (f32x2v){bf2f(b_ & 0xffffu), bf2f(b_ >> 16)}; xm1 = (f32x2v){bf2f(c_ & 0xffffu), bf2f(c_ >> 16)};
                if (u.kind == 1) { xm3 = (f32x2v){0.f, 0.f}; xm2 = xm3; xm1 = xm3; } }
#pragma unroll 8
            for (int ii = 0; ii < 32; ++ii) { const int i = i0 + ii; const unsigned w_ = *(const LAS unsigned*)(xr + i * 768);
                f32x2v x = (f32x2v){bf2f(w_ & 0xffffu), bf2f(w_ >> 16)};
                if (u.kind == 1 && i < 48) x = (f32x2v){0.f, 0.f};
                const f32x2v y = cw[0] * xm3 + cw[1] * xm2 + cw[2] * xm1 + cw[3] * x;
                *(LAS unsigned*)(dst + i * (PB_ST * 2)) = pkbf(silu1(y.x), silu1(y.y)); xm3 = xm2; xm2 = xm1; xm1 = x; }
        } else if (wv == 6) {
            float be = 0.f, g = 0.f;
            if (!(u.kind == 1 && lane < 48)) { be = 1.f / (1.f + expf(-bl)); const float x = al + P.in[I_DTB][u.h]; const float sp = fmaxf(x, 0.f) + log1pf(expf(-fabsf(x))); g = -expf(P.in[I_ALOG][u.h]) * sp; }
            float v = g;
#pragma unroll
            for (int o = 1; o < 64; o <<= 1) { const float t = __shfl_up(v, o); if (lane >= o) v += t; }
            const float last = __shfl(v, 63);
            TAB[T_BETA * 64 + lane] = be; TAB[T_GC * 64 + lane] = v; TAB[T_EG * 64 + lane] = expf(v); TAB[T_EK * 64 + lane] = expf(last - v);
        } }
        PB_BAR();
        if (uidx + F.G < N_GUNITS) { un_ = prep_decode(uidx + F.G); PB_PREFETCH(un_); }
        __builtin_amdgcn_sched_barrier(0);
        if (!(abl & 4)) { int tl_ = tid; asm volatile("" : "+v"(tl_)); const int lane = tl_ & 63, c16 = lane & 15, q4 = lane >> 4;
#pragma unroll
        for (int tk = 0; tk < 3; ++tk) { const int task = wv + 8 * tk;
            int rb, cb; const LAS unsigned char *Ap, *Bp;
            if (task < 20) { const int t10 = task < 10 ? task : task - 10; int a = 0, b = t10;
                if (b >= 1) { a = 1; b -= 1; if (b >= 2) { a = 2; b -= 2; if (b >= 3) { a = 3; b -= 3; } } }
                if (task < 10) { rb = a; cb = b; Ap = KB; Bp = KB; } else { rb = b; cb = a; Ap = KB; Bp = QB; } }
            else { rb = task - 20; cb = rb; Ap = QB; Bp = QB; }
            f32x4 acc = {0.f, 0.f, 0.f, 0.f};
#pragma unroll
            for (int s = 0; s < 4; ++s) { const bf16x8 A = *(const LAS bf16x8*)(Ap + (16 * rb + c16) * (PB_ST * 2) + 64 * s + 16 * q4), B = *(const LAS bf16x8*)(Bp + (16 * cb + c16) * (PB_ST * 2) + 64 * s + 16 * q4);
                acc = __builtin_amdgcn_mfma_f32_16x16x32_bf16(A, B, acc, 0, 0, 0); }
            if (task < 10) { *(LAS f32x4*)(AT + (16 * cb + c16) * 68 + 16 * rb + 4 * q4) = acc;
                if (rb == cb) {
#pragma unroll
                    for (int r = 0; r < 4; ++r) if (c16 == 4 * q4 + r) TAB[T_RK2 * 64 + 16 * rb + c16] = acc[r]; } }
            else if (task < 20) { *(LAS f32x4*)(QKR + (16 * cb + c16) * 68 + 16 * rb + 4 * q4) = acc; }
            else {
#pragma unroll
                for (int r = 0; r < 4; ++r) if (c16 == 4 * q4 + r) TAB[T_RQ2 * 64 + 16 * rb + c16] = acc[r]; }
        } }
        PB_BAR();
        if (!(abl & 4)) { int tid = tid_; asm volatile("" : "+v"(tid));
        { const int j = tid >> 3, i8 = (tid & 7) * 8;
            const float rkj = rsqrtf(TAB[T_RK2 * 64 + j] + RMS_EPS), gcj = TAB[T_GC * 64 + j];
#pragma unroll
            for (int e = 0; e < 8; ++e) { const int i = i8 + e; const float v = AT[j * 68 + i];
                const float sc = TAB[T_BETA * 64 + i] * rsqrtf(TAB[T_RK2 * 64 + i] + RMS_EPS) * rkj * expf(fminf(TAB[T_GC * 64 + i] - gcj, 0.f));
                AT[j * 68 + i] = (i > j) ? v * sc : 0.f; } }
        { const int i = tid >> 3, sl = tid & 7, g = sl >> 2, qq = sl & 3;
            const float rqi = rsqrtf(TAB[T_RQ2 * 64 + i] + RMS_EPS) * 0.08838834764831845f, gci = TAB[T_GC * 64 + i];
            float v[8];
#pragma unroll
            for (int e = 0; e < 8; ++e) { const int j = 32 * g + 4 * qq + (e & 3) + 16 * (e >> 2); const float raw = QKR[i * 68 + j];
                v[e] = (i >= j) ? raw * rqi * rsqrtf(TAB[T_RK2 * 64 + j] + RMS_EPS) * expf(fminf(gci - TAB[T_GC * 64 + j], 0.f)) : 0.f; }
            v4u o; o.x = pkbf(v[0], v[1]); o.y = pkbf(v[2], v[3]); o.z = pkbf(v[4], v[5]); o.w = pkbf(v[6], v[7]);
            *(GAS v4u*)(ud + GU_QK + i * 128 + ((sl ^ ((i >> 1) & 7)) * 16)) = o; }
        if (tid < 64) { const int i = tid; const float rk = rsqrtf(TAB[T_RK2 * 64 + i] + RMS_EPS), rq = rsqrtf(TAB[T_RQ2 * 64 + i] + RMS_EPS) * 0.08838834764831845f, be = TAB[T_BETA * 64 + i], eg = TAB[T_EG * 64 + i];
            TAB[T_SU * 64 + i] = be; TAB[T_SW * 64 + i] = be * eg * rk; TAB[T_SKD * 64 + i] = TAB[T_EK * 64 + i] * rk; TAB[T_SQD * 64 + i] = eg * rq;
            if (i == 63) *(GAS float*)(ud + GU_GL) = eg; } }
        PB_BAR();
        { int tid = tid_; asm volatile("" : "+v"(tid)); const int lane = tid & 63, c16 = lane & 15, q4 = lane >> 4;
        if (tid < 128) { if (!(abl & 1)) prep_solve2<true>(AT, TAB, VB, KB, OUTW, ud, tid); }
        else if (tid < 256) { if (!(abl & 1)) prep_solve2<false>(AT, TAB, VB, KB, OUTW, ud, tid); }
        else if (!(abl & 2)) {
            const int t = tid - 256;
#pragma unroll
            for (int k = 0; k < 4; ++k) { const int id = t + 256 * k, i = id >> 4, sl = id & 15, g = sl >> 2, qq = sl & 3; const float sc = TAB[T_SQD * 64 + i];
                const u32x2v lo = *(const LAS u32x2v*)(QB + i * (PB_ST * 2) + (32 * g + 4 * qq) * 2), hi = *(const LAS u32x2v*)(QB + i * (PB_ST * 2) + (32 * g + 16 + 4 * qq) * 2);
                v4u o; o.x = pkbf(bf2f(lo.x & 0xffffu) * sc, bf2f(lo.x >> 16) * sc); o.y = pkbf(bf2f(lo.y & 0xffffu) * sc, bf2f(lo.y >> 16) * sc);
                o.z = pkbf(bf2f(hi.x & 0xffffu) * sc, bf2f(hi.x >> 16) * sc); o.w = pkbf(bf2f(hi.y & 0xffffu) * sc, bf2f(hi.y >> 16) * sc);
                *(GAS v4u*)(ud + GU_QD + i * 256 + ((sl ^ (i & 15)) * 16)) = o; }
            const int w4 = wv - 4;
#pragma unroll
            for (int k = 0; k < 4; ++k) { const int task = w4 * 4 + k, db = task >> 1, g = task & 1;
                const int addr = (int)(size_t)KB + (32 * g + 4 * q4 + ((lane & 15) >> 2)) * (PB_ST * 2) + (16 * db + 4 * (lane & 3)) * 2;
                const f32x4 s0 = *(const LAS f32x4*)(TAB + T_SKD * 64 + 32 * g + 4 * q4), s1 = *(const LAS f32x4*)(TAB + T_SKD * 64 + 32 * g + 16 + 4 * q4);
                s16x4 lo, hi;
                asm volatile("ds_read_b64_tr_b16 %0, %2\n\tds_read_b64_tr_b16 %1, %2 offset:4352\n\ts_waitcnt lgkmcnt(0)" : "=&v"(lo), "=&v"(hi) : "v"(addr) : "memory");
                v4u o; o.x = pkbf(bf2f((unsigned short)lo[0]) * s0.x, bf2f((unsigned short)lo[1]) * s0.y); o.y = pkbf(bf2f((unsigned short)lo[2]) * s0.z, bf2f((unsigned short)lo[3]) * s0.w);
                o.z = pkbf(bf2f((unsigned short)hi[0]) * s1.x, bf2f((unsigned short)hi[1]) * s1.y); o.w = pkbf(bf2f((unsigned short)hi[2]) * s1.z, bf2f((unsigned short)hi[3]) * s1.w);
                const int d = 16 * db + c16;
                *(GAS v4u*)(ud + GU_KDT + d * 128 + (((4 * g + q4) ^ ((d >> 1) & 7)) * 16)) = o; }
        } }
        PB_BAR();
        if (!(abl & 1)) { int tid = tid_; asm volatile("" : "+v"(tid));
#pragma unroll
        for (int k = 0; k < 2; ++k) { const int o16 = (tid + 512 * k) * 16; *(GAS v4u*)(ud + GU_W + o16) = *(const LAS v4u*)(OUTW + o16); } }
    }
    asm volatile("s_waitcnt vmcnt(0) lgkmcnt(0)" ::: "memory"); __syncthreads();
#undef PB_PREFETCH
}
#undef PB_BAR

typedef float f32x16 __attribute__((ext_vector_type(16)));
#define KSWZ(row, colB) ((row) * 256 + ((colB) ^ (((row) & 7) << 4)))
#define SBAR() __builtin_amdgcn_sched_barrier(0)
__device__ __forceinline__ int crow(int r, int hi) { return (r & 3) + 8 * (r >> 2) + 4 * hi; }
__device__ __forceinline__ unsigned cvtpk(float lo, float hi) { unsigned r; asm volatile("v_cvt_pk_bf16_f32 %0, %1, %2" : "=v"(r) : "v"(lo), "v"(hi)); return r; }
__device__ __forceinline__ void qkt(f32x16& p0, f32x16& p1, const LAS unsigned char* Ks, const bf16x8* qr, int r32, int hi) {
    p0 = f32x16{}; p1 = f32x16{};
#pragma unroll
    for (int d0 = 0; d0 < 8; ++d0) { const int cb = (d0 * 16 + hi * 8) * 2;
        const bf16x8 b0 = *(const LAS bf16x8*)(Ks + KSWZ(r32, cb)), b1 = *(const LAS bf16x8*)(Ks + KSWZ(32 + r32, cb));
        p0 = __builtin_amdgcn_mfma_f32_32x32x16_bf16(b0, qr[d0], p0, 0, 0, 0);
        p1 = __builtin_amdgcn_mfma_f32_32x32x16_bf16(b1, qr[d0], p1, 0, 0, 0); }
}
__device__ __forceinline__ int v_st(int k, int c) { const int kk = (k & ~0xC) | ((k & 4) << 1) | ((k & 8) >> 1); return ((kk >> 3) * 4 + (c >> 5)) * 512 + ((kk & 7) * 32 + (c & 31)) * 2; }
__device__ __forceinline__ int v_rd_base(int lane) { return ((lane & 3) << 3) | (((lane >> 2) & 3) << 6) | (((lane >> 4) & 1) << 5) | (((lane >> 5) & 1) << 8); }
constexpr int v_rd_off(int d0, int ks, int half) { return d0 * 512 + ks * 4096 + half * 2048; }
template <int OFF> __device__ __forceinline__ s16x4 tr_read(int vb) { s16x4 r; asm volatile("ds_read_b64_tr_b16 %0, %1 offset:%2" : "=&v"(r) : "v"(vb), "i"(OFF) : "memory"); return r; }
template <int D0> __device__ __forceinline__ void pv_one(f32x16& od, int vb, bf16x8 pa0, bf16x8 pa1, bf16x8 pa2, bf16x8 pa3) {
    const s16x4 l0 = tr_read<v_rd_off(D0, 0, 0)>(vb), h0 = tr_read<v_rd_off(D0, 0, 1)>(vb), l1 = tr_read<v_rd_off(D0, 1, 0)>(vb), h1 = tr_read<v_rd_off(D0, 1, 1)>(vb);
    const s16x4 l2 = tr_read<v_rd_off(D0, 2, 0)>(vb), h2 = tr_read<v_rd_off(D0, 2, 1)>(vb), l3 = tr_read<v_rd_off(D0, 3, 0)>(vb), h3 = tr_read<v_rd_off(D0, 3, 1)>(vb);
    asm volatile("s_waitcnt lgkmcnt(0)" ::: "memory"); SBAR();
#define PK(L, H) (bf16x8){L[0], L[1], L[2], L[3], H[0], H[1], H[2], H[3]}
    od = __builtin_amdgcn_mfma_f32_32x32x16_bf16(pa0, PK(l0, h0), od, 0, 0, 0);
    od = __builtin_amdgcn_mfma_f32_32x32x16_bf16(pa1, PK(l1, h1), od, 0, 0, 0);
    od = __builtin_amdgcn_mfma_f32_32x32x16_bf16(pa2, PK(l2, h2), od, 0, 0, 0);
    od = __builtin_amdgcn_mfma_f32_32x32x16_bf16(pa3, PK(l3, h3), od, 0, 0, 0);
#undef PK
}
constexpr int ATT_V = 0, ATT_K = 16384, ATT_WS = 32768;
__device__ __forceinline__ void attn_unit(Frame& F, const Ptrs& P, int a) {
    constexpr float SCALE = 0.088388347648318440f, C = SCALE * 1.4426950408889634f;
    int tid_ = F.tid; asm volatile("" : "+v"(tid_));
    const int tid = tid_, wid = F.wave, lane = tid & 63, r32 = lane & 31, hi = lane >> 5;
    const bool isp = a < 512; const int kvh = a & 3, ab = isp ? (a >> 7) : ((a - 512) >> 2), ac = isp ? ((a >> 2) & 31) : 0;
    const int qrow0 = isp ? ab * SEQ_P + 64 * ac : ROW_S + ab * SEQ_S, pos0 = isp ? NMETA + 64 * ac : NMETA + PAST;
    LAS unsigned char* V_lds = F.lds + ATT_V; LAS unsigned char* K_lds = F.lds + ATT_K;
    LAS float* ws = (LAS float*)(F.lds + ATT_WS) + wid * 64; LAS float* li_l = ws; LAS float* al_l = ws + 32;
    const int g = wid >> 1, qoff = 32 * (wid & 1), hq = kvh * 4 + g;
    bf16x8 qr[8];
    { const bf16* qp = P.H + (size_t)(qrow0 + qoff + r32) * DINP + C_Q + hq * HD + hi * 8; const GAS f32x2v* cs = (const GAS f32x2v*)P.ROPE + (size_t)(pos0 + qoff + r32) * 64 + hi * 8;
#pragma unroll
        for (int d0 = 0; d0 < 4; ++d0) { const v4u lo = *(const GAS v4u*)(qp + d0 * 16), hh = *(const GAS v4u*)(qp + 64 + d0 * 16);
            const unsigned lw[4] = {lo.x, lo.y, lo.z, lo.w}, hw[4] = {hh.x, hh.y, hh.z, hh.w}; unsigned o1[4], o2[4];
#pragma unroll
            for (int j = 0; j < 4; ++j) { const f32x2v c0 = cs[d0 * 16 + 2 * j], c1 = cs[d0 * 16 + 2 * j + 1];
                const float a0 = bf2f(lw[j] & 0xffffu), a1 = bf2f(lw[j] >> 16), b0 = bf2f(hw[j] & 0xffffu), b1 = bf2f(hw[j] >> 16);
                o1[j] = cvtpk(a0 * c0.x - b0 * c0.y, a1 * c1.x - b1 * c1.y); o2[j] = cvtpk(b0 * c0.x + a0 * c0.y, b1 * c1.x + a1 * c1.y); }
            const v4u w1 = {o1[0], o1[1], o1[2], o1[3]}, w2 = {o2[0], o2[1], o2[2], o2[3]};
            qr[d0] = __builtin_bit_cast(bf16x8, w1); qr[d0 + 4] = __builtin_bit_cast(bf16x8, w2); } }
    float m_reg = -1e30f, l_reg = 0.f; f32x16 o[4] = {};
    const int sr = tid >> 4, sc = (tid & 15) * 8, vst0 = v_st(sr, sc), vst1 = v_st(32 + sr, sc);
    const int vb0 = (int)(size_t)V_lds + v_rd_base(lane);
    const int tmin = isp ? (ac >= 2 ? 1 : 3 - ac) : 1;
#define ATT_KROW(t) ((t) == 0 ? (isp ? ROW_M : KVR_SMETA + ab * NMETA) : (isp ? ab * SEQ_P + 64 * (ac - 3 + (t)) : ((t) == 3 ? ROW_S + ab * SEQ_S : KVR_SWIN + ab * WIN + 64 * ((t) - 1))))
#define ATT_LOAD(t) do { const int ra_ = ((t) == 0) ? (sr & 15) : sr, rb_ = ((t) == 0) ? (sr & 15) : 32 + sr;     \
        const bf16* kp_ = P.KB + (size_t)ATT_KROW(t) * KVW + kvh * HD + sc; const bf16* vp_ = P.VB + (size_t)ATT_KROW(t) * KVW + kvh * HD + sc; \
        nk0 = *(const GAS v4u*)(kp_ + (size_t)ra_ * KVW); nk1 = *(const GAS v4u*)(kp_ + (size_t)rb_ * KVW); nv0 = *(const GAS v4u*)(vp_ + (size_t)ra_ * KVW); nv1 = *(const GAS v4u*)(vp_ + (size_t)rb_ * KVW); } while (0)
    v4u nk0, nk1, nv0, nv1; ATT_LOAD(0);
#pragma unroll
    for (int t = 0; t < 4; ++t) {
        const bool kval_t = (t == 0) || (t >= tmin);
        if (kval_t) {
        const v4u k0 = nk0, k1 = nk1, v0 = nv0, v1 = nv1;
        __syncthreads();
        *(LAS v4u*)(V_lds + vst0) = v0; *(LAS v4u*)(V_lds + vst1) = v1; *(LAS v4u*)(K_lds + KSWZ(sr, sc * 2)) = k0; *(LAS v4u*)(K_lds + KSWZ(32 + sr, sc * 2)) = k1;
        __syncthreads();
        { const int nt_ = (t == 0) ? tmin : t + 1; if (nt_ <= 3) { if (nt_ == 1) ATT_LOAD(1); else if (nt_ == 2) ATT_LOAD(2); else ATT_LOAD(3); } }
        f32x16 p0, p1; qkt(p0, p1, K_lds, qr, r32, hi);
        if (t == 0) {
#pragma unroll
            for (int r = 8; r < 16; ++r) p0[r] = -INFINITY;
#pragma unroll
            for (int r = 0; r < 16; ++r) p1[r] = -INFINITY; }
        float pmax = p0[0];
#pragma unroll
        for (int r = 1; r < 16; ++r) pmax = fmaxf(pmax, p0[r]);
#pragma unroll
        for (int r = 0; r < 16; ++r) pmax = fmaxf(pmax, p1[r]);
        { auto rr = __builtin_amdgcn_permlane32_swap(__float_as_uint(pmax), __float_as_uint(pmax), false, false); pmax = fmaxf(__uint_as_float(rr[0]), __uint_as_float(rr[1])); }
        const float mn = fmaxf(m_reg, pmax), alpha = __builtin_amdgcn_exp2f((m_reg - mn) * C), mnC = -mn * C; m_reg = mn;
        float ps = 0.f;
#pragma unroll
        for (int r = 0; r < 16; ++r) { p0[r] = __builtin_amdgcn_exp2f(fmaf(p0[r], C, mnC)); p1[r] = __builtin_amdgcn_exp2f(fmaf(p1[r], C, mnC)); ps += p0[r] + p1[r]; }
        { auto rr = __builtin_amdgcn_permlane32_swap(__float_as_uint(ps), __float_as_uint(ps), false, false); ps = __uint_as_float(rr[0]) + __uint_as_float(rr[1]); }
        l_reg = l_reg * alpha + ps;
        if (hi == 0) al_l[r32] = alpha;
        asm volatile("s_waitcnt lgkmcnt(0)" ::: "memory");
#pragma unroll
        for (int d = 0; d < 4; ++d)
#pragma unroll
            for (int r = 0; r < 16; ++r) o[d][r] *= al_l[crow(r, hi)];
        bf16x8 pa0, pa1, pa2, pa3;
#define PK4(Pv, BASE, OUT) do { unsigned a0 = cvtpk(Pv[BASE + 0], Pv[BASE + 1]), a1 = cvtpk(Pv[BASE + 2], Pv[BASE + 3]);   \
    unsigned b0 = cvtpk(Pv[BASE + 4], Pv[BASE + 5]), b1 = cvtpk(Pv[BASE + 6], Pv[BASE + 7]);                              \
    auto r0 = __builtin_amdgcn_permlane32_swap(a0, b0, false, false); auto r1 = __builtin_amdgcn_permlane32_swap(a1, b1, false, false); \
    v4u w = {r0[0], r1[0], r0[1], r1[1]}; OUT = __builtin_bit_cast(bf16x8, w); } while (0)
        PK4(p0, 0, pa0); PK4(p0, 8, pa1); PK4(p1, 0, pa2); PK4(p1, 8, pa3);
#undef PK4
        SBAR();
        pv_one<0>(o[0], vb0, pa0, pa1, pa2, pa3); pv_one<1>(o[1], vb0, pa0, pa1, pa2, pa3); pv_one<2>(o[2], vb0, pa0, pa1, pa2, pa3); pv_one<3>(o[3], vb0, pa0, pa1, pa2, pa3);
        }
    }
#undef ATT_KROW
#undef ATT_LOAD
    l_reg += __builtin_amdgcn_exp2f(P.in[I_SINK][hq] * 1.4426950408889634f - m_reg * C);
    if (hi == 0) li_l[r32] = l_reg;
    asm volatile("s_waitcnt lgkmcnt(0)" ::: "memory");
    bf16* Ow = P.MIX + (size_t)(qrow0 + qoff) * D + hq * HD;
#pragma unroll
    for (int r = 0; r < 16; ++r) { const int orow = crow(r, hi); const float rl = __builtin_amdgcn_rcpf(li_l[orow]);
#pragma unroll
        for (int d0 = 0; d0 < 4; ++d0) Ow[(size_t)orow * D + d0 * 32 + r32] = (bf16)f2bf(o[d0][r] * rl); }
    __syncthreads();
}

typedef const GAS unsigned char* gcp;
template <class T> __device__ __forceinline__ T ldg_u(gcp ubase, unsigned voff) { return *(const GAS T*)(ubase + voff); }
constexpr int SC_ABUF = 57344, SC_SSQ_OFF = 2 * SC_ABUF;
template <int MODE  > __device__ __forceinline__ void gdn_scan_seq(Frame& F, const Ptrs& P, int kind  , int b, int h) {
    int lane_ = F.lane; asm volatile("" : "+v"(lane_));
    const int w = F.wave, lane = lane_, c16 = lane & 15, q4 = lane >> 4;
    LAS float* SSQ = (LAS float*)(F.lds + SC_SSQ_OFF);
    const unsigned ecol = (unsigned)(16 * w + c16);
    const unsigned voU = (unsigned)(q4 * 2048) + ecol * 4u;
    const unsigned voZ = (unsigned)(q4 * 4 * DINP * 2) + ecol * 2u;
    const unsigned voM = (unsigned)(q4 * 4 * D * 2) + ecol * 2u;
    unsigned fo256[4], fo128[2];
#pragma unroll
    for (int s = 0; s < 4; ++s) fo256[s] = (unsigned)(c16 * 256 + (((4 * s + q4) ^ c16) * 16));
#pragma unroll
    for (int s = 0; s < 2; ++s) fo128[s] = (unsigned)(c16 * 128 + (((4 * s + q4) ^ ((c16 >> 1) & 7)) * 16));
    const unsigned dma_lane = (unsigned)(w * 7168 + lane * 16);
    f32x4 S[8];
    if (kind == 2) { gcp s0 = (gcp)(P.in[I_SGDN] + (size_t)(b * NHG + h) * 128 * 128);
#pragma unroll
        for (int db = 0; db < 8; ++db)
#pragma unroll
            for (int r = 0; r < 4; ++r) S[db][r] = ldg_u<float>(s0 + db * 8192, voU + r * 512); }
    else {
#pragma unroll
        for (int db = 0; db < 8; ++db) S[db] = (f32x4){0.f, 0.f, 0.f, 0.f}; }
    const int nsteps = kind == 0 ? 33 : 1;
    const float nw = P.in[I_NORMW][ecol];
    const int seq = b * NHG + h;
#define SC_UD(t) ((gcp)(P.GDN + (size_t)(kind == 2 ? 2064 + seq : ((t) == 0 ? 2048 + h : seq * 32 + (t) - 1)) * GU_BYTES))
#define SC_ROW0(t) (kind == 0 ? b * SEQ_P + 64 * ((t) - 1) : ROW_S + b * SEQ_S)
#define SC_DMA(ud, buf) do { _Pragma("unroll") for (int _i = 0; _i < 7; ++_i) \
        __builtin_amdgcn_global_load_lds((const GAS unsigned*)((ud) + GU_W + dma_lane + _i * 1024), (LAS unsigned*)(F.lds + (buf) * SC_ABUF + w * 7168 + _i * 1024), 16, 0, 0); } while (0)
    float un[4][4], gln; unsigned zn[4][4];
#define SC_PREFETCH(udp) do { gln = *(const GAS float*)((udp) + GU_GL); \
        _Pragma("unroll") for (int m = 0; m < 4; ++m) _Pragma("unroll") for (int r = 0; r < 4; ++r) un[m][r] = ldg_u<float>((udp) + GU_U + m * 8192, voU + r * 512); } while (0)
#define SC_LD256(dst, off, m0) do { _Pragma("unroll") for (int mm = 0; mm < 2; ++mm) _Pragma("unroll") for (int s = 0; s < 4; ++s) dst[mm * 4 + s] = *(const LAS bf16x8*)(img + (off) + ((m0) + mm) * 4096 + fo256[s]); } while (0)
#define SC_LD128(dst, off, r0) do { _Pragma("unroll") for (int rr = 0; rr < 4; ++rr) _Pragma("unroll") for (int s = 0; s < 2; ++s) dst[rr * 2 + s] = *(const LAS bf16x8*)(img + (off) + ((r0) + rr) * 2048 + fo128[s]); } while (0)
#define SC_SCHED __builtin_amdgcn_sched_barrier(0)
#define SC_EPI(t, ov, zv) do { const LAS float* sq_ = SSQ + ((t) & 1) * 512; GAS unsigned char* mb_ = (GAS unsigned char*)((MODE == 0 ? P.MIX : P.XN) + (size_t)SC_ROW0(t) * D + 2048 + h * 128); \
        _Pragma("unroll") for (int m = 0; m < 4; ++m) _Pragma("unroll") for (int r = 0; r < 4; ++r) { const int i_ = 16 * m + 4 * q4 + r; \
            const f32x4 t0_ = *(const LAS f32x4*)(sq_ + i_ * 8), t1_ = *(const LAS f32x4*)(sq_ + i_ * 8 + 4); const float tot_ = ((t0_.x + t0_.y) + (t0_.z + t0_.w)) + ((t1_.x + t1_.y) + (t1_.z + t1_.w)); \
            const float rstd_ = rsqrtf(tot_ * (1.f / 128.f) + RMS_EPS); \
            *(GAS unsigned short*)(mb_ + (16 * m + r) * (D * 2) + voM) = (unsigned short)f2bf(ov[m][r] * rstd_ * nw * silu1(bf2f(zv[m][r]))); } } while (0)
    { gcp ud0 = SC_UD(0); if (MODE != 1) { SC_DMA(ud0, 0); } SC_PREFETCH(ud0); }
#pragma unroll
    for (int m = 0; m < 4; ++m)
#pragma unroll
        for (int r = 0; r < 4; ++r) zn[m][r] = 0u;
    f32x4 op[4]; unsigned zp[4][4];
#pragma unroll
    for (int m = 0; m < 4; ++m) { op[m] = (f32x4){0.f, 0.f, 0.f, 0.f};
#pragma unroll
        for (int r = 0; r < 4; ++r) zp[m][r] = 0u; }
    for (int step = 0; step < nsteps; ++step) {
        const bool has_out = !(kind == 0 && step == 0), prev_out = step > 0 && !(kind == 0 && step == 1);
        asm volatile("s_waitcnt vmcnt(0) lgkmcnt(0)" ::: "memory"); __builtin_amdgcn_s_barrier(); asm volatile("" ::: "memory");
        float uc[4][4], gl = gln;
#pragma unroll
        for (int m = 0; m < 4; ++m) {
#pragma unroll
            for (int r = 0; r < 4; ++r) { uc[m][r] = un[m][r]; zp[m][r] = zn[m][r]; }
            asm volatile("" : "+v"(uc[m][0]), "+v"(uc[m][1]), "+v"(uc[m][2]), "+v"(uc[m][3]), "+v"(zp[m][0]), "+v"(zp[m][1]), "+v"(zp[m][2]), "+v"(zp[m][3])); }
        asm volatile("" : "+v"(gl));
        SC_SCHED;
        if (has_out && MODE != 1) { gcp zb_ = (gcp)(P.H + (size_t)SC_ROW0(step) * DINP + C_Z + h * 128);
#pragma unroll
            for (int m = 0; m < 4; ++m)
#pragma unroll
                for (int r = 0; r < 4; ++r) zn[m][r] = ldg_u<unsigned short>(zb_ + (16 * m + r) * (DINP * 2), voZ); }
        if (step + 1 < nsteps && MODE != 1) { gcp udn = SC_UD(step + 1); SC_DMA(udn, (step + 1) & 1); SC_PREFETCH(udn); }
        SC_SCHED;
        if (prev_out) SC_EPI(step - 1, op, zp);
        SC_SCHED;
        if (MODE != 2) {
        const LAS unsigned char* img = F.lds + (step & 1) * SC_ABUF;
        bf16x8 X[8], Y[8];
        SC_LD256(X, GU_W - GU_W, 0); SC_LD256(Y, GU_W - GU_W, 2); SC_SCHED;
        bf16x8 Bs[4];
#pragma unroll
        for (int s = 0; s < 4; ++s) { const v4u t = {pkbf(S[2 * s][0], S[2 * s][1]), pkbf(S[2 * s][2], S[2 * s][3]), pkbf(S[2 * s + 1][0], S[2 * s + 1][1]), pkbf(S[2 * s + 1][2], S[2 * s + 1][3])}; Bs[s] = __builtin_bit_cast(bf16x8, t); }
        f32x4 vn[4], o[4];
#pragma unroll
        for (int mm = 0; mm < 2; ++mm) { f32x4 acc = {0.f, 0.f, 0.f, 0.f};
#pragma unroll
            for (int s = 0; s < 4; ++s) acc = __builtin_amdgcn_mfma_f32_16x16x32_bf16(X[mm * 4 + s], Bs[s], acc, 0, 0, 0);
#pragma unroll
            for (int r = 0; r < 4; ++r) vn[mm][r] = uc[mm][r] - acc[r]; }
        SC_SCHED; SC_LD256(X, GU_QD - GU_W, 0); SC_SCHED;
#pragma unroll
        for (int mm = 0; mm < 2; ++mm) { f32x4 acc = {0.f, 0.f, 0.f, 0.f};
#pragma unroll
            for (int s = 0; s < 4; ++s) acc = __builtin_amdgcn_mfma_f32_16x16x32_bf16(Y[mm * 4 + s], Bs[s], acc, 0, 0, 0);
#pragma unroll
            for (int r = 0; r < 4; ++r) vn[2 + mm][r] = uc[2 + mm][r] - acc[r]; }
        SC_SCHED; SC_LD256(Y, GU_QD - GU_W, 2); SC_SCHED;
        bf16x8 Bv[2];
#pragma unroll
        for (int s = 0; s < 2; ++s) { const v4u t = {pkbf(vn[2 * s][0], vn[2 * s][1]), pkbf(vn[2 * s][2], vn[2 * s][3]), pkbf(vn[2 * s + 1][0], vn[2 * s + 1][1]), pkbf(vn[2 * s + 1][2], vn[2 * s + 1][3])}; Bv[s] = __builtin_bit_cast(bf16x8, t); }
#pragma unroll
        for (int mm = 0; mm < 2; ++mm) { f32x4 acc = {0.f, 0.f, 0.f, 0.f};
#pragma unroll
            for (int s = 0; s < 4; ++s) acc = __builtin_amdgcn_mfma_f32_16x16x32_bf16(X[mm * 4 + s], Bs[s], acc, 0, 0, 0);
            o[mm] = acc; }
        SC_SCHED; SC_LD128(X, GU_KDT - GU_W, 0); SC_SCHED;
#pragma unroll
        for (int mm = 0; mm < 2; ++mm) { f32x4 acc = {0.f, 0.f, 0.f, 0.f};
#pragma unroll
            for (int s = 0; s < 4; ++s) acc = __builtin_amdgcn_mfma_f32_16x16x32_bf16(Y[mm * 4 + s], Bs[s], acc, 0, 0, 0);
            o[2 + mm] = acc; }
        SC_SCHED; SC_LD128(Y, GU_KDT - GU_W, 4); SC_SCHED;
#pragma unroll
        for (int rr = 0; rr < 4; ++rr) { f32x4 acc = S[rr] * gl;
#pragma unroll
            for (int s = 0; s < 2; ++s) acc = __builtin_amdgcn_mfma_f32_16x16x32_bf16(X[rr * 2 + s], Bv[s], acc, 0, 0, 0);
            S[rr] = acc; }
        SC_SCHED; SC_LD128(X, GU_QK - GU_W, 0); SC_SCHED;
#pragma unroll
        for (int rr = 0; rr < 4; ++rr) { f32x4 acc = S[4 + rr] * gl;
#pragma unroll
            for (int s = 0; s < 2; ++s) acc = __builtin_amdgcn_mfma_f32_16x16x32_bf16(Y[rr * 2 + s], Bv[s], acc, 0, 0, 0);
            S[4 + rr] = acc; }
        SC_SCHED;
#pragma unroll
        for (int m = 0; m < 4; ++m)
#pragma unroll
            for (int s = 0; s < 2; ++s) o[m] = __builtin_amdgcn_mfma_f32_16x16x32_bf16(X[m * 2 + s], Bv[s], o[m], 0, 0, 0);
        if (has_out) { LAS float* sq = SSQ + (step & 1) * 512;
#pragma unroll
            for (int m = 0; m < 4; ++m)
#pragma unroll
                for (int r = 0; r < 4; ++r) { float p = o[m][r] * o[m][r];
                    p += __builtin_bit_cast(float, __builtin_amdgcn_update_dpp(0, __builtin_bit_cast(int, p), 0xB1, 0xF, 0xF, true));
                    p += __builtin_bit_cast(float, __builtin_amdgcn_update_dpp(0, __builtin_bit_cast(int, p), 0x4E, 0xF, 0xF, true));
                    p += __builtin_bit_cast(float, __builtin_amdgcn_update_dpp(0, __builtin_bit_cast(int, p), 0x141, 0xF, 0xF, true));
                    p += __builtin_bit_cast(float, __builtin_amdgcn_update_dpp(0, __builtin_bit_cast(int, p), 0x140, 0xF, 0xF, true));
                    if (c16 == 0) sq[(16 * m + 4 * q4 + r) * 8 + w] = p; op[m][r] = o[m][r]; } }
            }
    }
    asm volatile("s_waitcnt vmcnt(0) lgkmcnt(0)" ::: "memory"); __builtin_amdgcn_s_barrier(); asm volatile("" ::: "memory");
    { const int t = nsteps - 1;
#pragma unroll
      for (int m = 0; m < 4; ++m) {
#pragma unroll
        for (int r = 0; r < 4; ++r) zp[m][r] = zn[m][r]; }
      if (!(kind == 0 && t == 0)) SC_EPI(t, op, zp); }
#undef SC_PREFETCH
#undef SC_LD256
#undef SC_LD128
#undef SC_SCHED
#undef SC_EPI
#undef SC_UD
#undef SC_ROW0
#undef SC_DMA
    GAS unsigned char* dst = (GAS unsigned char*)((MODE != 0 ? (float*)(P.GDN + (size_t)N_GUNITS * GU_BYTES) : (kind == 0 ? P.out + O_PGDN : P.out + O_SGDN)) + (size_t)(b * NHG + h) * 128 * 128);
#pragma unroll
    for (int db = 0; db < 8; ++db)
#pragma unroll
        for (int r = 0; r < 4; ++r) *(GAS float*)(dst + db * 8192 + (voU + r * 512)) = S[db][r];
    asm volatile("s_waitcnt vmcnt(0) lgkmcnt(0)" ::: "memory"); __syncthreads();
}

#ifndef SPLIT_P1
#define SPLIT_P1 2
#endif
#ifndef SPLIT_P9
#define SPLIT_P9 8
#endif
#ifndef SPLIT_P2
#define SPLIT_P2 3
#endif
#ifndef SPLIT_P7
#define SPLIT_P7 4
#endif
#ifndef SPLIT_P10
#define SPLIT_P10 4
#endif
struct Args { const float* in[N_IN]; float* out; unsigned char* ws; int ph_lo, ph_hi, li, pad; };
static_assert(sizeof(Args) == (N_IN + 2) * 8 + 16, "Args has no padding");
__global__ void __launch_bounds__(NWAVES * 64, 2) fwd_kernel(Args args) {
    extern __shared__ __attribute__((aligned(16))) unsigned char lds[];
    Frame F;
    F.lds = (LAS unsigned char*)lds;
    F.MISC = (volatile LAS unsigned*)(F.lds + MISC_OFF);
    F.tid = threadIdx.x; F.lane = F.tid & 63; F.wave = __builtin_amdgcn_readfirstlane(F.tid >> 6);
    F.G = gridDim.x; { const int bx = blockIdx.x; F.vcu = (F.G % 8 == 0) ? (bx % 8) * (F.G / 8) + bx / 8 : bx; }
    unsigned char* ws = args.ws;
    F.ctl = (gu32*)(ws + WS_CTL);
    Ptrs P;
#pragma unroll
    for (int i = 0; i < N_IN; ++i) P.in[i] = args.in[i];
    P.out = args.out;
    P.Wgu1 = (bf16*)(ws + WS_WGU1); P.Wd1 = (bf16*)(ws + WS_WD1); P.Wgu2 = (bf16*)(ws + WS_WGU2); P.Wd2 = (bf16*)(ws + WS_WD2); P.Win = (bf16*)(ws + WS_WIN); P.Wout = (bf16*)(ws + WS_WOUT);
    P.XN = (bf16*)(ws + WS_XN); P.MIX = (bf16*)(ws + WS_MIX); P.H = (bf16*)(ws + WS_H); P.KB = (bf16*)(ws + WS_KB); P.VB = (bf16*)(ws + WS_VB);
    P.Y = (float*)(ws + WS_Y); P.ROPE = (float*)(ws + WS_ROPE); P.GDN = ws + WS_GDN; P.SLAB = (float*)(ws + WS_SLAB); P.XQ = (signed char*)(ws + WS_XQ); P.SA = (float*)(ws + WS_SA); P.SB1 = (float*)(ws + WS_SB); P.SB2 = (float*)(ws + WS_SB + AL((size_t)NGU * 4)); P.CMAX = (unsigned*)(ws + WS_CTL) + CW_CMAX; P.HQ = (signed char*)(ws + WS_HQ); P.SH = (float*)(ws + WS_SH); P.SBD1 = (float*)(ws + WS_SBD); P.SBD2 = (float*)(ws + WS_SBD + AL((size_t)D * 4)); P.CMAXD = (unsigned*)(ws + WS_CTL) + CW_CMAXD; P.RMAX = (unsigned*)(ws + WS_CTL) + CW_RMAX;
    for (int u = F.tid; u < (LDS_BYTES - LDSCTL_OFF) / 4; u += NWAVES * 64) ((LAS unsigned*)(F.lds + LDSCTL_OFF))[u] = 0u;
    __syncthreads();
    XcdBarrier bar; bar.bar = (unsigned*)(F.ctl + CW_BAR) + args.li * XCD_BAR_WORDS; bar.x = 0; bar.st = nullptr;
    if (N_LAUNCHES == 1) bar = xcd_barrier_post((unsigned*)(F.ctl + CW_BAR) + args.li * XCD_BAR_WORDS, F.MISC + 8);
#define GRID_BAR() do { if (N_LAUNCHES == 1) xcd_barrier(bar); } while (0)
    const int lo = args.ph_lo, hi = args.ph_hi;
#define IN(k) (lo <= (k) && (k) < hi)
#define BOTH(k) (IN(k) && IN((k) + 1))

#ifndef PROBE_REPEAT
#define PROBE_REPEAT 0
#endif
#define REP(k) (((PROBE_REPEAT >> (k)) & 1) ? 2 : 1)
    if (IN(0)) { p0_prologue(F, P); GRID_BAR(); p0_quant_wgu1(F, P); if (BOTH(0)) GRID_BAR(); }
    if (IN(1)) { pg8::Gemm g{(const pg8::bf16_t*)P.XQ, (const pg8::bf16_t*)P.Wgu1, M1, NGU, D / 2}; pg8::StaticOrder S; S.init(M1, NGU, D / 2, F.G, (int)blockIdx.x);
        pg8::EpiSwiGLU<true> E{P.H, FF, P.SLAB, 1, P.SA, P.SB1, nullptr};
        pg8::gemm_phase<pg8::EpiSwiGLU<true>, pg8::StaticOrder, true, true, true>(F.lds + RING_OFF, g, S, E);
        PHASE_DONE(1); q_fill(F, P, 1); q_catch_up(F, P, Q_E1);
        GRID_BAR(); quant_h(F, P.H, P.HQ, P.RMAX, P.SH, M1V);
        if (BOTH(1)) GRID_BAR(); }
    if (IN(2)) { pg8::Gemm g{(const pg8::bf16_t*)P.HQ, (const pg8::bf16_t*)P.Wd1, M1, D, FF / 2}; pg8::SplitOrder S; S.init(M1, D, FF / 2, F.G, (int)blockIdx.x, SPLIT_P2);
        typedef pg8::EpiResF32<0, true, false, true, true> Epi; Epi E{P.Y, D, pg8::RowSrc<0>{P.in[I_XP], P.in[I_XS], P.in[I_META], ROW_S, ROW_M, M1V, D}, P.SLAB, SPLIT_P2, P.SH, P.SBD1};
        pg8::gemm_phase<Epi, pg8::SplitOrder, true, true, true>(F.lds + RING_OFF, g, S, E);
        PHASE_DONE(2); q_fill(F, P, 2); q_catch_up(F, P, Q_E2);
        if (BOTH(2)) GRID_BAR(); }
    if (IN(3)) { pg8::SplitOrder SO; SO.init(M1, D, FF / 2, F.G, 0, SPLIT_P2); ln_phase(F, (const bf16*)P.Y, nullptr, P.XN, P.in[I_LNG], P.in[I_LNB], M1V, SO, P.SLAB, 0.5f, nullptr, nullptr); q_catch_up(F, P, Q_E2); if (BOTH(3)) GRID_BAR(); }
    if (IN(4)) { pg8::Gemm g{P.XN, P.Win, M1, DINP, D}; pg8::StaticOrder S; S.init(M1, DINP, D, F.G, (int)blockIdx.x);
        pg8::EpiStoreBf16 E{P.H, DINP};
        pg8::gemm_phase<pg8::EpiStoreBf16, pg8::StaticOrder, true, true>(F.lds + RING_OFF, g, S, E);
        PHASE_DONE(4); q_fill(F, P, 4);
        if (BOTH(4)) GRID_BAR(); }
#ifndef PROBE_ABL5
#define PROBE_ABL5 0
#endif
    if (IN(5)) { for (int rep = 0; rep < REP(5); ++rep) { const int abl = (args.li == 1) ? PROBE_ABL5 : 0;
        if (!(abl & 8)) kv_prep(F, P);
        gdn_prep_all(F, P, abl);
        q_catch_up(F, P, Q_E3);
        if (BOTH(5)) GRID_BAR(); } }
    if (IN(6)) {
        int it = blockIdx.x, st = (it < 64) ? (1 << 20) : F.G - 64;
        for (; it < 896; it += st) {
            if (it < 320) { const int s = it < 64 ? it : it - 64; gdn_scan_seq<0>(F, P, it < 64 ? 0 : 2, s >> 4, s & 15); }
            else attn_unit(F, P, it - 320);
        }
        if ((int)blockIdx.x >= 64) {
            sub_barrier(F, F.ctl + CW_SUB, (unsigned)(F.G - 64));
            pg8::Gemm g{P.MIX, P.Wout, M2, D, D}; pg8::StaticOrder S; S.init(M2, D, D, F.G - 64, (int)blockIdx.x - 64); S.set_k(0, 32);
            typedef pg8::EpiResF32<1, false, false, false, true> Epi; Epi E{P.Y, D, pg8::RowSrc<1>{(const float*)P.XN, (const float*)P.XN, (const float*)P.XN, M2, M2, M2, D}, P.SLAB, 1, nullptr, nullptr};
            pg8::gemm_phase<Epi, pg8::StaticOrder, true, true>(F.lds + RING_OFF, g, S, E);
        }
        PHASE_DONE(6); q_fill(F, P, 6);
        if (BOTH(6)) GRID_BAR(); }
    if (IN(7)) {
        pg8::Gemm g{P.MIX, P.Wout, M2, D, D}; pg8::SplitOrder S; S.init(M2, D, D, F.G, (int)blockIdx.x, SPLIT_P7); S.set_k(32, 32);
        typedef pg8::EpiResF32<1, false, true, false, true> Epi; Epi E{P.Y, D, pg8::RowSrc<1>{P.Y, P.Y, P.Y, M2, M2, M2, D}, P.SLAB, SPLIT_P7, nullptr, nullptr};
        pg8::gemm_phase<Epi, pg8::SplitOrder, true, true>(F.lds + RING_OFF, g, S, E);
        PHASE_DONE(7); q_fill(F, P, 7);
        if (BOTH(7)) GRID_BAR(); }
    if (IN(8)) { pg8::SplitOrder SO; SO.init(M2, D, D, F.G, 0, SPLIT_P7); ln_phase(F, (const bf16*)P.Y, nullptr, P.XN, P.in[I_LNG] + D, P.in[I_LNB] + D, M2, SO, P.SLAB, 1.0f, P.XQ, P.SA); q_catch_up(F, P, Q_E4); if (BOTH(8)) GRID_BAR(); }
    if (IN(9)) { pg8::Gemm g{(const pg8::bf16_t*)P.XQ, (const pg8::bf16_t*)P.Wgu2, M2, NGU, D / 2}; pg8::StaticOrder S; S.init(M2, NGU, D / 2, F.G, (int)blockIdx.x);
        pg8::EpiSwiGLU<true> E{P.H, FF, P.SLAB, 1, P.SA, P.SB2, nullptr};
        pg8::gemm_phase<pg8::EpiSwiGLU<true>, pg8::StaticOrder, true, true, true>(F.lds + RING_OFF, g, S, E);
        PHASE_DONE(9); q_fill(F, P, 9); q_catch_up(F, P, Q_E5);
        GRID_BAR(); quant_h(F, P.H, P.HQ, P.RMAX + M1, P.SH, M2);
        if (BOTH(9)) GRID_BAR(); }
    if (IN(10)) { pg8::Gemm g{(const pg8::bf16_t*)P.HQ, (const pg8::bf16_t*)P.Wd2, M2, D, FF / 2}; pg8::SplitOrder S; S.init(M2, D, FF / 2, F.G, (int)blockIdx.x, SPLIT_P10);
        typedef pg8::EpiResF32<1, true, false, true, true> Epi; Epi E{P.Y, D, pg8::RowSrc<1>{(const float*)P.XN, (const float*)P.XN, (const float*)P.XN, M2, M2, M2, D}, P.SLAB, SPLIT_P10, P.SH, P.SBD2};
        pg8::gemm_phase<Epi, pg8::SplitOrder, true, true, true>(F.lds + RING_OFF, g, S, E);
        if (BOTH(10)) GRID_BAR(); }
    if (IN(11)) { for (int rep = 0; rep < REP(11); ++rep) { pg8::SplitOrder SO; SO.init(M2, D, FF / 2, F.G, 0, SPLIT_P10); ln_phase(F, (const bf16*)P.Y, P.out + O_YP, nullptr, P.in[I_LNG] + 2 * D, P.in[I_LNB] + 2 * D, M2, SO, P.SLAB, 0.5f, nullptr, nullptr); if (rep + 1 < REP(11)) GRID_BAR(); } }
#undef IN
#undef BOTH
#undef GRID_BAR
}

extern "C" void kernel_launch(void* const* d_in, const int* in_sizes, int n_in, void* d_out, int out_size, void* d_ws, size_t ws_size, hipStream_t stream) {
    static int grid = 0;
    if (grid == 0) {
        if (n_in != N_IN || in_sizes[I_XP] != ROW_S * D || in_sizes[I_WIN] != D * DIN || (size_t)out_size != O_END || ws_size < WS_END) {
            fprintf(stderr, "kernel_launch: shape mismatch: n_in %d in0 %d out %d ws %zu (need %zu); nothing launched\n", n_in, n_in > 0 ? in_sizes[0] : -1, out_size, ws_size, (size_t)WS_END); grid = -1; return; }
        int dev = 0, cus = 0, per_cu = 0;
        if (hipGetDevice(&dev) != hipSuccess || hipDeviceGetAttribute(&cus, hipDeviceAttributeMultiprocessorCount, dev) != hipSuccess) { fprintf(stderr, "kernel_launch: device query failed\n"); grid = -1; return; }
        if (hipFuncSetAttribute((const void*)fwd_kernel, hipFuncAttributeMaxDynamicSharedMemorySize, LDS_BYTES) != hipSuccess) { fprintf(stderr, "kernel_launch: hipFuncSetAttribute failed\n"); grid = -1; return; }
        if (hipOccupancyMaxActiveBlocksPerMultiprocessor(&per_cu, (const void*)fwd_kernel, NWAVES * 64, LDS_BYTES) != hipSuccess || per_cu < 1)
            fprintf(stderr, "kernel_launch: note: occupancy query reports %d workgroups per CU\n", per_cu);
        (void)hipGetLastError();
        if (cus <= 64) { fprintf(stderr, "kernel_launch: %d CUs: this program needs more than 64 workgroups (64 of them run the GDN scans while the others start w_out); nothing launched\n", cus); grid = -1; return; }
        grid = cus;
    }
    if (grid < 0) return;
    if (hipMemsetAsync((char*)d_ws + WS_CTL, 0, CTL_ZERO_BYTES, stream) != hipSuccess) { fprintf(stderr, "kernel_launch: hipMemsetAsync failed\n"); return; }
    Args a{};
    for (int i = 0; i < N_IN; ++i) a.in[i] = (const float*)d_in[i];
    a.out = (float*)d_out; a.ws = (unsigned char*)d_ws;
#ifndef PROBE_PLAN
#define PROBE_PLAN {0, N_PHASES}
#endif
    const int plan[][2] = { PROBE_PLAN }; const int n_plan = (N_LAUNCHES == 1) ? (int)(sizeof(plan) / sizeof(plan[0])) : N_LAUNCHES;
    for (int li = 0; li < n_plan; ++li) {
        a.ph_lo = (N_LAUNCHES == 1) ? plan[li][0] : li; a.ph_hi = (N_LAUNCHES == 1) ? plan[li][1] : li + 1; a.li = (N_LAUNCHES == 1) ? li : 0;
        hipLaunchKernelGGL(fwd_kernel, dim3(grid), dim3(NWAVES * 64), LDS_BYTES, stream, a);
        const hipError_t le = hipPeekAtLastError();
        if (le != hipSuccess) { fprintf(stderr, "kernel_launch: launch %d failed: %s\n", li, hipGetErrorName(le)); break; }
    }
}
```
